# Optimizing an MI355X kernel written in HIP

```python
import math
import jax
import jax.numpy as jnp
from jax import lax
import numpy as np

D_MODEL = 2048
BATCH = 8
SEQ = 2048
DEPTH = 2

MEM_LEN = 256
RMS_EPS = 1e-6
ML_HEADS = 4
ML_DQK = 128
ML_DV = 256
ML_CHUNK = 64
SSM_HEADS = 16
SSM_HEADDIM = 64
SSM_DINNER = SSM_HEADS * SSM_HEADDIM
SSM_GROUPS = 2
SSM_STATE = 128
SSM_CONV = 4
SSM_CHUNK = 128
SSM_CONV_CH = SSM_DINNER + 2 * SSM_GROUPS * SSM_STATE
MLA_HEADS = 8
MLA_Q_LORA = 512
MLA_KV_LORA = 256
MLA_NOPE = 128
MLA_ROPE = 64
MLA_V = 128
ROPE_THETA = 10000.0
ATTN_BLOCK = 128
SWA_HEADS = 16
SWA_KV_HEADS = 4
SWA_HEAD_DIM = 64
SWA_WINDOW = 128
N_BRANCH = 4
BRANCH_W = 1024
XA_HEADS = 4
XA_HEAD_DIM = 128
FFN_DIM = 7168
N_EXPERTS = 8
TOP_K = 2
MOE_BLOCK = 512
N_DENSE = (DEPTH + 1) // 2
N_MOE = DEPTH // 2

IN_SPLITS = (
    ML_HEADS * ML_DQK,
    ML_HEADS * ML_DQK,
    ML_HEADS * ML_DV,
    ML_HEADS * ML_DV,
    ML_HEADS,
    ML_HEADS,
    SSM_DINNER,
    SSM_CONV_CH,
    SSM_HEADS,
    MLA_Q_LORA,
    MLA_KV_LORA,
    MLA_ROPE,
    SWA_HEADS * SWA_HEAD_DIM,
    SWA_KV_HEADS * SWA_HEAD_DIM,
    SWA_KV_HEADS * SWA_HEAD_DIM,
    N_BRANCH * D_MODEL,
)
IN_TOTAL = sum(IN_SPLITS)
IN_OFFSETS = tuple(int(v) for v in np.cumsum(IN_SPLITS)[:-1])

kernel_name = 'hybrid_gated_mlstm_ssd_mla_swa_moe'


def rms_norm(x, w):
    xf = x.astype(jnp.float32)
    y = xf * lax.rsqrt(jnp.mean(xf * xf, axis=-1, keepdims=True) + RMS_EPS)
    return (y * w.astype(jnp.float32)).astype(x.dtype)


def rope_tables(seq, dim):
    inv_freq = 1.0 / (ROPE_THETA ** (jnp.arange(0, dim, 2, dtype=jnp.float32) / dim))
    ang = jnp.arange(seq, dtype=jnp.float32)[:, None] * inv_freq[None, :]
    return jnp.cos(ang), jnp.sin(ang)


def apply_rope(x, cos, sin):
    x1, x2 = jnp.split(x, 2, axis=-1)
    c = cos[None, :, None, :].astype(x.dtype)
    s = sin[None, :, None, :].astype(x.dtype)
    return jnp.concatenate([x1 * c - x2 * s, x2 * c + x1 * s], axis=-1)


def mlstm(q, k, v, i_pre, f_pre):
    f32 = jnp.float32
    bsz, seq, nh, dk = q.shape
    dv = v.shape[-1]
    L = ML_CHUNK
    nc = seq // L

    def chunks(t):
        t = t.astype(f32).reshape((bsz, nc, L, nh) + t.shape[3:])
        return jnp.moveaxis(t, 3, 1)

    qc = chunks(q)
    kc = chunks(k) * dk ** -0.5
    vc = chunks(v)
    ig = chunks(i_pre)
    b = jnp.cumsum(jax.nn.log_sigmoid(chunks(f_pre)), axis=-1)
    causal = jnp.tril(jnp.ones((L, L), dtype=bool))
    dmat = jnp.where(causal, b[..., :, None] - b[..., None, :] + ig[..., None, :], -jnp.inf)
    m_intra = jnp.max(dmat, axis=-1)
    a = b[..., -1:] - b + ig
    m_loc = jnp.max(a, axis=-1)
    wl = jnp.exp(a - m_loc[..., None])
    s_loc = jnp.einsum('bhclv,bhclk->bhcvk', vc * wl[..., None], kc)
    n_loc = jnp.einsum('bhcl,bhclk->bhck', wl, kc)
    b_tot = b[..., -1]

    def step(carry, inp):
        c_st, n_st, m_st = carry
        bt, ml, sl, nl = inp
        m_new = jnp.maximum(bt + m_st, ml)
        da = jnp.exp(bt + m_st - m_new)
        db = jnp.exp(ml - m_new)
        c_new = da[..., None, None] * c_st + db[..., None, None] * sl
        n_new = da[..., None] * n_st + db[..., None] * nl
        return (c_new, n_new, m_new), (c_st, n_st, m_st)

    init = (jnp.zeros((bsz, nh, dv, dk), f32), jnp.zeros((bsz, nh, dk), f32), jnp.zeros((bsz, nh), f32))
    xs = tuple(jnp.moveaxis(t, 2, 0) for t in (b_tot, m_loc, s_loc, n_loc))
    _, (c_prev, n_prev, m_prev) = lax.scan(step, init, xs)
    c_prev = jnp.moveaxis(c_prev, 0, 2)
    n_prev = jnp.moveaxis(n_prev, 0, 2)
    m_prev = jnp.moveaxis(m_prev, 0, 2)

    g = b + m_prev[..., None]
    m_s = jnp.maximum(g, m_intra)
    p = jnp.exp(dmat - m_s[..., None]) * jnp.einsum('bhcsk,bhctk->bhcst', qc, kc)
    inter = jnp.exp(g - m_s)
    num = jnp.einsum('bhcst,bhctv->bhcsv', p, vc) + inter[..., None] * jnp.einsum('bhcvk,bhcsk->bhcsv', c_prev, qc)
    den = jnp.sum(p, axis=-1) + inter * jnp.einsum('bhck,bhcsk->bhcs', n_prev, qc)
    h = num / jnp.maximum(jnp.abs(den), jnp.exp(-m_s))[..., None]
    h = jnp.moveaxis(h, 1, 3).reshape(bsz, seq, nh, dv)
    return h.astype(q.dtype)


def causal_conv(x, w, b):
    K = w.shape[0]
    seq = x.shape[1]
    xp = jnp.pad(x, ((0, 0), (K - 1, 0), (0, 0)))
    y = xp[:, 0:seq] * w[0]
    for j in range(1, K):
        y = y + xp[:, j:j + seq] * w[j]
    return y + b


def ssd(x, dt, a_neg, bm, cm):
    f32 = jnp.float32
    bsz, seq, nh, hp = x.shape
    ng, ns = bm.shape[2], bm.shape[3]
    R = nh // ng
    L = SSM_CHUNK
    nc = seq // L
    xs = (x.astype(f32) * dt[..., None]).reshape(bsz, nc, L, ng, R, hp)
    a = jnp.transpose((dt * a_neg).reshape(bsz, nc, L, ng, R), (0, 3, 4, 1, 2))
    a_cs = jnp.cumsum(a, axis=-1)
    bc = bm.astype(f32).reshape(bsz, nc, L, ng, ns)
    cc = cm.astype(f32).reshape(bsz, nc, L, ng, ns)
    causal = jnp.tril(jnp.ones((L, L), dtype=bool))
    decay = jnp.exp(jnp.where(causal, a_cs[..., :, None] - a_cs[..., None, :], -jnp.inf))
    cb = jnp.einsum('bcsgn,bctgn->bgcst', cc, bc)
    y_diag = jnp.einsum('bgrcst,bctgrp->bcsgrp', decay * cb[:, :, None], xs)
    decay_st = jnp.transpose(jnp.exp(a_cs[..., -1:] - a_cs), (0, 3, 4, 1, 2))
    states = jnp.einsum('bctgn,bctgrp->bcgrpn', bc, xs * decay_st[..., None])
    chunk_decay = jnp.moveaxis(jnp.exp(a_cs[..., -1]), 3, 0)

    def step(st, inp):
        dec, s_new = inp
        return dec[..., None, None] * st + s_new, st

    _, prev = lax.scan(step, jnp.zeros((bsz, ng, R, hp, ns), f32), (chunk_decay, jnp.moveaxis(states, 1, 0)))
    prev = jnp.moveaxis(prev, 0, 1)
    in_decay = jnp.transpose(jnp.exp(a_cs), (0, 3, 4, 1, 2))
    y_off = jnp.einsum('bcsgn,bcgrpn->bcsgrp', cc, prev) * in_decay[..., None]
    return (y_diag + y_off).reshape(bsz, seq, nh, hp)


def causal_block_attention(q, k, v, scale):
    seq = q.shape[1]
    blk = ATTN_BLOCK
    outs = []
    for i in range(seq // blk):
        kend = (i + 1) * blk
        s = jnp.einsum('bqhd,bkhd->bhqk', q[:, i * blk:kend], k[:, :kend]).astype(jnp.float32) * scale
        qpos = i * blk + jnp.arange(blk)
        mask = jnp.arange(kend)[None, :] <= qpos[:, None]
        p = jax.nn.softmax(jnp.where(mask, s, -jnp.inf), axis=-1)
        outs.append(jnp.einsum('bhqk,bkhd->bqhd', p.astype(v.dtype), v[:, :kend]))
    return jnp.concatenate(outs, axis=1)


def swa_sink_attention(q, k, v, sinks):
    f32 = jnp.float32
    bsz, seq, hq, d = q.shape
    hkv = k.shape[2]
    grp = hq // hkv
    W = SWA_WINDOW
    nb = seq // W
    qb = q.reshape(bsz, nb, W, hkv, grp, d)

    def with_prev(t):
        prev = jnp.concatenate([jnp.zeros_like(t[:, :1]), t[:, :-1]], axis=1)
        return jnp.concatenate([prev, t], axis=2)

    kk = with_prev(k.reshape(bsz, nb, W, hkv, d))
    vv = with_prev(v.reshape(bsz, nb, W, hkv, d))
    s = jnp.einsum('bnqkgd,bntkd->bnkgqt', qb, kk).astype(f32) * d ** -0.5
    qpos = jnp.arange(W)[:, None] + W
    tpos = jnp.arange(2 * W)[None, :]
    band = (tpos <= qpos) & (qpos - tpos < W)
    valid = (jnp.arange(nb)[:, None, None] * W + tpos[None] - W) >= 0
    mask = band[None] & valid
    s = jnp.where(mask[None, :, None, None], s, -jnp.inf)
    sink = jnp.broadcast_to(sinks.astype(f32).reshape(1, 1, hkv, grp, 1, 1), s.shape[:-1] + (1,))
    p = jax.nn.softmax(jnp.concatenate([s, sink], axis=-1), axis=-1)[..., :-1]
    o = jnp.einsum('bnkgqt,bntkd->bnqkgd', p.astype(v.dtype), vv)
    return o.reshape(bsz, seq, hq * d)


def hybrid_mixer(xn, w_in, ml_igate_bias, ml_fgate_bias, ml_norm, ssm_conv_w, ssm_conv_b, ssm_dt_bias,
                 ssm_a_log, ssm_d, ssm_norm, mla_q_norm, mla_w_uq, mla_kv_norm, mla_w_ukv, swa_sinks,
                 w_branch, w_out, cos, sin):
    bsz, seq, _ = xn.shape
    u = xn @ w_in
    (ml_q, ml_k, ml_v, ml_o, ml_i, ml_f, ssm_z, ssm_xbc, ssm_dt, mla_cq, mla_ckv, mla_kr,
     swa_q, swa_k, swa_v, gate_pre) = jnp.split(u, IN_OFFSETS, axis=-1)

    h_a = mlstm(ml_q.reshape(bsz, seq, ML_HEADS, ML_DQK), ml_k.reshape(bsz, seq, ML_HEADS, ML_DQK),
                ml_v.reshape(bsz, seq, ML_HEADS, ML_DV), ml_i + ml_igate_bias, ml_f + ml_fgate_bias)
    h_a = rms_norm(h_a, ml_norm.reshape(ML_HEADS, ML_DV))
    y_a = jax.nn.sigmoid(ml_o) * h_a.reshape(bsz, seq, ML_HEADS * ML_DV)

    xbc = jax.nn.silu(causal_conv(ssm_xbc, ssm_conv_w, ssm_conv_b))
    x_s, b_s, c_s = jnp.split(xbc, (SSM_DINNER, SSM_DINNER + SSM_GROUPS * SSM_STATE), axis=-1)
    x_s = x_s.reshape(bsz, seq, SSM_HEADS, SSM_HEADDIM)
    dt = jax.nn.softplus((ssm_dt + ssm_dt_bias).astype(jnp.float32))
    a_neg = -jnp.exp(ssm_a_log.astype(jnp.float32))
    y_s = ssd(x_s, dt, a_neg, b_s.reshape(bsz, seq, SSM_GROUPS, SSM_STATE),
              c_s.reshape(bsz, seq, SSM_GROUPS, SSM_STATE))
    y_s = y_s.astype(xn.dtype) + x_s * ssm_d[:, None]
    y_s = y_s.reshape(bsz, seq, SSM_DINNER) * jax.nn.silu(ssm_z)
    y_b = rms_norm(y_s.reshape(bsz, seq, SSM_GROUPS, SSM_DINNER // SSM_GROUPS),
                   ssm_norm.reshape(SSM_GROUPS, SSM_DINNER // SSM_GROUPS)).reshape(bsz, seq, SSM_DINNER)

    qf = (rms_norm(mla_cq, mla_q_norm) @ mla_w_uq).reshape(bsz, seq, MLA_HEADS, MLA_NOPE + MLA_ROPE)
    q_nope, q_rope = jnp.split(qf, (MLA_NOPE,), axis=-1)
    kvf = (rms_norm(mla_ckv, mla_kv_norm) @ mla_w_ukv).reshape(bsz, seq, MLA_HEADS, MLA_NOPE + MLA_V)
    k_nope, v_c = jnp.split(kvf, (MLA_NOPE,), axis=-1)
    k_rope = apply_rope(mla_kr.reshape(bsz, seq, 1, MLA_ROPE), cos, sin)
    q_c = jnp.concatenate([q_nope, apply_rope(q_rope, cos, sin)], axis=-1)
    k_c = jnp.concatenate([k_nope, jnp.broadcast_to(k_rope, (bsz, seq, MLA_HEADS, MLA_ROPE))], axis=-1)
    y_c = causal_block_attention(q_c, k_c, v_c, (MLA_NOPE + MLA_ROPE) ** -0.5).reshape(bsz, seq, MLA_HEADS * MLA_V)

    y_d = swa_sink_attention(swa_q.reshape(bsz, seq, SWA_HEADS, SWA_HEAD_DIM),
                             swa_k.reshape(bsz, seq, SWA_KV_HEADS, SWA_HEAD_DIM),
                             swa_v.reshape(bsz, seq, SWA_KV_HEADS, SWA_HEAD_DIM), swa_sinks)

    branches = jnp.stack([y_a, y_b, y_c, y_d], axis=2)
    gates = jax.nn.sigmoid(gate_pre).reshape(bsz, seq, N_BRANCH, D_MODEL)
    merged = jnp.sum(gates * jnp.einsum('bsnw,nwd->bsnd', branches, w_branch), axis=2)
    return merged @ w_out


def cross_attention(hn, memn, wq, wkv, wo):
    bsz, seq, _ = hn.shape
    m = memn.shape[1]
    q = (hn @ wq).reshape(bsz, seq, XA_HEADS, XA_HEAD_DIM)
    k, v = jnp.split(memn @ wkv, 2, axis=-1)
    k = k.reshape(bsz, m, XA_HEADS, XA_HEAD_DIM)
    v = v.reshape(bsz, m, XA_HEADS, XA_HEAD_DIM)
    s = jnp.einsum('bshd,bmhd->bhsm', q, k).astype(jnp.float32) * XA_HEAD_DIM ** -0.5
    p = jax.nn.softmax(s, axis=-1)
    o = jnp.einsum('bhsm,bmhd->bshd', p.astype(v.dtype), v).reshape(bsz, seq, XA_HEADS * XA_HEAD_DIM)
    return o @ wo


def swiglu(xn, w13, w2):
    h1, h3 = jnp.split(xn @ w13, 2, axis=-1)
    return (jax.nn.silu(h1) * h3) @ w2


def moe_swiglu(xn, router, w13, w2):
    bsz, seq, dm = xn.shape
    n = bsz * seq
    nk = n * TOP_K
    xf = xn.reshape(n, dm)
    logits = (xf @ router).astype(jnp.float32)
    top_val, top_idx = lax.top_k(logits, TOP_K)
    gate = jax.nn.softmax(top_val, axis=-1).astype(xn.dtype)
    e_flat = top_idx.reshape(-1).astype(jnp.int32)
    tok_flat = jnp.arange(nk, dtype=jnp.int32) // TOP_K
    g_flat = gate.reshape(-1)
    order = jnp.argsort(e_flat)
    e_sorted = e_flat[order]
    counts = jnp.bincount(e_flat, length=N_EXPERTS).astype(jnp.int32)
    padded = (counts + MOE_BLOCK - 1) // MOE_BLOCK * MOE_BLOCK
    start = jnp.cumsum(counts) - counts
    pend = jnp.cumsum(padded)
    pstart = pend - padded
    dest = pstart[e_sorted] + (jnp.arange(nk, dtype=jnp.int32) - start[e_sorted])
    cap = (-(-nk // MOE_BLOCK) + N_EXPERTS) * MOE_BLOCK
    n_blocks = cap // MOE_BLOCK
    row_tok = jnp.full((cap,), n, dtype=jnp.int32).at[dest].set(tok_flat[order])
    row_gate = jnp.zeros((cap,), xn.dtype).at[dest].set(g_flat[order])
    blk_expert = jnp.minimum(
        jnp.searchsorted(pend, jnp.arange(n_blocks, dtype=jnp.int32) * MOE_BLOCK, side='right'), N_EXPERTS - 1)
    x_pad = jnp.concatenate([xf, jnp.zeros((1, dm), xf.dtype)], axis=0)
    xg = x_pad[row_tok].reshape(n_blocks, MOE_BLOCK, dm)

    def expert_block(args):
        xb, e = args
        return swiglu(xb, w13[e], w2[e])

    yg = lax.map(expert_block, (xg, blk_expert)).reshape(cap, dm)
    y = jax.ops.segment_sum(yg * row_gate[:, None], row_tok, num_segments=n + 1)[:n]
    return y.reshape(bsz, seq, dm)


def setup_inputs(seed: int = 0) -> dict:
    key = jax.random.key(seed)
    ks = iter(jax.random.split(key, 40))
    f32 = jnp.float32

    def nrm(shape, fan_in):
        return jax.random.normal(next(ks), shape, f32) * fan_in ** -0.5

    def gain(shape):
        return 1.0 + 0.02 * jax.random.normal(next(ks), shape, f32)

    def small(shape, scale):
        return scale * jax.random.normal(next(ks), shape, f32)

    x = jax.random.normal(next(ks), (BATCH, SEQ, D_MODEL), f32)
    mem = jax.random.normal(next(ks), (BATCH, MEM_LEN, D_MODEL), f32)
    norm_mix = gain((DEPTH, D_MODEL))
    w_in = nrm((DEPTH, D_MODEL, IN_TOTAL), D_MODEL)
    ml_igate_bias = small((DEPTH, ML_HEADS), 0.1)
    ml_fgate_bias = jnp.linspace(3.0, 6.0, ML_HEADS, dtype=f32)[None, :] + small((DEPTH, ML_HEADS), 0.1)
    ml_norm = gain((DEPTH, ML_HEADS * ML_DV))
    ssm_conv_w = nrm((DEPTH, SSM_CONV, SSM_CONV_CH), SSM_CONV)
    ssm_conv_b = small((DEPTH, SSM_CONV_CH), 0.02)
    dt0 = jnp.exp(jax.random.uniform(next(ks), (DEPTH, SSM_HEADS), f32, math.log(1e-3), math.log(1e-1)))
    ssm_dt_bias = dt0 + jnp.log(-jnp.expm1(-dt0))
    ssm_a_log = jnp.log(jax.random.uniform(next(ks), (DEPTH, SSM_HEADS), f32, 1.0, 16.0))
    ssm_d = gain((DEPTH, SSM_HEADS))
    ssm_norm = gain((DEPTH, SSM_DINNER))
    mla_q_norm = gain((DEPTH, MLA_Q_LORA))
    mla_w_uq = nrm((DEPTH, MLA_Q_LORA, MLA_HEADS * (MLA_NOPE + MLA_ROPE)), MLA_Q_LORA)
    mla_kv_norm = gain((DEPTH, MLA_KV_LORA))
    mla_w_ukv = nrm((DEPTH, MLA_KV_LORA, MLA_HEADS * (MLA_NOPE + MLA_V)), MLA_KV_LORA)
    swa_sinks = small((DEPTH, SWA_HEADS), 0.5)
    w_branch = nrm((DEPTH, N_BRANCH, BRANCH_W, D_MODEL), BRANCH_W)
    w_out = nrm((DEPTH, D_MODEL, D_MODEL), D_MODEL)
    norm_cross = gain((DEPTH, D_MODEL))
    norm_mem = gain((DEPTH, D_MODEL))
    xa_wq = nrm((DEPTH, D_MODEL, XA_HEADS * XA_HEAD_DIM), D_MODEL)
    xa_wkv = nrm((DEPTH, D_MODEL, 2 * XA_HEADS * XA_HEAD_DIM), D_MODEL)
    xa_wo = nrm((DEPTH, XA_HEADS * XA_HEAD_DIM, D_MODEL), XA_HEADS * XA_HEAD_DIM)
    norm_ffn = gain((DEPTH, D_MODEL))
    ffn_w13 = nrm((N_DENSE, D_MODEL, 2 * FFN_DIM), D_MODEL)
    ffn_w2 = nrm((N_DENSE, FFN_DIM, D_MODEL), FFN_DIM)
    moe_router = nrm((N_MOE, D_MODEL, N_EXPERTS), D_MODEL)
    moe_w13 = nrm((N_MOE, N_EXPERTS, D_MODEL, 2 * FFN_DIM), D_MODEL)
    moe_w2 = nrm((N_MOE, N_EXPERTS, FFN_DIM, D_MODEL), FFN_DIM)
    norm_final = gain((D_MODEL,))
    return {
        'x': x, 'mem': mem, 'norm_mix': norm_mix, 'w_in': w_in,
        'ml_igate_bias': ml_igate_bias, 'ml_fgate_bias': ml_fgate_bias, 'ml_norm': ml_norm,
        'ssm_conv_w': ssm_conv_w, 'ssm_conv_b': ssm_conv_b, 'ssm_dt_bias': ssm_dt_bias,
        'ssm_a_log': ssm_a_log, 'ssm_d': ssm_d, 'ssm_norm': ssm_norm,
        'mla_q_norm': mla_q_norm, 'mla_w_uq': mla_w_uq, 'mla_kv_norm': mla_kv_norm, 'mla_w_ukv': mla_w_ukv,
        'swa_sinks': swa_sinks, 'w_branch': w_branch, 'w_out': w_out,
        'norm_cross': norm_cross, 'norm_mem': norm_mem, 'xa_wq': xa_wq, 'xa_wkv': xa_wkv, 'xa_wo': xa_wo,
        'norm_ffn': norm_ffn, 'ffn_w13': ffn_w13, 'ffn_w2': ffn_w2,
        'moe_router': moe_router, 'moe_w13': moe_w13, 'moe_w2': moe_w2, 'norm_final': norm_final,
    }


def reference(x, mem, norm_mix, w_in, ml_igate_bias, ml_fgate_bias, ml_norm, ssm_conv_w, ssm_conv_b,
              ssm_dt_bias, ssm_a_log, ssm_d, ssm_norm, mla_q_norm, mla_w_uq, mla_kv_norm, mla_w_ukv,
              swa_sinks, w_branch, w_out, norm_cross, norm_mem, xa_wq, xa_wkv, xa_wo, norm_ffn,
              ffn_w13, ffn_w2, moe_router, moe_w13, moe_w2, norm_final):
    seq = x.shape[1]
    cos, sin = rope_tables(seq, MLA_ROPE)
    h = x
    for l in range(DEPTH):
        xn = rms_norm(h, norm_mix[l])
        h = h + hybrid_mixer(xn, w_in[l], ml_igate_bias[l], ml_fgate_bias[l], ml_norm[l], ssm_conv_w[l],
                             ssm_conv_b[l], ssm_dt_bias[l], ssm_a_log[l], ssm_d[l], ssm_norm[l],
                             mla_q_norm[l], mla_w_uq[l], mla_kv_norm[l], mla_w_ukv[l], swa_sinks[l],
                             w_branch[l], w_out[l], cos, sin)
        h = h + cross_attention(rms_norm(h, norm_cross[l]), rms_norm(mem, norm_mem[l]),
                                xa_wq[l], xa_wkv[l], xa_wo[l])
        hn = rms_norm(h, norm_ffn[l])
        if l % 2 == 0:
            h = h + swiglu(hn, ffn_w13[l // 2], ffn_w2[l // 2])
        else:
            h = h + moe_swiglu(hn, moe_router[l // 2], moe_w13[l // 2], moe_w2[l // 2])
    return rms_norm(h, norm_final)
```

```cpp
#ifndef HOST_EMU
#include <hip/hip_runtime.h>
#endif
#include <cstdio>
#include <cstdint>
#include <cstddef>

#ifndef CFG_BATCH
#define CFG_BATCH 8
#endif
#ifndef CFG_SEQ
#define CFG_SEQ 2048
#endif
#ifndef MK_N_LAUNCHES
#define MK_N_LAUNCHES 1
#endif

typedef unsigned short bf16_t;
#ifndef HOST_EMU
#define DI __device__ __forceinline__
#define LAS __attribute__((address_space(3)))
#define GAS __attribute__((address_space(1)))
typedef short bf16x8 __attribute__((ext_vector_type(8)));
typedef short s16x4 __attribute__((ext_vector_type(4)));
typedef float f32x4 __attribute__((ext_vector_type(4)));
typedef float f32x2 __attribute__((ext_vector_type(2)));
typedef unsigned u32x4 __attribute__((ext_vector_type(4)));
typedef unsigned u32x2 __attribute__((ext_vector_type(2)));
DI f32x4 mfma16(bf16x8 a, bf16x8 b, f32x4 c) { return __builtin_amdgcn_mfma_f32_16x16x32_bf16(a, b, c, 0, 0, 0); }
DI s16x4 lds_tr4(const void* p) { return __builtin_amdgcn_ds_read_tr16_b64_v4i16((LAS s16x4*)(p)); }
DI float shfl_xor_f(float v, int m) { return __shfl_xor(v, m); }
DI float shfl_f(float v, int src) { return __shfl(v, src); }
DI int shfl_xor_i(int v, int m) { return __shfl_xor(v, m); }
DI int rfl(int v) { return __builtin_amdgcn_readfirstlane(v); }
DI int lane_id_hw() { return (int)__builtin_amdgcn_mbcnt_hi(~0u, __builtin_amdgcn_mbcnt_lo(~0u, 0u)); }
DI float fexp2(float x) { return __builtin_amdgcn_exp2f(x); }
DI float fexp(float x) { return __expf(x); }
DI float flog(float x) { return __logf(x); }
DI float frcp(float x) { return __builtin_amdgcn_rcpf(x); }
DI float frsqrt(float x) { return __builtin_amdgcn_rsqf(x); }
DI float fsin_rev(float rev) { return __builtin_amdgcn_sinf(rev); }
DI float fcos_rev(float rev) { return __builtin_amdgcn_cosf(rev); }
DI int atomic_add_i(int* p, int v) { return __hip_atomic_fetch_add(p, v, __ATOMIC_RELAXED, __HIP_MEMORY_SCOPE_AGENT); }
DI int lds_atomic_add_i(int* p, int v) { return __hip_atomic_fetch_add(p, v, __ATOMIC_RELAXED, __HIP_MEMORY_SCOPE_WORKGROUP); }
DI void atomic_add_f(float* p, float v) { (void)__hip_atomic_fetch_add(p, v, __ATOMIC_RELAXED, __HIP_MEMORY_SCOPE_AGENT); }
DI unsigned cvt_pk_bf16(float lo, float hi) { unsigned r; asm volatile("s_nop 0\n\tv_cvt_pk_bf16_f32 %0, %1, %2" : "=v"(r) : "v"(lo), "v"(hi)); return r; }
#define WAVE_FENCE() asm volatile("s_waitcnt lgkmcnt(0)" ::: "memory")
#define SCHED_BAR() __builtin_amdgcn_sched_barrier(0)
#define SETPRIO(n) __builtin_amdgcn_s_setprio(n)
#define PIN_ACC8(a) asm volatile("" : "+v"((a)[0]), "+v"((a)[1]), "+v"((a)[2]), "+v"((a)[3]), "+v"((a)[4]), "+v"((a)[5]), "+v"((a)[6]), "+v"((a)[7]))
DI float u2f(unsigned u) { return __uint_as_float(u); }
DI unsigned f2u(float f) { return __float_as_uint(f); }
#else
#define DI inline __attribute__((always_inline))
#define WAVE_FENCE() emu::wave_sync()
#define SCHED_BAR()
#define SETPRIO(n)
#define PIN_ACC8(a)
DI float u2f(unsigned u) { float f; memcpy(&f, &u, 4); return f; }
DI unsigned f2u(float f) { unsigned u; memcpy(&u, &f, 4); return u; }
#endif

#ifndef HOST_EMU
#define LAUNDER_V(x) asm volatile("" : "+v"(x))
#define LAUNDER_S(x) asm volatile("" : "+s"(x))
#else
#define LAUNDER_V(x)
#define LAUNDER_S(x)
#endif
#ifndef HOST_EMU
typedef int i32x8 __attribute__((ext_vector_type(8)));
DI unsigned cvt_pk4_fp8(float a, float b, float c, float d) { int v = __builtin_amdgcn_cvt_pk_fp8_f32(a, b, 0, false); v = __builtin_amdgcn_cvt_pk_fp8_f32(c, d, v, true); return (unsigned)v; }
#else
DI unsigned f2fp8_host(float f) {
    unsigned s = f < 0.f ? 0x80u : 0u; float a = fabsf(f); if (!(a == a)) return s | 0x7f; if (a >= 448.f) return s | 0x7e;
    if (a < 0.0009765625f) return s;
    int e; float m = frexpf(a, &e); e -= 1; m *= 2.f;
    if (e < -6) { const float q = a * 512.f; int n = (int)lrintf(q); return s | (unsigned)n; }
    int n = (int)lrintf((m - 1.f) * 8.f); if (n == 8) { n = 0; e += 1; } if (e > 8 || (e == 8 && n > 6)) return s | 0x7e;
    return s | (unsigned)((e + 7) << 3) | (unsigned)n; }
DI unsigned cvt_pk4_fp8(float a, float b, float c, float d) { return f2fp8_host(a) | (f2fp8_host(b) << 8) | (f2fp8_host(c) << 16) | (f2fp8_host(d) << 24); }
DI float fp82f_host(unsigned v) { const unsigned s = v & 0x80u, e = (v >> 3) & 15u, m = v & 7u; float r = e == 0 ? (float)m * 0.001953125f : (1.f + (float)m * 0.125f) * exp2f((float)e - 7.f); return s ? -r : r; }
#endif
constexpr float F8_ASCALE = 16.0f, F8_WSCALE = 1024.0f;
#ifndef F8_FULL
#define F8_FULL 1
#endif
constexpr int F8_NBJ = F8_FULL ? 2 : 1;
DI float bf2f(bf16_t b) { return u2f(((unsigned)b) << 16); }
DI bf16_t f2bf(float f) { unsigned u = f2u(f); return (bf16_t)((u + 0x7fffu + ((u >> 16) & 1u)) >> 16); }
DI float bflo(unsigned w) { return u2f(w << 16); }
DI float bfhi(unsigned w) { return u2f(w & 0xffff0000u); }
DI float wave_sum(float v) {
#pragma unroll
    for (int o = 1; o < 64; o <<= 1) v += shfl_xor_f(v, o);
    return v;
}
#ifndef HOST_EMU
DI bool wave_any(bool p) { return __any(p ? 1 : 0) != 0; }
#else
DI bool wave_any(bool p) { int v = p ? 1 : 0;
    for (int o = 1; o < 64; o <<= 1) v |= shfl_xor_i(v, o);
    return v != 0; }
#endif
DI unsigned vzero() { unsigned z = 0u; LAUNDER_V(z); return z; }
DI float sigmoidf_(float x) { return frcp(1.0f + fexp(-x)); }
DI float siluf_(float x) { return x * frcp(1.0f + fexp(-x)); }

constexpr int BATCH = CFG_BATCH, SEQ = CFG_SEQ, NTOK = BATCH * SEQ, D = 2048, DEPTH = 2, MEMLEN = 256, NMEM = BATCH * MEMLEN;
constexpr int IN_TOTAL = 16216, UW = 16384, UWP = UW + 64;
constexpr float RMS_EPS = 1e-6f;
constexpr int FFN = 7168, NEXP = 8;
constexpr int UC_MLQ = 0, UC_MLK = 512, UC_MLV = 1024, UC_MLO = 2048, UC_SSZ = 3072, UC_XBC = 4096, UC_CQ = 5632, UC_CKV = 6144, UC_SM = 6400,
              UC_SWQ = 6656, UC_SWK = 7680, UC_SWV = 7936, UC_GATE = 8192;
constexpr int SM_TILE = UC_SM / 256;
constexpr int SO_MLI = 3072, SO_SSZ = 3080, SO_XBC = 4104, SO_DT = 5640, SO_CQ = 5656, SO_CKV = 6168, SO_KR = 6424, SO_SWQ = 6488, SO_SWK = 7512, SO_SWV = 7768, SO_GATE = 8024;
constexpr int SLOTS = 2 * NTOK + NEXP * 256;
constexpr int MAXTILES = SLOTS / 256;

constexpr size_t al256(size_t x) { return (x + 255) & ~(size_t)255; }
constexpr size_t O_CTL = 0, SZ_CTL = 1u << 20;
constexpr size_t O_WIN = O_CTL + SZ_CTL;
constexpr size_t O_WUQ = O_WIN + (size_t)DEPTH * UW * D * 2;
constexpr size_t O_WUKV = O_WUQ + (size_t)DEPTH * 1536 * 512 * 2;
constexpr size_t O_WBR = O_WUKV + (size_t)DEPTH * 2048 * 256 * 2;
constexpr size_t O_WOUT = O_WBR + (size_t)DEPTH * 4 * 2048 * 1024 * 2;
constexpr size_t O_WXQ = O_WOUT + (size_t)DEPTH * 2048 * 2048 * 2;
constexpr size_t O_WXKV = O_WXQ + (size_t)DEPTH * 512 * 2048 * 2;
constexpr size_t O_WXO = O_WXKV + (size_t)DEPTH * 1024 * 2048 * 2;
constexpr size_t O_W13 = O_WXO + (size_t)DEPTH * 2048 * 512 * 2;
constexpr size_t O_W2 = O_W13 + (size_t)2 * FFN * D * 2;
constexpr size_t O_MW13 = O_W2 + (size_t)D * FFN * 2;
constexpr size_t O_MW2 = O_MW13 + (size_t)NEXP * 2 * FFN * D * 2;
constexpr size_t O_ROPE = O_MW2 + (size_t)NEXP * D * FFN * 2;
constexpr size_t O_H = al256(O_ROPE + (size_t)SEQ * 64 * 4);
constexpr size_t O_G8 = O_H + (size_t)NTOK * D * 2;
constexpr size_t O_XN = O_H + (size_t)NTOK * D * 4;
constexpr size_t O_MEMN = O_XN + (size_t)NTOK * D * 2;
constexpr size_t O_U = O_MEMN + (size_t)DEPTH * NMEM * D * 2;
constexpr size_t O_SM = O_U + (size_t)NTOK * UWP * 2;
constexpr size_t O_CQN = O_SM + (size_t)NTOK * 256 * 4;
constexpr size_t O_CKVN = O_CQN + (size_t)NTOK * 512 * 2;
constexpr size_t O_KR = O_CKVN + (size_t)NTOK * 256 * 2;
constexpr size_t O_XBC = O_KR + (size_t)NTOK * 64 * 2;
constexpr size_t O_DT = O_XBC + (size_t)NTOK * 1536 * 2;
constexpr size_t O_DA = O_DT + (size_t)NTOK * 16 * 4;
constexpr size_t O_GI = O_DA + (size_t)NTOK * 16 * 4;
constexpr size_t O_LF = O_GI + (size_t)NTOK * 4 * 4;
constexpr size_t O_QF = O_LF + (size_t)NTOK * 4 * 4;
constexpr size_t O_KVF = O_QF + (size_t)NTOK * 1536 * 2;
constexpr size_t O_Y = O_KVF + (size_t)NTOK * 2048 * 2;
constexpr size_t O_MACC = O_Y + (size_t)4 * NTOK * 1024 * 2;
constexpr size_t O_SSQ = O_MACC;
constexpr size_t O_RSTD = O_SSQ + (size_t)NTOK * 32 * 4;
constexpr size_t O_MERGED = O_MACC + (size_t)NTOK * D * 4;
constexpr size_t O_XQ = O_MERGED + (size_t)NTOK * D * 2;
constexpr size_t O_XKV = O_XQ + (size_t)NTOK * 512 * 2;
constexpr size_t O_XO = O_XKV + (size_t)NMEM * 1024 * 2;
constexpr size_t O_ACT = O_XO + (size_t)NTOK * 512 * 2;
constexpr size_t O_XG = O_ACT + (size_t)NTOK * FFN * 2;
constexpr size_t O_YG = O_XG + (size_t)SLOTS * D * 2;
constexpr size_t O_ROUTE = O_YG + (size_t)SLOTS * D * 2;
constexpr size_t O_BLKCNT = O_ROUTE + (size_t)NTOK * 2 * 4 * 3;
constexpr size_t O_TAILACC = al256(O_BLKCNT + 1024 * 8 * 4);
constexpr size_t O_XN8 = al256(O_TAILACC + (size_t)256 * 65536 * 4);
constexpr size_t O_WG8 = O_XN8 + (size_t)NTOK * D;
constexpr size_t O_ACTM = al256(O_WG8 + (size_t)DEPTH * 8192 * D);
constexpr size_t WS_END = O_ACTM + (size_t)SLOTS * FFN * 2;

constexpr int LDS_BYTES = 147456;
constexpr int LDS_MISC = 143360;
constexpr int NTHREADS = 512;

struct Params { const float* in[32]; float* out; unsigned char* ws; int ph_lo, ph_hi, flags, pad; };

#ifndef HOST_EMU
#define XB_TMO      128
#define XB_XCNT(j)  (256  + 64 * (j))
#define XB_XSUB(j)  (1280 + 64 * (j))
#define XB_XGEN(j)  (2304 + 64 * (j))
#define XB_TOP      3328
#define XB_TOPGEN   3392
#define XCD_BAR_WORDS 3456
#define XB_SPIN_CAP (1u << 22)
__device__ __forceinline__ unsigned xb_ld(unsigned* p)              { return __hip_atomic_load(p, __ATOMIC_RELAXED, __HIP_MEMORY_SCOPE_AGENT); }
__device__ __forceinline__ unsigned xb_add(unsigned* p, unsigned v) { return __hip_atomic_fetch_add(p, v, __ATOMIC_RELAXED, __HIP_MEMORY_SCOPE_AGENT); }
__device__ __forceinline__ unsigned xb_xcc_id() { return (unsigned)__builtin_amdgcn_s_getreg((3 << 11) | 20) & 0xFu; }
#define XB_SPIN(cond, bar) do { unsigned _sp = 0; while (cond) { __builtin_amdgcn_s_sleep(1); \
    if ((++_sp & 255u) == 0u) { if (xb_ld(&(bar)[XB_TMO])) break; if (_sp > XB_SPIN_CAP) { atomicAdd(&(bar)[XB_TMO], 1u); break; } } } } while (0)
struct XcdBarrier { unsigned* bar; unsigned x; volatile LAS unsigned* st; int wave; };
__device__ __forceinline__ bool xb_thread0(int wave) { return wave == 0 && lane_id_hw() == 0; }
__device__ __forceinline__ XcdBarrier xcd_barrier_post(unsigned* bar, volatile LAS unsigned* st, int wave) {
    XcdBarrier b; b.bar = bar; b.x = xb_xcc_id(); b.st = st; b.wave = wave;
    if (xb_thread0(wave)) (void)xb_add(&bar[XB_XCNT(b.x)], 1u);
    return b;
}
__device__ __forceinline__ void xcd_barrier_complete(unsigned* bar, unsigned x, unsigned& nloc, unsigned& nx) {
    const unsigned G = gridDim.x * gridDim.y * gridDim.z;
    unsigned sum, cnt, mine, sp = 0u;
    for (;;) {
        sum = 0u; cnt = 0u; mine = 0u;
#pragma unroll
        for (unsigned j = 0; j < 16; ++j) { const unsigned c = xb_ld(&bar[XB_XCNT(j)]); sum += c; cnt += (c > 0u) ? 1u : 0u; mine = (j == x) ? c : mine; }
        if (sum == G) break;
        __builtin_amdgcn_s_sleep(1);
        if ((++sp & 255u) == 0u) { if (xb_ld(&bar[XB_TMO])) break; if (sp > XB_SPIN_CAP) { atomicAdd(&bar[XB_TMO], 1u); break; } }
    }
    nloc = mine > 0u ? mine : 1u; nx = cnt > 0u ? cnt : 1u;
}
__device__ __forceinline__ void xcd_barrier(const XcdBarrier& b) {
    asm volatile("s_waitcnt vmcnt(0)" ::: "memory");
    __syncthreads();
    if (xb_thread0(b.wave)) {
        unsigned* bar = b.bar;
        __builtin_amdgcn_s_waitcnt(0);
        unsigned nloc = b.st[0], nx = b.st[1];
        if (nloc == 0u) { xcd_barrier_complete(bar, b.x, nloc, nx); b.st[0] = nloc; b.st[1] = nx; }
        const unsigned old = xb_add(&bar[XB_XSUB(b.x)], 1u);
        const unsigned gen = old / nloc;
        if (old + 1u == (gen + 1u) * nloc) {
            __builtin_amdgcn_fence(__ATOMIC_RELEASE, "agent");
            asm volatile("s_waitcnt vmcnt(0)" ::: "memory");
            const unsigned og = xb_add(&bar[XB_TOP], 1u);
            const unsigned tg = og / nx;
            if (og + 1u == (tg + 1u) * nx) xb_add(&bar[XB_TOPGEN], 1u);
            else XB_SPIN(xb_ld(&bar[XB_TOPGEN]) == tg, bar);
            __builtin_amdgcn_fence(__ATOMIC_ACQUIRE, "agent");
            xb_add(&bar[XB_XGEN(b.x)], 1u);
            asm volatile("s_waitcnt vmcnt(0)" ::: "memory");
        } else {
            XB_SPIN(xb_ld(&bar[XB_XGEN(b.x)]) == gen, bar);
            __builtin_amdgcn_fence(__ATOMIC_ACQUIRE, "agent");
            asm volatile("s_waitcnt vmcnt(0)" ::: "memory");
        }
    }
    __syncthreads();
}
#endif

namespace pg8 {
constexpr int BM = 256, BK = 64, HALF = 128, HTB = HALF * BK * 2, STAGE_BYTES = 8 * HTB, NXCD = 8, WGM = 4;
DI int lds_byte(int r, int c) { const int st = (r >> 4) * 2 + (c >> 5), rr = r & 15, cc = c & 31, ob = rr * 64 + cc * 2; return st * 1024 + (ob ^ (((ob >> 9) & 1) << 5)); }
DI void stage_rc(int b, int& R, int& C) { const int st = b / 1024, sb = b % 1024, swz = sb ^ (((sb >> 9) & 1) << 5); R = (st >> 1) * 16 + swz / 64; C = (st & 1) * 32 + (swz % 64) / 2; }
DI int perm32(int rho) { const int n = rho >> 4, i = rho & 15; return 8 * (i >> 2) + 4 * n + (i & 3); }
struct Unit { int pa, pb, pm, pn, aux, ui; };
struct Gemm { const bf16_t* A; int lda; const bf16_t* Bt; int ldb; int K; };
DI bool static_map(long L, int nM, int nN, int& pm, int& pn) {
    const int nwg = nM * nN; if (L >= nwg) return false;
    int wgid = (int)L; { const int q = nwg / NXCD, r = nwg % NXCD, xcd = wgid % NXCD, off = wgid / NXCD; wgid = (xcd < r ? xcd * (q + 1) : r * (q + 1) + (xcd - r) * q) + off; }
    const int nig = WGM * nN, gid = wgid / nig, fm = gid * WGM, gsz = (nM - fm) < WGM ? (nM - fm) : WGM;
    pm = fm + ((wgid % nig) % gsz); pn = (wgid % nig) / gsz; return true;
}
struct OrdStatic { int nM, nN, G, c;
    DI bool next(int i, Unit& u) const { if (!static_map((long)i * G + c, nM, nN, u.pm, u.pn)) return false; u.pa = u.pm; u.pb = u.pn; u.aux = 0; u.ui = i; return true; } };
struct OrdMerge { int nM, nN, G, c;
    DI bool next(int i, Unit& u) const { if (!static_map((long)(i >> 2) * G + c, nM, nN, u.pm, u.pn)) return false; u.aux = i & 3; u.pa = u.aux * nM + u.pm; u.pb = u.aux * nN + u.pn; u.ui = i; return true; } };
struct OrdMoe { int nM, nN, G, c; const int* tile_e; int imax;
    DI bool next(int i, Unit& u) const { if (i >= imax || !static_map((long)i * G + c, nM, nN, u.pm, u.pn)) return false; u.aux = tile_e[u.pm]; u.pa = u.pm; u.pb = u.aux * nN + u.pn; u.ui = i; return true; } };
struct OrdOne { Unit u; bool valid;
    DI bool next(int i, Unit& o) const { if (i != 0 || !valid) return false; o = u; return true; } };
DI void moe_tail_split(int ntiles, int G, int& full, int& R, int& sp) {
    const int units = ntiles * 8; full = units / G; R = units - full * G; sp = 0;
    if (R > 0) { sp = 1; if (R * 2 <= G) sp = 2; if (R * 4 <= G) sp = 4; if (R * 7 <= G) sp = 7; }
}

#ifndef HOST_EMU
template <class Epi, class Sched>
__device__ __forceinline__ void gemm_phase(LAS unsigned char* lds, const Gemm g, const Sched& S, const Epi& E, int wave_id) {
    int lane_ = lane_id_hw(); asm volatile("" : "+v"(lane_)); int wid_ = wave_id; asm volatile("" : "+s"(wid_));
    const int tid = wid_ * 64 + lane_, wid = wid_, lane = tid & 63, wr = wid >> 2, wc = wid & 3, fr = lane & 15, fq = lane >> 4;
    const int K = g.K, nt = K / BK;
    unsigned voffA[2], voffB[2];
#pragma unroll
    for (int i = 0; i < 2; ++i) { int R, C; stage_rc(tid * 16 + i * 8192, R, C); const int Rb = Epi::PERM ? ((R & ~31) + perm32(R & 31)) : R;
        voffA[i] = (unsigned)(R * g.lda + C) * 2u; voffB[i] = (unsigned)(Rb * g.ldb + C) * 2u; }
    const size_t kstep = (size_t)(BK * 2);
    const size_t hstepA = (size_t)HALF * g.lda * 2, hstepB = (size_t)HALF * g.ldb * 2;
    const size_t tstepA = 2 * hstepA, tstepB = 2 * hstepB;
    const unsigned ldsw = (unsigned)wid * 1024u;
    const int aoff = lds_byte(wr * 64 + fr, fq * 8), boff = lds_byte(wc * 32 + fr, fq * 8);
#define PG8_SA(b, h) (((b) * 2 + (h)) * HTB)
#define PG8_SB(b, h) ((4 + (b) * 2 + (h)) * HTB)
#define PG8_STAGE(bufoff, gbase, voff) do { _Pragma("unroll") for (int _i = 0; _i < 2; ++_i) \
        __builtin_amdgcn_global_load_lds((const unsigned*)((const char*)(gbase) + (voff)[_i]), (LAS unsigned*)(lds + (bufoff) + ldsw + _i * 8192), 16, 0, 0); } while (0)
#define PG8_LDA(dst, b, h) do { _Pragma("unroll") for (int m = 0; m < 4; ++m) _Pragma("unroll") for (int k = 0; k < 2; ++k) dst[m][k] = *(const LAS bf16x8*)(lds + PG8_SA(b, h) + aoff + m * 2048 + k * 1024); } while (0)
#define PG8_LDB(dst, b, h) do { _Pragma("unroll") for (int n = 0; n < 2; ++n) _Pragma("unroll") for (int k = 0; k < 2; ++k) dst[n][k] = *(const LAS bf16x8*)(lds + PG8_SB(b, h) + boff + n * 2048 + k * 1024); } while (0)
#define PG8_MMA(ai, bj, At, Bt) do { __builtin_amdgcn_s_setprio(1); _Pragma("unroll") for (int m = 0; m < 4; ++m) _Pragma("unroll") for (int n = 0; n < 2; ++n) _Pragma("unroll") for (int k = 0; k < 2; ++k) \
        acc[ai][bj][m][n] = __builtin_amdgcn_mfma_f32_16x16x32_bf16(Bt[n][k], At[m][k], acc[ai][bj][m][n], 0, 0, 0); __builtin_amdgcn_s_setprio(0); } while (0)
#define PG8_WAIT_V(n) asm volatile("s_waitcnt vmcnt(" #n ")" ::: "memory")
#define PG8_WAIT_L(n) asm volatile("s_waitcnt lgkmcnt(" #n ")" ::: "memory")
#define PG8_BAR __builtin_amdgcn_s_barrier()
#define PG8_SCHED __builtin_amdgcn_sched_barrier(0)
    Unit cur, nxt; int ui = 0;
    if (!S.next(0, cur)) return;
    if constexpr (Epi::HAS_PREP) E.prep(cur, tid);
    f32x4 acc[2][2][4][2];
#pragma unroll
    for (int a = 0; a < 2; ++a)
#pragma unroll
        for (int b = 0; b < 2; ++b)
#pragma unroll
            for (int m = 0; m < 4; ++m)
#pragma unroll
                for (int n = 0; n < 2; ++n) acc[a][b][m][n] = (f32x4){0.f, 0.f, 0.f, 0.f};
    bf16x8 At[4][2], B0[2][2], B1[2][2];
    const char* cA = (const char*)g.A + (size_t)cur.pa * tstepA; const char* cB = (const char*)g.Bt + (size_t)cur.pb * tstepB;
    PG8_STAGE(PG8_SB(0, 0), cB, voffB); PG8_STAGE(PG8_SB(0, 1), cB + hstepB, voffB); PG8_STAGE(PG8_SA(0, 0), cA, voffA); PG8_STAGE(PG8_SA(0, 1), cA + hstepA, voffA);
    if (wr == 1) PG8_BAR;
    PG8_WAIT_V(2); PG8_BAR;
    PG8_STAGE(PG8_SB(1, 0), cB + kstep, voffB); PG8_STAGE(PG8_SA(1, 0), cA + kstep, voffA); PG8_STAGE(PG8_SB(1, 1), cB + hstepB + kstep, voffB);
    PG8_WAIT_V(6); PG8_BAR;
    for (;;) {
        const bool has_next = S.next(ui + 1, nxt);
        const char* nA = has_next ? (const char*)g.A + (size_t)nxt.pa * tstepA : cA; const char* nB = has_next ? (const char*)g.Bt + (size_t)nxt.pb * tstepB : cB;
        for (int t = 0; t < nt; t += 2) {
            const bool last = (t == nt - 2);
            const char* a1 = cA + (size_t)(t + 1) * kstep;
            const char* a2 = last ? nA : cA + (size_t)(t + 2) * kstep; const char* b2 = last ? nB : cB + (size_t)(t + 2) * kstep;
            const char* a3 = a2 + kstep; const char* b3 = b2 + kstep;
            PG8_LDB(B0, 0, 0); PG8_LDB(B1, 0, 1); PG8_SCHED; PG8_LDA(At, 0, 0); PG8_STAGE(PG8_SA(1, 1), a1 + hstepA, voffA);
            PG8_WAIT_V(8); PG8_WAIT_L(0); PG8_BAR; PG8_MMA(0, 0, At, B0); PG8_MMA(0, 1, At, B1); PG8_BAR; PG8_SCHED;
            PG8_LDA(At, 0, 1); PG8_STAGE(PG8_SB(0, 0), b2, voffB); PG8_STAGE(PG8_SB(0, 1), b2 + hstepB, voffB); PG8_STAGE(PG8_SA(0, 0), a2, voffA);
            PG8_WAIT_V(8); PG8_WAIT_L(0); PG8_BAR; PG8_MMA(1, 0, At, B0); PG8_MMA(1, 1, At, B1); PG8_BAR; PG8_SCHED;
            PG8_LDB(B0, 1, 0); PG8_LDB(B1, 1, 1); PG8_SCHED; PG8_LDA(At, 1, 0); PG8_STAGE(PG8_SA(0, 1), a2 + hstepA, voffA);
            PG8_WAIT_V(8); PG8_WAIT_L(0); PG8_BAR; PG8_MMA(0, 0, At, B0); PG8_MMA(0, 1, At, B1); PG8_BAR; PG8_SCHED;
            PG8_LDA(At, 1, 1); PG8_STAGE(PG8_SB(1, 0), b3, voffB); PG8_STAGE(PG8_SB(1, 1), b3 + hstepB, voffB); PG8_STAGE(PG8_SA(1, 0), a3, voffA);
            PG8_WAIT_V(8); PG8_WAIT_L(0); PG8_BAR; PG8_MMA(1, 0, At, B0); PG8_MMA(1, 1, At, B1); PG8_BAR; PG8_SCHED;
        }
        if (wr == 0) PG8_BAR;
        E(acc, cur, wr, wc, fr, fq);
        if (!has_next) break;
        if constexpr (Epi::HAS_PREP) E.prep(nxt, tid);
#pragma unroll
        for (int a = 0; a < 2; ++a)
#pragma unroll
            for (int b = 0; b < 2; ++b)
#pragma unroll
                for (int m = 0; m < 4; ++m)
#pragma unroll
                    for (int n = 0; n < 2; ++n) acc[a][b][m][n] = (f32x4){0.f, 0.f, 0.f, 0.f};
        cur = nxt; cA = nA; cB = nB; ++ui;
        if (wr == 1) PG8_BAR;
    }
    PG8_WAIT_V(0);
    PG8_BAR;
#undef PG8_SA
#undef PG8_SB
#undef PG8_STAGE
#undef PG8_LDA
#undef PG8_LDB
#undef PG8_MMA
#undef PG8_WAIT_V
#undef PG8_WAIT_L
#undef PG8_BAR
#undef PG8_SCHED
}
template <class Epi, class Sched, bool FULLN = false>
__device__ __forceinline__ void gemm_phase_f8(LAS unsigned char* lds, const Gemm g, const Sched& S, const Epi& E, int wave_id) {
    int lane_ = lane_id_hw(); asm volatile("" : "+v"(lane_)); int wid_ = wave_id; asm volatile("" : "+s"(wid_));
    const int tid = wid_ * 64 + lane_, wid = wid_, lane = tid & 63, wr = wid >> 2, wc = wid & 3, fr = lane & 15, fq = lane >> 4;
    const int K = g.K, nt = K / BK;
    unsigned voffA[2], voffB[2];
#pragma unroll
    for (int i = 0; i < 2; ++i) { int R, C; stage_rc(tid * 16 + i * 8192, R, C); const int Rb = Epi::PERM ? ((R & ~31) + perm32(R & 31)) : R;
        voffA[i] = (unsigned)(R * g.lda + C) * 2u; voffB[i] = (unsigned)(Rb * g.ldb + C) * 2u; }
    const size_t kstep = (size_t)(BK * 2);
    const size_t hstepA = (size_t)HALF * g.lda * 2, hstepB = (size_t)HALF * g.ldb * 2;
    const size_t tstepA = 2 * hstepA, tstepB = 2 * hstepB;
    const unsigned ldsw = (unsigned)wid * 1024u;
    const int aoff0 = lds_byte(wr * 64 + fr, ((2 * fq) & 3) * 8) + (fq >> 1) * 1024, aoff1 = lds_byte(wr * 64 + fr, ((2 * fq + 1) & 3) * 8) + (fq >> 1) * 1024;
    const int boff0 = lds_byte(wc * 32 + fr, ((2 * fq) & 3) * 8) + (fq >> 1) * 1024, boff1 = lds_byte(wc * 32 + fr, ((2 * fq + 1) & 3) * 8) + (fq >> 1) * 1024;
#define PG8_SA(b, h) (((b) * 2 + (h)) * HTB)
#define PG8_SB(b, h) ((4 + (b) * 2 + (h)) * HTB)
#define PG8_STAGE(bufoff, gbase, voff) do { _Pragma("unroll") for (int _i = 0; _i < 2; ++_i) \
        __builtin_amdgcn_global_load_lds((const unsigned*)((const char*)(gbase) + (voff)[_i]), (LAS unsigned*)(lds + (bufoff) + ldsw + _i * 8192), 16, 0, 0); } while (0)
#define PG8_LDA(dst, b, h) do { _Pragma("unroll") for (int m = 0; m < 4; ++m) { dst[m][0] = *(const LAS u32x4*)(lds + PG8_SA(b, h) + aoff0 + m * 2048); dst[m][1] = *(const LAS u32x4*)(lds + PG8_SA(b, h) + aoff1 + m * 2048); } } while (0)
#define PG8_LDB(dst, b, h) do { _Pragma("unroll") for (int n = 0; n < 2; ++n) { dst[n][0] = *(const LAS u32x4*)(lds + PG8_SB(b, h) + boff0 + n * 2048); dst[n][1] = *(const LAS u32x4*)(lds + PG8_SB(b, h) + boff1 + n * 2048); } } while (0)
#define PG8_F8OP(x) __builtin_shufflevector(__builtin_bit_cast(i32x4_, (x)[0]), __builtin_bit_cast(i32x4_, (x)[1]), 0, 1, 2, 3, 4, 5, 6, 7)
#define PG8_MMA(ai, bj, At, Bt) do { __builtin_amdgcn_s_setprio(1); _Pragma("unroll") for (int m = 0; m < 4; ++m) _Pragma("unroll") for (int n = 0; n < 2; ++n) { \
        const i32x8 a8_ = PG8_F8OP(Bt[n]), b8_ = PG8_F8OP(At[m]); \
        asm volatile("v_mfma_scale_f32_16x16x128_f8f6f4 %0, %1, %2, %0, %3, %3 op_sel_hi:[0,0,0]" : "+v"(acc[ai][bj][m][n]) : "v"(a8_), "v"(b8_), "v"(f8one)); } \
        __builtin_amdgcn_s_setprio(0); } while (0)
#define PG8_WAIT_V(n) asm volatile("s_waitcnt vmcnt(" #n ")" ::: "memory")
#define PG8_WAIT_L(n) asm volatile("s_waitcnt lgkmcnt(" #n ")" ::: "memory")
#define PG8_BAR __builtin_amdgcn_s_barrier()
#define PG8_SCHED __builtin_amdgcn_sched_barrier(0)
    Unit cur, nxt; int ui = 0;
    if (!S.next(0, cur)) return;
    f32x4 acc[2][2][4][2];
#pragma unroll
    for (int a = 0; a < 2; ++a)
#pragma unroll
        for (int b = 0; b < 2; ++b)
#pragma unroll
            for (int m = 0; m < 4; ++m)
#pragma unroll
                for (int n = 0; n < 2; ++n) acc[a][b][m][n] = (f32x4){0.f, 0.f, 0.f, 0.f};
    typedef int i32x4_ __attribute__((ext_vector_type(4)));
    int f8one = 0x7F7F7F7F; asm volatile("" : "+v"(f8one));
    u32x4 At[4][2], B0[2][2], B1[2][2];
    const char* cA = (const char*)g.A + (size_t)cur.pa * tstepA; const char* cB = (const char*)g.Bt + (size_t)cur.pb * (FULLN ? tstepB : hstepB);
    PG8_STAGE(PG8_SB(0, 0), cB, voffB); PG8_STAGE(PG8_SB(0, 1), cB + hstepB, voffB); PG8_STAGE(PG8_SA(0, 0), cA, voffA); PG8_STAGE(PG8_SA(0, 1), cA + hstepA, voffA);
    if (wr == 1) PG8_BAR;
    PG8_WAIT_V(2); PG8_BAR;
    PG8_STAGE(PG8_SB(1, 0), cB + kstep, voffB); PG8_STAGE(PG8_SA(1, 0), cA + kstep, voffA); PG8_STAGE(PG8_SB(1, 1), cB + hstepB + kstep, voffB);
    PG8_WAIT_V(6); PG8_BAR;
    for (;;) {
        const bool has_next = S.next(ui + 1, nxt);
        const char* nA = has_next ? (const char*)g.A + (size_t)nxt.pa * tstepA : cA; const char* nB = has_next ? (const char*)g.Bt + (size_t)nxt.pb * (FULLN ? tstepB : hstepB) : cB;
        for (int t = 0; t < nt; t += 2) {
            const bool last = (t == nt - 2);
            const char* a1 = cA + (size_t)(t + 1) * kstep;
            const char* a2 = last ? nA : cA + (size_t)(t + 2) * kstep; const char* b2 = last ? nB : cB + (size_t)(t + 2) * kstep;
            const char* a3 = a2 + kstep; const char* b3 = b2 + kstep;
            PG8_LDB(B0, 0, 0); if constexpr (FULLN) PG8_LDB(B1, 0, 1); PG8_SCHED; PG8_LDA(At, 0, 0); PG8_STAGE(PG8_SA(1, 1), a1 + hstepA, voffA);
            PG8_WAIT_V(8); PG8_WAIT_L(0); PG8_BAR; PG8_MMA(0, 0, At, B0); if constexpr (FULLN) PG8_MMA(0, 1, At, B1); PG8_BAR; PG8_SCHED;
            PG8_LDA(At, 0, 1); PG8_STAGE(PG8_SB(0, 0), b2, voffB); PG8_STAGE(PG8_SB(0, 1), b2 + hstepB, voffB); PG8_STAGE(PG8_SA(0, 0), a2, voffA);
            PG8_WAIT_V(8); PG8_WAIT_L(0); PG8_BAR; PG8_MMA(1, 0, At, B0); if constexpr (FULLN) PG8_MMA(1, 1, At, B1); PG8_BAR; PG8_SCHED;
            PG8_LDB(B0, 1, 0); if constexpr (FULLN) PG8_LDB(B1, 1, 1); PG8_SCHED; PG8_LDA(At, 1, 0); PG8_STAGE(PG8_SA(0, 1), a2 + hstepA, voffA);
            PG8_WAIT_V(8); PG8_WAIT_L(0); PG8_BAR; PG8_MMA(0, 0, At, B0); if constexpr (FULLN) PG8_MMA(0, 1, At, B1); PG8_BAR; PG8_SCHED;
            PG8_LDA(At, 1, 1); PG8_STAGE(PG8_SB(1, 0), b3, voffB); PG8_STAGE(PG8_SB(1, 1), b3 + hstepB, voffB); PG8_STAGE(PG8_SA(1, 0), a3, voffA);
            PG8_WAIT_V(8); PG8_WAIT_L(0); PG8_BAR; PG8_MMA(1, 0, At, B0); if constexpr (FULLN) PG8_MMA(1, 1, At, B1); PG8_BAR; PG8_SCHED;
        }
        if (wr == 0) PG8_BAR;
        asm volatile("s_nop 15\n\ts_nop 15" : "+v"(acc[0][0][0][0]), "+v"(acc[0][0][0][1]), "+v"(acc[0][0][1][0]), "+v"(acc[0][0][1][1]), "+v"(acc[0][0][2][0]), "+v"(acc[0][0][2][1]), "+v"(acc[0][0][3][0]), "+v"(acc[0][0][3][1]) :: "memory");
        PIN_ACC8(&acc[0][1][0][0]); PIN_ACC8(&acc[1][0][0][0]); PIN_ACC8(&acc[1][1][0][0]);
        E(acc, cur, wr, wc, fr, fq);
        if (!has_next) break;
#pragma unroll
        for (int a = 0; a < 2; ++a)
#pragma unroll
            for (int b = 0; b < 2; ++b)
#pragma unroll
                for (int m = 0; m < 4; ++m)
#pragma unroll
                    for (int n = 0; n < 2; ++n) acc[a][b][m][n] = (f32x4){0.f, 0.f, 0.f, 0.f};
        cur = nxt; cA = nA; cB = nB; ++ui;
        if (wr == 1) PG8_BAR;
    }
    PG8_WAIT_V(0);
    PG8_BAR;
#undef PG8_SA
#undef PG8_SB
#undef PG8_STAGE
#undef PG8_LDA
#undef PG8_LDB
#undef PG8_MMA
#undef PG8_F8OP
#undef PG8_WAIT_V
#undef PG8_WAIT_L
#undef PG8_BAR
#undef PG8_SCHED
}
#else
template <class Epi, class Sched>
static void gemm_phase(unsigned char* lds, const Gemm g, const Sched& S, const Epi& E, int wave_id) {
    const int tid = threadIdx.x, wid = tid >> 6, lane = tid & 63, wr = wid >> 2, wc = wid & 3, fr = lane & 15, fq = lane >> 4;
    static thread_local float* Cbuf = nullptr; static thread_local float* Af = nullptr; static thread_local float* Bf = nullptr;
    Unit u;
    for (int i = 0; S.next(i, u); ++i) {
        __syncthreads();
        if constexpr (Epi::HAS_PREP) E.prep(u, tid);
        if (tid == 0) {
            if (!Cbuf) { Cbuf = (float*)malloc(256 * 256 * 4); Af = (float*)malloc((size_t)256 * 8192 * 4); Bf = (float*)malloc((size_t)256 * 8192 * 4); }
            const int K = g.K;
            for (int r = 0; r < 256; ++r) for (int k = 0; k < K; ++k) { Af[(size_t)r * K + k] = bf2f(g.A[((size_t)u.pa * 256 + r) * g.lda + k]); Bf[(size_t)r * K + k] = bf2f(g.Bt[((size_t)u.pb * 256 + r) * g.ldb + k]); }
            for (int r = 0; r < 256; ++r) for (int c = 0; c < 256; ++c) { const float* a = Af + (size_t)r * K; const float* b = Bf + (size_t)c * K; float s = 0.f;
                for (int k = 0; k < K; ++k) s += a[k] * b[k]; Cbuf[r * 256 + c] = s; }
        }
        __syncthreads();
        f32x4 acc[2][2][4][2];
        for (int ai = 0; ai < 2; ++ai) for (int bj = 0; bj < 2; ++bj) for (int m = 0; m < 4; ++m) for (int n = 0; n < 2; ++n) for (int j = 0; j < 4; ++j) {
            const int r = 128 * ai + 64 * wr + 16 * m + fr;
            const int c = Epi::PERM ? (128 * bj + 32 * wc + 8 * fq + 4 * n + j) : (128 * bj + 32 * wc + 16 * n + 4 * fq + j);
            acc[ai][bj][m][n][j] = Cbuf[r * 256 + c]; }
        E(acc, u, wr, wc, fr, fq);
    }
    __syncthreads();
}
#endif

typedef const f32x4 (&AccRef)[2][2][4][2];
struct EpiBf16 {
    static constexpr bool PERM = true; static constexpr bool HAS_PREP = false;
    bf16_t* O; int ldc;
    DI void operator()(AccRef acc, const Unit& u, int wr, int wc, int fr, int fq) const {
        const int row0 = u.pm * BM + wr * 64 + fr, col0 = u.pn * BM + wc * 32 + 8 * fq;
        float one = 1.0f; LAUNDER_S(one);
#pragma unroll
        for (int ai = 0; ai < 2; ++ai)
#pragma unroll
            for (int m = 0; m < 4; ++m) { bf16_t* rowp = O + (size_t)(row0 + ai * HALF + m * 16) * ldc + col0;
#pragma unroll
                for (int bj = 0; bj < 2; ++bj) { const f32x4 v0 = acc[ai][bj][m][0] * one, v1 = acc[ai][bj][m][1] * one;
                    u32x4 w; w.x = cvt_pk_bf16(v0[0], v0[1]); w.y = cvt_pk_bf16(v0[2], v0[3]); w.z = cvt_pk_bf16(v1[0], v1[1]); w.w = cvt_pk_bf16(v1[2], v1[3]);
                    *(u32x4*)(rowp + bj * HALF) = w; } }
    }
};
template <int NBJ, bool SIGM = false> struct EpiBf16S {
    static constexpr bool PERM = true; static constexpr bool HAS_PREP = false;
    bf16_t* O; int ldc; float scale;
    DI void operator()(AccRef acc, const Unit& u, int wr, int wc, int fr, int fq) const {
        const int row0 = u.pm * BM + wr * 64 + fr, col0 = u.pn * (HALF * NBJ) + wc * 32 + 8 * fq;
#pragma unroll
        for (int ai = 0; ai < 2; ++ai)
#pragma unroll
            for (int m = 0; m < 4; ++m) { bf16_t* rowp = O + (size_t)(row0 + ai * HALF + m * 16) * ldc + col0;
#pragma unroll
                for (int bj = 0; bj < NBJ; ++bj) { f32x4 v0 = acc[ai][bj][m][0] * scale, v1 = acc[ai][bj][m][1] * scale;
                    if constexpr (SIGM) {
#pragma unroll
                        for (int q = 0; q < 4; ++q) { v0[q] = frcp(1.0f + fexp2(v0[q] * -1.4426950408889634f)); v1[q] = frcp(1.0f + fexp2(v1[q] * -1.4426950408889634f)); } }
                    u32x4 w; w.x = cvt_pk_bf16(v0[0], v0[1]); w.y = cvt_pk_bf16(v0[2], v0[3]); w.z = cvt_pk_bf16(v1[0], v1[1]); w.w = cvt_pk_bf16(v1[2], v1[3]);
                    *(u32x4*)(rowp + bj * HALF) = w; } }
    }
};
struct EpiGate8 {
    static constexpr bool PERM = true; static constexpr bool HAS_PREP = false;
    unsigned char* G; float scale;
    DI void operator()(AccRef acc, const Unit& u, int wr, int wc, int fr, int fq) const {
        const int row0 = u.pm * BM + wr * 64 + fr, col0 = u.pn * BM + wc * 32 + 8 * fq;
#pragma unroll
        for (int ai = 0; ai < 2; ++ai)
#pragma unroll
            for (int m = 0; m < 4; ++m) { unsigned char* rowp = G + (size_t)(row0 + ai * HALF + m * 16) * (4 * D) + col0;
#pragma unroll
                for (int bj = 0; bj < 2; ++bj) { const f32x4 v0 = acc[ai][bj][m][0] * scale, v1 = acc[ai][bj][m][1] * scale; unsigned b[8];
#pragma unroll
                    for (int q = 0; q < 4; ++q) { b[q] = (unsigned)(frcp(1.0f + fexp2(v0[q] * -1.4426950408889634f)) * 255.0f + 0.5f); b[4 + q] = (unsigned)(frcp(1.0f + fexp2(v1[q] * -1.4426950408889634f)) * 255.0f + 0.5f); }
                    u32x2 w; w.x = b[0] | (b[1] << 8) | (b[2] << 16) | (b[3] << 24); w.y = b[4] | (b[5] << 8) | (b[6] << 16) | (b[7] << 24);
                    *(u32x2*)(rowp + bj * HALF) = w; } }
    }
};
template <int NBJ> struct EpiSwiGLU8 {
    static constexpr bool PERM = true; static constexpr bool HAS_PREP = false;
    unsigned char* act8; float scale;
    DI void operator()(AccRef acc, const Unit& u, int wr, int wc, int fr, int fq) const {
        const int row0 = u.pm * BM + wr * 64 + fr;
#pragma unroll
        for (int ai = 0; ai < 2; ++ai)
#pragma unroll
            for (int m = 0; m < 4; ++m)
#pragma unroll
                for (int bj = 0; bj < NBJ; ++bj) { const int col0 = (u.pn * NBJ + bj) * 64 + 4 * (4 * wc + fq);
                    const f32x4 a = acc[ai][bj][m][0] * scale, b = acc[ai][bj][m][1] * scale; float o[4];
#pragma unroll
                    for (int j = 0; j < 4; ++j) o[j] = siluf_(a[j]) * b[j] * F8_ASCALE;
                    *(unsigned*)(act8 + (size_t)(row0 + ai * HALF + m * 16) * FFN + col0) = cvt_pk4_fp8(o[0], o[1], o[2], o[3]); }
    }
};
struct EpiU {
    static constexpr bool PERM = true; static constexpr bool HAS_PREP = true;
    bf16_t* U; float* SM; const float* rstd; LAS float* tab;
    DI void prep(const Unit& u, int tid) const { if (tid < 256) tab[(u.ui & 1) * 256 + tid] = rstd[u.pm * BM + tid]; }
    DI void operator()(AccRef acc, const Unit& u, int wr, int wc, int fr, int fq) const {
        const int row0 = u.pm * BM + wr * 64 + fr;
        const LAS float* tb = tab + (u.ui & 1) * 256 + wr * 64 + fr;
        if (u.pn == SM_TILE) {
#pragma unroll
            for (int ai = 0; ai < 2; ++ai)
#pragma unroll
                for (int m = 0; m < 4; ++m) { float* rowp = SM + (size_t)(row0 + ai * HALF + m * 16) * 256 + wc * 32 + 8 * fq; const float rs = tb[ai * HALF + m * 16];
#pragma unroll
                    for (int bj = 0; bj < 2; ++bj) { *(f32x4*)(rowp + bj * HALF) = acc[ai][bj][m][0] * rs; *(f32x4*)(rowp + bj * HALF + 4) = acc[ai][bj][m][1] * rs; } }
        } else {
            const int col0 = u.pn * BM + wc * 32 + 8 * fq;
#pragma unroll
            for (int ai = 0; ai < 2; ++ai)
#pragma unroll
                for (int m = 0; m < 4; ++m) { bf16_t* rowp = U + (size_t)(row0 + ai * HALF + m * 16) * UWP + col0; const float rs = tb[ai * HALF + m * 16];
#pragma unroll
                    for (int bj = 0; bj < 2; ++bj) { const f32x4 v0 = acc[ai][bj][m][0] * rs, v1 = acc[ai][bj][m][1] * rs;
                        u32x4 w; w.x = cvt_pk_bf16(v0[0], v0[1]); w.y = cvt_pk_bf16(v0[2], v0[3]); w.z = cvt_pk_bf16(v1[0], v1[1]); w.w = cvt_pk_bf16(v1[2], v1[3]);
                        *(u32x4*)(rowp + bj * HALF) = w; } }
        }
    }
};
struct EpiPart {
    static constexpr bool PERM = true; static constexpr bool HAS_PREP = false;
    float* dst; float scale;
    DI void operator()(AccRef a, const Unit& u, int wr, int wc, int fr, int fq) const {
        const int row0 = wr * 64 + fr, col0 = wc * 32 + 8 * fq;
#pragma unroll
        for (int ai = 0; ai < 2; ++ai)
#pragma unroll
            for (int m = 0; m < 4; ++m) { float* rowp = dst + (row0 + ai * HALF + m * 16) * 256 + col0;
#pragma unroll
                for (int bj = 0; bj < 2; ++bj) { *(f32x4*)(rowp + bj * HALF) = a[ai][bj][m][0] * scale; *(f32x4*)(rowp + bj * HALF + 4) = a[ai][bj][m][1] * scale; } }
    }
};
struct EpiNull {
    static constexpr bool PERM = true; static constexpr bool HAS_PREP = false;
    float* sink;
    DI void operator()(AccRef acc, const Unit& u, int wr, int wc, int fr, int fq) const {
        f32x4 s = {0.f, 0.f, 0.f, 0.f};
#pragma unroll
        for (int ai = 0; ai < 2; ++ai)
#pragma unroll
            for (int bj = 0; bj < 2; ++bj)
#pragma unroll
                for (int m = 0; m < 4; ++m)
#pragma unroll
                    for (int n = 0; n < 2; ++n) s += acc[ai][bj][m][n];
        if (s[0] + s[1] + s[2] + s[3] == 123456.789f) sink[0] = s[0];
    }
};
struct EpiUL2 {
    static constexpr bool PERM = true; static constexpr bool HAS_PREP = false;
    bf16_t* T;
    DI void operator()(AccRef acc, const Unit& u, int wr, int wc, int fr, int fq) const {
        const int row0 = wr * 64 + fr, col0 = wc * 32 + 8 * fq;
#pragma unroll
        for (int ai = 0; ai < 2; ++ai)
#pragma unroll
            for (int m = 0; m < 4; ++m) { bf16_t* rowp = T + (size_t)(row0 + ai * HALF + m * 16) * 256 + col0;
#pragma unroll
                for (int bj = 0; bj < 2; ++bj) { const f32x4 v0 = acc[ai][bj][m][0], v1 = acc[ai][bj][m][1];
                    u32x4 w; w.x = cvt_pk_bf16(v0[0], v0[1]); w.y = cvt_pk_bf16(v0[2], v0[3]); w.z = cvt_pk_bf16(v1[0], v1[1]); w.w = cvt_pk_bf16(v1[2], v1[3]);
                    *(u32x4*)(rowp + bj * HALF) = w; } }
    }
};
template <bool SSQ> struct EpiResidT {
    static constexpr bool PERM = true; static constexpr bool HAS_PREP = false;
    const bf16_t* base; bf16_t* out; float* ssq;
    DI void operator()(AccRef acc, const Unit& u, int wr, int wc, int fr, int fq) const {
        const int row0 = u.pm * BM + wr * 64 + fr, col0 = u.pn * BM + wc * 32 + 8 * fq;
        u32x4 bv[4][2];
#define ER_LOAD(slot, rg) do { const size_t off_ = (size_t)(row0 + ((rg) >> 2) * HALF + ((rg) & 3) * 16) * D + col0; \
        _Pragma("unroll") for (int bj_ = 0; bj_ < 2; ++bj_) bv[slot][bj_] = *(const u32x4*)(base + off_ + bj_ * HALF); } while (0)
        ER_LOAD(0, 0); ER_LOAD(1, 1); ER_LOAD(2, 2);
#pragma unroll
        for (int rg = 0; rg < 8; ++rg) { const int ai = rg >> 2, m = rg & 3; const size_t off = (size_t)(row0 + ai * HALF + m * 16) * D + col0;
            if (rg + 3 < 8) ER_LOAD((rg + 3) & 3, rg + 3);
            asm volatile("" ::: "memory");
            float sq = 0.f;
#pragma unroll
            for (int bj = 0; bj < 2; ++bj) { const u32x4 b = bv[rg & 3][bj];
                const f32x4 v0 = (f32x4){bflo(b.x), bfhi(b.x), bflo(b.y), bfhi(b.y)} + acc[ai][bj][m][0], v1 = (f32x4){bflo(b.z), bfhi(b.z), bflo(b.w), bfhi(b.w)} + acc[ai][bj][m][1];
                if constexpr (SSQ) sq += (v0[0] * v0[0] + v0[1] * v0[1]) + (v0[2] * v0[2] + v0[3] * v0[3]) + (v1[0] * v1[0] + v1[1] * v1[1]) + (v1[2] * v1[2] + v1[3] * v1[3]);
                u32x4 w; w.x = cvt_pk_bf16(v0[0], v0[1]); w.y = cvt_pk_bf16(v0[2], v0[3]); w.z = cvt_pk_bf16(v1[0], v1[1]); w.w = cvt_pk_bf16(v1[2], v1[3]);
                *(u32x4*)(out + off + bj * HALF) = w; }
            if constexpr (SSQ) { sq += shfl_xor_f(sq, 16); sq += shfl_xor_f(sq, 32);
                if (fq == 0) ssq[(size_t)(row0 + ai * HALF + m * 16) * 32 + u.pn * 4 + wc] = sq; } }
#undef ER_LOAD
    }
};
typedef EpiResidT<false> EpiResid;
constexpr int RS_TAB = STAGE_BYTES;
DI float row_rstd(const float* ssq, int row) { const f32x4* p = (const f32x4*)(ssq + (size_t)row * 32); f32x4 t = p[0];
#pragma unroll
    for (int j = 1; j < 8; ++j) t += p[j];
    return 1.0f / sqrtf(((t[0] + t[1]) + (t[2] + t[3])) * (1.0f / D) + RMS_EPS); }
struct EpiBf16R {
    static constexpr bool PERM = true; static constexpr bool HAS_PREP = true;
    bf16_t* O; int ldc; const float* ssq; LAS float* tab;
    DI void prep(const Unit& u, int tid) const { if (tid < 256) tab[(u.ui & 1) * 256 + tid] = row_rstd(ssq, u.pm * BM + tid); }
    DI void operator()(AccRef acc, const Unit& u, int wr, int wc, int fr, int fq) const {
        const int row0 = u.pm * BM + wr * 64 + fr, col0 = u.pn * BM + wc * 32 + 8 * fq;
        const LAS float* tb = tab + (u.ui & 1) * 256 + wr * 64 + fr;
#pragma unroll
        for (int ai = 0; ai < 2; ++ai)
#pragma unroll
            for (int m = 0; m < 4; ++m) { bf16_t* rowp = O + (size_t)(row0 + ai * HALF + m * 16) * ldc + col0; const float rs = tb[ai * HALF + m * 16];
#pragma unroll
                for (int bj = 0; bj < 2; ++bj) { const f32x4 v0 = acc[ai][bj][m][0] * rs, v1 = acc[ai][bj][m][1] * rs;
                    u32x4 w; w.x = cvt_pk_bf16(v0[0], v0[1]); w.y = cvt_pk_bf16(v0[2], v0[3]); w.z = cvt_pk_bf16(v1[0], v1[1]); w.w = cvt_pk_bf16(v1[2], v1[3]);
                    *(u32x4*)(rowp + bj * HALF) = w; } }
    }
};
struct EpiMerge {
    static constexpr bool PERM = true; static constexpr bool HAS_PREP = false;
    const unsigned char* G; bf16_t* merged;
    DI void operator()(AccRef acc, const Unit& u, int wr, int wc, int fr, int fq) const {
        const int row0 = u.pm * BM + wr * 64 + fr, col0 = u.pn * BM + wc * 32 + 8 * fq, n_br = u.aux;
        u32x2 gv[4][2]; u32x4 pv[4][2];
#define EM_LOAD(slot, rg) do { const size_t row_ = (size_t)(row0 + ((rg) >> 2) * HALF + ((rg) & 3) * 16); \
        _Pragma("unroll") for (int bj_ = 0; bj_ < 2; ++bj_) { gv[slot][bj_] = *(const u32x2*)(G + row_ * (4 * D) + n_br * D + col0 + bj_ * HALF); \
            if (n_br > 0) pv[slot][bj_] = *(const u32x4*)(merged + row_ * D + col0 + bj_ * HALF); } } while (0)
        EM_LOAD(0, 0); EM_LOAD(1, 1); EM_LOAD(2, 2);
#pragma unroll
        for (int rg = 0; rg < 8; ++rg) { const int ai = rg >> 2, m = rg & 3; const size_t row = (size_t)(row0 + ai * HALF + m * 16);
            if (rg + 3 < 8) EM_LOAD((rg + 3) & 3, rg + 3);
            asm volatile("" ::: "memory");
#pragma unroll
            for (int bj = 0; bj < 2; ++bj) { const int c = col0 + bj * HALF; const u32x2 gw = gv[rg & 3][bj];
                f32x4 v0 = acc[ai][bj][m][0], v1 = acc[ai][bj][m][1];
                {
                    const float k = 1.0f / 255.0f;
                    v0[0] *= (float)(gw.x & 255u) * k; v0[1] *= (float)((gw.x >> 8) & 255u) * k; v0[2] *= (float)((gw.x >> 16) & 255u) * k; v0[3] *= (float)(gw.x >> 24) * k;
                    v1[0] *= (float)(gw.y & 255u) * k; v1[1] *= (float)((gw.y >> 8) & 255u) * k; v1[2] *= (float)((gw.y >> 16) & 255u) * k; v1[3] *= (float)(gw.y >> 24) * k; }
                if (n_br > 0) { const u32x4 pw = pv[rg & 3][bj];
                    v0[0] += bflo(pw.x); v0[1] += bfhi(pw.x); v0[2] += bflo(pw.y); v0[3] += bfhi(pw.y); v1[0] += bflo(pw.z); v1[1] += bfhi(pw.z); v1[2] += bflo(pw.w); v1[3] += bfhi(pw.w); }
                u32x4 w; w.x = cvt_pk_bf16(v0[0], v0[1]); w.y = cvt_pk_bf16(v0[2], v0[3]); w.z = cvt_pk_bf16(v1[0], v1[1]); w.w = cvt_pk_bf16(v1[2], v1[3]);
                *(u32x4*)(merged + row * D + c) = w; } }
#undef EM_LOAD
    }
};
struct EpiSwiGLU {
    static constexpr bool PERM = true; static constexpr bool HAS_PREP = false;
    bf16_t* act;
    DI void operator()(AccRef acc, const Unit& u, int wr, int wc, int fr, int fq) const {
        const int row0 = u.pm * BM + wr * 64 + fr, col0 = u.pn * HALF + wc * 32 + 8 * fq;
#pragma unroll
        for (int ai = 0; ai < 2; ++ai)
#pragma unroll
            for (int m = 0; m < 4; ++m) { bf16_t* rowp = act + (size_t)(row0 + ai * HALF + m * 16) * FFN + col0;
                float o[8];
#pragma unroll
                for (int n = 0; n < 2; ++n)
#pragma unroll
                    for (int jp = 0; jp < 2; ++jp) {
                        const f32x2 a = {acc[ai][0][m][n][2 * jp], acc[ai][0][m][n][2 * jp + 1]}, b = {acc[ai][1][m][n][2 * jp], acc[ai][1][m][n][2 * jp + 1]};
                        const f32x2 t = a * (-1.4426950408889634f); f32x2 e; e.x = fexp2(t.x); e.y = fexp2(t.y);
                        const f32x2 d = e + 1.0f; f32x2 r; r.x = frcp(d.x); r.y = frcp(d.y);
                        const f32x2 y = (a * b) * r; o[4 * n + 2 * jp] = y.x; o[4 * n + 2 * jp + 1] = y.y; }
                u32x4 w; w.x = cvt_pk_bf16(o[0], o[1]); w.y = cvt_pk_bf16(o[2], o[3]); w.z = cvt_pk_bf16(o[4], o[5]); w.w = cvt_pk_bf16(o[6], o[7]);
                *(u32x4*)rowp = w; asm volatile("" ::: "memory"); }
    }
};
struct EpiSwiGLUR {
    static constexpr bool PERM = true; static constexpr bool HAS_PREP = true;
    bf16_t* act; const float* ssq; LAS float* tab;
    DI void prep(const Unit& u, int tid) const { if (tid < 256) tab[(u.ui & 1) * 256 + tid] = row_rstd(ssq, u.pm * BM + tid); }
    DI void operator()(AccRef acc, const Unit& u, int wr, int wc, int fr, int fq) const {
        const int row0 = u.pm * BM + wr * 64 + fr, col0 = u.pn * HALF + wc * 32 + 8 * fq;
        const LAS float* tb = tab + (u.ui & 1) * 256 + wr * 64 + fr;
#pragma unroll
        for (int ai = 0; ai < 2; ++ai)
#pragma unroll
            for (int m = 0; m < 4; ++m) { bf16_t* rowp = act + (size_t)(row0 + ai * HALF + m * 16) * FFN + col0; const float rs = tb[ai * HALF + m * 16];
                float o[8];
#pragma unroll
                for (int n = 0; n < 2; ++n)
#pragma unroll
                    for (int jp = 0; jp < 2; ++jp) {
                        const f32x2 a = (f32x2){acc[ai][0][m][n][2 * jp], acc[ai][0][m][n][2 * jp + 1]} * rs, b = (f32x2){acc[ai][1][m][n][2 * jp], acc[ai][1][m][n][2 * jp + 1]} * rs;
                        const f32x2 t = a * (-1.4426950408889634f); f32x2 e; e.x = fexp2(t.x); e.y = fexp2(t.y);
                        const f32x2 d = e + 1.0f; f32x2 r; r.x = frcp(d.x); r.y = frcp(d.y);
                        const f32x2 y = (a * b) * r; o[4 * n + 2 * jp] = y.x; o[4 * n + 2 * jp + 1] = y.y; }
                u32x4 w; w.x = cvt_pk_bf16(o[0], o[1]); w.y = cvt_pk_bf16(o[2], o[3]); w.z = cvt_pk_bf16(o[4], o[5]); w.w = cvt_pk_bf16(o[6], o[7]);
                *(u32x4*)rowp = w; asm volatile("" ::: "memory"); }
    }
};
#ifdef HOST_EMU
template <class Epi, class Sched, bool FULLN = false>
static void gemm_phase_f8(unsigned char* lds, const Gemm g, const Sched& S, const Epi& E, int wave_id) {
    const int tid = threadIdx.x, wid = tid >> 6, lane = tid & 63, wr = wid >> 2, wc = wid & 3, fr = lane & 15, fq = lane >> 4;
    static thread_local float* Cbuf = nullptr; static thread_local float* Af = nullptr; static thread_local float* Bf = nullptr;
    Unit u;
    for (int i = 0; S.next(i, u); ++i) {
        __syncthreads();
        if (tid == 0) {
            if (!Cbuf) { Cbuf = (float*)malloc(256 * 256 * 4); Af = (float*)malloc((size_t)256 * 8192 * 4); Bf = (float*)malloc((size_t)256 * 8192 * 4); }
            const int K = 2 * g.K; const unsigned char* A8 = (const unsigned char*)g.A; const unsigned char* B8 = (const unsigned char*)g.Bt;
            for (int r = 0; r < 256; ++r) for (int k = 0; k < K; ++k) { Af[(size_t)r * K + k] = fp82f_host(A8[((size_t)u.pa * 256 + r) * 2 * g.lda + k]); Bf[(size_t)r * K + k] = (FULLN || r < 128) ? fp82f_host(B8[((size_t)u.pb * (FULLN ? 256 : 128) + r) * 2 * g.ldb + k]) : 0.f; }
            for (int r = 0; r < 256; ++r) for (int c = 0; c < 256; ++c) { const float* a = Af + (size_t)r * K; const float* b = Bf + (size_t)c * K; float sum = 0.f;
                for (int k = 0; k < K; ++k) sum += a[k] * b[k]; Cbuf[r * 256 + c] = sum; }
        }
        __syncthreads();
        f32x4 acc[2][2][4][2];
        for (int ai = 0; ai < 2; ++ai) for (int bj = 0; bj < 2; ++bj) for (int m = 0; m < 4; ++m) for (int n = 0; n < 2; ++n) for (int j = 0; j < 4; ++j) {
            const int r = 128 * ai + 64 * wr + 16 * m + fr;
            const int c = 128 * bj + 32 * wc + 8 * fq + 4 * n + j;
            acc[ai][bj][m][n][j] = Cbuf[r * 256 + c]; }
        E(acc, u, wr, wc, fr, fq);
    }
    __syncthreads();
}
#endif
}

struct Frame {
    unsigned char* lds; int tid, lane, wave, G, bid, flags;
    const float* const* in; float* out; unsigned char* ws;
#ifndef HOST_EMU
    template <class T> DI T* wp(size_t off) const { return (T*)(GAS T*)(ws + off); }
    DI const float* inp(int i) const { return (const float*)(GAS const float*)in[i]; }
    DI float* outp() const { return (float*)(GAS float*)out; }
#else
    template <class T> DI T* wp(size_t off) const { return (T*)(ws + off); }
    DI const float* inp(int i) const { return in[i]; }
    DI float* outp() const { return out; }
#endif
};

DI void make_frame(Frame& F, const Params& P, unsigned char* lds, int wave0) {
#ifndef HOST_EMU
    int wv = wave0; LAUNDER_S(wv); int ln = lane_id_hw(); LAUNDER_V(ln); int tid = wv * 64 + ln;
#else
    int tid = threadIdx.x;
#endif
    size_t wz = 0; LAUNDER_S(wz); unsigned char* ws = P.ws + wz;
    F.lds = lds; F.tid = tid; F.lane = tid & 63; F.wave = tid >> 6;
#ifndef HOST_EMU
    F.wave = wv;
#endif
    F.G = gridDim.x; F.bid = blockIdx.x;
    F.in = P.in; F.out = P.out; F.ws = ws; F.flags = P.flags;
}
#define REFRAME() make_frame(F, P, lds, wave0)
DI bf16x8 frag_r(const bf16_t* T, int pitch, int r0, int k0, int lane) { return *(const bf16x8*)(T + (r0 + (lane & 15)) * pitch + k0 + 8 * (lane >> 4)); }
DI bf16x8 frag_k(const bf16_t* T, int pitch, int k0, int n0, int lane) {
    const int g = lane >> 4, q = (lane & 15) >> 2, p = lane & 3;
    const bf16_t* p0 = T + (k0 + 8 * g + q) * pitch + n0 + 4 * p;
    const s16x4 lo = lds_tr4(p0), hi = lds_tr4(p0 + 4 * pitch);
    return __builtin_shufflevector(lo, hi, 0, 1, 2, 3, 4, 5, 6, 7);
}
#ifndef HOST_EMU
template <int CTRL> DI float dppf(float v) { return __builtin_bit_cast(float, __builtin_amdgcn_update_dpp(0, __builtin_bit_cast(int, v), CTRL, 0xF, 0xF, true)); }
DI float grp16_max(float v) { v = fmaxf(v, dppf<0xB1>(v)); v = fmaxf(v, dppf<0x4E>(v)); v = fmaxf(v, dppf<0x141>(v)); v = fmaxf(v, dppf<0x140>(v)); return v; }
DI float grp16_sum(float v) { v += dppf<0xB1>(v); v += dppf<0x4E>(v); v += dppf<0x141>(v); v += dppf<0x140>(v); return v; }
#else
DI float grp16_max(float v) { v = fmaxf(v, shfl_xor_f(v, 1)); v = fmaxf(v, shfl_xor_f(v, 2)); v = fmaxf(v, shfl_xor_f(v, 4)); v = fmaxf(v, shfl_xor_f(v, 8)); return v; }
DI float grp16_sum(float v) { v += shfl_xor_f(v, 1); v += shfl_xor_f(v, 2); v += shfl_xor_f(v, 4); v += shfl_xor_f(v, 8); return v; }
#endif

template <class ColMap>
DI void tr_load(const float* W, int ldw, const ColMap& cm, int item, int nblk  , int lane, f32x4 (&v)[16]) {
    const int kb = item / nblk, nb = item - kb * nblk, k0 = 64 * kb, n0 = 64 * nb;
    const int col = cm(n0 + 4 * (lane & 15)), rq = lane >> 4;
#pragma unroll
    for (int i = 0; i < 16; ++i) v[i] = (f32x4){0.f, 0.f, 0.f, 0.f};
    if (col >= 0) {
        const float* src = W + (size_t)(k0 + rq) * ldw + col;
#pragma unroll
        for (int i = 0; i < 16; ++i) v[i] = *(const f32x4*)(src + (size_t)(4 * i) * ldw);
    }
}
DI void tr_store(int K, bf16_t* WT, bf16_t* scr  , int item, int nblk, int lane, const f32x4 (&v)[16], const float* ks  ) {
    const int kb = item / nblk, nb = item - kb * nblk, k0 = 64 * kb, n0 = 64 * nb, rq = lane >> 4;
#pragma unroll
    for (int i = 0; i < 16; ++i) { f32x4 x = v[i]; if (ks) x *= ks[k0 + rq + 4 * i];
        u32x2 o; o.x = cvt_pk_bf16(x[0], x[1]); o.y = cvt_pk_bf16(x[2], x[3]); *(u32x2*)(scr + (rq + 4 * i) * 72 + 4 * (lane & 15)) = o; }
    WAVE_FENCE();
#pragma unroll
    for (int kq = 0; kq < 2; ++kq)
#pragma unroll
        for (int nq = 0; nq < 4; ++nq) { const bf16x8 f = frag_k(scr, 72, 32 * kq, 16 * nq, lane);
            *(bf16x8*)(WT + (size_t)(n0 + 16 * nq + (lane & 15)) * K + k0 + 32 * kq + 8 * (lane >> 4)) = f; }
    WAVE_FENCE();
}
DI void tr_store_f8(int K, unsigned char* WT8, bf16_t* scr, int item, int nblk, int lane, const f32x4 (&v)[16], float wscale) {
    const int kb = item / nblk, nb = item - kb * nblk, k0 = 64 * kb, n0 = 64 * nb, rq = lane >> 4;
#pragma unroll
    for (int i = 0; i < 16; ++i) { u32x2 o; o.x = cvt_pk_bf16(v[i][0] * wscale, v[i][1] * wscale); o.y = cvt_pk_bf16(v[i][2] * wscale, v[i][3] * wscale); *(u32x2*)(scr + (rq + 4 * i) * 72 + 4 * (lane & 15)) = o; }
    WAVE_FENCE();
#pragma unroll
    for (int kq = 0; kq < 2; ++kq)
#pragma unroll
        for (int nq = 0; nq < 4; ++nq) { const bf16x8 f = frag_k(scr, 72, 32 * kq, 16 * nq, lane);
            u32x2 o; o.x = cvt_pk4_fp8(bf2f((bf16_t)f[0]), bf2f((bf16_t)f[1]), bf2f((bf16_t)f[2]), bf2f((bf16_t)f[3])); o.y = cvt_pk4_fp8(bf2f((bf16_t)f[4]), bf2f((bf16_t)f[5]), bf2f((bf16_t)f[6]), bf2f((bf16_t)f[7]));
            *(u32x2*)(WT8 + (size_t)(n0 + 16 * nq + (lane & 15)) * K + k0 + 32 * kq + 8 * (lane >> 4)) = o; }
    WAVE_FENCE();
}
struct CmGate { DI int operator()(int n) const { return SO_GATE + n; } };
struct CmW13F8 { DI int operator()(int r) const { const int pn = r >> 7, c = r & 127, q = c >> 3, n = (c >> 2) & 1, j = c & 3; return (n ? FFN : 0) + 64 * pn + 4 * q + j; } };
struct CmIdent { DI int operator()(int n) const { return n; } };
struct CmWin { DI int operator()(int r) const {
    if (r < 3072) return r;
    if (r < 4096) return SO_SSZ + (r - 3072);
    if (r < 5632) return SO_XBC + (r - 4096);
    if (r < 6144) return SO_CQ + (r - 5632);
    if (r < 6400) return SO_CKV + (r - 6144);
    if (r < 6656) { const int j = r - 6400; if (j < 64) return SO_KR + j; if (j < 72) return SO_MLI + (j - 64); if (j < 88) return SO_DT + (j - 72); return -1; }
    if (r < 7680) return SO_SWQ + (r - 6656);
    if (r < 7936) return SO_SWK + (r - 7680);
    if (r < 8192) return SO_SWV + (r - 7936);
    return SO_GATE + (r - 8192); } };
struct CmW13 { DI int operator()(int r) const { const int pn = r >> 8, rr = r & 255; return rr < 128 ? 128 * pn + rr : FFN + 128 * pn + (rr - 128); } };
template <class ColMap>
DI void convert_weight_f8(const Frame& F, const float* W, int ldw, int K, int N, unsigned char* WT8, const ColMap& cm, float wscale, int& rot) {
    bf16_t* scr = (bf16_t*)(F.lds + F.wave * 16384);
    const int NGW = F.G * 8, nblk = N / 64, items = (K / 64) * nblk;
    int gw = F.bid * 8 + F.wave - rot; if (gw < 0) gw += NGW;
    rot = (rot + items) % NGW;
    if (gw < items) {
        f32x4 v[16]; tr_load(W, ldw, cm, gw, nblk, F.lane, v);
        for (int it = gw;;) { const int nx = it + NGW; f32x4 vn[16];
            if (nx < items) tr_load(W, ldw, cm, nx, nblk, F.lane, vn);
            tr_store_f8(K, WT8, scr, it, nblk, F.lane, v, wscale);
            if (nx >= items) break;
#pragma unroll
            for (int i = 0; i < 16; ++i) v[i] = vn[i];
            it = nx; }
    }
}
template <class ColMap>
DI void convert_weight(const Frame& F, const float* W, int ldw, int K, int N, bf16_t* WT, const ColMap& cm, int& rot, const float* ks = nullptr) {
    bf16_t* scr = (bf16_t*)(F.lds + F.wave * 16384);
    const int NGW = F.G * 8, nblk = N / 64, items = (K / 64) * nblk;
    int gw = F.bid * 8 + F.wave - rot; if (gw < 0) gw += NGW;
    rot = (rot + items) % NGW;
    if (gw < items) {
        f32x4 v[16]; tr_load(W, ldw, cm, gw, nblk, F.lane, v);
        for (int it = gw;;) { const int nx = it + NGW; f32x4 vn[16];
            if (nx < items) tr_load(W, ldw, cm, nx, nblk, F.lane, vn);
            tr_store(K, WT, scr, it, nblk, F.lane, v, ks);
            if (nx >= items) break;
#pragma unroll
            for (int i = 0; i < 16; ++i) v[i] = vn[i];
            it = nx; }
    }
}
DI void rms_row_to_bf16(const float* xrow, const float* w, bf16_t* orow, int lane, unsigned char* o8 = nullptr, bf16_t* h16 = nullptr, float* rs_out = nullptr) {
    f32x4 v[8]; float s = 0.f;
#pragma unroll
    for (int j = 0; j < 8; ++j) { v[j] = *(const f32x4*)(xrow + 4 * (lane + 64 * j)); s += (v[j][0] * v[j][0] + v[j][1] * v[j][1]) + (v[j][2] * v[j][2] + v[j][3] * v[j][3]);
        if (h16) { u32x2 hc; hc.x = cvt_pk_bf16(v[j][0], v[j][1]); hc.y = cvt_pk_bf16(v[j][2], v[j][3]); *(u32x2*)(h16 + 4 * (lane + 64 * j)) = hc; } }
    const float rstd = 1.0f / sqrtf(wave_sum(s) * (1.0f / D) + RMS_EPS);
    if (rs_out && lane == 0) *rs_out = rstd;
#pragma unroll
    for (int j = 0; j < 8; ++j) { const f32x4 ww = *(const f32x4*)(w + 4 * (lane + 64 * j));
        const float y0 = v[j][0] * rstd * ww[0], y1 = v[j][1] * rstd * ww[1], y2 = v[j][2] * rstd * ww[2], y3 = v[j][3] * rstd * ww[3];
        u32x2 o; o.x = cvt_pk_bf16(y0, y1); o.y = cvt_pk_bf16(y2, y3);
        if (orow) *(u32x2*)(orow + 4 * (lane + 64 * j)) = o;
        if (o8) *(unsigned*)(o8 + 4 * (lane + 64 * j)) = cvt_pk4_fp8(y0 * F8_ASCALE, y1 * F8_ASCALE, y2 * F8_ASCALE, y3 * F8_ASCALE); }
}
DI void rms_row16_to_bf16(const bf16_t* xrow, const float* w, bf16_t* orow, int lane, unsigned char* o8 = nullptr, float* rs_out = nullptr) {
    f32x4 v[8]; float s = 0.f;
#pragma unroll
    for (int j = 0; j < 8; ++j) { const u32x2 a = *(const u32x2*)(xrow + 4 * (lane + 64 * j)); v[j] = (f32x4){bflo(a.x), bfhi(a.x), bflo(a.y), bfhi(a.y)};
        s += (v[j][0] * v[j][0] + v[j][1] * v[j][1]) + (v[j][2] * v[j][2] + v[j][3] * v[j][3]); }
    const float rstd = 1.0f / sqrtf(wave_sum(s) * (1.0f / D) + RMS_EPS);
    if (rs_out && lane == 0) *rs_out = rstd;
#pragma unroll
    for (int j = 0; j < 8; ++j) { const f32x4 ww = *(const f32x4*)(w + 4 * (lane + 64 * j));
        const float y0 = v[j][0] * rstd * ww[0], y1 = v[j][1] * rstd * ww[1], y2 = v[j][2] * rstd * ww[2], y3 = v[j][3] * rstd * ww[3];
        u32x2 o; o.x = cvt_pk_bf16(y0, y1); o.y = cvt_pk_bf16(y2, y3);
        if (orow) *(u32x2*)(orow + 4 * (lane + 64 * j)) = o;
        if (o8) *(unsigned*)(o8 + 4 * (lane + 64 * j)) = cvt_pk4_fp8(y0 * F8_ASCALE, y1 * F8_ASCALE, y2 * F8_ASCALE, y3 * F8_ASCALE); }
}
DI void phase_prologue(const Frame& F) {
    CmIdent id; int rot = 0;
    for (int l = 0; l < DEPTH; ++l) {
        if (!(F.flags & 4)) { convert_weight(F, F.inp(3) + (size_t)l * D * IN_TOTAL, IN_TOTAL, D, UC_GATE, F.wp<bf16_t>(O_WIN) + (size_t)l * UW * D, CmWin(), rot, F.inp(2) + (size_t)l * D);
            convert_weight_f8(F, F.inp(3) + (size_t)l * D * IN_TOTAL, IN_TOTAL, D, 8192, F.wp<unsigned char>(O_WG8) + (size_t)l * 8192 * D, CmGate(), F8_WSCALE, rot); }
        convert_weight(F, F.inp(14) + (size_t)l * 512 * 1536, 1536, 512, 1536, F.wp<bf16_t>(O_WUQ) + (size_t)l * 1536 * 512, id, rot);
        convert_weight(F, F.inp(16) + (size_t)l * 256 * 2048, 2048, 256, 2048, F.wp<bf16_t>(O_WUKV) + (size_t)l * 2048 * 256, id, rot);
        for (int n = 0; n < 4; ++n)
            convert_weight(F, F.inp(18) + ((size_t)l * 4 + n) * 1024 * 2048, 2048, 1024, 2048, F.wp<bf16_t>(O_WBR) + ((size_t)l * 4 + n) * 2048 * 1024, id, rot);
        convert_weight(F, F.inp(19) + (size_t)l * D * D, D, D, D, F.wp<bf16_t>(O_WOUT) + (size_t)l * D * D, id, rot);
        convert_weight(F, F.inp(22) + (size_t)l * D * 512, 512, D, 512, F.wp<bf16_t>(O_WXQ) + (size_t)l * 512 * D, id, rot, F.inp(20) + (size_t)l * D);
        convert_weight(F, F.inp(23) + (size_t)l * D * 1024, 1024, D, 1024, F.wp<bf16_t>(O_WXKV) + (size_t)l * 1024 * D, id, rot);
        convert_weight(F, F.inp(24) + (size_t)l * 512 * D, D, 512, D, F.wp<bf16_t>(O_WXO) + (size_t)l * D * 512, id, rot);
    }
    if (!(F.flags & 2)) { convert_weight(F, F.inp(26), 2 * FFN, D, 2 * FFN, F.wp<bf16_t>(O_W13), CmW13(), rot, F.inp(25));
    convert_weight(F, F.inp(27), D, FFN, D, F.wp<bf16_t>(O_W2), id, rot); }
    if (!(F.flags & 1)) for (int e = 0; e < NEXP; ++e) {
        convert_weight_f8(F, F.inp(29) + (size_t)e * D * 2 * FFN, 2 * FFN, D, 2 * FFN, F.wp<unsigned char>(O_MW13) + (size_t)e * 2 * FFN * D, CmW13F8(), F8_WSCALE, rot);
        convert_weight_f8(F, F.inp(30) + (size_t)e * FFN * D, D, FFN, D, F.wp<unsigned char>(O_MW2) + (size_t)e * D * FFN, id, F8_WSCALE, rot);
    }
    float* rope = F.wp<float>(O_ROPE);
    for (int idx = F.bid * NTHREADS + F.tid; idx < SEQ * 32; idx += F.G * NTHREADS) {
        const int t = idx >> 5, i = idx & 31;
        const float inv_freq = fexp2(-(float)i * (13.287712379549449f / 32.0f));
        const float ang = (float)t * inv_freq;
        const double rev = (double)ang * 0.15915494309189535; const float fr = (float)(rev - (double)(long long)rev);
        rope[2 * idx] = fcos_rev(fr); rope[2 * idx + 1] = fsin_rev(fr);
    }
    const int gw = F.bid * 8 + F.wave, NGW = F.G * 8;
    for (int r = gw; r < DEPTH * NMEM; r += NGW) { const int l = r / NMEM, m = r % NMEM;
        rms_row_to_bf16(F.inp(1) + (size_t)m * D, F.inp(21) + (size_t)l * D, F.wp<bf16_t>(O_MEMN) + (size_t)r * D, F.lane); }
}

DI void phase_rmsnorm_x(const Frame& F, const float* src, const float* w) {
    const int gw = F.bid * 8 + F.wave, NGW = F.G * 8;
    unsigned char* x8 = F.wp<unsigned char>(O_XN8);
    for (int r = gw; r < NTOK; r += NGW) rms_row_to_bf16(src + (size_t)r * D, w, nullptr, F.lane, x8 + (size_t)r * D, F.wp<bf16_t>(O_H) + (size_t)r * D, F.wp<float>(O_RSTD) + r);
}
DI void phase_rmsnorm(const Frame& F, const bf16_t* src, const float* w) {
    const int gw = F.bid * 8 + F.wave, NGW = F.G * 8;
    unsigned char* x8 = F.wp<unsigned char>(O_XN8);
    const int lane = F.lane; float* rsd = F.wp<float>(O_RSTD);
    for (int r = gw; r < NTOK; r += 2 * NGW) { const int r2 = r + NGW;
        if (r2 >= NTOK) { rms_row16_to_bf16(src + (size_t)r * D, w, nullptr, lane, x8 + (size_t)r * D, rsd + r); break; }
        u32x2 a[8], b[8];
#pragma unroll
        for (int j = 0; j < 8; ++j) { a[j] = *(const u32x2*)(src + (size_t)r * D + 4 * (lane + 64 * j)); b[j] = *(const u32x2*)(src + (size_t)r2 * D + 4 * (lane + 64 * j)); }
        float sa = 0.f, sb = 0.f;
#pragma unroll
        for (int j = 0; j < 8; ++j) { sa += (bflo(a[j].x) * bflo(a[j].x) + bfhi(a[j].x) * bfhi(a[j].x)) + (bflo(a[j].y) * bflo(a[j].y) + bfhi(a[j].y) * bfhi(a[j].y));
            sb += (bflo(b[j].x) * bflo(b[j].x) + bfhi(b[j].x) * bfhi(b[j].x)) + (bflo(b[j].y) * bflo(b[j].y) + bfhi(b[j].y) * bfhi(b[j].y)); }
        const float ra = 1.0f / sqrtf(wave_sum(sa) * (1.0f / D) + RMS_EPS), rb = 1.0f / sqrtf(wave_sum(sb) * (1.0f / D) + RMS_EPS);
        if (lane == 0) { rsd[r] = ra; rsd[r2] = rb; }
#pragma unroll
        for (int j = 0; j < 8; ++j) { const int c0 = 4 * (lane + 64 * j); const f32x4 ww = *(const f32x4*)(w + c0);
            *(unsigned*)(x8 + (size_t)r * D + c0) = cvt_pk4_fp8(bflo(a[j].x) * ra * ww[0] * F8_ASCALE, bfhi(a[j].x) * ra * ww[1] * F8_ASCALE, bflo(a[j].y) * ra * ww[2] * F8_ASCALE, bfhi(a[j].y) * ra * ww[3] * F8_ASCALE);
            *(unsigned*)(x8 + (size_t)r2 * D + c0) = cvt_pk4_fp8(bflo(b[j].x) * rb * ww[0] * F8_ASCALE, bfhi(b[j].x) * rb * ww[1] * F8_ASCALE, bflo(b[j].y) * rb * ww[2] * F8_ASCALE, bfhi(b[j].y) * rb * ww[3] * F8_ASCALE); }
    }
}
DI void block_rows(const Frame& F, int& r0, int& r1) { r0 = (int)(((long)NTOK * F.bid) / F.G); r1 = (int)(((long)NTOK * (F.bid + 1)) / F.G); }
DI void phase_rmsnorm_route(const Frame& F, const bf16_t* src, const float* w, const float* router) {
    int* cnt = (int*)(F.lds);
    float* RT = (float*)(F.lds + 1024);
    if (F.tid < 8) cnt[F.tid] = 0;
    for (int c = F.tid; c < D; c += NTHREADS) { const f32x4 ra = *(const f32x4*)(router + (size_t)c * 8), rb = *(const f32x4*)(router + (size_t)c * 8 + 4);
        RT[c] = ra[0]; RT[D + c] = ra[1]; RT[2 * D + c] = ra[2]; RT[3 * D + c] = ra[3]; RT[4 * D + c] = rb[0]; RT[5 * D + c] = rb[1]; RT[6 * D + c] = rb[2]; RT[7 * D + c] = rb[3]; }
    __syncthreads();
    int r0, r1; block_rows(F, r0, r1);
    int* r_e = F.wp<int>(O_ROUTE); float* r_g = (float*)(r_e + 2 * NTOK);
    u32x2 nx[8];
    if (r0 + F.wave < r1) {
#pragma unroll
        for (int j = 0; j < 8; ++j) nx[j] = *(const u32x2*)(src + (size_t)(r0 + F.wave) * D + 4 * (F.lane + 64 * j)); }
    for (int r = r0 + F.wave; r < r1; r += 8) {
        const int lane = F.lane;
        u32x2 cur[8];
#pragma unroll
        for (int j = 0; j < 8; ++j) cur[j] = nx[j];
        if (r + 8 < r1) {
#pragma unroll
            for (int j = 0; j < 8; ++j) nx[j] = *(const u32x2*)(src + (size_t)(r + 8) * D + 4 * (lane + 64 * j)); }
        f32x4 v[8]; float s = 0.f;
#pragma unroll
        for (int j = 0; j < 8; ++j) { const u32x2 a_ = cur[j]; v[j] = (f32x4){bflo(a_.x), bfhi(a_.x), bflo(a_.y), bfhi(a_.y)}; s += (v[j][0] * v[j][0] + v[j][1] * v[j][1]) + (v[j][2] * v[j][2] + v[j][3] * v[j][3]); }
        const float rstd = 1.0f / sqrtf(wave_sum(s) * (1.0f / D) + RMS_EPS);
        float lg[8];
#pragma unroll
        for (int e = 0; e < 8; ++e) lg[e] = 0.f;
        unsigned char* orow = F.wp<unsigned char>(O_XN8) + (size_t)r * D;
#pragma unroll
        for (int j = 0; j < 8; ++j) { const int c0 = 4 * (lane + 64 * j); const f32x4 ww = *(const f32x4*)(w + c0);
            const f32x4 y = {v[j][0] * rstd * ww[0], v[j][1] * rstd * ww[1], v[j][2] * rstd * ww[2], v[j][3] * rstd * ww[3]};
            *(unsigned*)(orow + c0) = cvt_pk4_fp8(y[0] * F8_ASCALE, y[1] * F8_ASCALE, y[2] * F8_ASCALE, y[3] * F8_ASCALE);
#pragma unroll
            for (int e = 0; e < 8; ++e) { const f32x4 rw = *(const f32x4*)(RT + e * D + c0); lg[e] += (y[0] * rw[0] + y[1] * rw[1]) + (y[2] * rw[2] + y[3] * rw[3]); }
            SCHED_BAR(); }
#pragma unroll
        for (int e = 0; e < 8; ++e) lg[e] = wave_sum(lg[e]);
        int i0 = 0; float v0 = lg[0];
#pragma unroll
        for (int e = 1; e < 8; ++e) if (lg[e] > v0) { v0 = lg[e]; i0 = e; }
        int i1 = -1; float v1 = -3.0e38f;
#pragma unroll
        for (int e = 0; e < 8; ++e) if (e != i0 && lg[e] > v1) { v1 = lg[e]; i1 = e; }
        const float e1 = fexp(v1 - v0), g0 = 1.0f / (1.0f + e1), g1 = e1 * g0;
        if (lane == 0) { r_e[2 * r] = i0; r_e[2 * r + 1] = i1; r_g[2 * r] = g0; r_g[2 * r + 1] = g1; lds_atomic_add_i(&cnt[i0], 1); lds_atomic_add_i(&cnt[i1], 1); }
    }
    __syncthreads();
    if (F.tid < 8) F.wp<int>(O_BLKCNT)[F.bid * 8 + F.tid] = cnt[F.tid];
}
DI void moe_tables(const Frame& F, int* tile_e, int* pstart, int* ntiles_out) {
    const int* bc = F.wp<int>(O_BLKCNT);
    if (F.tid == 0) {
        int tot[8];
        for (int e = 0; e < 8; ++e) tot[e] = 0;
        for (int b = 0; b < F.G; ++b) for (int e = 0; e < 8; ++e) tot[e] += bc[b * 8 + e];
        int ps = 0, nt = 0;
        for (int e = 0; e < 8; ++e) { pstart[e] = ps; const int t = (tot[e] + 255) >> 8;
_Pragma("clang loop vectorize(disable) unroll(disable)")
            for (int j = 0; j < t; ++j) tile_e[nt + j] = e;
            nt += t; ps += t * 256; }
        *ntiles_out = nt;
    }
    __syncthreads();
}
DI void phase_moe_scatter(const Frame& F, int* tile_e, int* pstart, int* ntiles, int* myoff  ) {
    moe_tables(F, tile_e, pstart, ntiles);
    const int* bc = F.wp<int>(O_BLKCNT);
    int r0, r1; block_rows(F, r0, r1);
    int* r_e = F.wp<int>(O_ROUTE); int* r_s = r_e + 4 * NTOK;
    if (F.tid < 8) { int s = 0; for (int b = 0; b < F.bid; ++b) s += bc[b * 8 + F.tid]; myoff[F.tid] = pstart[F.tid] + s; }
    __syncthreads();
    {
        int* es = (int*)F.lds; const int np = 2 * (r1 - r0);
        for (int p = F.tid; p < np; p += NTHREADS) es[p] = r_e[2 * r0 + p];
        __syncthreads();
        for (int p = F.tid; p < np; p += NTHREADS) { const int e = es[p]; int before = 0;
            for (int q = 0; q < p; ++q) before += (es[q] == e) ? 1 : 0;
            r_s[2 * r0 + p] = myoff[e] + before; }
    }
    __syncthreads();
    asm volatile("" ::: "memory");
    const unsigned char* xn8 = F.wp<unsigned char>(O_XN8); unsigned char* xg8 = F.wp<unsigned char>(O_XG);
    for (int i = 2 * r0 + F.wave; i < 2 * r1; i += 32) {
        u32x4 v[4][2]; int slot[4];
#pragma unroll
        for (int q = 0; q < 4; ++q) { const int ii = i + 8 * q; const bool ok = ii < 2 * r1; const int ic = ok ? ii : i; slot[q] = ok ? r_s[ic] : -1;
            const u32x4* sp_ = (const u32x4*)(xn8 + (size_t)(ic >> 1) * D); v[q][0] = sp_[F.lane]; v[q][1] = sp_[F.lane + 64]; }
#pragma unroll
        for (int q = 0; q < 4; ++q) if (slot[q] >= 0) { u32x4* dp_ = (u32x4*)(xg8 + (size_t)slot[q] * D); dp_[F.lane] = v[q][0]; dp_[F.lane + 64] = v[q][1]; } }
}
DI void phase_final(const Frame& F, bool moe_last, const int* ntiles_p, unsigned char* tail_of  ) {
    const int gw = F.bid * 8 + F.wave, NGW = F.G * 8, lane = F.lane;
    const bf16_t* H = F.wp<bf16_t>(O_H); const bf16_t* yg = F.wp<bf16_t>(O_YG); const float* w = F.inp(31); const float* tacc = F.wp<float>(O_TAILACC);
    const int* r_e = F.wp<int>(O_ROUTE); const float* r_g = (const float*)(r_e + 2 * NTOK); const int* r_s = r_e + 4 * NTOK;
    int full = 0, R = 0, sp = 0;
    if (moe_last) {
        pg8::moe_tail_split(*ntiles_p, F.G, full, R, sp);
_Pragma("clang loop vectorize(disable) unroll(disable)")
        for (int i = F.tid; i < MAXTILES * 8; i += NTHREADS) tail_of[i] = 0;
        __syncthreads();
        for (int u = F.tid; u < R; u += NTHREADS) { int pm, pn; pg8::static_map((long)full * F.G + u, *ntiles_p, D / 256, pm, pn); tail_of[pm * 8 + pn] = (unsigned char)(u + 1); }
        __syncthreads();
    }
    for (int r = gw; r < NTOK; r += NGW) {
        f32x4 v[8]; float s = 0.f;
        float g0 = 0.f, g1 = 0.f; int s0 = 0, s1 = 0;
        if (moe_last) { g0 = r_g[2 * r]; g1 = r_g[2 * r + 1]; s0 = r_s[2 * r]; s1 = r_s[2 * r + 1]; }
#pragma unroll
        for (int j = 0; j < 8; ++j) { const int c0 = 4 * (lane + 64 * j); { const u32x2 a_ = *(const u32x2*)(H + (size_t)r * D + c0); v[j] = (f32x4){bflo(a_.x), bfhi(a_.x), bflo(a_.y), bfhi(a_.y)}; }
            if (moe_last) {
                f32x4 ya, yb;
                const int t0 = tail_of[(s0 >> 8) * 8 + j], t1 = tail_of[(s1 >> 8) * 8 + j];
                if (t0) { ya = (f32x4){0.f, 0.f, 0.f, 0.f}; for (int p = 0; p < sp; ++p) ya += *(const f32x4*)(tacc + (size_t)((t0 - 1) * sp + p) * 65536 + (s0 & 255) * 256 + 4 * lane); }
                else { const u32x2 a = *(const u32x2*)(yg + (size_t)s0 * D + c0); ya = (f32x4){bflo(a.x), bfhi(a.x), bflo(a.y), bfhi(a.y)}; }
                if (t1) { yb = (f32x4){0.f, 0.f, 0.f, 0.f}; for (int p = 0; p < sp; ++p) yb += *(const f32x4*)(tacc + (size_t)((t1 - 1) * sp + p) * 65536 + (s1 & 255) * 256 + 4 * lane); }
                else { const u32x2 bb = *(const u32x2*)(yg + (size_t)s1 * D + c0); yb = (f32x4){bflo(bb.x), bfhi(bb.x), bflo(bb.y), bfhi(bb.y)}; }
                v[j] += g0 * ya + g1 * yb; }
            s += (v[j][0] * v[j][0] + v[j][1] * v[j][1]) + (v[j][2] * v[j][2] + v[j][3] * v[j][3]); }
        const float rstd = 1.0f / sqrtf(wave_sum(s) * (1.0f / D) + RMS_EPS);
#pragma unroll
        for (int j = 0; j < 8; ++j) { const int c0 = 4 * (lane + 64 * j); const f32x4 ww = *(const f32x4*)(w + c0);
            *(f32x4*)(F.outp() + (size_t)r * D + c0) = (f32x4){v[j][0] * rstd * ww[0], v[j][1] * rstd * ww[1], v[j][2] * rstd * ww[2], v[j][3] * rstd * ww[3]}; }
    }
}

DI float log_sigmoid_(float x) { return fminf(x, 0.f) - log1pf(expf(-fabsf(x))); }
DI float softplus_(float x) { return fmaxf(x, 0.f) + log1pf(expf(-fabsf(x))); }
DI void phase_prep(const Frame& F, int l) {
    const int gw = F.bid * 8 + F.wave, NGW = F.G * 8, lane = F.lane;
    const bf16_t* U = F.wp<bf16_t>(O_U); const float* SM = F.wp<float>(O_SM); const float* rope = F.wp<float>(O_ROPE);
    const float* qnorm = F.inp(13) + l * 512; const float* kvnorm = F.inp(15) + l * 256;
    const float* convw = F.inp(7) + (size_t)l * 4 * 1536; const float* convb = F.inp(8) + l * 1536;
    for (int r = gw; r < NTOK; r += NGW) {
        const int t = r % SEQ; const bf16_t* urow = U + (size_t)r * UWP; const float* smrow = SM + (size_t)r * 256;
        const int ckc = 8 * (lane & 31);
        const u32x4 wq = *(const u32x4*)(urow + UC_CQ + 8 * lane), wkv = *(const u32x4*)(urow + UC_CKV + ckc);
        const float sm_x1 = smrow[lane & 31], sm_x2 = smrow[32 + (lane & 31)], sm_gi = smrow[64 + (lane & 3)], sm_gf = smrow[68 + (lane & 3)], sm_dt = smrow[72 + (lane & 15)];
        const float rp_c = rope[2 * (t * 32 + (lane & 31))], rp_s = rope[2 * (t * 32 + (lane & 31)) + 1];
        u32x4 xw[3][4];
#pragma unroll
        for (int j = 0; j < 3; ++j)
#pragma unroll
            for (int tap = 0; tap < 4; ++tap) { const bool ok = (t - 3 + tap) >= 0;
                const u32x4 w = *(const u32x4*)(urow + (ok ? (long)(tap - 3) * UWP : 0l) + UC_XBC + 8 * lane + 512 * j);
                xw[j][tap].x = ok ? w.x : 0u; xw[j][tap].y = ok ? w.y : 0u; xw[j][tap].z = ok ? w.z : 0u; xw[j][tap].w = ok ? w.w : 0u; }
        {
            const u32x4 w = wq;
            float x[8] = {bflo(w.x), bfhi(w.x), bflo(w.y), bfhi(w.y), bflo(w.z), bfhi(w.z), bflo(w.w), bfhi(w.w)}; float s = 0.f;
#pragma unroll
            for (int i = 0; i < 8; ++i) s += x[i] * x[i];
            const float rstd = 1.0f / sqrtf(wave_sum(s) * (1.0f / 512) + RMS_EPS);
            const f32x4 n0 = *(const f32x4*)(qnorm + 8 * lane), n1 = *(const f32x4*)(qnorm + 8 * lane + 4);
            u32x4 o; o.x = cvt_pk_bf16(x[0] * rstd * n0[0], x[1] * rstd * n0[1]); o.y = cvt_pk_bf16(x[2] * rstd * n0[2], x[3] * rstd * n0[3]);
            o.z = cvt_pk_bf16(x[4] * rstd * n1[0], x[5] * rstd * n1[1]); o.w = cvt_pk_bf16(x[6] * rstd * n1[2], x[7] * rstd * n1[3]);
            *(u32x4*)(F.wp<bf16_t>(O_CQN) + (size_t)r * 512 + 8 * lane) = o;
        }
        {
            const int c = ckc;
            const u32x4 w = wkv;
            float x[8] = {bflo(w.x), bfhi(w.x), bflo(w.y), bfhi(w.y), bflo(w.z), bfhi(w.z), bflo(w.w), bfhi(w.w)}; float s = 0.f;
#pragma unroll
            for (int i = 0; i < 8; ++i) s += x[i] * x[i];
            if (lane >= 32) s = 0.f;
            const float rstd = 1.0f / sqrtf(wave_sum(s) * (1.0f / 256) + RMS_EPS);
            const f32x4 n0 = *(const f32x4*)(kvnorm + c), n1 = *(const f32x4*)(kvnorm + c + 4);
            u32x4 o; o.x = cvt_pk_bf16(x[0] * rstd * n0[0], x[1] * rstd * n0[1]); o.y = cvt_pk_bf16(x[2] * rstd * n0[2], x[3] * rstd * n0[3]);
            o.z = cvt_pk_bf16(x[4] * rstd * n1[0], x[5] * rstd * n1[1]); o.w = cvt_pk_bf16(x[6] * rstd * n1[2], x[7] * rstd * n1[3]);
            if (lane < 32) *(u32x4*)(F.wp<bf16_t>(O_CKVN) + (size_t)r * 256 + c) = o;
        }
        if (lane < 32) {
            const float x1 = sm_x1, x2 = sm_x2, cs = rp_c, sn = rp_s;
            bf16_t* kr = F.wp<bf16_t>(O_KR) + (size_t)r * 64;
            kr[lane] = f2bf(x1 * cs - x2 * sn); kr[32 + lane] = f2bf(x2 * cs + x1 * sn);
        }
        if (lane < 4) {
            F.wp<float>(O_GI)[(size_t)r * 4 + lane] = sm_gi + F.inp(4)[l * 4 + lane];
            F.wp<float>(O_LF)[(size_t)r * 4 + lane] = log_sigmoid_(sm_gf + F.inp(5)[l * 4 + lane]);
        }
        if (lane < 16) {
            const float dtv = softplus_(sm_dt + F.inp(9)[l * 16 + lane]);
            F.wp<float>(O_DT)[(size_t)r * 16 + lane] = dtv;
            F.wp<float>(O_DA)[(size_t)r * 16 + lane] = -dtv * expf(F.inp(10)[l * 16 + lane]);
        }
#pragma unroll
        for (int j = 0; j < 3; ++j) { const int c0 = 8 * lane + 512 * j;
            float y[8];
            { const f32x4 b0 = *(const f32x4*)(convb + c0), b1 = *(const f32x4*)(convb + c0 + 4); y[0] = b0[0]; y[1] = b0[1]; y[2] = b0[2]; y[3] = b0[3]; y[4] = b1[0]; y[5] = b1[1]; y[6] = b1[2]; y[7] = b1[3]; }
#pragma unroll
            for (int tap = 0; tap < 4; ++tap) { const u32x4 w = xw[j][tap];
                const f32x4 w0 = *(const f32x4*)(convw + tap * 1536 + c0), w1 = *(const f32x4*)(convw + tap * 1536 + c0 + 4);
                y[0] += bflo(w.x) * w0[0]; y[1] += bfhi(w.x) * w0[1]; y[2] += bflo(w.y) * w0[2]; y[3] += bfhi(w.y) * w0[3];
                y[4] += bflo(w.z) * w1[0]; y[5] += bfhi(w.z) * w1[1]; y[6] += bflo(w.w) * w1[2]; y[7] += bfhi(w.w) * w1[3]; }
            u32x4 o; o.x = cvt_pk_bf16(siluf_(y[0]), siluf_(y[1])); o.y = cvt_pk_bf16(siluf_(y[2]), siluf_(y[3])); o.z = cvt_pk_bf16(siluf_(y[4]), siluf_(y[5])); o.w = cvt_pk_bf16(siluf_(y[6]), siluf_(y[7]));
            *(u32x4*)(F.wp<bf16_t>(O_XBC) + (size_t)r * 1536 + c0) = o; }
    }
}

constexpr int ML_NC = SEQ / 64;
DI void mlstm_item(const Frame& F, int item) {
    const int vs = item & 7, hh = (item >> 3) & 3, b = item >> 5;
    int tid_ = F.tid; LAUNDER_V(tid_);
    const int tid = tid_, lane = tid & 63, w = F.wave, g = lane >> 4, lc = lane & 15;
    float* s_bb = (float*)F.lds; float* s_dd = s_bb + SEQ; float* s_cm = s_dd + SEQ; float* s_ch = s_cm + SEQ;
    bf16_t* sQ = (bf16_t*)(s_ch + 4 * ML_NC);
    bf16_t* sK = sQ + 64 * 136;
    bf16_t* sV = sK + 64 * 136;
    bf16_t* sVw = sV + 64 * 56;
    bf16_t* sCb = sVw + 64 * 56;
    const bf16_t* U = F.wp<bf16_t>(O_U); const float* GI = F.wp<float>(O_GI); const float* LF = F.wp<float>(O_LF);
    bf16_t* Ya = F.wp<bf16_t>(O_Y);
    const float scale = 0.08838834764831845f;
    const unsigned z0 = vzero();
    for (int i = tid; i < SEQ; i += NTHREADS) { const size_t row = (size_t)b * SEQ + i; s_dd[i] = GI[row * 4 + hh]; s_bb[i] = LF[row * 4 + hh]; }
    for (int i = tid; i < 48 * 136 / 2; i += NTHREADS) ((unsigned*)sCb)[i] = z0;
    __syncthreads();
    if (tid < ML_NC) { float acc = 0.f, cm = -3.0e38f;
        for (int t = 0; t < 64; ++t) { const int i = tid * 64 + t; acc += s_bb[i]; s_bb[i] = acc; const float d = s_dd[i] - acc; s_dd[i] = d; cm = fmaxf(cm, d); s_cm[i] = cm; } }
    __syncthreads();
    if (tid == 0) { float m = 0.f;
        for (int c = 0; c < ML_NC; ++c) { const float btot = s_bb[c * 64 + 63], cmL = s_cm[c * 64 + 63], mloc = btot + cmL, mnew = fmaxf(btot + m, mloc);
            s_ch[c] = m; s_ch[ML_NC + c] = fexp(btot + m - mnew); s_ch[2 * ML_NC + c] = fexp(mloc - mnew); s_ch[3 * ML_NC + c] = cmL; m = mnew; } }
    __syncthreads();
    f32x4 Cst[3][2];
#pragma unroll
    for (int a = 0; a < 3; ++a)
#pragma unroll
        for (int c = 0; c < 2; ++c) Cst[a][c] = (f32x4){0.f, 0.f, 0.f, 0.f};
    const bf16_t* Ub = U + (size_t)b * SEQ * UWP;
    u32x4 qr[2], kr[2], vr = {z0, z0, z0, z0};
#define ML_FETCH(c_) do { const bf16_t* ub_ = Ub + (size_t)(c_) * 64 * UWP; \
        _Pragma("unroll") for (int i_ = 0; i_ < 2; ++i_) { const unsigned ch_ = tid + i_ * NTHREADS, r_ = ch_ >> 4, cc_ = (ch_ & 15) * 8; \
            qr[i_] = *(const u32x4*)(ub_ + (r_ * (unsigned)UWP + UC_MLQ + hh * 128u + cc_)); kr[i_] = *(const u32x4*)(ub_ + (r_ * (unsigned)UWP + UC_MLK + hh * 128u + cc_)); } \
        if (tid < 256) { const unsigned r_ = tid >> 2, cc_ = (tid & 3) * 8; vr = *(const u32x4*)(ub_ + (r_ * (unsigned)UWP + UC_MLV + hh * 256u + vs * 32u + cc_)); } } while (0)
    ML_FETCH(0);
    for (int c = 0; c < ML_NC; ++c) {
        const float m_prev = s_ch[c], da = s_ch[ML_NC + c], db = s_ch[2 * ML_NC + c], cmL = s_ch[3 * ML_NC + c];
        const size_t row0 = (size_t)b * SEQ + c * 64;
#pragma unroll
        for (int i = 0; i < 2; ++i) { const int ch = tid + i * NTHREADS, r = ch >> 4, cc = (ch & 15) * 8;
            *(u32x4*)(sQ + r * 136 + cc) = qr[i]; *(u32x4*)(sK + r * 136 + cc) = kr[i]; }
        if (tid < 256) { const int r = tid >> 2, cc = (tid & 3) * 8;
            const u32x4 v = vr;
            *(u32x4*)(sV + r * 56 + cc) = v;
            const float wt = db * fexp(s_dd[c * 64 + r] - cmL) * scale;
            u32x4 o; o.x = cvt_pk_bf16(bflo(v.x) * wt, bfhi(v.x) * wt); o.y = cvt_pk_bf16(bflo(v.y) * wt, bfhi(v.y) * wt); o.z = cvt_pk_bf16(bflo(v.z) * wt, bfhi(v.z) * wt); o.w = cvt_pk_bf16(bflo(v.w) * wt, bfhi(v.w) * wt);
            *(u32x4*)(sVw + r * 56 + cc) = o;
        } else if (tid < 320) { const int r = tid - 256;
            const float wt = db * fexp(s_dd[c * 64 + r] - cmL) * scale;
            *(u32x4*)(sV + r * 56 + 32) = (u32x4){0x3F80u | z0, z0, z0, z0}; *(u32x4*)(sV + r * 56 + 40) = (u32x4){z0, z0, z0, z0};
            *(u32x4*)(sVw + r * 56 + 32) = (u32x4){(unsigned)f2bf(wt), z0, z0, z0}; *(u32x4*)(sVw + r * 56 + 40) = (u32x4){z0, z0, z0, z0};
        }
        __syncthreads();
        if (c + 1 < ML_NC) ML_FETCH(c + 1);
        if (w < 4) {
            const int sl = 16 * w + lc; const float mx = fmaxf(m_prev, s_cm[c * 64 + sl]), inter = fexp(m_prev - mx);
            bf16x8 bq[4];
#pragma unroll
            for (int kt = 0; kt < 4; ++kt) bq[kt] = frag_r(sQ, 136, 16 * w, 32 * kt, lane);
            f32x4 st[4];
#pragma unroll
            for (int j = 0; j < 4; ++j) st[j] = (f32x4){0.f, 0.f, 0.f, 0.f};
#pragma unroll
            for (int j = 0; j < 4; ++j) if (j <= w) {
#pragma unroll
                for (int kt = 0; kt < 4; ++kt) st[j] = mfma16(frag_r(sK, 136, 16 * j, 32 * kt, lane), bq[kt], st[j]);
                const f32x4 d4 = *(const f32x4*)(s_dd + c * 64 + 16 * j + 4 * g);
#pragma unroll
                for (int i = 0; i < 4; ++i) { const int t = 16 * j + 4 * g + i; st[j][i] = (t <= sl) ? fexp(d4[i] - mx) * st[j][i] * scale : 0.f; } }
            f32x4 n1[3], n2[3];
#pragma unroll
            for (int vt = 0; vt < 3; ++vt) { n1[vt] = (f32x4){0.f, 0.f, 0.f, 0.f}; n2[vt] = (f32x4){0.f, 0.f, 0.f, 0.f}; }
            const bf16_t* vb = sV + (4 * g + ((lane & 15) >> 2)) * 56 + 4 * (lane & 3);
#pragma unroll
            for (int ks = 0; ks < 2; ++ks) if (2 * ks <= w) {
                u32x4 pw; pw.x = cvt_pk_bf16(st[2 * ks][0], st[2 * ks][1]); pw.y = cvt_pk_bf16(st[2 * ks][2], st[2 * ks][3]); pw.z = cvt_pk_bf16(st[2 * ks + 1][0], st[2 * ks + 1][1]); pw.w = cvt_pk_bf16(st[2 * ks + 1][2], st[2 * ks + 1][3]);
                const bf16x8 pb = __builtin_bit_cast(bf16x8, pw);
#pragma unroll
                for (int vt = 0; vt < 3; ++vt) { const s16x4 lo = lds_tr4(vb + (32 * ks) * 56 + 16 * vt), hi = lds_tr4(vb + (32 * ks + 16) * 56 + 16 * vt);
                    n1[vt] = mfma16(__builtin_shufflevector(lo, hi, 0, 1, 2, 3, 4, 5, 6, 7), pb, n1[vt]); } }
#pragma unroll
            for (int kt = 0; kt < 4; ++kt)
#pragma unroll
                for (int vt = 0; vt < 3; ++vt) n2[vt] = mfma16(frag_r(sCb, 136, 16 * vt, 32 * kt, lane), bq[kt], n2[vt]);
            const float den = shfl_f(n1[2][0] + inter * n2[2][0], lc);
            const float inv = frcp(fmaxf(fabsf(den), fexp(-(s_bb[c * 64 + sl] + mx))));
#pragma unroll
            for (int vt = 0; vt < 2; ++vt) { u32x2 ov; ov.x = cvt_pk_bf16((n1[vt][0] + inter * n2[vt][0]) * inv, (n1[vt][1] + inter * n2[vt][1]) * inv);
                ov.y = cvt_pk_bf16((n1[vt][2] + inter * n2[vt][2]) * inv, (n1[vt][3] + inter * n2[vt][3]) * inv);
                *(u32x2*)(Ya + ((row0 + sl) * 1024 + hh * 256 + vs * 32 + 16 * vt + 4 * g)) = ov; }
        } else {
            const int j = w - 4;
#pragma unroll
            for (int mt = 0; mt < 3; ++mt)
#pragma unroll
                for (int nl = 0; nl < 2; ++nl) Cst[mt][nl] *= da;
#pragma unroll
            for (int kt = 0; kt < 2; ++kt) {
                bf16x8 bk[2];
#pragma unroll
                for (int nl = 0; nl < 2; ++nl) bk[nl] = frag_k(sK, 136, 32 * kt, 16 * (2 * j + nl), lane);
#pragma unroll
                for (int mt = 0; mt < 3; ++mt) { const bf16x8 a = frag_k(sVw, 56, 32 * kt, 16 * mt, lane);
#pragma unroll
                    for (int nl = 0; nl < 2; ++nl) Cst[mt][nl] = mfma16(a, bk[nl], Cst[mt][nl]); } }
        }
        __syncthreads();
        if (w >= 4) { const int j = w - 4;
#pragma unroll
            for (int mt = 0; mt < 3; ++mt)
#pragma unroll
                for (int nl = 0; nl < 2; ++nl)
#pragma unroll
                    for (int i = 0; i < 4; ++i) sCb[(16 * mt + 4 * g + i) * 136 + 16 * (2 * j + nl) + lc] = f2bf(Cst[mt][nl][i]); }
    }
#undef ML_FETCH
    __syncthreads();
}

constexpr int SS_NC = SEQ / 128;
DI void ssd_item(const Frame& F, int item, int l) {
    const int ps = item & 1, hd = (item >> 1) & 15, b = item >> 5, grp = hd >> 3;
    int tid_ = F.tid; LAUNDER_V(tid_);
    const int tid = tid_, lane = tid & 63, w = F.wave, g = lane >> 4, lc = lane & 15;
    float* s_acs = (float*)F.lds; float* s_dt = s_acs + 256;
    bf16_t* sC = (bf16_t*)(s_dt + 256);
    bf16_t* sB = sC + 128 * 136;
    bf16_t* sX = sB + 128 * 136;
    bf16_t* sXw = sX + 128 * 40;
    bf16_t* sHb = sXw + 128 * 40;
    const bf16_t* XBC = F.wp<bf16_t>(O_XBC) + (size_t)b * SEQ * 1536; const bf16_t* Uz = F.wp<bf16_t>(O_U) + (size_t)b * SEQ * UWP + UC_SSZ + hd * 64 + ps * 32;
    const float* DT = F.wp<float>(O_DT) + (size_t)b * SEQ * 16 + hd; const float* DA = F.wp<float>(O_DA) + (size_t)b * SEQ * 16 + hd;
    bf16_t* Yb = F.wp<bf16_t>(O_Y) + (size_t)NTOK * 1024 + (size_t)b * SEQ * 1024 + hd * 64 + ps * 32;
    const float Dh = F.inp(11)[l * 16 + hd];
    const unsigned z0 = vzero();
    for (int i = tid; i < 32 * 136 / 2; i += NTHREADS) ((unsigned*)sHb)[i] = z0;
    f32x4 Hst[2];
    Hst[0] = (f32x4){0.f, 0.f, 0.f, 0.f}; Hst[1] = (f32x4){0.f, 0.f, 0.f, 0.f};
    u32x4 cr[4], br[4], xr; float da0 = 0.f, da1 = 0.f, dtv = 0.f;
#define SSD_FETCH(c_) do { const bf16_t* xb_ = XBC + (size_t)(c_) * 128 * 1536; \
        _Pragma("unroll") for (int i_ = 0; i_ < 4; ++i_) { const unsigned ch_ = tid + i_ * NTHREADS, r_ = ch_ >> 4, cc_ = (ch_ & 15) * 8; \
            cr[i_] = *(const u32x4*)(xb_ + (r_ * 1536u + 1280u + grp * 128u + cc_)); br[i_] = *(const u32x4*)(xb_ + (r_ * 1536u + 1024u + grp * 128u + cc_)); } \
        { const unsigned r_ = tid >> 2, cc_ = (tid & 3) * 8; xr = *(const u32x4*)(xb_ + (r_ * 1536u + hd * 64u + ps * 32u + cc_)); } \
        if (w == 0) { da0 = DA[((c_) * 128 + 2 * lane) * 16]; da1 = DA[((c_) * 128 + 2 * lane + 1) * 16]; } else if (w < 3) dtv = DT[((c_) * 128 + tid - 64) * 16]; } while (0)
#define SSD_SCAN(nb_) do { if (w == 0) { float p_ = da0 + da1; \
            _Pragma("unroll") for (int off_ = 1; off_ < 64; off_ <<= 1) { const float t_ = shfl_f(p_, (lane - off_) & 63); if (lane >= off_) p_ += t_; } \
            s_acs[(nb_) * 128 + 2 * lane + 1] = p_; s_acs[(nb_) * 128 + 2 * lane] = p_ - da1; } \
        else if (w < 3) s_dt[(nb_) * 128 + tid - 64] = dtv; } while (0)
    SSD_FETCH(0);
    SSD_SCAN(0);
    __syncthreads();
    for (int c = 0; c < SS_NC; ++c) {
        const int row0 = c * 128; const float* acs = s_acs + (c & 1) * 128; const float* dtc = s_dt + (c & 1) * 128;
        const float acsL = acs[127];
#pragma unroll
        for (int i = 0; i < 4; ++i) { const int ch = tid + i * NTHREADS, r = ch >> 4, cc = (ch & 15) * 8; *(u32x4*)(sC + r * 136 + cc) = cr[i]; *(u32x4*)(sB + r * 136 + cc) = br[i]; }
        { const int r = tid >> 2, cc = (tid & 3) * 8; const u32x4 v = xr;
            *(u32x4*)(sX + r * 40 + cc) = v;
            const float wt = dtc[r] * fexp(acsL - acs[r]);
            u32x4 o; o.x = cvt_pk_bf16(bflo(v.x) * wt, bfhi(v.x) * wt); o.y = cvt_pk_bf16(bflo(v.y) * wt, bfhi(v.y) * wt); o.z = cvt_pk_bf16(bflo(v.z) * wt, bfhi(v.z) * wt); o.w = cvt_pk_bf16(bflo(v.w) * wt, bfhi(v.w) * wt);
            *(u32x4*)(sXw + r * 40 + cc) = o; }
        __syncthreads();
        u32x2 zr[2];
#pragma unroll
        for (int pt = 0; pt < 2; ++pt) zr[pt] = *(const u32x2*)(Uz + ((unsigned)(row0 + 16 * w + lc) * (unsigned)UWP + 16u * pt + 4u * g));
        if (c + 1 < SS_NC) SSD_FETCH(c + 1);
        {
            const int sl = 16 * w + lc; const float as = acs[sl];
            bf16x8 bq[4];
#pragma unroll
            for (int kt = 0; kt < 4; ++kt) bq[kt] = frag_r(sC, 136, 16 * w, 32 * kt, lane);
            f32x4 ct[8];
#pragma unroll
            for (int j = 0; j < 8; ++j) ct[j] = (f32x4){0.f, 0.f, 0.f, 0.f};
#pragma unroll
            for (int j = 0; j < 8; ++j) if (j <= w) {
#pragma unroll
                for (int kt = 0; kt < 4; ++kt) ct[j] = mfma16(frag_r(sB, 136, 16 * j, 32 * kt, lane), bq[kt], ct[j]);
                const f32x4 a4 = *(const f32x4*)(acs + 16 * j + 4 * g), d4 = *(const f32x4*)(dtc + 16 * j + 4 * g);
#pragma unroll
                for (int i = 0; i < 4; ++i) { const int t = 16 * j + 4 * g + i; ct[j][i] = (t <= sl) ? ct[j][i] * fexp(as - a4[i]) * d4[i] : 0.f; } }
            f32x4 y1[2], y2[2];
#pragma unroll
            for (int pt = 0; pt < 2; ++pt) { y1[pt] = (f32x4){0.f, 0.f, 0.f, 0.f}; y2[pt] = (f32x4){0.f, 0.f, 0.f, 0.f}; }
            const bf16_t* xb = sX + (4 * g + ((lane & 15) >> 2)) * 40 + 4 * (lane & 3);
#pragma unroll
            for (int ks = 0; ks < 4; ++ks) if (2 * ks <= w) {
                u32x4 pw; pw.x = cvt_pk_bf16(ct[2 * ks][0], ct[2 * ks][1]); pw.y = cvt_pk_bf16(ct[2 * ks][2], ct[2 * ks][3]); pw.z = cvt_pk_bf16(ct[2 * ks + 1][0], ct[2 * ks + 1][1]); pw.w = cvt_pk_bf16(ct[2 * ks + 1][2], ct[2 * ks + 1][3]);
                const bf16x8 pb = __builtin_bit_cast(bf16x8, pw);
#pragma unroll
                for (int pt = 0; pt < 2; ++pt) { const s16x4 lo = lds_tr4(xb + (32 * ks) * 40 + 16 * pt), hi = lds_tr4(xb + (32 * ks + 16) * 40 + 16 * pt);
                    y1[pt] = mfma16(__builtin_shufflevector(lo, hi, 0, 1, 2, 3, 4, 5, 6, 7), pb, y1[pt]); } }
#pragma unroll
            for (int kt = 0; kt < 4; ++kt)
#pragma unroll
                for (int pt = 0; pt < 2; ++pt) y2[pt] = mfma16(frag_r(sHb, 136, 16 * pt, 32 * kt, lane), bq[kt], y2[pt]);
            const float ea = fexp(as);
#pragma unroll
            for (int pt = 0; pt < 2; ++pt) { const u32x2 xw = *(const u32x2*)(sX + sl * 40 + 16 * pt + 4 * g);
                const float x0 = bflo(xw.x), x1 = bfhi(xw.x), x2 = bflo(xw.y), x3 = bfhi(xw.y), z0f = bflo(zr[pt].x), z1f = bfhi(zr[pt].x), z2f = bflo(zr[pt].y), z3f = bfhi(zr[pt].y);
                u32x2 ov; ov.x = cvt_pk_bf16((y1[pt][0] + ea * y2[pt][0] + x0 * Dh) * siluf_(z0f), (y1[pt][1] + ea * y2[pt][1] + x1 * Dh) * siluf_(z1f));
                ov.y = cvt_pk_bf16((y1[pt][2] + ea * y2[pt][2] + x2 * Dh) * siluf_(z2f), (y1[pt][3] + ea * y2[pt][3] + x3 * Dh) * siluf_(z3f));
                *(u32x2*)(Yb + ((unsigned)(row0 + sl) * 1024u + 16u * pt + 4u * g)) = ov; }
            const float cd = fexp(acsL);
            Hst[0] *= cd; Hst[1] *= cd;
#pragma unroll
            for (int kt = 0; kt < 4; ++kt) { const bf16x8 bb = frag_k(sB, 136, 32 * kt, 16 * w, lane);
#pragma unroll
                for (int mt2 = 0; mt2 < 2; ++mt2) Hst[mt2] = mfma16(frag_k(sXw, 40, 32 * kt, 16 * mt2, lane), bb, Hst[mt2]); }
        }
        if (c + 1 < SS_NC) SSD_SCAN((c + 1) & 1);
        __syncthreads();
#pragma unroll
        for (int mt2 = 0; mt2 < 2; ++mt2)
#pragma unroll
            for (int i = 0; i < 4; ++i) sHb[(16 * mt2 + 4 * g + i) * 136 + 16 * w + lc] = f2bf(Hst[mt2][i]);
    }
#undef SSD_FETCH
#undef SSD_SCAN
    __syncthreads();
}

constexpr int SW_NB = SEQ / 128;
DI void swa_item(const Frame& F, int item, int l) {
    const int nb = item % SW_NB, kvh = (item / SW_NB) & 3, b = item / (SW_NB * 4);
    int tid_ = F.tid; LAUNDER_V(tid_);
    const int tid = tid_, lane = tid & 63, w = F.wave, g = lane >> 4, lc = lane & 15;
    bf16_t* sK = (bf16_t*)F.lds;
    bf16_t* sV = sK + 256 * 72;
    const long rowb = (long)b * SEQ + (long)nb * 128 - 128;
    const bf16_t* Ub = F.wp<bf16_t>(O_U) + rowb * UWP; bf16_t* Yd = F.wp<bf16_t>(O_Y) + (size_t)3 * NTOK * 1024 + (rowb + 128) * 1024;
    const unsigned z0 = vzero();
#pragma unroll
    for (int i = 0; i < 4; ++i) { const unsigned ch = tid + i * NTHREADS, r = ch >> 3, cc = (ch & 7) * 8;
        u32x4 kv = {z0, z0, z0, z0}, vv = {z0, z0, z0, z0};
        if (nb > 0 || r >= 128) { kv = *(const u32x4*)(Ub + (r * (unsigned)UWP + UC_SWK + kvh * 64u + cc)); vv = *(const u32x4*)(Ub + (r * (unsigned)UWP + UC_SWV + kvh * 64u + cc)); }
        *(u32x4*)(sK + r * 72 + cc) = kv; *(u32x4*)(sV + r * 72 + cc) = vv; }
    if (tid < 128) { const int r = 256 + (tid >> 3), cc = (tid & 7) * 8; *(u32x4*)(sV + r * 72 + cc) = (u32x4){z0, z0, z0, z0}; }
    __syncthreads();
    const int hq = kvh * 4 + (w >> 1);
    const float sink2 = F.inp(17)[l * 16 + hq] * 1.4426950408889634f;
    for (int gi = 0; gi < 4; ++gi) {
        const int r0 = 64 * (w & 1) + 16 * gi;
        const unsigned qoff = (unsigned)(128 + r0 + lc) * (unsigned)UWP + UC_SWQ + hq * 64u + 8u * g;
        const bf16x8 bq0 = *(const bf16x8*)(Ub + qoff), bq1 = *(const bf16x8*)(Ub + (qoff + 32u));
        f32x4 st[10];
#pragma unroll
        for (int j = 0; j < 10; ++j) st[j] = (f32x4){0.f, 0.f, 0.f, 0.f};
#pragma unroll
        for (int j = 0; j < 9; ++j) { st[j] = mfma16(frag_r(sK, 72, r0 + 16 * j, 0, lane), bq0, st[j]); st[j] = mfma16(frag_r(sK, 72, r0 + 16 * j, 32, lane), bq1, st[j]); }
        const int qpos = 128 + r0 + lc;
        float mx = -3.0e38f;
#pragma unroll
        for (int j = 0; j < 9; ++j)
#pragma unroll
            for (int i = 0; i < 4; ++i) { const int tp = r0 + 16 * j + 4 * g + i; const bool ok = (tp <= qpos) && (qpos - tp < 128) && (nb > 0 || tp >= 128);
                const float v = ok ? st[j][i] * (0.125f * 1.4426950408889634f) : -3.0e38f; st[j][i] = v; mx = fmaxf(mx, v); }
        mx = fmaxf(mx, shfl_xor_f(mx, 16)); mx = fmaxf(mx, shfl_xor_f(mx, 32));
        mx = fmaxf(mx, sink2);
        float sum = 0.f;
#pragma unroll
        for (int j = 0; j < 9; ++j)
#pragma unroll
            for (int i = 0; i < 4; ++i) { const float e = fexp2(st[j][i] - mx); st[j][i] = e; sum += e; }
        sum += shfl_xor_f(sum, 16); sum += shfl_xor_f(sum, 32);
        sum += fexp2(sink2 - mx);
        const float inv = frcp(sum);
        f32x4 o[4];
#pragma unroll
        for (int nt = 0; nt < 4; ++nt) o[nt] = (f32x4){0.f, 0.f, 0.f, 0.f};
        const bf16_t* vb = sV + (r0 + 4 * g + ((lane & 15) >> 2)) * 72 + 4 * (lane & 3);
#pragma unroll
        for (int ks = 0; ks < 5; ++ks) {
            u32x4 pw; pw.x = cvt_pk_bf16(st[2 * ks][0], st[2 * ks][1]); pw.y = cvt_pk_bf16(st[2 * ks][2], st[2 * ks][3]); pw.z = cvt_pk_bf16(st[2 * ks + 1][0], st[2 * ks + 1][1]); pw.w = cvt_pk_bf16(st[2 * ks + 1][2], st[2 * ks + 1][3]);
            const bf16x8 pb = __builtin_bit_cast(bf16x8, pw);
#pragma unroll
            for (int nt = 0; nt < 4; ++nt) { const s16x4 lo = lds_tr4(vb + (32 * ks) * 72 + 16 * nt), hi = lds_tr4(vb + (32 * ks + 16) * 72 + 16 * nt);
                o[nt] = mfma16(__builtin_shufflevector(lo, hi, 0, 1, 2, 3, 4, 5, 6, 7), pb, o[nt]); } }
        const unsigned ooff = (unsigned)(r0 + lc) * 1024u + hq * 64u + 4u * g;
#pragma unroll
        for (int nt = 0; nt < 4; ++nt) { u32x2 ov; ov.x = cvt_pk_bf16(o[nt][0] * inv, o[nt][1] * inv); ov.y = cvt_pk_bf16(o[nt][2] * inv, o[nt][3] * inv); *(u32x2*)(Yd + (ooff + 16u * nt)) = ov; }
    }
    __syncthreads();
}

template <int DQK, bool MLA>
DI void attn_block(const Frame& F, const bf16_t* Qp, int ldq, const bf16_t* Kp, int ldk, const bf16_t* K2p  , const bf16_t* Vp, int ldv, bf16_t* Op, int ldo,
                   int nkt  , int qpos0  , float scale_log2e) {
    constexpr int PQ = DQK + 8, NKR = MLA ? 1 : 0, NKT = DQK / 32;
    int tid_ = F.tid; LAUNDER_V(tid_);
    const int tid = tid_, lane = tid & 63, w = F.wave, g = lane >> 4, lc = lane & 15;
    bf16_t* sK = (bf16_t*)F.lds;
    bf16_t* sV = sK + 2 * 64 * PQ;
    u32x4 kreg[2], rreg[1], vreg[2];
    unsigned koffb[2], voffb[2];
#pragma unroll
    for (int i_ = 0; i_ < 2; ++i_) { const unsigned c_ = tid + i_ * NTHREADS, r_ = c_ >> 4, ch_ = c_ & 15; koffb[i_] = (r_ * (unsigned)ldk + ch_ * 8u) * 2u; voffb[i_] = (r_ * (unsigned)ldv + ch_ * 8u) * 2u; }
    const unsigned roffb = ((tid >> 3) * 64u + (tid & 7) * 8u) * 2u;
#define ATTN_FETCH(t) do { int t_ = (t); LAUNDER_S(t_);     \
        const char* kb_ = (const char*)(Kp + (size_t)t_ * 64 * ldk); const char* vb_ = (const char*)(Vp + (size_t)t_ * 64 * ldv); const char* rb_ = (const char*)(K2p + (size_t)t_ * 64 * 64); \
        _Pragma("unroll") for (int i_ = 0; i_ < 2; ++i_) { kreg[i_] = *(const u32x4*)(kb_ + koffb[i_]); vreg[i_] = *(const u32x4*)(vb_ + voffb[i_]); } \
        _Pragma("unroll") for (int i_ = 0; i_ < NKR; ++i_) { rreg[i_] = *(const u32x4*)(rb_ + roffb); } } while (0)
#define ATTN_STORE(bf) do { bf16_t* k_ = sK + (bf) * 64 * PQ; bf16_t* v_ = sV + (bf) * 64 * 136; \
        _Pragma("unroll") for (int i_ = 0; i_ < 2; ++i_) { const int c_ = tid + i_ * NTHREADS, r_ = c_ >> 4, ch_ = c_ & 15; *(u32x4*)(k_ + r_ * PQ + ch_ * 8) = kreg[i_]; *(u32x4*)(v_ + r_ * 136 + ch_ * 8) = vreg[i_]; } \
        _Pragma("unroll") for (int i_ = 0; i_ < NKR; ++i_) { const int r_ = tid >> 3, ch_ = tid & 7; *(u32x4*)(k_ + r_ * PQ + 128 + ch_ * 8) = rreg[i_]; } } while (0)
    ATTN_FETCH(0);
    bf16x8 bq[2][NKT];
#pragma unroll
    for (int qg = 0; qg < 2; ++qg) { const unsigned qoff = (unsigned)(32 * w + 16 * qg + lc) * (unsigned)ldq + 8u * g;
#pragma unroll
        for (int kt = 0; kt < NKT; ++kt) bq[qg][kt] = *(const bf16x8*)(Qp + (qoff + 32u * kt));
        if constexpr (MLA) {
            const char* rpb = (const char*)F.wp<float>(O_ROPE); const unsigned rpo = 8u * ((unsigned)(qpos0 + 32 * w + 16 * qg + lc) * 32u + 8u * g);
            bf16x8 x1 = bq[qg][4], x2 = bq[qg][5];
#pragma unroll
            for (int j = 0; j < 4; ++j) { const f32x4 cs4 = *(const f32x4*)(rpb + (rpo + 16u * j));
#pragma unroll
              for (int h = 0; h < 2; ++h) { const int jj = 2 * j + h; const float a = bf2f((bf16_t)x1[jj]), c2 = bf2f((bf16_t)x2[jj]), cs = cs4[2 * h], sn = cs4[2 * h + 1];
                x1[jj] = (short)f2bf(a * cs - c2 * sn); x2[jj] = (short)f2bf(c2 * cs + a * sn); } }
#if 0
            for (int j = 0; j < 8; ++j) { const float a = 0, c2 = 0, cs = 0, sn = 0;
                x1[j] = (short)f2bf(a * cs - c2 * sn); x2[j] = (short)f2bf(c2 * cs + a * sn); }
#endif
            bq[qg][4] = x1; bq[qg][5] = x2; } }
    __syncthreads();
    ATTN_STORE(0);
    __syncthreads();
    f32x4 o[2][8]; float mrow[2] = {-3.0e38f, -3.0e38f}, lrow[2] = {0.f, 0.f};
#pragma unroll
    for (int qg = 0; qg < 2; ++qg)
#pragma unroll
        for (int nt = 0; nt < 8; ++nt) o[qg][nt] = (f32x4){0.f, 0.f, 0.f, 0.f};
    if (nkt > 1) ATTN_FETCH(1);
    for (int kt0 = 0; kt0 < nkt; ++kt0) {
        const bf16_t* cK = sK + (kt0 & 1) * 64 * PQ; const bf16_t* cV = sV + (kt0 & 1) * 64 * 136;
        if (kt0 + 1 < nkt) ATTN_STORE((kt0 + 1) & 1);
        if (kt0 + 2 < nkt) ATTN_FETCH(kt0 + 2);
        f32x4 st[2][4];
#pragma unroll
        for (int qg = 0; qg < 2; ++qg)
#pragma unroll
            for (int j = 0; j < 4; ++j) st[qg][j] = (f32x4){0.f, 0.f, 0.f, 0.f};
        {
            bf16x8 ak[2][4];
#pragma unroll
            for (int j = 0; j < 4; ++j) ak[0][j] = frag_r(cK, PQ, 16 * j, 0, lane);
#pragma unroll
            for (int kt = 0; kt < NKT; ++kt) {
                if (kt + 1 < NKT) {
#pragma unroll
                    for (int j = 0; j < 4; ++j) ak[(kt + 1) & 1][j] = frag_r(cK, PQ, 16 * j, 32 * (kt + 1), lane); }
                SETPRIO(1);
#pragma unroll
                for (int j = 0; j < 4; ++j) { st[0][j] = mfma16(ak[kt & 1][j], bq[0][kt], st[0][j]); st[1][j] = mfma16(ak[kt & 1][j], bq[1][kt], st[1][j]); }
                SETPRIO(0);
                SCHED_BAR(); } }
        const bool need_mask = MLA && (kt0 * 64 + 63 > qpos0 + 32 * w);
        bf16x8 pb[2][2];
        float mxq[2];
#pragma unroll
        for (int qg = 0; qg < 2; ++qg) {
            const int qp = qpos0 + 32 * w + 16 * qg + lc;
            float mx = -3.0e38f;
#pragma unroll
            for (int j = 0; j < 4; ++j)
#pragma unroll
                for (int i = 0; i < 4; ++i) { float v = st[qg][j][i] * scale_log2e;
                    if (need_mask) { const int kp = kt0 * 64 + 16 * j + 4 * g + i; v = (kp <= qp) ? v : -3.0e38f; }
                    st[qg][j][i] = v; mx = fmaxf(mx, v); }
            mx = fmaxf(mx, shfl_xor_f(mx, 16)); mx = fmaxf(mx, shfl_xor_f(mx, 32));
            mxq[qg] = mx; }
        if (wave_any((mxq[0] - mrow[0] > 8.0f) || (mxq[1] - mrow[1] > 8.0f))) {
#pragma unroll
            for (int qg = 0; qg < 2; ++qg) { const float mnew = fmaxf(mrow[qg], mxq[qg]), alpha = fexp2(mrow[qg] - mnew);
                lrow[qg] *= alpha; mrow[qg] = mnew;
#pragma unroll
                for (int nt = 0; nt < 8; ++nt) o[qg][nt] *= alpha; } }
#pragma unroll
        for (int qg = 0; qg < 2; ++qg) {
            const float mcur = mrow[qg];
            float sum = 0.f;
#pragma unroll
            for (int j = 0; j < 4; ++j)
#pragma unroll
                for (int i = 0; i < 4; ++i) { const float e = fexp2(st[qg][j][i] - mcur); st[qg][j][i] = e; sum += e; }
            sum += shfl_xor_f(sum, 16); sum += shfl_xor_f(sum, 32);
            lrow[qg] += sum;
#pragma unroll
            for (int ks = 0; ks < 2; ++ks) { u32x4 pw; pw.x = cvt_pk_bf16(st[qg][2 * ks][0], st[qg][2 * ks][1]); pw.y = cvt_pk_bf16(st[qg][2 * ks][2], st[qg][2 * ks][3]);
                pw.z = cvt_pk_bf16(st[qg][2 * ks + 1][0], st[qg][2 * ks + 1][1]); pw.w = cvt_pk_bf16(st[qg][2 * ks + 1][2], st[qg][2 * ks + 1][3]); pb[qg][ks] = __builtin_bit_cast(bf16x8, pw); }
        }
        {
            const bf16_t* vb = cV + (4 * g + ((lane & 15) >> 2)) * 136 + 4 * (lane & 3);
            bf16x8 av[2][4];
#define ATTN_LDV(dst, ks_, h_) do { _Pragma("unroll") for (int n_ = 0; n_ < 4; ++n_) { const s16x4 lo_ = lds_tr4(vb + (32 * (ks_)) * 136 + 16 * (4 * (h_) + n_)), hi_ = lds_tr4(vb + (32 * (ks_) + 16) * 136 + 16 * (4 * (h_) + n_)); \
                dst[n_] = __builtin_shufflevector(lo_, hi_, 0, 1, 2, 3, 4, 5, 6, 7); } } while (0)
            ATTN_LDV(av[0], 0, 0);
#pragma unroll
            for (int hs = 0; hs < 4; ++hs) { const int ks = hs >> 1, h = hs & 1;
                if (hs + 1 < 4) ATTN_LDV(av[(hs + 1) & 1], (hs + 1) >> 1, (hs + 1) & 1);
                SETPRIO(1);
#pragma unroll
                for (int n = 0; n < 4; ++n) { o[0][4 * h + n] = mfma16(av[hs & 1][n], pb[0][ks], o[0][4 * h + n]); o[1][4 * h + n] = mfma16(av[hs & 1][n], pb[1][ks], o[1][4 * h + n]); }
                SETPRIO(0);
                SCHED_BAR(); }
#undef ATTN_LDV
            PIN_ACC8(o[0]); PIN_ACC8(o[1]);
        }
        __syncthreads();
    }
#undef ATTN_FETCH
#undef ATTN_STORE
#pragma unroll
    for (int qg = 0; qg < 2; ++qg) { const float inv = frcp(lrow[qg]); int lid = lane; LAUNDER_V(lid);
        const unsigned ooff = (unsigned)(32 * w + 16 * qg + (lid & 15)) * (unsigned)ldo + 4u * (lid >> 4);
#pragma unroll
        for (int nt = 0; nt < 8; ++nt) { u32x2 ov; ov.x = cvt_pk_bf16(o[qg][nt][0] * inv, o[qg][nt][1] * inv); ov.y = cvt_pk_bf16(o[qg][nt][2] * inv, o[qg][nt][3] * inv); *(u32x2*)(Op + (ooff + 16u * nt)) = ov; } }
}
constexpr int NQB = SEQ / 256, NQP = (NQB + 1) / 2;
DI void mla_attn_item(const Frame& F, int item) {
    const int pj = item % NQP, hh = (item / NQP) & 7, b = item / (NQP * 8);
    const bf16_t* QF = F.wp<bf16_t>(O_QF); const bf16_t* KVF = F.wp<bf16_t>(O_KVF); const bf16_t* KR = F.wp<bf16_t>(O_KR); bf16_t* Yc = F.wp<bf16_t>(O_Y) + (size_t)2 * NTOK * 1024;
    const size_t rb = (size_t)b * SEQ;
    for (int k = 0; k < 2; ++k) { const int qb = k ? (NQB - 1 - pj) : pj;
        if (k == 1 && qb == pj) break;
        attn_block<192, true>(F, QF + (rb + qb * 256) * 1536 + hh * 192, 1536, KVF + rb * 2048 + hh * 256, 2048, KR + rb * 64, KVF + rb * 2048 + hh * 256 + 128, 2048,
                              Yc + (rb + qb * 256) * 1024 + hh * 128, 1024, (qb + 1) * 4, qb * 256, 0.07216878364870322f * 1.4426950408889634f); }
}
DI void xattn_item(const Frame& F, int item) {
    const int qb = item % NQB, hh = (item / NQB) & 3, b = item / (NQB * 4);
    const bf16_t* XQ = F.wp<bf16_t>(O_XQ); const bf16_t* XKV = F.wp<bf16_t>(O_XKV); bf16_t* XO = F.wp<bf16_t>(O_XO);
    attn_block<128, false>(F, XQ + ((size_t)b * SEQ + qb * 256) * 512 + hh * 128, 512, XKV + (size_t)b * MEMLEN * 1024 + hh * 128, 1024, nullptr,
                           XKV + (size_t)b * MEMLEN * 1024 + 512 + hh * 128, 1024, XO + ((size_t)b * SEQ + qb * 256) * 512 + hh * 128, 512, MEMLEN / 64, 0, 0.08838834764831845f * 1.4426950408889634f);
}

DI void phase_fixup(const Frame& F, int l) {
    const int gw = F.bid * 8 + F.wave, NGW = F.G * 8, lane = F.lane;
    bf16_t* Ya = F.wp<bf16_t>(O_Y); bf16_t* Yb = Ya + (size_t)NTOK * 1024; const bf16_t* U = F.wp<bf16_t>(O_U);
    const float* mlnorm = F.inp(6) + l * 1024; const float* ssnorm = F.inp(12) + l * 1024;
    for (int r = gw; r < NTOK; r += NGW) {
        u32x4 hva[2], hvb[2], ovp[2];
        hva[0] = *(const u32x4*)(Ya + (size_t)r * 1024 + 16 * lane); hva[1] = *(const u32x4*)(Ya + (size_t)r * 1024 + 16 * lane + 8);
        hvb[0] = *(const u32x4*)(Yb + (size_t)r * 1024 + 16 * lane); hvb[1] = *(const u32x4*)(Yb + (size_t)r * 1024 + 16 * lane + 8);
        ovp[0] = *(const u32x4*)(U + (size_t)r * UWP + UC_MLO + 16 * lane); ovp[1] = *(const u32x4*)(U + (size_t)r * UWP + UC_MLO + 16 * lane + 8);
        {   u32x4 hv[2]; float x[16]; float s = 0.f;
            hv[0] = hva[0]; hv[1] = hva[1];
#pragma unroll
            for (int k = 0; k < 2; ++k) { x[8 * k + 0] = bflo(hv[k].x); x[8 * k + 1] = bfhi(hv[k].x); x[8 * k + 2] = bflo(hv[k].y); x[8 * k + 3] = bfhi(hv[k].y); x[8 * k + 4] = bflo(hv[k].z); x[8 * k + 5] = bfhi(hv[k].z); x[8 * k + 6] = bflo(hv[k].w); x[8 * k + 7] = bfhi(hv[k].w); }
#pragma unroll
            for (int i = 0; i < 16; ++i) s += x[i] * x[i];
            s = grp16_sum(s);
            const float rstd = 1.0f / sqrtf(s * (1.0f / 256) + RMS_EPS);
            u32x4 ov[2]; ov[0] = ovp[0]; ov[1] = ovp[1];
            float og[16];
#pragma unroll
            for (int k = 0; k < 2; ++k) { og[8 * k + 0] = bflo(ov[k].x); og[8 * k + 1] = bfhi(ov[k].x); og[8 * k + 2] = bflo(ov[k].y); og[8 * k + 3] = bfhi(ov[k].y); og[8 * k + 4] = bflo(ov[k].z); og[8 * k + 5] = bfhi(ov[k].z); og[8 * k + 6] = bflo(ov[k].w); og[8 * k + 7] = bfhi(ov[k].w); }
            float y[16];
#pragma unroll
            for (int i = 0; i < 16; ++i) y[i] = sigmoidf_(og[i]) * x[i] * rstd * mlnorm[16 * lane + i];
            u32x4 o0, o1; o0.x = cvt_pk_bf16(y[0], y[1]); o0.y = cvt_pk_bf16(y[2], y[3]); o0.z = cvt_pk_bf16(y[4], y[5]); o0.w = cvt_pk_bf16(y[6], y[7]);
            o1.x = cvt_pk_bf16(y[8], y[9]); o1.y = cvt_pk_bf16(y[10], y[11]); o1.z = cvt_pk_bf16(y[12], y[13]); o1.w = cvt_pk_bf16(y[14], y[15]);
            *(u32x4*)(Ya + (size_t)r * 1024 + 16 * lane) = o0; *(u32x4*)(Ya + (size_t)r * 1024 + 16 * lane + 8) = o1; }
        {   u32x4 hv[2]; float x[16]; float s = 0.f;
            hv[0] = hvb[0]; hv[1] = hvb[1];
#pragma unroll
            for (int k = 0; k < 2; ++k) { x[8 * k + 0] = bflo(hv[k].x); x[8 * k + 1] = bfhi(hv[k].x); x[8 * k + 2] = bflo(hv[k].y); x[8 * k + 3] = bfhi(hv[k].y); x[8 * k + 4] = bflo(hv[k].z); x[8 * k + 5] = bfhi(hv[k].z); x[8 * k + 6] = bflo(hv[k].w); x[8 * k + 7] = bfhi(hv[k].w); }
#pragma unroll
            for (int i = 0; i < 16; ++i) s += x[i] * x[i];
            s = grp16_sum(s); s += shfl_xor_f(s, 16);
            const float rstd = 1.0f / sqrtf(s * (1.0f / 512) + RMS_EPS);
            float y[16];
#pragma unroll
            for (int i = 0; i < 16; ++i) y[i] = x[i] * rstd * ssnorm[16 * lane + i];
            u32x4 o0, o1; o0.x = cvt_pk_bf16(y[0], y[1]); o0.y = cvt_pk_bf16(y[2], y[3]); o0.z = cvt_pk_bf16(y[4], y[5]); o0.w = cvt_pk_bf16(y[6], y[7]);
            o1.x = cvt_pk_bf16(y[8], y[9]); o1.y = cvt_pk_bf16(y[10], y[11]); o1.z = cvt_pk_bf16(y[12], y[13]); o1.w = cvt_pk_bf16(y[14], y[15]);
            *(u32x4*)(Yb + (size_t)r * 1024 + 16 * lane) = o0; *(u32x4*)(Yb + (size_t)r * 1024 + 16 * lane + 8) = o1; }
    }
}

#ifndef PHMASK
#define PHMASK 0xFFFFFFFFu
#endif
#define EN(b) (((PHMASK) >> (b)) & 1u)
#ifndef REPMASK
#define REPMASK 0u
#endif
#define RP(b) (((REPMASK) >> (b)) & 1u)
constexpr int PH_PER_LAYER = 16, PH_FINAL = 1 + DEPTH * PH_PER_LAYER, PH_COUNT = PH_FINAL + 1;
#ifndef HOST_EMU
#define GEMM_LDS ((LAS unsigned char*)lds)
__global__ void __launch_bounds__(NTHREADS, 2) mk_fwd(Params P) {
    extern __shared__ __attribute__((aligned(16))) unsigned char lds[];
#else
#define GEMM_LDS (lds)
static void mk_fwd(Params P) {
    unsigned char* lds = emu::B->lds;
#endif
    const int wave0 = rfl((int)threadIdx.x >> 6);
    Frame F; make_frame(F, P, lds, wave0);
    int* misc = (int*)(lds + LDS_MISC);
    if (F.tid < 256) misc[F.tid] = 0;
    __syncthreads();
#ifndef HOST_EMU
    XcdBarrier bar; bar.bar = (unsigned*)(P.ws + O_CTL) + 4096; bar.x = 0; bar.st = nullptr; bar.wave = wave0;
    if (MK_N_LAUNCHES == 1) bar = xcd_barrier_post((unsigned*)(P.ws + O_CTL) + 4096, (volatile LAS unsigned*)(lds + LDS_MISC), wave0);
#define GRID_BAR() xcd_barrier(bar)
#else
#define GRID_BAR() emu::grid_sync()
#endif
    int* tile_e = misc + 16; int* pstart = misc + 16 + 160; int* ntiles = misc + 16 + 160 + 8; int* myoff = misc + 16 + 160 + 16;
    const int lo = P.ph_lo, hi = P.ph_hi;
#define IN(k) (lo <= (k) && (k) < hi)
#define SEAM(k) do { if (IN(k) && IN((k) + 1)) GRID_BAR(); } while (0)
    const int c = F.bid, cr = F.G - 1 - F.bid;

    if (EN(0) && IN(0)) for (int rep_ = 0; rep_ <= (int)RP(0); ++rep_) { REFRAME(); phase_prologue(F); REFRAME(); phase_rmsnorm_x(F, F.inp(0), F.inp(2)); }
    SEAM(0);
    for (int l = 0; l < DEPTH; ++l) {
        const int pb = 1 + l * PH_PER_LAYER;
        const bool moe = (l & 1) != 0;
#define HIN() (F.wp<bf16_t>(O_H))
#define HBUF() (F.wp<bf16_t>(O_H))
        if (l > 0) { if (EN(1) && IN(pb + 0)) for (int rep_ = 0; rep_ <= (int)RP(1); ++rep_) { REFRAME(); phase_rmsnorm(F, HBUF(), F.inp(2) + l * D); }
        SEAM(pb + 0); }
        if (EN(2) && IN(pb + 1)) for (int rep_ = 0; rep_ <= (int)RP(2); ++rep_) { REFRAME();
            pg8::Gemm g{HBUF(), D, F.wp<bf16_t>(O_WIN) + (size_t)l * UW * D, D, D}; pg8::OrdStatic S{NTOK / 256, UC_GATE / 256, F.G, c};
            pg8::EpiU E{F.wp<bf16_t>(O_U), F.wp<float>(O_SM), F.wp<float>(O_RSTD), (LAS float*)(GEMM_LDS + pg8::RS_TAB)};
            pg8::gemm_phase(GEMM_LDS, g, S, E, F.wave);
            {
                REFRAME();
                pg8::Gemm g8{(const bf16_t*)F.wp<unsigned char>(O_XN8), D / 2, (const bf16_t*)(F.wp<unsigned char>(O_WG8) + (size_t)l * 8192 * D), D / 2, D / 2};
                pg8::OrdStatic S8{NTOK / 256, 8192 / (128 * F8_NBJ), F.G, c};
                pg8::EpiGate8 E8{F.wp<unsigned char>(O_G8), 1.0f / (F8_ASCALE * F8_WSCALE)};
                pg8::gemm_phase_f8<pg8::EpiGate8, pg8::OrdStatic, true>(GEMM_LDS, g8, S8, E8, F.wave); }
#ifdef PROBE_NULL_WIN
            { pg8::EpiNull E0{F.wp<float>(O_CTL) + 1024}; pg8::gemm_phase(GEMM_LDS, g, S, E0, F.wave); }
#endif
#ifdef PROBE_L2_WIN
            { pg8::EpiUL2 E0{F.wp<bf16_t>(O_MACC) + (size_t)F.bid * 256 * 256}; pg8::gemm_phase(GEMM_LDS, g, S, E0, F.wave); }
#endif
        }
        SEAM(pb + 1);
        if (EN(3) && IN(pb + 2)) for (int rep_ = 0; rep_ <= (int)RP(3); ++rep_) { REFRAME(); phase_prep(F, l); }
        SEAM(pb + 2);
        if (IN(pb + 3)) {
            if (EN(4)) for (int rep_ = 0; rep_ <= (int)RP(4); ++rep_) { REFRAME(); pg8::Gemm g{F.wp<bf16_t>(O_CQN), 512, F.wp<bf16_t>(O_WUQ) + (size_t)l * 1536 * 512, 512, 512}; pg8::OrdStatic S{NTOK / 256, 1536 / 256, F.G, c};
              pg8::EpiBf16 E{F.wp<bf16_t>(O_QF), 1536}; pg8::gemm_phase(GEMM_LDS, g, S, E, F.wave); }
            if (EN(4)) for (int rep_ = 0; rep_ <= (int)RP(4); ++rep_) { REFRAME(); pg8::Gemm g{F.wp<bf16_t>(O_CKVN), 256, F.wp<bf16_t>(O_WUKV) + (size_t)l * 2048 * 256, 256, 256}; pg8::OrdStatic S{NTOK / 256, 2048 / 256, F.G, cr};
              pg8::EpiBf16 E{F.wp<bf16_t>(O_KVF), 2048}; pg8::gemm_phase(GEMM_LDS, g, S, E, F.wave); }
            __syncthreads();
            REFRAME(); if (EN(5)) for (int rep_ = 0; rep_ <= (int)RP(5); ++rep_) for (int it = c; it < BATCH * 4 * 8; it += F.G) mlstm_item(F, it);
            REFRAME(); if (EN(6)) for (int rep_ = 0; rep_ <= (int)RP(6); ++rep_) for (int it = cr; it < BATCH * 16 * 2; it += F.G) ssd_item(F, it, l);
            REFRAME(); if (EN(7)) for (int rep_ = 0; rep_ <= (int)RP(7); ++rep_) for (int it = c; it < BATCH * 4 * SW_NB; it += F.G) swa_item(F, it, l);
        }
        SEAM(pb + 3);
        if (IN(pb + 4)) {
            if (EN(8)) for (int rep_ = 0; rep_ <= (int)RP(8); ++rep_) for (int it = c; it < BATCH * 8 * NQP; it += F.G) mla_attn_item(F, it);
            REFRAME(); if (EN(9)) phase_fixup(F, l);
        }
        SEAM(pb + 4);
        if (EN(10) && IN(pb + 5)) for (int rep_ = 0; rep_ <= (int)RP(10); ++rep_) { REFRAME();
            pg8::Gemm g{F.wp<bf16_t>(O_Y), 1024, F.wp<bf16_t>(O_WBR) + (size_t)l * 4 * 2048 * 1024, 1024, 1024}; pg8::OrdMerge S{NTOK / 256, D / 256, F.G, c};
            pg8::EpiMerge E{F.wp<unsigned char>(O_G8), F.wp<bf16_t>(O_MERGED)};
            pg8::gemm_phase(GEMM_LDS, g, S, E, F.wave);
        }
        SEAM(pb + 5);
        if (EN(11) && IN(pb + 6)) for (int rep_ = 0; rep_ <= (int)RP(11); ++rep_) { REFRAME();
            pg8::Gemm g{F.wp<bf16_t>(O_MERGED), D, F.wp<bf16_t>(O_WOUT) + (size_t)l * D * D, D, D}; pg8::OrdStatic S{NTOK / 256, D / 256, F.G, c};
            pg8::EpiResidT<true> E{HIN(), HBUF(), F.wp<float>(O_SSQ)};
            pg8::gemm_phase(GEMM_LDS, g, S, E, F.wave);
        }
        SEAM(pb + 6);
        if (EN(12) && IN(pb + 8)) for (int rep_ = 0; rep_ <= (int)RP(12); ++rep_) { REFRAME();
            { pg8::Gemm g{HBUF(), D, F.wp<bf16_t>(O_WXQ) + (size_t)l * 512 * D, D, D}; pg8::OrdStatic S{NTOK / 256, 512 / 256, F.G, c};
              pg8::EpiBf16R E{F.wp<bf16_t>(O_XQ), 512, F.wp<float>(O_SSQ), (LAS float*)(GEMM_LDS + pg8::RS_TAB)}; pg8::gemm_phase(GEMM_LDS, g, S, E, F.wave); }
            { REFRAME(); pg8::Gemm g{F.wp<bf16_t>(O_MEMN) + (size_t)l * NMEM * D, D, F.wp<bf16_t>(O_WXKV) + (size_t)l * 1024 * D, D, D}; pg8::OrdStatic S{NMEM / 256, 1024 / 256, F.G, cr};
              pg8::EpiBf16 E{F.wp<bf16_t>(O_XKV), 1024}; pg8::gemm_phase(GEMM_LDS, g, S, E, F.wave); }
        }
        SEAM(pb + 8);
        if (EN(13) && IN(pb + 9)) for (int rep_ = 0; rep_ <= (int)RP(13); ++rep_) { REFRAME(); for (int it = c; it < BATCH * 4 * NQB; it += F.G) xattn_item(F, it); }
        SEAM(pb + 9);
        if (EN(14) && IN(pb + 10)) for (int rep_ = 0; rep_ <= (int)RP(14); ++rep_) { REFRAME();
            pg8::Gemm g{F.wp<bf16_t>(O_XO), 512, F.wp<bf16_t>(O_WXO) + (size_t)l * D * 512, 512, 512}; pg8::OrdStatic S{NTOK / 256, D / 256, F.G, c};
            if (!moe) { pg8::EpiResidT<true> E{HBUF(), HBUF(), F.wp<float>(O_SSQ)}; pg8::gemm_phase(GEMM_LDS, g, S, E, F.wave); }
            else { pg8::EpiResid E{HBUF(), HBUF(), nullptr}; pg8::gemm_phase(GEMM_LDS, g, S, E, F.wave); }
        }
        SEAM(pb + 10);
        if (!moe) {
            if (EN(15) && IN(pb + 12)) for (int rep_ = 0; rep_ <= (int)RP(15); ++rep_) { REFRAME();
                pg8::Gemm g{HBUF(), D, F.wp<bf16_t>(O_W13), D, D}; pg8::OrdStatic S{NTOK / 256, 2 * FFN / 256, F.G, c};
                pg8::EpiSwiGLUR E{F.wp<bf16_t>(O_ACT), F.wp<float>(O_SSQ), (LAS float*)(GEMM_LDS + pg8::RS_TAB)};
                pg8::gemm_phase(GEMM_LDS, g, S, E, F.wave);
            }
            SEAM(pb + 12);
            if (EN(16) && IN(pb + 13)) for (int rep_ = 0; rep_ <= (int)RP(16); ++rep_) { REFRAME();
                pg8::Gemm g{F.wp<bf16_t>(O_ACT), FFN, F.wp<bf16_t>(O_W2), FFN, FFN}; pg8::OrdStatic S{NTOK / 256, D / 256, F.G, c};
                pg8::EpiResid E{HBUF(), HBUF(), nullptr};
                pg8::gemm_phase(GEMM_LDS, g, S, E, F.wave);
            }
            if (IN(pb + 13) && IN(pb + PH_PER_LAYER)) GRID_BAR();
        } else {
            if (EN(17) && IN(pb + 11)) for (int rep_ = 0; rep_ <= (int)RP(17); ++rep_) { REFRAME(); phase_rmsnorm_route(F, HBUF(), F.inp(25) + l * D, F.inp(28)); }
            SEAM(pb + 11);
            if (EN(18) && IN(pb + 12)) for (int rep_ = 0; rep_ <= (int)RP(18); ++rep_) { REFRAME(); phase_moe_scatter(F, tile_e, pstart, ntiles, myoff); }
            SEAM(pb + 12);
            if (EN(19) && IN(pb + 13)) for (int rep_ = 0; rep_ <= (int)RP(19); ++rep_) { REFRAME();
                if (!IN(pb + 12)) moe_tables(F, tile_e, pstart, ntiles);
                pg8::Gemm g{(const bf16_t*)F.wp<unsigned char>(O_XG), D / 2, (const bf16_t*)F.wp<unsigned char>(O_MW13), D / 2, D / 2}; pg8::OrdMoe S{*ntiles, 2 * FFN / (128 * F8_NBJ), F.G, c, tile_e, 1 << 30};
                pg8::EpiSwiGLU8<F8_NBJ> E{F.wp<unsigned char>(O_ACTM), 1.0f / (F8_ASCALE * F8_WSCALE)};
                pg8::gemm_phase_f8<pg8::EpiSwiGLU8<F8_NBJ>, pg8::OrdMoe, F8_FULL != 0>(GEMM_LDS, g, S, E, F.wave);
            }
            SEAM(pb + 13);
            if (EN(20) && IN(pb + 14)) for (int rep_ = 0; rep_ <= (int)RP(20); ++rep_) { REFRAME();
                if (!IN(pb + 13)) moe_tables(F, tile_e, pstart, ntiles);
                int full, R, sp; pg8::moe_tail_split(*ntiles, F.G, full, R, sp);
                { pg8::Gemm g{(const bf16_t*)F.wp<unsigned char>(O_ACTM), FFN / 2, (const bf16_t*)F.wp<unsigned char>(O_MW2), FFN / 2, FFN / 2}; pg8::OrdMoe S{*ntiles, D / 256, F.G, c, tile_e, full};
                  pg8::EpiBf16S<2> E{F.wp<bf16_t>(O_YG), D, 1.0f / (F8_ASCALE * F8_WSCALE)};
                  pg8::gemm_phase_f8<pg8::EpiBf16S<2>, pg8::OrdMoe, true>(GEMM_LDS, g, S, E, F.wave); }
                if (R > 0) {
                    REFRAME();
                    const int uix = c / sp, kp = c - uix * sp, Kp = FFN / sp;
                    pg8::OrdOne S1; S1.valid = (uix < R); S1.u.pm = 0; S1.u.pn = 0; S1.u.pa = 0; S1.u.pb = 0; S1.u.aux = 0; S1.u.ui = 0;
                    if (S1.valid) { pg8::static_map((long)full * F.G + uix, *ntiles, D / 256, S1.u.pm, S1.u.pn); S1.u.aux = tile_e[S1.u.pm]; S1.u.pa = S1.u.pm; S1.u.pb = S1.u.aux * (D / 256) + S1.u.pn; }
                    pg8::Gemm g1{(const bf16_t*)(F.wp<unsigned char>(O_ACTM) + (size_t)kp * Kp), FFN / 2, (const bf16_t*)(F.wp<unsigned char>(O_MW2) + (size_t)kp * Kp), FFN / 2, Kp / 2};
                    pg8::EpiPart E1{F.wp<float>(O_TAILACC) + (size_t)(S1.valid ? c : 0) * 65536, 1.0f / (F8_ASCALE * F8_WSCALE)};
                    pg8::gemm_phase_f8<pg8::EpiPart, pg8::OrdOne, true>(GEMM_LDS, g1, S1, E1, F.wave);
                }
            }
            if (IN(pb + 14) && IN(pb + PH_PER_LAYER)) GRID_BAR();
        }
    }
    if (EN(21) && IN(PH_FINAL)) for (int rep_ = 0; rep_ <= (int)RP(21); ++rep_) { REFRAME(); if (!IN(PH_FINAL - 2) && (((DEPTH - 1) & 1) != 0)) moe_tables(F, tile_e, pstart, ntiles); phase_final(F, ((DEPTH - 1) & 1) != 0, ntiles, (unsigned char*)(misc + 256)); }
#undef IN
#undef SEAM
}

#ifndef HOST_EMU
extern "C" void kernel_launch(void* const* d_in, const int* in_sizes, int n_in, void* d_out, int out_size, void* d_ws, size_t ws_size, hipStream_t stream) {
    static int grid = 0;
    if (grid == 0) {
        if (n_in != 32 || in_sizes[0] != NTOK * D || out_size != NTOK * D || ws_size < WS_END) {
            fprintf(stderr, "kernel_launch: shape/workspace mismatch: n_in %d in0 %d out %d ws %zu (need %zu)\n", n_in, n_in > 0 ? in_sizes[0] : -1, out_size, ws_size, (size_t)WS_END); grid = -1; return; }
        int dev = 0, cus = 0, per_cu = 0;
        if (hipGetDevice(&dev) != hipSuccess || hipDeviceGetAttribute(&cus, hipDeviceAttributeMultiprocessorCount, dev) != hipSuccess) { grid = -1; return; }
        if (hipFuncSetAttribute((const void*)mk_fwd, hipFuncAttributeMaxDynamicSharedMemorySize, LDS_BYTES) != hipSuccess) { fprintf(stderr, "kernel_launch: hipFuncSetAttribute failed\n"); grid = -1; return; }
        if (hipOccupancyMaxActiveBlocksPerMultiprocessor(&per_cu, (const void*)mk_fwd, NTHREADS, LDS_BYTES) != hipSuccess || per_cu < 1)
            fprintf(stderr, "kernel_launch: occupancy query reports %d workgroups per CU\n", per_cu);
        (void)hipGetLastError();
        grid = cus;
    }
    if (grid < 0) return;
    if (hipMemsetAsync((char*)d_ws + O_CTL, 0, SZ_CTL, stream) != hipSuccess) { fprintf(stderr, "kernel_launch: memset failed\n"); return; }
    Params p{};
    for (int i = 0; i < 32; ++i) p.in[i] = (const float*)d_in[i];
    p.out = (float*)d_out; p.ws = (unsigned char*)d_ws;
    if (MK_N_LAUNCHES == 1) {
        p.ph_lo = 0; p.ph_hi = PH_COUNT;
        hipLaunchKernelGGL(mk_fwd, dim3(grid), dim3(NTHREADS), LDS_BYTES, stream, p);
    } else {
        for (int ph = 0; ph < PH_COUNT; ++ph) {
            const int k = (ph - 1) % PH_PER_LAYER, l = (ph - 1) / PH_PER_LAYER;
            if (ph >= 1 && ph < PH_FINAL && (k == 15 || (k == 14 && (l & 1) == 0) || (k == 0 && l == 0))) continue;
            p.ph_lo = ph; p.ph_hi = ph + 1;
            hipLaunchKernelGGL(mk_fwd, dim3(grid), dim3(NTHREADS), LDS_BYTES, stream, p);
        }
    }
    const hipError_t le = hipPeekAtLastError();
    if (le != hipSuccess) fprintf(stderr, "kernel_launch: launch failed: %s\n", hipGetErrorName(le));
}
#endif
```

```cpp
#ifndef HOST_EMU
#include <hip/hip_runtime.h>
#endif
#include <cstdio>
#include <cstdint>
#include <cstddef>

#ifndef CFG_BATCH
#define CFG_BATCH 8
#endif
#ifndef CFG_SEQ
#define CFG_SEQ 2048
#endif
#ifndef MK_N_LAUNCHES
#define MK_N_LAUNCHES 1
#endif

typedef unsigned short bf16_t;
#ifndef HOST_EMU
#define DI __device__ __forceinline__
#define LAS __attribute__((address_space(3)))
#define GAS __attribute__((address_space(1)))
typedef short bf16x8 __attribute__((ext_vector_type(8)));
typedef short s16x4 __attribute__((ext_vector_type(4)));
typedef float f32x4 __attribute__((ext_vector_type(4)));
typedef float f32x2 __attribute__((ext_vector_type(2)));
typedef unsigned u32x4 __attribute__((ext_vector_type(4)));
typedef unsigned u32x2 __attribute__((ext_vector_type(2)));
DI f32x4 mfma16(bf16x8 a, bf16x8 b, f32x4 c) { return __builtin_amdgcn_mfma_f32_16x16x32_bf16(a, b, c, 0, 0, 0); }
DI s16x4 lds_tr4(const void* p) { return __builtin_amdgcn_ds_read_tr16_b64_v4i16((LAS s16x4*)(p)); }
DI float shfl_xor_f(float v, int m) { return __shfl_xor(v, m); }
DI float shfl_f(float v, int src) { return __shfl(v, src); }
DI int shfl_xor_i(int v, int m) { return __shfl_xor(v, m); }
DI int rfl(int v) { return __builtin_amdgcn_readfirstlane(v); }
DI int lane_id_hw() { return (int)__builtin_amdgcn_mbcnt_hi(~0u, __builtin_amdgcn_mbcnt_lo(~0u, 0u)); }
DI float fexp2(float x) { return __builtin_amdgcn_exp2f(x); }
DI float fexp(float x) { return __expf(x); }
DI float flog(float x) { return __logf(x); }
DI float frcp(float x) { return __builtin_amdgcn_rcpf(x); }
DI float frsqrt(float x) { return __builtin_amdgcn_rsqf(x); }
DI float fsin_rev(float rev) { return __builtin_amdgcn_sinf(rev); }
DI float fcos_rev(float rev) { return __builtin_amdgcn_cosf(rev); }
DI int atomic_add_i(int* p, int v) { return __hip_atomic_fetch_add(p, v, __ATOMIC_RELAXED, __HIP_MEMORY_SCOPE_AGENT); }
DI int lds_atomic_add_i(int* p, int v) { return __hip_atomic_fetch_add(p, v, __ATOMIC_RELAXED, __HIP_MEMORY_SCOPE_WORKGROUP); }
DI void atomic_add_f(float* p, float v) { (void)__hip_atomic_fetch_add(p, v, __ATOMIC_RELAXED, __HIP_MEMORY_SCOPE_AGENT); }
DI unsigned cvt_pk_bf16(float lo, float hi) { unsigned r; asm volatile("s_nop 0\n\tv_cvt_pk_bf16_f32 %0, %1, %2" : "=v"(r) : "v"(lo), "v"(hi)); return r; }
#define WAVE_FENCE() asm volatile("s_waitcnt lgkmcnt(0)" ::: "memory")
#define SCHED_BAR() __builtin_amdgcn_sched_barrier(0)
#define PIN_ACC8(a) asm volatile("" : "+v"((a)[0]), "+v"((a)[1]), "+v"((a)[2]), "+v"((a)[3]), "+v"((a)[4]), "+v"((a)[5]), "+v"((a)[6]), "+v"((a)[7]))
DI float u2f(unsigned u) { return __uint_as_float(u); }
DI unsigned f2u(float f) { return __float_as_uint(f); }
#else
#define DI inline __attribute__((always_inline))
#define WAVE_FENCE() emu::wave_sync()
#define SCHED_BAR()
#define PIN_ACC8(a)
DI float u2f(unsigned u) { float f; memcpy(&f, &u, 4); return f; }
DI unsigned f2u(float f) { unsigned u; memcpy(&u, &f, 4); return u; }
#endif

#ifndef HOST_EMU
#define LAUNDER_V(x) asm volatile("" : "+v"(x))
#define LAUNDER_S(x) asm volatile("" : "+s"(x))
#else
#define LAUNDER_V(x)
#define LAUNDER_S(x)
#endif
#ifndef HOST_EMU
typedef int i32x8 __attribute__((ext_vector_type(8)));
DI unsigned cvt_pk4_fp8(float a, float b, float c, float d) { int v = __builtin_amdgcn_cvt_pk_fp8_f32(a, b, 0, false); v = __builtin_amdgcn_cvt_pk_fp8_f32(c, d, v, true); return (unsigned)v; }
#else
DI unsigned f2fp8_host(float f) {
    unsigned s = f < 0.f ? 0x80u : 0u; float a = fabsf(f); if (!(a == a)) return s | 0x7f; if (a >= 448.f) return s | 0x7e;
    if (a < 0.0009765625f) return s;
    int e; float m = frexpf(a, &e); e -= 1; m *= 2.f;
    if (e < -6) { const float q = a * 512.f; int n = (int)lrintf(q); return s | (unsigned)n; }
    int n = (int)lrintf((m - 1.f) * 8.f); if (n == 8) { n = 0; e += 1; } if (e > 8 || (e == 8 && n > 6)) return s | 0x7e;
    return s | (unsigned)((e + 7) << 3) | (unsigned)n; }
DI unsigned cvt_pk4_fp8(float a, float b, float c, float d) { return f2fp8_host(a) | (f2fp8_host(b) << 8) | (f2fp8_host(c) << 16) | (f2fp8_host(d) << 24); }
DI float fp82f_host(unsigned v) { const unsigned s = v & 0x80u, e = (v >> 3) & 15u, m = v & 7u; float r = e == 0 ? (float)m * 0.001953125f : (1.f + (float)m * 0.125f) * exp2f((float)e - 7.f); return s ? -r : r; }
#endif
constexpr float F8_ASCALE = 16.0f, F8_WSCALE = 1024.0f;
#ifndef F8_FULL
#define F8_FULL 1
#endif
constexpr int F8_NBJ = F8_FULL ? 2 : 1;
DI float bf2f(bf16_t b) { return u2f(((unsigned)b) << 16); }
DI bf16_t f2bf(float f) { unsigned u = f2u(f); return (bf16_t)((u + 0x7fffu + ((u >> 16) & 1u)) >> 16); }
DI float bflo(unsigned w) { return u2f(w << 16); }
DI float bfhi(unsigned w) { return u2f(w & 0xffff0000u); }
DI float wave_sum(float v) {
#pragma unroll
    for (int o = 1; o < 64; o <<= 1) v += shfl_xor_f(v, o);
    return v;
}
#ifndef HOST_EMU
DI bool wave_any(bool p) { return __any(p ? 1 : 0) != 0; }
#else
DI bool wave_any(bool p) { int v = p ? 1 : 0;
    for (int o = 1; o < 64; o <<= 1) v |= shfl_xor_i(v, o);
    return v != 0; }
#endif
DI unsigned vzero() { unsigned z = 0u; LAUNDER_V(z); return z; }
DI float sigmoidf_(float x) { return frcp(1.0f + fexp(-x)); }
DI float siluf_(float x) { return x * frcp(1.0f + fexp(-x)); }

constexpr int BATCH = CFG_BATCH, SEQ = CFG_SEQ, NTOK = BATCH * SEQ, D = 2048, DEPTH = 2, MEMLEN = 256, NMEM = BATCH * MEMLEN;
constexpr int IN_TOTAL = 16216, UW = 16384, UWP = UW + 64;
constexpr float RMS_EPS = 1e-6f;
constexpr int FFN = 7168, NEXP = 8;
constexpr int UC_MLQ = 0, UC_MLK = 512, UC_MLV = 1024, UC_MLO = 2048, UC_SSZ = 3072, UC_XBC = 4096, UC_CQ = 5632, UC_CKV = 6144, UC_SM = 6400,
              UC_SWQ = 6656, UC_SWK = 7680, UC_SWV = 7936, UC_GATE = 8192;
constexpr int SM_TILE = UC_SM / 256;
constexpr int SO_MLI = 3072, SO_SSZ = 3080, SO_XBC = 4104, SO_DT = 5640, SO_CQ = 5656, SO_CKV = 6168, SO_KR = 6424, SO_SWQ = 6488, SO_SWK = 7512, SO_SWV = 7768, SO_GATE = 8024;
constexpr int SLOTS = 2 * NTOK + NEXP * 256;
constexpr int MAXTILES = SLOTS / 256;

constexpr size_t al256(size_t x) { return (x + 255) & ~(size_t)255; }
constexpr size_t O_CTL = 0, SZ_CTL = 1u << 20;
constexpr size_t O_WIN = O_CTL + SZ_CTL;
constexpr size_t O_WUQ = O_WIN + (size_t)DEPTH * UW * D * 2;
constexpr size_t O_WUKV = O_WUQ + (size_t)DEPTH * 1536 * 512 * 2;
constexpr size_t O_WBR = O_WUKV + (size_t)DEPTH * 2048 * 256 * 2;
constexpr size_t O_WOUT = O_WBR + (size_t)DEPTH * 4 * 2048 * 1024 * 2;
constexpr size_t O_WXQ = O_WOUT + (size_t)DEPTH * 2048 * 2048 * 2;
constexpr size_t O_WXKV = O_WXQ + (size_t)DEPTH * 512 * 2048 * 2;
constexpr size_t O_WXO = O_WXKV + (size_t)DEPTH * 1024 * 2048 * 2;
constexpr size_t O_W13 = O_WXO + (size_t)DEPTH * 2048 * 512 * 2;
constexpr size_t O_W2 = O_W13 + (size_t)2 * FFN * D * 2;
constexpr size_t O_MW13 = O_W2 + (size_t)D * FFN * 2;
constexpr size_t O_MW2 = O_MW13 + (size_t)NEXP * 2 * FFN * D * 2;
constexpr size_t O_ROPE = O_MW2 + (size_t)NEXP * D * FFN * 2;
constexpr size_t O_H = al256(O_ROPE + (size_t)SEQ * 64 * 4);
constexpr size_t O_G8 = O_H + (size_t)NTOK * D * 2;
constexpr size_t O_XN = O_H + (size_t)NTOK * D * 4;
constexpr size_t O_MEMN = O_XN + (size_t)NTOK * D * 2;
constexpr size_t O_U = O_MEMN + (size_t)DEPTH * NMEM * D * 2;
constexpr size_t O_SM = O_U + (size_t)NTOK * UWP * 2;
constexpr size_t O_CQN = O_SM + (size_t)NTOK * 256 * 4;
constexpr size_t O_CKVN = O_CQN + (size_t)NTOK * 512 * 2;
constexpr size_t O_KR = O_CKVN + (size_t)NTOK * 256 * 2;
constexpr size_t O_XBC = O_KR + (size_t)NTOK * 64 * 2;
constexpr size_t O_DT = O_XBC + (size_t)NTOK * 1536 * 2;
constexpr size_t O_DA = O_DT + (size_t)NTOK * 16 * 4;
constexpr size_t O_GI = O_DA + (size_t)NTOK * 16 * 4;
constexpr size_t O_LF = O_GI + (size_t)NTOK * 4 * 4;
constexpr size_t O_QF = O_LF + (size_t)NTOK * 4 * 4;
constexpr size_t O_KVF = O_QF + (size_t)NTOK * 1536 * 2;
constexpr size_t O_Y = O_KVF + (size_t)NTOK * 2048 * 2;
constexpr size_t O_MACC = O_Y + (size_t)4 * NTOK * 1024 * 2;
constexpr size_t O_SSQ = O_MACC;
constexpr size_t O_RSTD = O_SSQ + (size_t)NTOK * 32 * 4;
constexpr size_t O_MERGED = O_MACC + (size_t)NTOK * D * 4;
constexpr size_t O_XQ = O_MERGED + (size_t)NTOK * D * 2;
constexpr size_t O_XKV = O_XQ + (size_t)NTOK * 512 * 2;
constexpr size_t O_XO = O_XKV + (size_t)NMEM * 1024 * 2;
constexpr size_t O_ACT = O_XO + (size_t)NTOK * 512 * 2;
constexpr size_t O_XG = O_ACT + (size_t)NTOK * FFN * 2;
constexpr size_t O_YG = O_XG + (size_t)SLOTS * D * 2;
constexpr size_t O_ROUTE = O_YG + (size_t)SLOTS * D * 2;
constexpr size_t O_BLKCNT = O_ROUTE + (size_t)NTOK * 2 * 4 * 3;
constexpr size_t O_TAILACC = al256(O_BLKCNT + 1024 * 8 * 4);
constexpr size_t O_XN8 = al256(O_TAILACC + (size_t)256 * 65536 * 4);
constexpr size_t O_WG8 = O_XN8 + (size_t)NTOK * D;
constexpr size_t O_ACTM = al256(O_WG8 + (size_t)DEPTH * 8192 * D);
constexpr size_t WS_END = O_ACTM + (size_t)SLOTS * FFN * 2;

constexpr int LDS_BYTES = 147456;
constexpr int LDS_MISC = 143360;
constexpr int NTHREADS = 512;

struct Params { const float* in[32]; float* out; unsigned char* ws; int ph_lo, ph_hi, flags, pad; };

#ifndef HOST_EMU
#define XB_TMO      128
#define XB_XCNT(j)  (256  + 64 * (j))
#define XB_XSUB(j)  (1280 + 64 * (j))
#define XB_XGEN(j)  (2304 + 64 * (j))
#define XB_TOP      3328
#define XB_TOPGEN   3392
#define XCD_BAR_WORDS 3456
#define XB_SPIN_CAP (1u << 22)
__device__ __forceinline__ unsigned xb_ld(unsigned* p)              { return __hip_atomic_load(p, __ATOMIC_RELAXED, __HIP_MEMORY_SCOPE_AGENT); }
__device__ __forceinline__ unsigned xb_add(unsigned* p, unsigned v) { return __hip_atomic_fetch_add(p, v, __ATOMIC_RELAXED, __HIP_MEMORY_SCOPE_AGENT); }
__device__ __forceinline__ unsigned xb_xcc_id() { return (unsigned)__builtin_amdgcn_s_getreg((3 << 11) | 20) & 0xFu; }
#define XB_SPIN(cond, bar) do { unsigned _sp = 0; while (cond) { __builtin_amdgcn_s_sleep(1); \
    if ((++_sp & 255u) == 0u) { if (xb_ld(&(bar)[XB_TMO])) break; if (_sp > XB_SPIN_CAP) { atomicAdd(&(bar)[XB_TMO], 1u); break; } } } } while (0)
struct XcdBarrier { unsigned* bar; unsigned x; volatile LAS unsigned* st; int wave; };
__device__ __forceinline__ bool xb_thread0(int wave) { return wave == 0 && lane_id_hw() == 0; }
__device__ __forceinline__ XcdBarrier xcd_barrier_post(unsigned* bar, volatile LAS unsigned* st, int wave) {
    XcdBarrier b; b.bar = bar; b.x = xb_xcc_id(); b.st = st; b.wave = wave;
    if (xb_thread0(wave)) (void)xb_add(&bar[XB_XCNT(b.x)], 1u);
    return b;
}
__device__ __forceinline__ void xcd_barrier_complete(unsigned* bar, unsigned x, unsigned& nloc, unsigned& nx) {
    const unsigned G = gridDim.x * gridDim.y * gridDim.z;
    unsigned sum, cnt, mine, sp = 0u;
    for (;;) {
        sum = 0u; cnt = 0u; mine = 0u;
#pragma unroll
        for (unsigned j = 0; j < 16; ++j) { const unsigned c = xb_ld(&bar[XB_XCNT(j)]); sum += c; cnt += (c > 0u) ? 1u : 0u; mine = (j == x) ? c : mine; }
        if (sum == G) break;
        __builtin_amdgcn_s_sleep(1);
        if ((++sp & 255u) == 0u) { if (xb_ld(&bar[XB_TMO])) break; if (sp > XB_SPIN_CAP) { atomicAdd(&bar[XB_TMO], 1u); break; } }
    }
    nloc = mine > 0u ? mine : 1u; nx = cnt > 0u ? cnt : 1u;
}
__device__ __forceinline__ void xcd_barrier(const XcdBarrier& b) {
    asm volatile("s_waitcnt vmcnt(0)" ::: "memory");
    __syncthreads();
    if (xb_thread0(b.wave)) {
        unsigned* bar = b.bar;
        __builtin_amdgcn_s_waitcnt(0);
        unsigned nloc = b.st[0], nx = b.st[1];
        if (nloc == 0u) { xcd_barrier_complete(bar, b.x, nloc, nx); b.st[0] = nloc; b.st[1] = nx; }
        const unsigned old = xb_add(&bar[XB_XSUB(b.x)], 1u);
        const unsigned gen = old / nloc;
        if (old + 1u == (gen + 1u) * nloc) {
            __builtin_amdgcn_fence(__ATOMIC_RELEASE, "agent");
            asm volatile("s_waitcnt vmcnt(0)" ::: "memory");
            const unsigned og = xb_add(&bar[XB_TOP], 1u);
            const unsigned tg = og / nx;
            if (og + 1u == (tg + 1u) * nx) xb_add(&bar[XB_TOPGEN], 1u);
            else XB_SPIN(xb_ld(&bar[XB_TOPGEN]) == tg, bar);
            __builtin_amdgcn_fence(__ATOMIC_ACQUIRE, "agent");
            xb_add(&bar[XB_XGEN(b.x)], 1u);
            asm volatile("s_waitcnt vmcnt(0)" ::: "memory");
        } else {
            XB_SPIN(xb_ld(&bar[XB_XGEN(b.x)]) == gen, bar);
            __builtin_amdgcn_fence(__ATOMIC_ACQUIRE, "agent");
            asm volatile("s_waitcnt vmcnt(0)" ::: "memory");
        }
    }
    __syncthreads();
}
#endif

namespace pg8 {
constexpr int BM = 256, BK = 64, HALF = 128, HTB = HALF * BK * 2, STAGE_BYTES = 8 * HTB, NXCD = 8, WGM = 4;
DI int lds_byte(int r, int c) { const int st = (r >> 4) * 2 + (c >> 5), rr = r & 15, cc = c & 31, ob = rr * 64 + cc * 2; return st * 1024 + (ob ^ (((ob >> 9) & 1) << 5)); }
DI void stage_rc(int b, int& R, int& C) { const int st = b / 1024, sb = b % 1024, swz = sb ^ (((sb >> 9) & 1) << 5); R = (st >> 1) * 16 + swz / 64; C = (st & 1) * 32 + (swz % 64) / 2; }
DI int perm32(int rho) { const int n = rho >> 4, i = rho & 15; return 8 * (i >> 2) + 4 * n + (i & 3); }
struct Unit { int pa, pb, pm, pn, aux, ui; };
struct Gemm { const bf16_t* A; int lda; const bf16_t* Bt; int ldb; int K; };
DI bool static_map(long L, int nM, int nN, int& pm, int& pn) {
    const int nwg = nM * nN; if (L >= nwg) return false;
    int wgid = (int)L; { const int q = nwg / NXCD, r = nwg % NXCD, xcd = wgid % NXCD, off = wgid / NXCD; wgid = (xcd < r ? xcd * (q + 1) : r * (q + 1) + (xcd - r) * q) + off; }
    const int nig = WGM * nN, gid = wgid / nig, fm = gid * WGM, gsz = (nM - fm) < WGM ? (nM - fm) : WGM;
    pm = fm + ((wgid % nig) % gsz); pn = (wgid % nig) / gsz; return true;
}
struct OrdStatic { int nM, nN, G, c;
    DI bool next(int i, Unit& u) const { if (!static_map((long)i * G + c, nM, nN, u.pm, u.pn)) return false; u.pa = u.pm; u.pb = u.pn; u.aux = 0; u.ui = i; return true; } };
struct OrdMerge { int nM, nN, G, c;
    DI bool next(int i, Unit& u) const { if (!static_map((long)(i >> 2) * G + c, nM, nN, u.pm, u.pn)) return false; u.aux = i & 3; u.pa = u.aux * nM + u.pm; u.pb = u.aux * nN + u.pn; u.ui = i; return true; } };
struct OrdMoe { int nM, nN, G, c; const int* tile_e; int imax;
    DI bool next(int i, Unit& u) const { if (i >= imax || !static_map((long)i * G + c, nM, nN, u.pm, u.pn)) return false; u.aux = tile_e[u.pm]; u.pa = u.pm; u.pb = u.aux * nN + u.pn; u.ui = i; return true; } };
struct OrdOne { Unit u; bool valid;
    DI bool next(int i, Unit& o) const { if (i != 0 || !valid) return false; o = u; return true; } };
DI void moe_tail_split(int ntiles, int G, int& full, int& R, int& sp) {
    const int units = ntiles * 8; full = units / G; R = units - full * G; sp = 0;
    if (R > 0) { sp = 1; if (R * 2 <= G) sp = 2; if (R * 4 <= G) sp = 4; if (R * 7 <= G) sp = 7; }
}

#ifndef HOST_EMU
template <class Epi, class Sched>
__device__ __forceinline__ void gemm_phase(LAS unsigned char* lds, const Gemm g, const Sched& S, const Epi& E, int wave_id) {
    int lane_ = lane_id_hw(); asm volatile("" : "+v"(lane_)); int wid_ = wave_id; asm volatile("" : "+s"(wid_));
    const int tid = wid_ * 64 + lane_, wid = wid_, lane = tid & 63, wr = wid >> 2, wc = wid & 3, fr = lane & 15, fq = lane >> 4;
    const int K = g.K, nt = K / BK;
    unsigned voffA[2], voffB[2];
#pragma unroll
    for (int i = 0; i < 2; ++i) { int R, C; stage_rc(tid * 16 + i * 8192, R, C); const int Rb = Epi::PERM ? ((R & ~31) + perm32(R & 31)) : R;
        voffA[i] = (unsigned)(R * g.lda + C) * 2u; voffB[i] = (unsigned)(Rb * g.ldb + C) * 2u; }
    const size_t kstep = (size_t)(BK * 2);
    const size_t hstepA = (size_t)HALF * g.lda * 2, hstepB = (size_t)HALF * g.ldb * 2;
    const size_t tstepA = 2 * hstepA, tstepB = 2 * hstepB;
    const unsigned ldsw = (unsigned)wid * 1024u;
    const int aoff = lds_byte(wr * 64 + fr, fq * 8), boff = lds_byte(wc * 32 + fr, fq * 8);
#define PG8_SA(b, h) (((b) * 2 + (h)) * HTB)
#define PG8_SB(b, h) ((4 + (b) * 2 + (h)) * HTB)
#define PG8_STAGE(bufoff, gbase, voff) do { _Pragma("unroll") for (int _i = 0; _i < 2; ++_i) \
        __builtin_amdgcn_global_load_lds((const unsigned*)((const char*)(gbase) + (voff)[_i]), (LAS unsigned*)(lds + (bufoff) + ldsw + _i * 8192), 16, 0, 0); } while (0)
#define PG8_LDA(dst, b, h) do { _Pragma("unroll") for (int m = 0; m < 4; ++m) _Pragma("unroll") for (int k = 0; k < 2; ++k) dst[m][k] = *(const LAS bf16x8*)(lds + PG8_SA(b, h) + aoff + m * 2048 + k * 1024); } while (0)
#define PG8_LDB(dst, b, h) do { _Pragma("unroll") for (int n = 0; n < 2; ++n) _Pragma("unroll") for (int k = 0; k < 2; ++k) dst[n][k] = *(const LAS bf16x8*)(lds + PG8_SB(b, h) + boff + n * 2048 + k * 1024); } while (0)
#define PG8_MMA(ai, bj, At, Bt) do { __builtin_amdgcn_s_setprio(1); _Pragma("unroll") for (int m = 0; m < 4; ++m) _Pragma("unroll") for (int n = 0; n < 2; ++n) _Pragma("unroll") for (int k = 0; k < 2; ++k) \
        acc[ai][bj][m][n] = __builtin_amdgcn_mfma_f32_16x16x32_bf16(Bt[n][k], At[m][k], acc[ai][bj][m][n], 0, 0, 0); __builtin_amdgcn_s_setprio(0); } while (0)
#define PG8_WAIT_V(n) asm volatile("s_waitcnt vmcnt(" #n ")" ::: "memory")
#define PG8_WAIT_L(n) asm volatile("s_waitcnt lgkmcnt(" #n ")" ::: "memory")
#define PG8_BAR __builtin_amdgcn_s_barrier()
#define PG8_SCHED __builtin_amdgcn_sched_barrier(0)
    Unit cur, nxt; int ui = 0;
    if (!S.next(0, cur)) return;
    if constexpr (Epi::HAS_PREP) E.prep(cur, tid);
    f32x4 acc[2][2][4][2];
#pragma unroll
    for (int a = 0; a < 2; ++a)
#pragma unroll
        for (int b = 0; b < 2; ++b)
#pragma unroll
            for (int m = 0; m < 4; ++m)
#pragma unroll
                for (int n = 0; n < 2; ++n) acc[a][b][m][n] = (f32x4){0.f, 0.f, 0.f, 0.f};
    bf16x8 At[4][2], B0[2][2], B1[2][2];
    const char* cA = (const char*)g.A + (size_t)cur.pa * tstepA; const char* cB = (const char*)g.Bt + (size_t)cur.pb * tstepB;
    PG8_STAGE(PG8_SB(0, 0), cB, voffB); PG8_STAGE(PG8_SB(0, 1), cB + hstepB, voffB); PG8_STAGE(PG8_SA(0, 0), cA, voffA); PG8_STAGE(PG8_SA(0, 1), cA + hstepA, voffA);
    if (wr == 1) PG8_BAR;
    PG8_WAIT_V(2); PG8_BAR;
    PG8_STAGE(PG8_SB(1, 0), cB + kstep, voffB); PG8_STAGE(PG8_SA(1, 0), cA + kstep, voffA); PG8_STAGE(PG8_SB(1, 1), cB + hstepB + kstep, voffB);
    PG8_WAIT_V(6); PG8_BAR;
    for (;;) {
        const bool has_next = S.next(ui + 1, nxt);
        const char* nA = has_next ? (const char*)g.A + (size_t)nxt.pa * tstepA : cA; const char* nB = has_next ? (const char*)g.Bt + (size_t)nxt.pb * tstepB : cB;
        for (int t = 0; t < nt; t += 2) {
            const bool last = (t == nt - 2);
            const char* a1 = cA + (size_t)(t + 1) * kstep;
            const char* a2 = last ? nA : cA + (size_t)(t + 2) * kstep; const char* b2 = last ? nB : cB + (size_t)(t + 2) * kstep;
            const char* a3 = a2 + kstep; const char* b3 = b2 + kstep;
            PG8_LDB(B0, 0, 0); PG8_LDB(B1, 0, 1); PG8_SCHED; PG8_LDA(At, 0, 0); PG8_STAGE(PG8_SA(1, 1), a1 + hstepA, voffA);
            PG8_WAIT_V(8); PG8_WAIT_L(0); PG8_BAR; PG8_MMA(0, 0, At, B0); PG8_MMA(0, 1, At, B1); PG8_BAR; PG8_SCHED;
            PG8_LDA(At, 0, 1); PG8_STAGE(PG8_SB(0, 0), b2, voffB); PG8_STAGE(PG8_SB(0, 1), b2 + hstepB, voffB); PG8_STAGE(PG8_SA(0, 0), a2, voffA);
            PG8_WAIT_V(8); PG8_WAIT_L(0); PG8_BAR; PG8_MMA(1, 0, At, B0); PG8_MMA(1, 1, At, B1); PG8_BAR; PG8_SCHED;
            PG8_LDB(B0, 1, 0); PG8_LDB(B1, 1, 1); PG8_SCHED; PG8_LDA(At, 1, 0); PG8_STAGE(PG8_SA(0, 1), a2 + hstepA, voffA);
            PG8_WAIT_V(8); PG8_WAIT_L(0); PG8_BAR; PG8_MMA(0, 0, At, B0); PG8_MMA(0, 1, At, B1); PG8_BAR; PG8_SCHED;
            PG8_LDA(At, 1, 1); PG8_STAGE(PG8_SB(1, 0), b3, voffB); PG8_STAGE(PG8_SB(1, 1), b3 + hstepB, voffB); PG8_STAGE(PG8_SA(1, 0), a3, voffA);
            PG8_WAIT_V(8); PG8_WAIT_L(0); PG8_BAR; PG8_MMA(1, 0, At, B0); PG8_MMA(1, 1, At, B1); PG8_BAR; PG8_SCHED;
        }
        if (wr == 0) PG8_BAR;
        E(acc, cur, wr, wc, fr, fq);
        if (!has_next) break;
        if constexpr (Epi::HAS_PREP) E.prep(nxt, tid);
#pragma unroll
        for (int a = 0; a < 2; ++a)
#pragma unroll
            for (int b = 0; b < 2; ++b)
#pragma unroll
                for (int m = 0; m < 4; ++m)
#pragma unroll
                    for (int n = 0; n < 2; ++n) acc[a][b][m][n] = (f32x4){0.f, 0.f, 0.f, 0.f};
        cur = nxt; cA = nA; cB = nB; ++ui;
        if (wr == 1) PG8_BAR;
    }
    PG8_WAIT_V(0);
    PG8_BAR;
#undef PG8_SA
#undef PG8_SB
#undef PG8_STAGE
#undef PG8_LDA
#undef PG8_LDB
#undef PG8_MMA
#undef PG8_WAIT_V
#undef PG8_WAIT_L
#undef PG8_BAR
#undef PG8_SCHED
}
template <class Epi, class Sched, bool FULLN = false>
__device__ __forceinline__ void gemm_phase_f8(LAS unsigned char* lds, const Gemm g, const Sched& S, const Epi& E, int wave_id) {
    int lane_ = lane_id_hw(); asm volatile("" : "+v"(lane_)); int wid_ = wave_id; asm volatile("" : "+s"(wid_));
    const int tid = wid_ * 64 + lane_, wid = wid_, lane = tid & 63, wr = wid >> 2, wc = wid & 3, fr = lane & 15, fq = lane >> 4;
    const int K = g.K, nt = K / BK;
    unsigned voffA[2], voffB[2];
#pragma unroll
    for (int i = 0; i < 2; ++i) { int R, C; stage_rc(tid * 16 + i * 8192, R, C); const int Rb = Epi::PERM ? ((R & ~31) + perm32(R & 31)) : R;
        voffA[i] = (unsigned)(R * g.lda + C) * 2u; voffB[i] = (unsigned)(Rb * g.ldb + C) * 2u; }
    const size_t kstep = (size_t)(BK * 2);
    const size_t hstepA = (size_t)HALF * g.lda * 2, hstepB = (size_t)HALF * g.ldb * 2;
    const size_t tstepA = 2 * hstepA, tstepB = 2 * hstepB;
    const unsigned ldsw = (unsigned)wid * 1024u;
    const int aoff0 = lds_byte(wr * 64 + fr, ((2 * fq) & 3) * 8) + (fq >> 1) * 1024, aoff1 = lds_byte(wr * 64 + fr, ((2 * fq + 1) & 3) * 8) + (fq >> 1) * 1024;
    const int boff0 = lds_byte(wc * 32 + fr, ((2 * fq) & 3) * 8) + (fq >> 1) * 1024, boff1 = lds_byte(wc * 32 + fr, ((2 * fq + 1) & 3) * 8) + (fq >> 1) * 1024;
#define PG8_SA(b, h) (((b) * 2 + (h)) * HTB)
#define PG8_SB(b, h) ((4 + (b) * 2 + (h)) * HTB)
#define PG8_STAGE(bufoff, gbase, voff) do { _Pragma("unroll") for (int _i = 0; _i < 2; ++_i) \
        __builtin_amdgcn_global_load_lds((const unsigned*)((const char*)(gbase) + (voff)[_i]), (LAS unsigned*)(lds + (bufoff) + ldsw + _i * 8192), 16, 0, 0); } while (0)
#define PG8_LDA(dst, b, h) do { _Pragma("unroll") for (int m = 0; m < 4; ++m) { dst[m][0] = *(const LAS u32x4*)(lds + PG8_SA(b, h) + aoff0 + m * 2048); dst[m][1] = *(const LAS u32x4*)(lds + PG8_SA(b, h) + aoff1 + m * 2048); } } while (0)
#define PG8_LDB(dst, b, h) do { _Pragma("unroll") for (int n = 0; n < 2; ++n) { dst[n][0] = *(const LAS u32x4*)(lds + PG8_SB(b, h) + boff0 + n * 2048); dst[n][1] = *(const LAS u32x4*)(lds + PG8_SB(b, h) + boff1 + n * 2048); } } while (0)
#define PG8_F8OP(x) __builtin_shufflevector(__builtin_bit_cast(i32x4_, (x)[0]), __builtin_bit_cast(i32x4_, (x)[1]), 0, 1, 2, 3, 4, 5, 6, 7)
#define PG8_MMA(ai, bj, At, Bt) do { __builtin_amdgcn_s_setprio(1); _Pragma("unroll") for (int m = 0; m < 4; ++m) _Pragma("unroll") for (int n = 0; n < 2; ++n) { \
        const i32x8 a8_ = PG8_F8OP(Bt[n]), b8_ = PG8_F8OP(At[m]); \
        asm volatile("v_mfma_scale_f32_16x16x128_f8f6f4 %0, %1, %2, %0, %3, %3 op_sel_hi:[0,0,0]" : "+v"(acc[ai][bj][m][n]) : "v"(a8_), "v"(b8_), "v"(f8one)); } \
        __builtin_amdgcn_s_setprio(0); } while (0)
#define PG8_WAIT_V(n) asm volatile("s_waitcnt vmcnt(" #n ")" ::: "memory")
#define PG8_WAIT_L(n) asm volatile("s_waitcnt lgkmcnt(" #n ")" ::: "memory")
#define PG8_BAR __builtin_amdgcn_s_barrier()
#define PG8_SCHED __builtin_amdgcn_sched_barrier(0)
    Unit cur, nxt; int ui = 0;
    if (!S.next(0, cur)) return;
    f32x4 acc[2][2][4][2];
#pragma unroll
    for (int a = 0; a < 2; ++a)
#pragma unroll
        for (int b = 0; b < 2; ++b)
#pragma unroll
            for (int m = 0; m < 4; ++m)
#pragma unroll
                for (int n = 0; n < 2; ++n) acc[a][b][m][n] = (f32x4){0.f, 0.f, 0.f, 0.f};
    typedef int i32x4_ __attribute__((ext_vector_type(4)));
    int f8one = 0x7F7F7F7F; asm volatile("" : "+v"(f8one));
    u32x4 At[4][2], B0[2][2], B1[2][2];
    const char* cA = (const char*)g.A + (size_t)cur.pa * tstepA; const char* cB = (const char*)g.Bt + (size_t)cur.pb * (FULLN ? tstepB : hstepB);
    PG8_STAGE(PG8_SB(0, 0), cB, voffB); PG8_STAGE(PG8_SB(0, 1), cB + hstepB, voffB); PG8_STAGE(PG8_SA(0, 0), cA, voffA); PG8_STAGE(PG8_SA(0, 1), cA + hstepA, voffA);
    if (wr == 1) PG8_BAR;
    PG8_WAIT_V(2); PG8_BAR;
    PG8_STAGE(PG8_SB(1, 0), cB + kstep, voffB); PG8_STAGE(PG8_SA(1, 0), cA + kstep, voffA); PG8_STAGE(PG8_SB(1, 1), cB + hstepB + kstep, voffB);
    PG8_WAIT_V(6); PG8_BAR;
    for (;;) {
        const bool has_next = S.next(ui + 1, nxt);
        const char* nA = has_next ? (const char*)g.A + (size_t)nxt.pa * tstepA : cA; const char* nB = has_next ? (const char*)g.Bt + (size_t)nxt.pb * (FULLN ? tstepB : hstepB) : cB;
        for (int t = 0; t < nt; t += 2) {
            const bool last = (t == nt - 2);
            const char* a1 = cA + (size_t)(t + 1) * kstep;
            const char* a2 = last ? nA : cA + (size_t)(t + 2) * kstep; const char* b2 = last ? nB : cB + (size_t)(t + 2) * kstep;
            const char* a3 = a2 + kstep; const char* b3 = b2 + kstep;
            PG8_LDB(B0, 0, 0); if constexpr (FULLN) PG8_LDB(B1, 0, 1); PG8_SCHED; PG8_LDA(At, 0, 0); PG8_STAGE(PG8_SA(1, 1), a1 + hstepA, voffA);
            PG8_WAIT_V(8); PG8_WAIT_L(0); PG8_BAR; PG8_MMA(0, 0, At, B0); if constexpr (FULLN) PG8_MMA(0, 1, At, B1); PG8_BAR; PG8_SCHED;
            PG8_LDA(At, 0, 1); PG8_STAGE(PG8_SB(0, 0), b2, voffB); PG8_STAGE(PG8_SB(0, 1), b2 + hstepB, voffB); PG8_STAGE(PG8_SA(0, 0), a2, voffA);
            PG8_WAIT_V(8); PG8_WAIT_L(0); PG8_BAR; PG8_MMA(1, 0, At, B0); if constexpr (FULLN) PG8_MMA(1, 1, At, B1); PG8_BAR; PG8_SCHED;
            PG8_LDB(B0, 1, 0); if constexpr (FULLN) PG8_LDB(B1, 1, 1); PG8_SCHED; PG8_LDA(At, 1, 0); PG8_STAGE(PG8_SA(0, 1), a2 + hstepA, voffA);
            PG8_WAIT_V(8); PG8_WAIT_L(0); PG8_BAR; PG8_MMA(0, 0, At, B0); if constexpr (FULLN) PG8_MMA(0, 1, At, B1); PG8_BAR; PG8_SCHED;
            PG8_LDA(At, 1, 1); PG8_STAGE(PG8_SB(1, 0), b3, voffB); PG8_STAGE(PG8_SB(1, 1), b3 + hstepB, voffB); PG8_STAGE(PG8_SA(1, 0), a3, voffA);
            PG8_WAIT_V(8); PG8_WAIT_L(0); PG8_BAR; PG8_MMA(1, 0, At, B0); if constexpr (FULLN) PG8_MMA(1, 1, At, B1); PG8_BAR; PG8_SCHED;
        }
        if (wr == 0) PG8_BAR;
        asm volatile("s_nop 15\n\ts_nop 15" : "+v"(acc[0][0][0][0]), "+v"(acc[0][0][0][1]), "+v"(acc[0][0][1][0]), "+v"(acc[0][0][1][1]), "+v"(acc[0][0][2][0]), "+v"(acc[0][0][2][1]), "+v"(acc[0][0][3][0]), "+v"(acc[0][0][3][1]) :: "memory");
        PIN_ACC8(&acc[0][1][0][0]); PIN_ACC8(&acc[1][0][0][0]); PIN_ACC8(&acc[1][1][0][0]);
        E(acc, cur, wr, wc, fr, fq);
        if (!has_next) break;
#pragma unroll
        for (int a = 0; a < 2; ++a)
#pragma unroll
            for (int b = 0; b < 2; ++b)
#pragma unroll
                for (int m = 0; m < 4; ++m)
#pragma unroll
                    for (int n = 0; n < 2; ++n) acc[a][b][m][n] = (f32x4){0.f, 0.f, 0.f, 0.f};
        cur = nxt; cA = nA; cB = nB; ++ui;
        if (wr == 1) PG8_BAR;
    }
    PG8_WAIT_V(0);
    PG8_BAR;
#undef PG8_SA
#undef PG8_SB
#undef PG8_STAGE
#undef PG8_LDA
#undef PG8_LDB
#undef PG8_MMA
#undef PG8_F8OP
#undef PG8_WAIT_V
#undef PG8_WAIT_L
#undef PG8_BAR
#undef PG8_SCHED
}
#else
template <class Epi, class Sched>
static void gemm_phase(unsigned char* lds, const Gemm g, const Sched& S, const Epi& E, int wave_id) {
    const int tid = threadIdx.x, wid = tid >> 6, lane = tid & 63, wr = wid >> 2, wc = wid & 3, fr = lane & 15, fq = lane >> 4;
    static thread_local float* Cbuf = nullptr; static thread_local float* Af = nullptr; static thread_local float* Bf = nullptr;
    Unit u;
    for (int i = 0; S.next(i, u); ++i) {
        __syncthreads();
        if constexpr (Epi::HAS_PREP) E.prep(u, tid);
        if (tid == 0) {
            if (!Cbuf) { Cbuf = (float*)malloc(256 * 256 * 4); Af = (float*)malloc((size_t)256 * 8192 * 4); Bf = (float*)malloc((size_t)256 * 8192 * 4); }
            const int K = g.K;
            for (int r = 0; r < 256; ++r) for (int k = 0; k < K; ++k) { Af[(size_t)r * K + k] = bf2f(g.A[((size_t)u.pa * 256 + r) * g.lda + k]); Bf[(size_t)r * K + k] = bf2f(g.Bt[((size_t)u.pb * 256 + r) * g.ldb + k]); }
            for (int r = 0; r < 256; ++r) for (int c = 0; c < 256; ++c) { const float* a = Af + (size_t)r * K; const float* b = Bf + (size_t)c * K; float s = 0.f;
                for (int k = 0; k < K; ++k) s += a[k] * b[k]; Cbuf[r * 256 + c] = s; }
        }
        __syncthreads();
        f32x4 acc[2][2][4][2];
        for (int ai = 0; ai < 2; ++ai) for (int bj = 0; bj < 2; ++bj) for (int m = 0; m < 4; ++m) for (int n = 0; n < 2; ++n) for (int j = 0; j < 4; ++j) {
            const int r = 128 * ai + 64 * wr + 16 * m + fr;
            const int c = Epi::PERM ? (128 * bj + 32 * wc + 8 * fq + 4 * n + j) : (128 * bj + 32 * wc + 16 * n + 4 * fq + j);
            acc[ai][bj][m][n][j] = Cbuf[r * 256 + c]; }
        E(acc, u, wr, wc, fr, fq);
    }
    __syncthreads();
}
#endif

typedef const f32x4 (&AccRef)[2][2][4][2];
struct EpiBf16 {
    static constexpr bool PERM = true; static constexpr bool HAS_PREP = false;
    bf16_t* O; int ldc;
    DI void operator()(AccRef acc, const Unit& u, int wr, int wc, int fr, int fq) const {
        const int row0 = u.pm * BM + wr * 64 + fr, col0 = u.pn * BM + wc * 32 + 8 * fq;
        float one = 1.0f; LAUNDER_S(one);
#pragma unroll
        for (int ai = 0; ai < 2; ++ai)
#pragma unroll
            for (int m = 0; m < 4; ++m) { bf16_t* rowp = O + (size_t)(row0 + ai * HALF + m * 16) * ldc + col0;
#pragma unroll
                for (int bj = 0; bj < 2; ++bj) { const f32x4 v0 = acc[ai][bj][m][0] * one, v1 = acc[ai][bj][m][1] * one;
                    u32x4 w; w.x = cvt_pk_bf16(v0[0], v0[1]); w.y = cvt_pk_bf16(v0[2], v0[3]); w.z = cvt_pk_bf16(v1[0], v1[1]); w.w = cvt_pk_bf16(v1[2], v1[3]);
                    *(u32x4*)(rowp + bj * HALF) = w; } }
    }
};
template <int NBJ, bool SIGM = false> struct EpiBf16S {
    static constexpr bool PERM = true; static constexpr bool HAS_PREP = false;
    bf16_t* O; int ldc; float scale;
    DI void operator()(AccRef acc, const Unit& u, int wr, int wc, int fr, int fq) const {
        const int row0 = u.pm * BM + wr * 64 + fr, col0 = u.pn * (HALF * NBJ) + wc * 32 + 8 * fq;
#pragma unroll
        for (int ai = 0; ai < 2; ++ai)
#pragma unroll
            for (int m = 0; m < 4; ++m) { bf16_t* rowp = O + (size_t)(row0 + ai * HALF + m * 16) * ldc + col0;
#pragma unroll
                for (int bj = 0; bj < NBJ; ++bj) { f32x4 v0 = acc[ai][bj][m][0] * scale, v1 = acc[ai][bj][m][1] * scale;
                    if constexpr (SIGM) {
#pragma unroll
                        for (int q = 0; q < 4; ++q) { v0[q] = frcp(1.0f + fexp2(v0[q] * -1.4426950408889634f)); v1[q] = frcp(1.0f + fexp2(v1[q] * -1.4426950408889634f)); } }
                    u32x4 w; w.x = cvt_pk_bf16(v0[0], v0[1]); w.y = cvt_pk_bf16(v0[2], v0[3]); w.z = cvt_pk_bf16(v1[0], v1[1]); w.w = cvt_pk_bf16(v1[2], v1[3]);
                    *(u32x4*)(rowp + bj * HALF) = w; } }
    }
};
struct EpiGate8 {
    static constexpr bool PERM = true; static constexpr bool HAS_PREP = false;
    unsigned char* G; float scale;
    DI void operator()(AccRef acc, const Unit& u, int wr, int wc, int fr, int fq) const {
        const int row0 = u.pm * BM + wr * 64 + fr, col0 = u.pn * BM + wc * 32 + 8 * fq;
#pragma unroll
        for (int ai = 0; ai < 2; ++ai)
#pragma unroll
            for (int m = 0; m < 4; ++m) { unsigned char* rowp = G + (size_t)(row0 + ai * HALF + m * 16) * (4 * D) + col0;
#pragma unroll
                for (int bj = 0; bj < 2; ++bj) { const f32x4 v0 = acc[ai][bj][m][0] * scale, v1 = acc[ai][bj][m][1] * scale; unsigned b[8];
#pragma unroll
                    for (int q = 0; q < 4; ++q) { b[q] = (unsigned)(frcp(1.0f + fexp2(v0[q] * -1.4426950408889634f)) * 255.0f + 0.5f); b[4 + q] = (unsigned)(frcp(1.0f + fexp2(v1[q] * -1.4426950408889634f)) * 255.0f + 0.5f); }
                    u32x2 w; w.x = b[0] | (b[1] << 8) | (b[2] << 16) | (b[3] << 24); w.y = b[4] | (b[5] << 8) | (b[6] << 16) | (b[7] << 24);
                    *(u32x2*)(rowp + bj * HALF) = w; } }
    }
};
template <int NBJ> struct EpiSwiGLU8 {
    static constexpr bool PERM = true; static constexpr bool HAS_PREP = false;
    unsigned char* act8; float scale;
    DI void operator()(AccRef acc, const Unit& u, int wr, int wc, int fr, int fq) const {
        const int row0 = u.pm * BM + wr * 64 + fr;
#pragma unroll
        for (int ai = 0; ai < 2; ++ai)
#pragma unroll
            for (int m = 0; m < 4; ++m)
#pragma unroll
                for (int bj = 0; bj < NBJ; ++bj) { const int col0 = (u.pn * NBJ + bj) * 64 + 4 * (4 * wc + fq);
                    const f32x4 a = acc[ai][bj][m][0] * scale, b = acc[ai][bj][m][1] * scale; float o[4];
#pragma unroll
                    for (int j = 0; j < 4; ++j) o[j] = siluf_(a[j]) * b[j] * F8_ASCALE;
                    *(unsigned*)(act8 + (size_t)(row0 + ai * HALF + m * 16) * FFN + col0) = cvt_pk4_fp8(o[0], o[1], o[2], o[3]); }
    }
};
struct EpiU {
    static constexpr bool PERM = true; static constexpr bool HAS_PREP = true;
    bf16_t* U; float* SM; const float* rstd; LAS float* tab;
    DI void prep(const Unit& u, int tid) const { if (tid < 256) tab[(u.ui & 1) * 256 + tid] = rstd[u.pm * BM + tid]; }
    DI void operator()(AccRef acc, const Unit& u, int wr, int wc, int fr, int fq) const {
        const int row0 = u.pm * BM + wr * 64 + fr;
        const LAS float* tb = tab + (u.ui & 1) * 256 + wr * 64 + fr;
        if (u.pn == SM_TILE) {
#pragma unroll
            for (int ai = 0; ai < 2; ++ai)
#pragma unroll
                for (int m = 0; m < 4; ++m) { float* rowp = SM + (size_t)(row0 + ai * HALF + m * 16) * 256 + wc * 32 + 8 * fq; const float rs = tb[ai * HALF + m * 16];
#pragma unroll
                    for (int bj = 0; bj < 2; ++bj) { *(f32x4*)(rowp + bj * HALF) = acc[ai][bj][m][0] * rs; *(f32x4*)(rowp + bj * HALF + 4) = acc[ai][bj][m][1] * rs; } }
        } else {
            const int col0 = u.pn * BM + wc * 32 + 8 * fq;
#pragma unroll
            for (int ai = 0; ai < 2; ++ai)
#pragma unroll
                for (int m = 0; m < 4; ++m) { bf16_t* rowp = U + (size_t)(row0 + ai * HALF + m * 16) * UWP + col0; const float rs = tb[ai * HALF + m * 16];
#pragma unroll
                    for (int bj = 0; bj < 2; ++bj) { const f32x4 v0 = acc[ai][bj][m][0] * rs, v1 = acc[ai][bj][m][1] * rs;
                        u32x4 w; w.x = cvt_pk_bf16(v0[0], v0[1]); w.y = cvt_pk_bf16(v0[2], v0[3]); w.z = cvt_pk_bf16(v1[0], v1[1]); w.w = cvt_pk_bf16(v1[2], v1[3]);
                        *(u32x4*)(rowp + bj * HALF) = w; } }
        }
    }
};
struct EpiPart {
    static constexpr bool PERM = true; static constexpr bool HAS_PREP = false;
    float* dst; float scale;
    DI void operator()(AccRef a, const Unit& u, int wr, int wc, int fr, int fq) const {
        const int row0 = wr * 64 + fr, col0 = wc * 32 + 8 * fq;
#pragma unroll
        for (int ai = 0; ai < 2; ++ai)
#pragma unroll
            for (int m = 0; m < 4; ++m) { float* rowp = dst + (row0 + ai * HALF + m * 16) * 256 + col0;
#pragma unroll
                for (int bj = 0; bj < 2; ++bj) { *(f32x4*)(rowp + bj * HALF) = a[ai][bj][m][0] * scale; *(f32x4*)(rowp + bj * HALF + 4) = a[ai][bj][m][1] * scale; } }
    }
};
struct EpiNull {
    static constexpr bool PERM = true; static constexpr bool HAS_PREP = false;
    float* sink;
    DI void operator()(AccRef acc, const Unit& u, int wr, int wc, int fr, int fq) const {
        f32x4 s = {0.f, 0.f, 0.f, 0.f};
#pragma unroll
        for (int ai = 0; ai < 2; ++ai)
#pragma unroll
            for (int bj = 0; bj < 2; ++bj)
#pragma unroll
                for (int m = 0; m < 4; ++m)
#pragma unroll
                    for (int n = 0; n < 2; ++n) s += acc[ai][bj][m][n];
        if (s[0] + s[1] + s[2] + s[3] == 123456.789f) sink[0] = s[0];
    }
};
struct EpiUL2 {
    static constexpr bool PERM = true; static constexpr bool HAS_PREP = false;
    bf16_t* T;
    DI void operator()(AccRef acc, const Unit& u, int wr, int wc, int fr, int fq) const {
        const int row0 = wr * 64 + fr, col0 = wc * 32 + 8 * fq;
#pragma unroll
        for (int ai = 0; ai < 2; ++ai)
#pragma unroll
            for (int m = 0; m < 4; ++m) { bf16_t* rowp = T + (size_t)(row0 + ai * HALF + m * 16) * 256 + col0;
#pragma unroll
                for (int bj = 0; bj < 2; ++bj) { const f32x4 v0 = acc[ai][bj][m][0], v1 = acc[ai][bj][m][1];
                    u32x4 w; w.x = cvt_pk_bf16(v0[0], v0[1]); w.y = cvt_pk_bf16(v0[2], v0[3]); w.z = cvt_pk_bf16(v1[0], v1[1]); w.w = cvt_pk_bf16(v1[2], v1[3]);
                    *(u32x4*)(rowp + bj * HALF) = w; } }
    }
};
template <bool SSQ> struct EpiResidT {
    static constexpr bool PERM = true; static constexpr bool HAS_PREP = false;
    const bf16_t* base; bf16_t* out; float* ssq;
    DI void operator()(AccRef acc, const Unit& u, int wr, int wc, int fr, int fq) const {
        const int row0 = u.pm * BM + wr * 64 + fr, col0 = u.pn * BM + wc * 32 + 8 * fq;
        u32x4 bv[4][2];
#define ER_LOAD(slot, rg) do { const size_t off_ = (size_t)(row0 + ((rg) >> 2) * HALF + ((rg) & 3) * 16) * D + col0; \
        _Pragma("unroll") for (int bj_ = 0; bj_ < 2; ++bj_) bv[slot][bj_] = *(const u32x4*)(base + off_ + bj_ * HALF); } while (0)
        ER_LOAD(0, 0); ER_LOAD(1, 1); ER_LOAD(2, 2);
#pragma unroll
        for (int rg = 0; rg < 8; ++rg) { const int ai = rg >> 2, m = rg & 3; const size_t off = (size_t)(row0 + ai * HALF + m * 16) * D + col0;
            if (rg + 3 < 8) ER_LOAD((rg + 3) & 3, rg + 3);
            asm volatile("" ::: "memory");
            float sq = 0.f;
#pragma unroll
            for (int bj = 0; bj < 2; ++bj) { const u32x4 b = bv[rg & 3][bj];
                const f32x4 v0 = (f32x4){bflo(b.x), bfhi(b.x), bflo(b.y), bfhi(b.y)} + acc[ai][bj][m][0], v1 = (f32x4){bflo(b.z), bfhi(b.z), bflo(b.w), bfhi(b.w)} + acc[ai][bj][m][1];
                if constexpr (SSQ) sq += (v0[0] * v0[0] + v0[1] * v0[1]) + (v0[2] * v0[2] + v0[3] * v0[3]) + (v1[0] * v1[0] + v1[1] * v1[1]) + (v1[2] * v1[2] + v1[3] * v1[3]);
                u32x4 w; w.x = cvt_pk_bf16(v0[0], v0[1]); w.y = cvt_pk_bf16(v0[2], v0[3]); w.z = cvt_pk_bf16(v1[0], v1[1]); w.w = cvt_pk_bf16(v1[2], v1[3]);
                *(u32x4*)(out + off + bj * HALF) = w; }
            if constexpr (SSQ) { sq += shfl_xor_f(sq, 16); sq += shfl_xor_f(sq, 32);
                if (fq == 0) ssq[(size_t)(row0 + ai * HALF + m * 16) * 32 + u.pn * 4 + wc] = sq; } }
#undef ER_LOAD
    }
};
typedef EpiResidT<false> EpiResid;
constexpr int RS_TAB = STAGE_BYTES;
DI float row_rstd(const float* ssq, int row) { const f32x4* p = (const f32x4*)(ssq + (size_t)row * 32); f32x4 t = p[0];
#pragma unroll
    for (int j = 1; j < 8; ++j) t += p[j];
    return 1.0f / sqrtf(((t[0] + t[1]) + (t[2] + t[3])) * (1.0f / D) + RMS_EPS); }
struct EpiBf16R {
    static constexpr bool PERM = true; static constexpr bool HAS_PREP = true;
    bf16_t* O; int ldc; const float* ssq; LAS float* tab;
    DI void prep(const Unit& u, int tid) const { if (tid < 256) tab[(u.ui & 1) * 256 + tid] = row_rstd(ssq, u.pm * BM + tid); }
    DI void operator()(AccRef acc, const Unit& u, int wr, int wc, int fr, int fq) const {
        const int row0 = u.pm * BM + wr * 64 + fr, col0 = u.pn * BM + wc * 32 + 8 * fq;
        const LAS float* tb = tab + (u.ui & 1) * 256 + wr * 64 + fr;
#pragma unroll
        for (int ai = 0; ai < 2; ++ai)
#pragma unroll
            for (int m = 0; m < 4; ++m) { bf16_t* rowp = O + (size_t)(row0 + ai * HALF + m * 16) * ldc + col0; const float rs = tb[ai * HALF + m * 16];
#pragma unroll
                for (int bj = 0; bj < 2; ++bj) { const f32x4 v0 = acc[ai][bj][m][0] * rs, v1 = acc[ai][bj][m][1] * rs;
                    u32x4 w; w.x = cvt_pk_bf16(v0[0], v0[1]); w.y = cvt_pk_bf16(v0[2], v0[3]); w.z = cvt_pk_bf16(v1[0], v1[1]); w.w = cvt_pk_bf16(v1[2], v1[3]);
                    *(u32x4*)(rowp + bj * HALF) = w; } }
    }
};
struct EpiMerge {
    static constexpr bool PERM = true; static constexpr bool HAS_PREP = false;
    const unsigned char* G; bf16_t* merged;
    DI void operator()(AccRef acc, const Unit& u, int wr, int wc, int fr, int fq) const {
        const int row0 = u.pm * BM + wr * 64 + fr, col0 = u.pn * BM + wc * 32 + 8 * fq, n_br = u.aux;
        u32x2 gv[4][2]; u32x4 pv[4][2];
#define EM_LOAD(slot, rg) do { const size_t row_ = (size_t)(row0 + ((rg) >> 2) * HALF + ((rg) & 3) * 16); \
        _Pragma("unroll") for (int bj_ = 0; bj_ < 2; ++bj_) { gv[slot][bj_] = *(const u32x2*)(G + row_ * (4 * D) + n_br * D + col0 + bj_ * HALF); \
            if (n_br > 0) pv[slot][bj_] = *(const u32x4*)(merged + row_ * D + col0 + bj_ * HALF); } } while (0)
        EM_LOAD(0, 0); EM_LOAD(1, 1); EM_LOAD(2, 2);
#pragma unroll
        for (int rg = 0; rg < 8; ++rg) { const int ai = rg >> 2, m = rg & 3; const size_t row = (size_t)(row0 + ai * HALF + m * 16);
            if (rg + 3 < 8) EM_LOAD((rg + 3) & 3, rg + 3);
            asm volatile("" ::: "memory");
#pragma unroll
            for (int bj = 0; bj < 2; ++bj) { const int c = col0 + bj * HALF; const u32x2 gw = gv[rg & 3][bj];
                f32x4 v0 = acc[ai][bj][m][0], v1 = acc[ai][bj][m][1];
                {
                    const float k = 1.0f / 255.0f;
                    v0[0] *= (float)(gw.x & 255u) * k; v0[1] *= (float)((gw.x >> 8) & 255u) * k; v0[2] *= (float)((gw.x >> 16) & 255u) * k; v0[3] *= (float)(gw.x >> 24) * k;
                    v1[0] *= (float)(gw.y & 255u) * k; v1[1] *= (float)((gw.y >> 8) & 255u) * k; v1[2] *= (float)((gw.y >> 16) & 255u) * k; v1[3] *= (float)(gw.y >> 24) * k; }
                if (n_br > 0) { const u32x4 pw = pv[rg & 3][bj];
                    v0[0] += bflo(pw.x); v0[1] += bfhi(pw.x); v0[2] += bflo(pw.y); v0[3] += bfhi(pw.y); v1[0] += bflo(pw.z); v1[1] += bfhi(pw.z); v1[2] += bflo(pw.w); v1[3] += bfhi(pw.w); }
                u32x4 w; w.x = cvt_pk_bf16(v0[0], v0[1]); w.y = cvt_pk_bf16(v0[2], v0[3]); w.z = cvt_pk_bf16(v1[0], v1[1]); w.w = cvt_pk_bf16(v1[2], v1[3]);
                *(u32x4*)(merged + row * D + c) = w; } }
#undef EM_LOAD
    }
};
struct EpiSwiGLU {
    static constexpr bool PERM = true; static constexpr bool HAS_PREP = false;
    bf16_t* act;
    DI void operator()(AccRef acc, const Unit& u, int wr, int wc, int fr, int fq) const {
        const int row0 = u.pm * BM + wr * 64 + fr, col0 = u.pn * HALF + wc * 32 + 8 * fq;
#pragma unroll
        for (int ai = 0; ai < 2; ++ai)
#pragma unroll
            for (int m = 0; m < 4; ++m) { bf16_t* rowp = act + (size_t)(row0 + ai * HALF + m * 16) * FFN + col0;
                float o[8];
#pragma unroll
                for (int n = 0; n < 2; ++n)
#pragma unroll
                    for (int jp = 0; jp < 2; ++jp) {
                        const f32x2 a = {acc[ai][0][m][n][2 * jp], acc[ai][0][m][n][2 * jp + 1]}, b = {acc[ai][1][m][n][2 * jp], acc[ai][1][m][n][2 * jp + 1]};
                        const f32x2 t = a * (-1.4426950408889634f); f32x2 e; e.x = fexp2(t.x); e.y = fexp2(t.y);
                        const f32x2 d = e + 1.0f; f32x2 r; r.x = frcp(d.x); r.y = frcp(d.y);
                        const f32x2 y = (a * b) * r; o[4 * n + 2 * jp] = y.x; o[4 * n + 2 * jp + 1] = y.y; }
                u32x4 w; w.x = cvt_pk_bf16(o[0], o[1]); w.y = cvt_pk_bf16(o[2], o[3]); w.z = cvt_pk_bf16(o[4], o[5]); w.w = cvt_pk_bf16(o[6], o[7]);
                *(u32x4*)rowp = w; asm volatile("" ::: "memory"); }
    }
};
struct EpiSwiGLUR {
    static constexpr bool PERM = true; static constexpr bool HAS_PREP = true;
    bf16_t* act; const float* ssq; LAS float* tab;
    DI void prep(const Unit& u, int tid) const { if (tid < 256) tab[(u.ui & 1) * 256 + tid] = row_rstd(ssq, u.pm * BM + tid); }
    DI void operator()(AccRef acc, const Unit& u, int wr, int wc, int fr, int fq) const {
        const int row0 = u.pm * BM + wr * 64 + fr, col0 = u.pn * HALF + wc * 32 + 8 * fq;
        const LAS float* tb = tab + (u.ui & 1) * 256 + wr * 64 + fr;
#pragma unroll
        for (int ai = 0; ai < 2; ++ai)
#pragma unroll
            for (int m = 0; m < 4; ++m) { bf16_t* rowp = act + (size_t)(row0 + ai * HALF + m * 16) * FFN + col0; const float rs = tb[ai * HALF + m * 16];
                float o[8];
#pragma unroll
                for (int n = 0; n < 2; ++n)
#pragma unroll
                    for (int jp = 0; jp < 2; ++jp) {
                        const f32x2 a = (f32x2){acc[ai][0][m][n][2 * jp], acc[ai][0][m][n][2 * jp + 1]} * rs, b = (f32x2){acc[ai][1][m][n][2 * jp], acc[ai][1][m][n][2 * jp + 1]} * rs;
                        const f32x2 t = a * (-1.4426950408889634f); f32x2 e; e.x = fexp2(t.x); e.y = fexp2(t.y);
                        const f32x2 d = e + 1.0f; f32x2 r; r.x = frcp(d.x); r.y = frcp(d.y);
                        const f32x2 y = (a * b) * r; o[4 * n + 2 * jp] = y.x; o[4 * n + 2 * jp + 1] = y.y; }
                u32x4 w; w.x = cvt_pk_bf16(o[0], o[1]); w.y = cvt_pk_bf16(o[2], o[3]); w.z = cvt_pk_bf16(o[4], o[5]); w.w = cvt_pk_bf16(o[6], o[7]);
                *(u32x4*)rowp = w; asm volatile("" ::: "memory"); }
    }
};
#ifdef HOST_EMU
template <class Epi, class Sched, bool FULLN = false>
static void gemm_phase_f8(unsigned char* lds, const Gemm g, const Sched& S, const Epi& E, int wave_id) {
    const int tid = threadIdx.x, wid = tid >> 6, lane = tid & 63, wr = wid >> 2, wc = wid & 3, fr = lane & 15, fq = lane >> 4;
    static thread_local float* Cbuf = nullptr; static thread_local float* Af = nullptr; static thread_local float* Bf = nullptr;
    Unit u;
    for (int i = 0; S.next(i, u); ++i) {
        __syncthreads();
        if (tid == 0) {
            if (!Cbuf) { Cbuf = (float*)malloc(256 * 256 * 4); Af = (float*)malloc((size_t)256 * 8192 * 4); Bf = (float*)malloc((size_t)256 * 8192 * 4); }
            const int K = 2 * g.K; const unsigned char* A8 = (const unsigned char*)g.A; const unsigned char* B8 = (const unsigned char*)g.Bt;
            for (int r = 0; r < 256; ++r) for (int k = 0; k < K; ++k) { Af[(size_t)r * K + k] = fp82f_host(A8[((size_t)u.pa * 256 + r) * 2 * g.lda + k]); Bf[(size_t)r * K + k] = (FULLN || r < 128) ? fp82f_host(B8[((size_t)u.pb * (FULLN ? 256 : 128) + r) * 2 * g.ldb + k]) : 0.f; }
            for (int r = 0; r < 256; ++r) for (int c = 0; c < 256; ++c) { const float* a = Af + (size_t)r * K; const float* b = Bf + (size_t)c * K; float sum = 0.f;
                for (int k = 0; k < K; ++k) sum += a[k] * b[k]; Cbuf[r * 256 + c] = sum; }
        }
        __syncthreads();
        f32x4 acc[2][2][4][2];
        for (int ai = 0; ai < 2; ++ai) for (int bj = 0; bj < 2; ++bj) for (int m = 0; m < 4; ++m) for (int n = 0; n < 2; ++n) for (int j = 0; j < 4; ++j) {
            const int r = 128 * ai + 64 * wr + 16 * m + fr;
            const int c = 128 * bj + 32 * wc + 8 * fq + 4 * n + j;
            acc[ai][bj][m][n][j] = Cbuf[r * 256 + c]; }
        E(acc, u, wr, wc, fr, fq);
    }
    __syncthreads();
}
#endif
}

struct Frame {
    unsigned char* lds; int tid, lane, wave, G, bid, flags;
    const float* const* in; float* out; unsigned char* ws;
#ifndef HOST_EMU
    template <class T> DI T* wp(size_t off) const { return (T*)(GAS T*)(ws + off); }
    DI const float* inp(int i) const { return (const float*)(GAS const float*)in[i]; }
    DI float* outp() const { return (float*)(GAS float*)out; }
#else
    template <class T> DI T* wp(size_t off) const { return (T*)(ws + off); }
    DI const float* inp(int i) const { return in[i]; }
    DI float* outp() const { return out; }
#endif
};

DI void make_frame(Frame& F, const Params& P, unsigned char* lds, int wave0) {
#ifndef HOST_EMU
    int wv = wave0; LAUNDER_S(wv); int ln = lane_id_hw(); LAUNDER_V(ln); int tid = wv * 64 + ln;
#else
    int tid = threadIdx.x;
#endif
    size_t wz = 0; LAUNDER_S(wz); unsigned char* ws = P.ws + wz;
    F.lds = lds; F.tid = tid; F.lane = tid & 63; F.wave = tid >> 6;
#ifndef HOST_EMU
    F.wave = wv;
#endif
    F.G = gridDim.x; F.bid = blockIdx.x;
    F.in = P.in; F.out = P.out; F.ws = ws; F.flags = P.flags;
}
#define REFRAME() make_frame(F, P, lds, wave0)
DI bf16x8 frag_r(const bf16_t* T, int pitch, int r0, int k0, int lane) { return *(const bf16x8*)(T + (r0 + (lane & 15)) * pitch + k0 + 8 * (lane >> 4)); }
DI bf16x8 frag_k(const bf16_t* T, int pitch, int k0, int n0, int lane) {
    const int g = lane >> 4, q = (lane & 15) >> 2, p = lane & 3;
    const bf16_t* p0 = T + (k0 + 8 * g + q) * pitch + n0 + 4 * p;
    const s16x4 lo = lds_tr4(p0), hi = lds_tr4(p0 + 4 * pitch);
    return __builtin_shufflevector(lo, hi, 0, 1, 2, 3, 4, 5, 6, 7);
}
#ifndef HOST_EMU
template <int CTRL> DI float dppf(float v) { return __builtin_bit_cast(float, __builtin_amdgcn_update_dpp(0, __builtin_bit_cast(int, v), CTRL, 0xF, 0xF, true)); }
DI float grp16_max(float v) { v = fmaxf(v, dppf<0xB1>(v)); v = fmaxf(v, dppf<0x4E>(v)); v = fmaxf(v, dppf<0x141>(v)); v = fmaxf(v, dppf<0x140>(v)); return v; }
DI float grp16_sum(float v) { v += dppf<0xB1>(v); v += dppf<0x4E>(v); v += dppf<0x141>(v); v += dppf<0x140>(v); return v; }
#else
DI float grp16_max(float v) { v = fmaxf(v, shfl_xor_f(v, 1)); v = fmaxf(v, shfl_xor_f(v, 2)); v = fmaxf(v, shfl_xor_f(v, 4)); v = fmaxf(v, shfl_xor_f(v, 8)); return v; }
DI float grp16_sum(float v) { v += shfl_xor_f(v, 1); v += shfl_xor_f(v, 2); v += shfl_xor_f(v, 4); v += shfl_xor_f(v, 8); return v; }
#endif

template <class ColMap>
DI void tr_load(const float* W, int ldw, const ColMap& cm, int item, int nblk  , int lane, f32x4 (&v)[16]) {
    const int kb = item / nblk, nb = item - kb * nblk, k0 = 64 * kb, n0 = 64 * nb;
    const int col = cm(n0 + 4 * (lane & 15)), rq = lane >> 4;
#pragma unroll
    for (int i = 0; i < 16; ++i) v[i] = (f32x4){0.f, 0.f, 0.f, 0.f};
    if (col >= 0) {
        const float* src = W + (size_t)(k0 + rq) * ldw + col;
#pragma unroll
        for (int i = 0; i < 16; ++i) v[i] = *(const f32x4*)(src + (size_t)(4 * i) * ldw);
    }
}
DI void tr_store(int K, bf16_t* WT, bf16_t* scr  , int item, int nblk, int lane, const f32x4 (&v)[16], const float* ks  ) {
    const int kb = item / nblk, nb = item - kb * nblk, k0 = 64 * kb, n0 = 64 * nb, rq = lane >> 4;
#pragma unroll
    for (int i = 0; i < 16; ++i) { f32x4 x = v[i]; if (ks) x *= ks[k0 + rq + 4 * i];
        u32x2 o; o.x = cvt_pk_bf16(x[0], x[1]); o.y = cvt_pk_bf16(x[2], x[3]); *(u32x2*)(scr + (rq + 4 * i) * 72 + 4 * (lane & 15)) = o; }
    WAVE_FENCE();
#pragma unroll
    for (int kq = 0; kq < 2; ++kq)
#pragma unroll
        for (int nq = 0; nq < 4; ++nq) { const bf16x8 f = frag_k(scr, 72, 32 * kq, 16 * nq, lane);
            *(bf16x8*)(WT + (size_t)(n0 + 16 * nq + (lane & 15)) * K + k0 + 32 * kq + 8 * (lane >> 4)) = f; }
    WAVE_FENCE();
}
DI void tr_store_f8(int K, unsigned char* WT8, bf16_t* scr, int item, int nblk, int lane, const f32x4 (&v)[16], float wscale) {
    const int kb = item / nblk, nb = item - kb * nblk, k0 = 64 * kb, n0 = 64 * nb, rq = lane >> 4;
#pragma unroll
    for (int i = 0; i < 16; ++i) { u32x2 o; o.x = cvt_pk_bf16(v[i][0] * wscale, v[i][1] * wscale); o.y = cvt_pk_bf16(v[i][2] * wscale, v[i][3] * wscale); *(u32x2*)(scr + (rq + 4 * i) * 72 + 4 * (lane & 15)) = o; }
    WAVE_FENCE();
#pragma unroll
    for (int kq = 0; kq < 2; ++kq)
#pragma unroll
        for (int nq = 0; nq < 4; ++nq) { const bf16x8 f = frag_k(scr, 72, 32 * kq, 16 * nq, lane);
            u32x2 o; o.x = cvt_pk4_fp8(bf2f((bf16_t)f[0]), bf2f((bf16_t)f[1]), bf2f((bf16_t)f[2]), bf2f((bf16_t)f[3])); o.y = cvt_pk4_fp8(bf2f((bf16_t)f[4]), bf2f((bf16_t)f[5]), bf2f((bf16_t)f[6]), bf2f((bf16_t)f[7]));
            *(u32x2*)(WT8 + (size_t)(n0 + 16 * nq + (lane & 15)) * K + k0 + 32 * kq + 8 * (lane >> 4)) = o; }
    WAVE_FENCE();
}
struct CmGate { DI int operator()(int n) const { return SO_GATE + n; } };
struct CmW13F8 { DI int operator()(int r) const { const int pn = r >> 7, c = r & 127, q = c >> 3, n = (c >> 2) & 1, j = c & 3; return (n ? FFN : 0) + 64 * pn + 4 * q + j; } };
struct CmIdent { DI int operator()(int n) const { return n; } };
struct CmWin { DI int operator()(int r) const {
    if (r < 3072) return r;
    if (r < 4096) return SO_SSZ + (r - 3072);
    if (r < 5632) return SO_XBC + (r - 4096);
    if (r < 6144) return SO_CQ + (r - 5632);
    if (r < 6400) return SO_CKV + (r - 6144);
    if (r < 6656) { const int j = r - 6400; if (j < 64) return SO_KR + j; if (j < 72) return SO_MLI + (j - 64); if (j < 88) return SO_DT + (j - 72); return -1; }
    if (r < 7680) return SO_SWQ + (r - 6656);
    if (r < 7936) return SO_SWK + (r - 7680);
    if (r < 8192) return SO_SWV + (r - 7936);
    return SO_GATE + (r - 8192); } };
struct CmW13 { DI int operator()(int r) const { const int pn = r >> 8, rr = r & 255; return rr < 128 ? 128 * pn + rr : FFN + 128 * pn + (rr - 128); } };
template <class ColMap>
DI void convert_weight_f8(const Frame& F, const float* W, int ldw, int K, int N, unsigned char* WT8, const ColMap& cm, float wscale, int& rot) {
    bf16_t* scr = (bf16_t*)(F.lds + F.wave * 16384);
    const int NGW = F.G * 8, nblk = N / 64, items = (K / 64) * nblk;
    int gw = F.bid * 8 + F.wave - rot; if (gw < 0) gw += NGW;
    rot = (rot + items) % NGW;
    if (gw < items) {
        f32x4 v[16]; tr_load(W, ldw, cm, gw, nblk, F.lane, v);
        for (int it = gw;;) { const int nx = it + NGW; f32x4 vn[16];
            if (nx < items) tr_load(W, ldw, cm, nx, nblk, F.lane, vn);
            tr_store_f8(K, WT8, scr, it, nblk, F.lane, v, wscale);
            if (nx >= items) break;
#pragma unroll
            for (int i = 0; i < 16; ++i) v[i] = vn[i];
            it = nx; }
    }
}
template <class ColMap>
DI void convert_weight(const Frame& F, const float* W, int ldw, int K, int N, bf16_t* WT, const ColMap& cm, int& rot, const float* ks = nullptr) {
    bf16_t* scr = (bf16_t*)(F.lds + F.wave * 16384);
    const int NGW = F.G * 8, nblk = N / 64, items = (K / 64) * nblk;
    int gw = F.bid * 8 + F.wave - rot; if (gw < 0) gw += NGW;
    rot = (rot + items) % NGW;
    if (gw < items) {
        f32x4 v[16]; tr_load(W, ldw, cm, gw, nblk, F.lane, v);
        for (int it = gw;;) { const int nx = it + NGW; f32x4 vn[16];
            if (nx < items) tr_load(W, ldw, cm, nx, nblk, F.lane, vn);
            tr_store(K, WT, scr, it, nblk, F.lane, v, ks);
            if (nx >= items) break;
#pragma unroll
            for (int i = 0; i < 16; ++i) v[i] = vn[i];
            it = nx; }
    }
}
DI void rms_row_to_bf16(const float* xrow, const float* w, bf16_t* orow, int lane, unsigned char* o8 = nullptr, bf16_t* h16 = nullptr, float* rs_out = nullptr) {
    f32x4 v[8]; float s = 0.f;
#pragma unroll
    for (int j = 0; j < 8; ++j) { v[j] = *(const f32x4*)(xrow + 4 * (lane + 64 * j)); s += (v[j][0] * v[j][0] + v[j][1] * v[j][1]) + (v[j][2] * v[j][2] + v[j][3] * v[j][3]);
        if (h16) { u32x2 hc; hc.x = cvt_pk_bf16(v[j][0], v[j][1]); hc.y = cvt_pk_bf16(v[j][2], v[j][3]); *(u32x2*)(h16 + 4 * (lane + 64 * j)) = hc; } }
    const float rstd = 1.0f / sqrtf(wave_sum(s) * (1.0f / D) + RMS_EPS);
    if (rs_out && lane == 0) *rs_out = rstd;
#pragma unroll
    for (int j = 0; j < 8; ++j) { const f32x4 ww = *(const f32x4*)(w + 4 * (lane + 64 * j));
        const float y0 = v[j][0] * rstd * ww[0], y1 = v[j][1] * rstd * ww[1], y2 = v[j][2] * rstd * ww[2], y3 = v[j][3] * rstd * ww[3];
        u32x2 o; o.x = cvt_pk_bf16(y0, y1); o.y = cvt_pk_bf16(y2, y3);
        if (orow) *(u32x2*)(orow + 4 * (lane + 64 * j)) = o;
        if (o8) *(unsigned*)(o8 + 4 * (lane + 64 * j)) = cvt_pk4_fp8(y0 * F8_ASCALE, y1 * F8_ASCALE, y2 * F8_ASCALE, y3 * F8_ASCALE); }
}
DI void rms_row16_to_bf16(const bf16_t* xrow, const float* w, bf16_t* orow, int lane, unsigned char* o8 = nullptr, float* rs_out = nullptr) {
    f32x4 v[8]; float s = 0.f;
#pragma unroll
    for (int j = 0; j < 8; ++j) { const u32x2 a = *(const u32x2*)(xrow + 4 * (lane + 64 * j)); v[j] = (f32x4){bflo(a.x), bfhi(a.x), bflo(a.y), bfhi(a.y)};
        s += (v[j][0] * v[j][0] + v[j][1] * v[j][1]) + (v[j][2] * v[j][2] + v[j][3] * v[j][3]); }
    const float rstd = 1.0f / sqrtf(wave_sum(s) * (1.0f / D) + RMS_EPS);
    if (rs_out && lane == 0) *rs_out = rstd;
#pragma unroll
    for (int j = 0; j < 8; ++j) { const f32x4 ww = *(const f32x4*)(w + 4 * (lane + 64 * j));
        const float y0 = v[j][0] * rstd * ww[0], y1 = v[j][1] * rstd * ww[1], y2 = v[j][2] * rstd * ww[2], y3 = v[j][3] * rstd * ww[3];
        u32x2 o; o.x = cvt_pk_bf16(y0, y1); o.y = cvt_pk_bf16(y2, y3);
        if (orow) *(u32x2*)(orow + 4 * (lane + 64 * j)) = o;
        if (o8) *(unsigned*)(o8 + 4 * (lane + 64 * j)) = cvt_pk4_fp8(y0 * F8_ASCALE, y1 * F8_ASCALE, y2 * F8_ASCALE, y3 * F8_ASCALE); }
}
DI void phase_prologue(const Frame& F) {
    CmIdent id; int rot = 0;
    for (int l = 0; l < DEPTH; ++l) {
        if (!(F.flags & 4)) { convert_weight(F, F.inp(3) + (size_t)l * D * IN_TOTAL, IN_TOTAL, D, UC_GATE, F.wp<bf16_t>(O_WIN) + (size_t)l * UW * D, CmWin(), rot, F.inp(2) + (size_t)l * D);
            convert_weight_f8(F, F.inp(3) + (size_t)l * D * IN_TOTAL, IN_TOTAL, D, 8192, F.wp<unsigned char>(O_WG8) + (size_t)l * 8192 * D, CmGate(), F8_WSCALE, rot); }
        convert_weight(F, F.inp(14) + (size_t)l * 512 * 1536, 1536, 512, 1536, F.wp<bf16_t>(O_WUQ) + (size_t)l * 1536 * 512, id, rot);
        convert_weight(F, F.inp(16) + (size_t)l * 256 * 2048, 2048, 256, 2048, F.wp<bf16_t>(O_WUKV) + (size_t)l * 2048 * 256, id, rot);
        for (int n = 0; n < 4; ++n)
            convert_weight(F, F.inp(18) + ((size_t)l * 4 + n) * 1024 * 2048, 2048, 1024, 2048, F.wp<bf16_t>(O_WBR) + ((size_t)l * 4 + n) * 2048 * 1024, id, rot);
        convert_weight(F, F.inp(19) + (size_t)l * D * D, D, D, D, F.wp<bf16_t>(O_WOUT) + (size_t)l * D * D, id, rot);
        convert_weight(F, F.inp(22) + (size_t)l * D * 512, 512, D, 512, F.wp<bf16_t>(O_WXQ) + (size_t)l * 512 * D, id, rot, F.inp(20) + (size_t)l * D);
        convert_weight(F, F.inp(23) + (size_t)l * D * 1024, 1024, D, 1024, F.wp<bf16_t>(O_WXKV) + (size_t)l * 1024 * D, id, rot);
        convert_weight(F, F.inp(24) + (size_t)l * 512 * D, D, 512, D, F.wp<bf16_t>(O_WXO) + (size_t)l * D * 512, id, rot);
    }
    if (!(F.flags & 2)) { convert_weight(F, F.inp(26), 2 * FFN, D, 2 * FFN, F.wp<bf16_t>(O_W13), CmW13(), rot, F.inp(25));
    convert_weight(F, F.inp(27), D, FFN, D, F.wp<bf16_t>(O_W2), id, rot); }
    if (!(F.flags & 1)) for (int e = 0; e < NEXP; ++e) {
        convert_weight_f8(F, F.inp(29) + (size_t)e * D * 2 * FFN, 2 * FFN, D, 2 * FFN, F.wp<unsigned char>(O_MW13) + (size_t)e * 2 * FFN * D, CmW13F8(), F8_WSCALE, rot);
        convert_weight_f8(F, F.inp(30) + (size_t)e * FFN * D, D, FFN, D, F.wp<unsigned char>(O_MW2) + (size_t)e * D * FFN, id, F8_WSCALE, rot);
    }
    float* rope = F.wp<float>(O_ROPE);
    for (int idx = F.bid * NTHREADS + F.tid; idx < SEQ * 32; idx += F.G * NTHREADS) {
        const int t = idx >> 5, i = idx & 31;
        const float inv_freq = fexp2(-(float)i * (13.287712379549449f / 32.0f));
        const float ang = (float)t * inv_freq;
        const double rev = (double)ang * 0.15915494309189535; const float fr = (float)(rev - (double)(long long)rev);
        rope[2 * idx] = fcos_rev(fr); rope[2 * idx + 1] = fsin_rev(fr);
    }
    const int gw = F.bid * 8 + F.wave, NGW = F.G * 8;
    for (int r = gw; r < DEPTH * NMEM; r += NGW) { const int l = r / NMEM, m = r % NMEM;
        rms_row_to_bf16(F.inp(1) + (size_t)m * D, F.inp(21) + (size_t)l * D, F.wp<bf16_t>(O_MEMN) + (size_t)r * D, F.lane); }
}

DI void phase_rmsnorm_x(const Frame& F, const float* src, const float* w) {
    const int gw = F.bid * 8 + F.wave, NGW = F.G * 8;
    unsigned char* x8 = F.wp<unsigned char>(O_XN8);
    for (int r = gw; r < NTOK; r += NGW) rms_row_to_bf16(src + (size_t)r * D, w, nullptr, F.lane, x8 + (size_t)r * D, F.wp<bf16_t>(O_H) + (size_t)r * D, F.wp<float>(O_RSTD) + r);
}
DI void phase_rmsnorm(const Frame& F, const bf16_t* src, const float* w) {
    const int gw = F.bid * 8 + F.wave, NGW = F.G * 8;
    unsigned char* x8 = F.wp<unsigned char>(O_XN8);
    const int lane = F.lane; float* rsd = F.wp<float>(O_RSTD);
    for (int r = gw; r < NTOK; r += 2 * NGW) { const int r2 = r + NGW;
        if (r2 >= NTOK) { rms_row16_to_bf16(src + (size_t)r * D, w, nullptr, lane, x8 + (size_t)r * D, rsd + r); break; }
        u32x2 a[8], b[8];
#pragma unroll
        for (int j = 0; j < 8; ++j) { a[j] = *(const u32x2*)(src + (size_t)r * D + 4 * (lane + 64 * j)); b[j] = *(const u32x2*)(src + (size_t)r2 * D + 4 * (lane + 64 * j)); }
        float sa = 0.f, sb = 0.f;
#pragma unroll
        for (int j = 0; j < 8; ++j) { sa += (bflo(a[j].x) * bflo(a[j].x) + bfhi(a[j].x) * bfhi(a[j].x)) + (bflo(a[j].y) * bflo(a[j].y) + bfhi(a[j].y) * bfhi(a[j].y));
            sb += (bflo(b[j].x) * bflo(b[j].x) + bfhi(b[j].x) * bfhi(b[j].x)) + (bflo(b[j].y) * bflo(b[j].y) + bfhi(b[j].y) * bfhi(b[j].y)); }
        const float ra = 1.0f / sqrtf(wave_sum(sa) * (1.0f / D) + RMS_EPS), rb = 1.0f / sqrtf(wave_sum(sb) * (1.0f / D) + RMS_EPS);
        if (lane == 0) { rsd[r] = ra; rsd[r2] = rb; }
#pragma unroll
        for (int j = 0; j < 8; ++j) { const int c0 = 4 * (lane + 64 * j); const f32x4 ww = *(const f32x4*)(w + c0);
            *(unsigned*)(x8 + (size_t)r * D + c0) = cvt_pk4_fp8(bflo(a[j].x) * ra * ww[0] * F8_ASCALE, bfhi(a[j].x) * ra * ww[1] * F8_ASCALE, bflo(a[j].y) * ra * ww[2] * F8_ASCALE, bfhi(a[j].y) * ra * ww[3] * F8_ASCALE);
            *(unsigned*)(x8 + (size_t)r2 * D + c0) = cvt_pk4_fp8(bflo(b[j].x) * rb * ww[0] * F8_ASCALE, bfhi(b[j].x) * rb * ww[1] * F8_ASCALE, bflo(b[j].y) * rb * ww[2] * F8_ASCALE, bfhi(b[j].y) * rb * ww[3] * F8_ASCALE); }
    }
}
DI void block_rows(const Frame& F, int& r0, int& r1) { r0 = (int)(((long)NTOK * F.bid) / F.G); r1 = (int)(((long)NTOK * (F.bid + 1)) / F.G); }
DI void phase_rmsnorm_route(const Frame& F, const bf16_t* src, const float* w, const float* router) {
    int* cnt = (int*)(F.lds);
    float* RT = (float*)(F.lds + 1024);
    if (F.tid < 8) cnt[F.tid] = 0;
    for (int c = F.tid; c < D; c += NTHREADS) { const f32x4 ra = *(const f32x4*)(router + (size_t)c * 8), rb = *(const f32x4*)(router + (size_t)c * 8 + 4);
        RT[c] = ra[0]; RT[D + c] = ra[1]; RT[2 * D + c] = ra[2]; RT[3 * D + c] = ra[3]; RT[4 * D + c] = rb[0]; RT[5 * D + c] = rb[1]; RT[6 * D + c] = rb[2]; RT[7 * D + c] = rb[3]; }
    __syncthreads();
    int r0, r1; block_rows(F, r0, r1);
    int* r_e = F.wp<int>(O_ROUTE); float* r_g = (float*)(r_e + 2 * NTOK);
    u32x2 nx[8];
    if (r0 + F.wave < r1) {
#pragma unroll
        for (int j = 0; j < 8; ++j) nx[j] = *(const u32x2*)(src + (size_t)(r0 + F.wave) * D + 4 * (F.lane + 64 * j)); }
    for (int r = r0 + F.wave; r < r1; r += 8) {
        const int lane = F.lane;
        u32x2 cur[8];
#pragma unroll
        for (int j = 0; j < 8; ++j) cur[j] = nx[j];
        if (r + 8 < r1) {
#pragma unroll
            for (int j = 0; j < 8; ++j) nx[j] = *(const u32x2*)(src + (size_t)(r + 8) * D + 4 * (lane + 64 * j)); }
        f32x4 v[8]; float s = 0.f;
#pragma unroll
        for (int j = 0; j < 8; ++j) { const u32x2 a_ = cur[j]; v[j] = (f32x4){bflo(a_.x), bfhi(a_.x), bflo(a_.y), bfhi(a_.y)}; s += (v[j][0] * v[j][0] + v[j][1] * v[j][1]) + (v[j][2] * v[j][2] + v[j][3] * v[j][3]); }
        const float rstd = 1.0f / sqrtf(wave_sum(s) * (1.0f / D) + RMS_EPS);
        float lg[8];
#pragma unroll
        for (int e = 0; e < 8; ++e) lg[e] = 0.f;
        unsigned char* orow = F.wp<unsigned char>(O_XN8) + (size_t)r * D;
#pragma unroll
        for (int j = 0; j < 8; ++j) { const int c0 = 4 * (lane + 64 * j); const f32x4 ww = *(const f32x4*)(w + c0);
            const f32x4 y = {v[j][0] * rstd * ww[0], v[j][1] * rstd * ww[1], v[j][2] * rstd * ww[2], v[j][3] * rstd * ww[3]};
            *(unsigned*)(orow + c0) = cvt_pk4_fp8(y[0] * F8_ASCALE, y[1] * F8_ASCALE, y[2] * F8_ASCALE, y[3] * F8_ASCALE);
#pragma unroll
            for (int e = 0; e < 8; ++e) { const f32x4 rw = *(const f32x4*)(RT + e * D + c0); lg[e] += (y[0] * rw[0] + y[1] * rw[1]) + (y[2] * rw[2] + y[3] * rw[3]); }
            SCHED_BAR(); }
#pragma unroll
        for (int e = 0; e < 8; ++e) lg[e] = wave_sum(lg[e]);
        int i0 = 0; float v0 = lg[0];
#pragma unroll
        for (int e = 1; e < 8; ++e) if (lg[e] > v0) { v0 = lg[e]; i0 = e; }
        int i1 = -1; float v1 = -3.0e38f;
#pragma unroll
        for (int e = 0; e < 8; ++e) if (e != i0 && lg[e] > v1) { v1 = lg[e]; i1 = e; }
        const float e1 = fexp(v1 - v0), g0 = 1.0f / (1.0f + e1), g1 = e1 * g0;
        if (lane == 0) { r_e[2 * r] = i0; r_e[2 * r + 1] = i1; r_g[2 * r] = g0; r_g[2 * r + 1] = g1; lds_atomic_add_i(&cnt[i0], 1); lds_atomic_add_i(&cnt[i1], 1); }
    }
    __syncthreads();
    if (F.tid < 8) F.wp<int>(O_BLKCNT)[F.bid * 8 + F.tid] = cnt[F.tid];
}
DI void moe_tables(const Frame& F, int* tile_e, int* pstart, int* ntiles_out) {
    const int* bc = F.wp<int>(O_BLKCNT);
    if (F.tid == 0) {
        int tot[8];
        for (int e = 0; e < 8; ++e) tot[e] = 0;
        for (int b = 0; b < F.G; ++b) for (int e = 0; e < 8; ++e) tot[e] += bc[b * 8 + e];
        int ps = 0, nt = 0;
        for (int e = 0; e < 8; ++e) { pstart[e] = ps; const int t = (tot[e] + 255) >> 8;
_Pragma("clang loop vectorize(disable) unroll(disable)")
            for (int j = 0; j < t; ++j) tile_e[nt + j] = e;
            nt += t; ps += t * 256; }
        *ntiles_out = nt;
    }
    __syncthreads();
}
DI void phase_moe_scatter(const Frame& F, int* tile_e, int* pstart, int* ntiles, int* myoff  ) {
    moe_tables(F, tile_e, pstart, ntiles);
    const int* bc = F.wp<int>(O_BLKCNT);
    int r0, r1; block_rows(F, r0, r1);
    int* r_e = F.wp<int>(O_ROUTE); int* r_s = r_e + 4 * NTOK;
    if (F.tid < 8) { int s = 0; for (int b = 0; b < F.bid; ++b) s += bc[b * 8 + F.tid]; myoff[F.tid] = pstart[F.tid] + s; }
    __syncthreads();
    {
        int* es = (int*)F.lds; const int np = 2 * (r1 - r0);
        for (int p = F.tid; p < np; p += NTHREADS) es[p] = r_e[2 * r0 + p];
        __syncthreads();
        for (int p = F.tid; p < np; p += NTHREADS) { const int e = es[p]; int before = 0;
            for (int q = 0; q < p; ++q) before += (es[q] == e) ? 1 : 0;
            r_s[2 * r0 + p] = myoff[e] + before; }
    }
    __syncthreads();
    asm volatile("" ::: "memory");
    const unsigned char* xn8 = F.wp<unsigned char>(O_XN8); unsigned char* xg8 = F.wp<unsigned char>(O_XG);
    for (int i = 2 * r0 + F.wave; i < 2 * r1; i += 32) {
        u32x4 v[4][2]; int slot[4];
#pragma unroll
        for (int q = 0; q < 4; ++q) { const int ii = i + 8 * q; const bool ok = ii < 2 * r1; const int ic = ok ? ii : i; slot[q] = ok ? r_s[ic] : -1;
            const u32x4* sp_ = (const u32x4*)(xn8 + (size_t)(ic >> 1) * D); v[q][0] = sp_[F.lane]; v[q][1] = sp_[F.lane + 64]; }
#pragma unroll
        for (int q = 0; q < 4; ++q) if (slot[q] >= 0) { u32x4* dp_ = (u32x4*)(xg8 + (size_t)slot[q] * D); dp_[F.lane] = v[q][0]; dp_[F.lane + 64] = v[q][1]; } }
}
DI void phase_final(const Frame& F, bool moe_last, const int* ntiles_p, unsigned char* tail_of  ) {
    const int gw = F.bid * 8 + F.wave, NGW = F.G * 8, lane = F.lane;
    const bf16_t* H = F.wp<bf16_t>(O_H); const bf16_t* yg = F.wp<bf16_t>(O_YG); const float* w = F.inp(31); const float* tacc = F.wp<float>(O_TAILACC);
    const int* r_e = F.wp<int>(O_ROUTE); const float* r_g = (const float*)(r_e + 2 * NTOK); const int* r_s = r_e + 4 * NTOK;
    int full = 0, R = 0, sp = 0;
    if (moe_last) {
        pg8::moe_tail_split(*ntiles_p, F.G, full, R, sp);
_Pragma("clang loop vectorize(disable) unroll(disable)")
        for (int i = F.tid; i < MAXTILES * 8; i += NTHREADS) tail_of[i] = 0;
        __syncthreads();
        for (int u = F.tid; u < R; u += NTHREADS) { int pm, pn; pg8::static_map((long)full * F.G + u, *ntiles_p, D / 256, pm, pn); tail_of[pm * 8 + pn] = (unsigned char)(u + 1); }
        __syncthreads();
    }
    for (int r = gw; r < NTOK; r += NGW) {
        f32x4 v[8]; float s = 0.f;
        float g0 = 0.f, g1 = 0.f; int s0 = 0, s1 = 0;
        if (moe_last) { g0 = r_g[2 * r]; g1 = r_g[2 * r + 1]; s0 = r_s[2 * r]; s1 = r_s[2 * r + 1]; }
#pragma unroll
        for (int j = 0; j < 8; ++j) { const int c0 = 4 * (lane + 64 * j); { const u32x2 a_ = *(const u32x2*)(H + (size_t)r * D + c0); v[j] = (f32x4){bflo(a_.x), bfhi(a_.x), bflo(a_.y), bfhi(a_.y)}; }
            if (moe_last) {
                f32x4 ya, yb;
                const int t0 = tail_of[(s0 >> 8) * 8 + j], t1 = tail_of[(s1 >> 8) * 8 + j];
                if (t0) { ya = (f32x4){0.f, 0.f, 0.f, 0.f}; for (int p = 0; p < sp; ++p) ya += *(const f32x4*)(tacc + (size_t)((t0 - 1) * sp + p) * 65536 + (s0 & 255) * 256 + 4 * lane); }
                else { const u32x2 a = *(const u32x2*)(yg + (size_t)s0 * D + c0); ya = (f32x4){bflo(a.x), bfhi(a.x), bflo(a.y), bfhi(a.y)}; }
                if (t1) { yb = (f32x4){0.f, 0.f, 0.f, 0.f}; for (int p = 0; p < sp; ++p) yb += *(const f32x4*)(tacc + (size_t)((t1 - 1) * sp + p) * 65536 + (s1 & 255) * 256 + 4 * lane); }
                else { const u32x2 bb = *(const u32x2*)(yg + (size_t)s1 * D + c0); yb = (f32x4){bflo(bb.x), bfhi(bb.x), bflo(bb.y), bfhi(bb.y)}; }
                v[j] += g0 * ya + g1 * yb; }
            s += (v[j][0] * v[j][0] + v[j][1] * v[j][1]) + (v[j][2] * v[j][2] + v[j][3] * v[j][3]); }
        const float rstd = 1.0f / sqrtf(wave_sum(s) * (1.0f / D) + RMS_EPS);
#pragma unroll
        for (int j = 0; j < 8; ++j) { const int c0 = 4 * (lane + 64 * j); const f32x4 ww = *(const f32x4*)(w + c0);
            *(f32x4*)(F.outp() + (size_t)r * D + c0) = (f32x4){v[j][0] * rstd * ww[0], v[j][1] * rstd * ww[1], v[j][2] * rstd * ww[2], v[j][3] * rstd * ww[3]}; }
    }
}

DI float log_sigmoid_(float x) { return fminf(x, 0.f) - log1pf(expf(-fabsf(x))); }
DI float softplus_(float x) { return fmaxf(x, 0.f) + log1pf(expf(-fabsf(x))); }
DI void phase_prep(const Frame& F, int l) {
    const int gw = F.bid * 8 + F.wave, NGW = F.G * 8, lane = F.lane;
    const bf16_t* U = F.wp<bf16_t>(O_U); const float* SM = F.wp<float>(O_SM); const float* rope = F.wp<float>(O_ROPE);
    const float* qnorm = F.inp(13) + l * 512; const float* kvnorm = F.inp(15) + l * 256;
    const float* convw = F.inp(7) + (size_t)l * 4 * 1536; const float* convb = F.inp(8) + l * 1536;
    for (int r = gw; r < NTOK; r += NGW) {
        const int t = r % SEQ; const bf16_t* urow = U + (size_t)r * UWP; const float* smrow = SM + (size_t)r * 256;
        const int ckc = 8 * (lane & 31);
        const u32x4 wq = *(const u32x4*)(urow + UC_CQ + 8 * lane), wkv = *(const u32x4*)(urow + UC_CKV + ckc);
        const float sm_x1 = smrow[lane & 31], sm_x2 = smrow[32 + (lane & 31)], sm_gi = smrow[64 + (lane & 3)], sm_gf = smrow[68 + (lane & 3)], sm_dt = smrow[72 + (lane & 15)];
        const float rp_c = rope[2 * (t * 32 + (lane & 31))], rp_s = rope[2 * (t * 32 + (lane & 31)) + 1];
        u32x4 xw[3][4];
#pragma unroll
        for (int j = 0; j < 3; ++j)
#pragma unroll
            for (int tap = 0; tap < 4; ++tap) { const bool ok = (t - 3 + tap) >= 0;
                const u32x4 w = *(const u32x4*)(urow + (ok ? (long)(tap - 3) * UWP : 0l) + UC_XBC + 8 * lane + 512 * j);
                xw[j][tap].x = ok ? w.x : 0u; xw[j][tap].y = ok ? w.y : 0u; xw[j][tap].z = ok ? w.z : 0u; xw[j][tap].w = ok ? w.w : 0u; }
        {
            const u32x4 w = wq;
            float x[8] = {bflo(w.x), bfhi(w.x), bflo(w.y), bfhi(w.y), bflo(w.z), bfhi(w.z), bflo(w.w), bfhi(w.w)}; float s = 0.f;
#pragma unroll
            for (int i = 0; i < 8; ++i) s += x[i] * x[i];
            const float rstd = 1.0f / sqrtf(wave_sum(s) * (1.0f / 512) + RMS_EPS);
            const f32x4 n0 = *(const f32x4*)(qnorm + 8 * lane), n1 = *(const f32x4*)(qnorm + 8 * lane + 4);
            u32x4 o; o.x = cvt_pk_bf16(x[0] * rstd * n0[0], x[1] * rstd * n0[1]); o.y = cvt_pk_bf16(x[2] * rstd * n0[2], x[3] * rstd * n0[3]);
            o.z = cvt_pk_bf16(x[4] * rstd * n1[0], x[5] * rstd * n1[1]); o.w = cvt_pk_bf16(x[6] * rstd * n1[2], x[7] * rstd * n1[3]);
            *(u32x4*)(F.wp<bf16_t>(O_CQN) + (size_t)r * 512 + 8 * lane) = o;
        }
        {
            const int c = ckc;
            const u32x4 w = wkv;
            float x[8] = {bflo(w.x), bfhi(w.x), bflo(w.y), bfhi(w.y), bflo(w.z), bfhi(w.z), bflo(w.w), bfhi(w.w)}; float s = 0.f;
#pragma unroll
            for (int i = 0; i < 8; ++i) s += x[i] * x[i];
            if (lane >= 32) s = 0.f;
            const float rstd = 1.0f / sqrtf(wave_sum(s) * (1.0f / 256) + RMS_EPS);
            const f32x4 n0 = *(const f32x4*)(kvnorm + c), n1 = *(const f32x4*)(kvnorm + c + 4);
            u32x4 o; o.x = cvt_pk_bf16(x[0] * rstd * n0[0], x[1] * rstd * n0[1]); o.y = cvt_pk_bf16(x[2] * rstd * n0[2], x[3] * rstd * n0[3]);
            o.z = cvt_pk_bf16(x[4] * rstd * n1[0], x[5] * rstd * n1[1]); o.w = cvt_pk_bf16(x[6] * rstd * n1[2], x[7] * rstd * n1[3]);
            if (lane < 32) *(u32x4*)(F.wp<bf16_t>(O_CKVN) + (size_t)r * 256 + c) = o;
        }
        if (lane < 32) {
            const float x1 = sm_x1, x2 = sm_x2, cs = rp_c, sn = rp_s;
            bf16_t* kr = F.wp<bf16_t>(O_KR) + (size_t)r * 64;
            kr[lane] = f2bf(x1 * cs - x2 * sn); kr[32 + lane] = f2bf(x2 * cs + x1 * sn);
        }
        if (lane < 4) {
            F.wp<float>(O_GI)[(size_t)r * 4 + lane] = sm_gi + F.inp(4)[l * 4 + lane];
            F.wp<float>(O_LF)[(size_t)r * 4 + lane] = log_sigmoid_(sm_gf + F.inp(5)[l * 4 + lane]);
        }
        if (lane < 16) {
            const float dtv = softplus_(sm_dt + F.inp(9)[l * 16 + lane]);
            F.wp<float>(O_DT)[(size_t)r * 16 + lane] = dtv;
            F.wp<float>(O_DA)[(size_t)r * 16 + lane] = -dtv * expf(F.inp(10)[l * 16 + lane]);
        }
#pragma unroll
        for (int j = 0; j < 3; ++j) { const int c0 = 8 * lane + 512 * j;
            float y[8];
            { const f32x4 b0 = *(const f32x4*)(convb + c0), b1 = *(const f32x4*)(convb + c0 + 4); y[0] = b0[0]; y[1] = b0[1]; y[2] = b0[2]; y[3] = b0[3]; y[4] = b1[0]; y[5] = b1[1]; y[6] = b1[2]; y[7] = b1[3]; }
#pragma unroll
            for (int tap = 0; tap < 4; ++tap) { const u32x4 w = xw[j][tap];
                const f32x4 w0 = *(const f32x4*)(convw + tap * 1536 + c0), w1 = *(const f32x4*)(convw + tap * 1536 + c0 + 4);
                y[0] += bflo(w.x) * w0[0]; y[1] += bfhi(w.x) * w0[1]; y[2] += bflo(w.y) * w0[2]; y[3] += bfhi(w.y) * w0[3];
                y[4] += bflo(w.z) * w1[0]; y[5] += bfhi(w.z) * w1[1]; y[6] += bflo(w.w) * w1[2]; y[7] += bfhi(w.w) * w1[3]; }
            u32x4 o; o.x = cvt_pk_bf16(siluf_(y[0]), siluf_(y[1])); o.y = cvt_pk_bf16(siluf_(y[2]), siluf_(y[3])); o.z = cvt_pk_bf16(siluf_(y[4]), siluf_(y[5])); o.w = cvt_pk_bf16(siluf_(y[6]), siluf_(y[7]));
            *(u32x4*)(F.wp<bf16_t>(O_XBC) + (size_t)r * 1536 + c0) = o; }
    }
}

constexpr int ML_NC = SEQ / 64;
DI void mlstm_item(const Frame& F, int item) {
    const int vs = item & 7, hh = (item >> 3) & 3, b = item >> 5;
    int tid_ = F.tid; LAUNDER_V(tid_);
    const int tid = tid_, lane = tid & 63, w = F.wave, g = lane >> 4, lc = lane & 15;
    float* s_bb = (float*)F.lds; float* s_dd = s_bb + SEQ; float* s_cm = s_dd + SEQ; float* s_ch = s_cm + SEQ;
    bf16_t* sQ = (bf16_t*)(s_ch + 4 * ML_NC);
    bf16_t* sK = sQ + 64 * 136;
    bf16_t* sV = sK + 64 * 136;
    bf16_t* sVw = sV + 64 * 56;
    bf16_t* sCb = sVw + 64 * 56;
    const bf16_t* U = F.wp<bf16_t>(O_U); const float* GI = F.wp<float>(O_GI); const float* LF = F.wp<float>(O_LF);
    bf16_t* Ya = F.wp<bf16_t>(O_Y);
    const float scale = 0.08838834764831845f;
    const unsigned z0 = vzero();
    for (int i = tid; i < SEQ; i += NTHREADS) { const size_t row = (size_t)b * SEQ + i; s_dd[i] = GI[row * 4 + hh]; s_bb[i] = LF[row * 4 + hh]; }
    for (int i = tid; i < 48 * 136 / 2; i += NTHREADS) ((unsigned*)sCb)[i] = z0;
    __syncthreads();
    if (tid < ML_NC) { float acc = 0.f, cm = -3.0e38f;
        for (int t = 0; t < 64; ++t) { const int i = tid * 64 + t; acc += s_bb[i]; s_bb[i] = acc; const float d = s_dd[i] - acc; s_dd[i] = d; cm = fmaxf(cm, d); s_cm[i] = cm; } }
    __syncthreads();
    if (tid == 0) { float m = 0.f;
        for (int c = 0; c < ML_NC; ++c) { const float btot = s_bb[c * 64 + 63], cmL = s_cm[c * 64 + 63], mloc = btot + cmL, mnew = fmaxf(btot + m, mloc);
            s_ch[c] = m; s_ch[ML_NC + c] = fexp(btot + m - mnew); s_ch[2 * ML_NC + c] = fexp(mloc - mnew); s_ch[3 * ML_NC + c] = cmL; m = mnew; } }
    __syncthreads();
    f32x4 Cst[3][2];
#pragma unroll
    for (int a = 0; a < 3; ++a)
#pragma unroll
        for (int c = 0; c < 2; ++c) Cst[a][c] = (f32x4){0.f, 0.f, 0.f, 0.f};
    const bf16_t* Ub = U + (size_t)b * SEQ * UWP;
    u32x4 qr[2], kr[2], vr = {z0, z0, z0, z0};
#define ML_FETCH(c_) do { const bf16_t* ub_ = Ub + (size_t)(c_) * 64 * UWP; \
        _Pragma("unroll") for (int i_ = 0; i_ < 2; ++i_) { const unsigned ch_ = tid + i_ * NTHREADS, r_ = ch_ >> 4, cc_ = (ch_ & 15) * 8; \
            qr[i_] = *(const u32x4*)(ub_ + (r_ * (unsigned)UWP + UC_MLQ + hh * 128u + cc_)); kr[i_] = *(const u32x4*)(ub_ + (r_ * (unsigned)UWP + UC_MLK + hh * 128u + cc_)); } \
        if (tid < 256) { const unsigned r_ = tid >> 2, cc_ = (tid & 3) * 8; vr = *(const u32x4*)(ub_ + (r_ * (unsigned)UWP + UC_MLV + hh * 256u + vs * 32u + cc_)); } } while (0)
    ML_FETCH(0);
    for (int c = 0; c < ML_NC; ++c) {
        const float m_prev = s_ch[c], da = s_ch[ML_NC + c], db = s_ch[2 * ML_NC + c], cmL = s_ch[3 * ML_NC + c];
        const size_t row0 = (size_t)b * SEQ + c * 64;
#pragma unroll
        for (int i = 0; i < 2; ++i) { const int ch = tid + i * NTHREADS, r = ch >> 4, cc = (ch & 15) * 8;
            *(u32x4*)(sQ + r * 136 + cc) = qr[i]; *(u32x4*)(sK + r * 136 + cc) = kr[i]; }
        if (tid < 256) { const int r = tid >> 2, cc = (tid & 3) * 8;
            const u32x4 v = vr;
            *(u32x4*)(sV + r * 56 + cc) = v;
            const float wt = db * fexp(s_dd[c * 64 + r] - cmL) * scale;
            u32x4 o; o.x = cvt_pk_bf16(bflo(v.x) * wt, bfhi(v.x) * wt); o.y = cvt_pk_bf16(bflo(v.y) * wt, bfhi(v.y) * wt); o.z = cvt_pk_bf16(bflo(v.z) * wt, bfhi(v.z) * wt); o.w = cvt_pk_bf16(bflo(v.w) * wt, bfhi(v.w) * wt);
            *(u32x4*)(sVw + r * 56 + cc) = o;
        } else if (tid < 320) { const int r = tid - 256;
            const float wt = db * fexp(s_dd[c * 64 + r] - cmL) * scale;
            *(u32x4*)(sV + r * 56 + 32) = (u32x4){0x3F80u | z0, z0, z0, z0}; *(u32x4*)(sV + r * 56 + 40) = (u32x4){z0, z0, z0, z0};
            *(u32x4*)(sVw + r * 56 + 32) = (u32x4){(unsigned)f2bf(wt), z0, z0, z0}; *(u32x4*)(sVw + r * 56 + 40) = (u32x4){z0, z0, z0, z0};
        }
        __syncthreads();
        if (c + 1 < ML_NC) ML_FETCH(c + 1);
        if (w < 4) {
            const int sl = 16 * w + lc; const float mx = fmaxf(m_prev, s_cm[c * 64 + sl]), inter = fexp(m_prev - mx);
            bf16x8 bq[4];
#pragma unroll
            for (int kt = 0; kt < 4; ++kt) bq[kt] = frag_r(sQ, 136, 16 * w, 32 * kt, lane);
            f32x4 st[4];
#pragma unroll
            for (int j = 0; j < 4; ++j) st[j] = (f32x4){0.f, 0.f, 0.f, 0.f};
#pragma unroll
            for (int j = 0; j < 4; ++j) if (j <= w) {
#pragma unroll
                for (int kt = 0; kt < 4; ++kt) st[j] = mfma16(frag_r(sK, 136, 16 * j, 32 * kt, lane), bq[kt], st[j]);
                const f32x4 d4 = *(const f32x4*)(s_dd + c * 64 + 16 * j + 4 * g);
#pragma unroll
                for (int i = 0; i < 4; ++i) { const int t = 16 * j + 4 * g + i; st[j][i] = (t <= sl) ? fexp(d4[i] - mx) * st[j][i] * scale : 0.f; } }
            f32x4 n1[3], n2[3];
#pragma unroll
            for (int vt = 0; vt < 3; ++vt) { n1[vt] = (f32x4){0.f, 0.f, 0.f, 0.f}; n2[vt] = (f32x4){0.f, 0.f, 0.f, 0.f}; }
            const bf16_t* vb = sV + (4 * g + ((lane & 15) >> 2)) * 56 + 4 * (lane & 3);
#pragma unroll
            for (int ks = 0; ks < 2; ++ks) if (2 * ks <= w) {
                u32x4 pw; pw.x = cvt_pk_bf16(st[2 * ks][0], st[2 * ks][1]); pw.y = cvt_pk_bf16(st[2 * ks][2], st[2 * ks][3]); pw.z = cvt_pk_bf16(st[2 * ks + 1][0], st[2 * ks + 1][1]); pw.w = cvt_pk_bf16(st[2 * ks + 1][2], st[2 * ks + 1][3]);
                const bf16x8 pb = __builtin_bit_cast(bf16x8, pw);
#pragma unroll
                for (int vt = 0; vt < 3; ++vt) { const s16x4 lo = lds_tr4(vb + (32 * ks) * 56 + 16 * vt), hi = lds_tr4(vb + (32 * ks + 16) * 56 + 16 * vt);
                    n1[vt] = mfma16(__builtin_shufflevector(lo, hi, 0, 1, 2, 3, 4, 5, 6, 7), pb, n1[vt]); } }
#pragma unroll
            for (int kt = 0; kt < 4; ++kt)
#pragma unroll
                for (int vt = 0; vt < 3; ++vt) n2[vt] = mfma16(frag_r(sCb, 136, 16 * vt, 32 * kt, lane), bq[kt], n2[vt]);
            const float den = shfl_f(n1[2][0] + inter * n2[2][0], lc);
            const float inv = frcp(fmaxf(fabsf(den), fexp(-(s_bb[c * 64 + sl] + mx))));
#pragma unroll
            for (int vt = 0; vt < 2; ++vt) { u32x2 ov; ov.x = cvt_pk_bf16((n1[vt][0] + inter * n2[vt][0]) * inv, (n1[vt][1] + inter * n2[vt][1]) * inv);
                ov.y = cvt_pk_bf16((n1[vt][2] + inter * n2[vt][2]) * inv, (n1[vt][3] + inter * n2[vt][3]) * inv);
                *(u32x2*)(Ya + ((row0 + sl) * 1024 + hh * 256 + vs * 32 + 16 * vt + 4 * g)) = ov; }
        } else {
            const int j = w - 4;
#pragma unroll
            for (int mt = 0; mt < 3; ++mt)
#pragma unroll
                for (int nl = 0; nl < 2; ++nl) Cst[mt][nl] *= da;
#pragma unroll
            for (int kt = 0; kt < 2; ++kt) {
                bf16x8 bk[2];
#pragma unroll
                for (int nl = 0; nl < 2; ++nl) bk[nl] = frag_k(sK, 136, 32 * kt, 16 * (2 * j + nl), lane);
#pragma unroll
                for (int mt = 0; mt < 3; ++mt) { const bf16x8 a = frag_k(sVw, 56, 32 * kt, 16 * mt, lane);
#pragma unroll
                    for (int nl = 0; nl < 2; ++nl) Cst[mt][nl] = mfma16(a, bk[nl], Cst[mt][nl]); } }
        }
        __syncthreads();
        if (w >= 4) { const int j = w - 4;
#pragma unroll
            for (int mt = 0; mt < 3; ++mt)
#pragma unroll
                for (int nl = 0; nl < 2; ++nl)
#pragma unroll
                    for (int i = 0; i < 4; ++i) sCb[(16 * mt + 4 * g + i) * 136 + 16 * (2 * j + nl) + lc] = f2bf(Cst[mt][nl][i]); }
    }
#undef ML_FETCH
    __syncthreads();
}

constexpr int SS_NC = SEQ / 128;
DI void ssd_item(const Frame& F, int item, int l) {
    const int ps = item & 1, hd = (item >> 1) & 15, b = item >> 5, grp = hd >> 3;
    int tid_ = F.tid; LAUNDER_V(tid_);
    const int tid = tid_, lane = tid & 63, w = F.wave, g = lane >> 4, lc = lane & 15;
    float* s_acs = (float*)F.lds; float* s_dt = s_acs + 256;
    bf16_t* sC = (bf16_t*)(s_dt + 256);
    bf16_t* sB = sC + 128 * 136;
    bf16_t* sX = sB + 128 * 136;
    bf16_t* sXw = sX + 128 * 40;
    bf16_t* sHb = sXw + 128 * 40;
    const bf16_t* XBC = F.wp<bf16_t>(O_XBC) + (size_t)b * SEQ * 1536; const bf16_t* Uz = F.wp<bf16_t>(O_U) + (size_t)b * SEQ * UWP + UC_SSZ + hd * 64 + ps * 32;
    const float* DT = F.wp<float>(O_DT) + (size_t)b * SEQ * 16 + hd; const float* DA = F.wp<float>(O_DA) + (size_t)b * SEQ * 16 + hd;
    bf16_t* Yb = F.wp<bf16_t>(O_Y) + (size_t)NTOK * 1024 + (size_t)b * SEQ * 1024 + hd * 64 + ps * 32;
    const float Dh = F.inp(11)[l * 16 + hd];
    const unsigned z0 = vzero();
    for (int i = tid; i < 32 * 136 / 2; i += NTHREADS) ((unsigned*)sHb)[i] = z0;
    f32x4 Hst[2];
    Hst[0] = (f32x4){0.f, 0.f, 0.f, 0.f}; Hst[1] = (f32x4){0.f, 0.f, 0.f, 0.f};
    u32x4 cr[4], br[4], xr; float da0 = 0.f, da1 = 0.f, dtv = 0.f;
#define SSD_FETCH(c_) do { const bf16_t* xb_ = XBC + (size_t)(c_) * 128 * 1536; \
        _Pragma("unroll") for (int i_ = 0; i_ < 4; ++i_) { const unsigned ch_ = tid + i_ * NTHREADS, r_ = ch_ >> 4, cc_ = (ch_ & 15) * 8; \
            cr[i_] = *(const u32x4*)(xb_ + (r_ * 1536u + 1280u + grp * 128u + cc_)); br[i_] = *(const u32x4*)(xb_ + (r_ * 1536u + 1024u + grp * 128u + cc_)); } \
        { const unsigned r_ = tid >> 2, cc_ = (tid & 3) * 8; xr = *(const u32x4*)(xb_ + (r_ * 1536u + hd * 64u + ps * 32u + cc_)); } \
        if (w == 0) { da0 = DA[((c_) * 128 + 2 * lane) * 16]; da1 = DA[((c_) * 128 + 2 * lane + 1) * 16]; } else if (w < 3) dtv = DT[((c_) * 128 + tid - 64) * 16]; } while (0)
#define SSD_SCAN(nb_) do { if (w == 0) { float p_ = da0 + da1; \
            _Pragma("unroll") for (int off_ = 1; off_ < 64; off_ <<= 1) { const float t_ = shfl_f(p_, (lane - off_) & 63); if (lane >= off_) p_ += t_; } \
            s_acs[(nb_) * 128 + 2 * lane + 1] = p_; s_acs[(nb_) * 128 + 2 * lane] = p_ - da1; } \
        else if (w < 3) s_dt[(nb_) * 128 + tid - 64] = dtv; } while (0)
    SSD_FETCH(0);
    SSD_SCAN(0);
    __syncthreads();
    for (int c = 0; c < SS_NC; ++c) {
        const int row0 = c * 128; const float* acs = s_acs + (c & 1) * 128; const float* dtc = s_dt + (c & 1) * 128;
        const float acsL = acs[127];
#pragma unroll
        for (int i = 0; i < 4; ++i) { const int ch = tid + i * NTHREADS, r = ch >> 4, cc = (ch & 15) * 8; *(u32x4*)(sC + r * 136 + cc) = cr[i]; *(u32x4*)(sB + r * 136 + cc) = br[i]; }
        { const int r = tid >> 2, cc = (tid & 3) * 8; const u32x4 v = xr;
            *(u32x4*)(sX + r * 40 + cc) = v;
            const float wt = dtc[r] * fexp(acsL - acs[r]);
            u32x4 o; o.x = cvt_pk_bf16(bflo(v.x) * wt, bfhi(v.x) * wt); o.y = cvt_pk_bf16(bflo(v.y) * wt, bfhi(v.y) * wt); o.z = cvt_pk_bf16(bflo(v.z) * wt, bfhi(v.z) * wt); o.w = cvt_pk_bf16(bflo(v.w) * wt, bfhi(v.w) * wt);
            *(u32x4*)(sXw + r * 40 + cc) = o; }
        __syncthreads();
        u32x2 zr[2];
#pragma unroll
        for (int pt = 0; pt < 2; ++pt) zr[pt] = *(const u32x2*)(Uz + ((unsigned)(row0 + 16 * w + lc) * (unsigned)UWP + 16u * pt + 4u * g));
        if (c + 1 < SS_NC) SSD_FETCH(c + 1);
        {
            const int sl = 16 * w + lc; const float as = acs[sl];
            bf16x8 bq[4];
#pragma unroll
            for (int kt = 0; kt < 4; ++kt) bq[kt] = frag_r(sC, 136, 16 * w, 32 * kt, lane);
            f32x4 ct[8];
#pragma unroll
            for (int j = 0; j < 8; ++j) ct[j] = (f32x4){0.f, 0.f, 0.f, 0.f};
#pragma unroll
            for (int j = 0; j < 8; ++j) if (j <= w) {
#pragma unroll
                for (int kt = 0; kt < 4; ++kt) ct[j] = mfma16(frag_r(sB, 136, 16 * j, 32 * kt, lane), bq[kt], ct[j]);
                const f32x4 a4 = *(const f32x4*)(acs + 16 * j + 4 * g), d4 = *(const f32x4*)(dtc + 16 * j + 4 * g);
#pragma unroll
                for (int i = 0; i < 4; ++i) { const int t = 16 * j + 4 * g + i; ct[j][i] = (t <= sl) ? ct[j][i] * fexp(as - a4[i]) * d4[i] : 0.f; } }
            f32x4 y1[2], y2[2];
#pragma unroll
            for (int pt = 0; pt < 2; ++pt) { y1[pt] = (f32x4){0.f, 0.f, 0.f, 0.f}; y2[pt] = (f32x4){0.f, 0.f, 0.f, 0.f}; }
            const bf16_t* xb = sX + (4 * g + ((lane & 15) >> 2)) * 40 + 4 * (lane & 3);
#pragma unroll
            for (int ks = 0; ks < 4; ++ks) if (2 * ks <= w) {
                u32x4 pw; pw.x = cvt_pk_bf16(ct[2 * ks][0], ct[2 * ks][1]); pw.y = cvt_pk_bf16(ct[2 * ks][2], ct[2 * ks][3]); pw.z = cvt_pk_bf16(ct[2 * ks + 1][0], ct[2 * ks + 1][1]); pw.w = cvt_pk_bf16(ct[2 * ks + 1][2], ct[2 * ks + 1][3]);
                const bf16x8 pb = __builtin_bit_cast(bf16x8, pw);
#pragma unroll
                for (int pt = 0; pt < 2; ++pt) { const s16x4 lo = lds_tr4(xb + (32 * ks) * 40 + 16 * pt), hi = lds_tr4(xb + (32 * ks + 16) * 40 + 16 * pt);
                    y1[pt] = mfma16(__builtin_shufflevector(lo, hi, 0, 1, 2, 3, 4, 5, 6, 7), pb, y1[pt]); } }
#pragma unroll
            for (int kt = 0; kt < 4; ++kt)
#pragma unroll
                for (int pt = 0; pt < 2; ++pt) y2[pt] = mfma16(frag_r(sHb, 136, 16 * pt, 32 * kt, lane), bq[kt], y2[pt]);
            const float ea = fexp(as);
#pragma unroll
            for (int pt = 0; pt < 2; ++pt) { const u32x2 xw = *(const u32x2*)(sX + sl * 40 + 16 * pt + 4 * g);
                const float x0 = bflo(xw.x), x1 = bfhi(xw.x), x2 = bflo(xw.y), x3 = bfhi(xw.y), z0f = bflo(zr[pt].x), z1f = bfhi(zr[pt].x), z2f = bflo(zr[pt].y), z3f = bfhi(zr[pt].y);
                u32x2 ov; ov.x = cvt_pk_bf16((y1[pt][0] + ea * y2[pt][0] + x0 * Dh) * siluf_(z0f), (y1[pt][1] + ea * y2[pt][1] + x1 * Dh) * siluf_(z1f));
                ov.y = cvt_pk_bf16((y1[pt][2] + ea * y2[pt][2] + x2 * Dh) * siluf_(z2f), (y1[pt][3] + ea * y2[pt][3] + x3 * Dh) * siluf_(z3f));
                *(u32x2*)(Yb + ((unsigned)(row0 + sl) * 1024u + 16u * pt + 4u * g)) = ov; }
            const float cd = fexp(acsL);
            Hst[0] *= cd; Hst[1] *= cd;
#pragma unroll
            for (int kt = 0; kt < 4; ++kt) { const bf16x8 bb = frag_k(sB, 136, 32 * kt, 16 * w, lane);
#pragma unroll
                for (int mt2 = 0; mt2 < 2; ++mt2) Hst[mt2] = mfma16(frag_k(sXw, 40, 32 * kt, 16 * mt2, lane), bb, Hst[mt2]); }
        }
        if (c + 1 < SS_NC) SSD_SCAN((c + 1) & 1);
        __syncthreads();
#pragma unroll
        for (int mt2 = 0; mt2 < 2; ++mt2)
#pragma unroll
            for (int i = 0; i < 4; ++i) sHb[(16 * mt2 + 4 * g + i) * 136 + 16 * w + lc] = f2bf(Hst[mt2][i]);
    }
#undef SSD_FETCH
#undef SSD_SCAN
    __syncthreads();
}

constexpr int SW_NB = SEQ / 128;
DI void swa_item(const Frame& F, int item, int l) {
    const int nb = item % SW_NB, kvh = (item / SW_NB) & 3, b = item / (SW_NB * 4);
    int tid_ = F.tid; LAUNDER_V(tid_);
    const int tid = tid_, lane = tid & 63, w = F.wave, g = lane >> 4, lc = lane & 15;
    bf16_t* sK = (bf16_t*)F.lds;
    bf16_t* sV = sK + 256 * 72;
    const long rowb = (long)b * SEQ + (long)nb * 128 - 128;
    const bf16_t* Ub = F.wp<bf16_t>(O_U) + rowb * UWP; bf16_t* Yd = F.wp<bf16_t>(O_Y) + (size_t)3 * NTOK * 1024 + (rowb + 128) * 1024;
    const unsigned z0 = vzero();
#pragma unroll
    for (int i = 0; i < 4; ++i) { const unsigned ch = tid + i * NTHREADS, r = ch >> 3, cc = (ch & 7) * 8;
        u32x4 kv = {z0, z0, z0, z0}, vv = {z0, z0, z0, z0};
        if (nb > 0 || r >= 128) { kv = *(const u32x4*)(Ub + (r * (unsigned)UWP + UC_SWK + kvh * 64u + cc)); vv = *(const u32x4*)(Ub + (r * (unsigned)UWP + UC_SWV + kvh * 64u + cc)); }
        *(u32x4*)(sK + r * 72 + cc) = kv; *(u32x4*)(sV + r * 72 + cc) = vv; }
    if (tid < 128) { const int r = 256 + (tid >> 3), cc = (tid & 7) * 8; *(u32x4*)(sV + r * 72 + cc) = (u32x4){z0, z0, z0, z0}; }
    __syncthreads();
    const int hq = kvh * 4 + (w >> 1);
    const float sink2 = F.inp(17)[l * 16 + hq] * 1.4426950408889634f;
    for (int gi = 0; gi < 4; ++gi) {
        const int r0 = 64 * (w & 1) + 16 * gi;
        const unsigned qoff = (unsigned)(128 + r0 + lc) * (unsigned)UWP + UC_SWQ + hq * 64u + 8u * g;
        const bf16x8 bq0 = *(const bf16x8*)(Ub + qoff), bq1 = *(const bf16x8*)(Ub + (qoff + 32u));
        f32x4 st[10];
#pragma unroll
        for (int j = 0; j < 10; ++j) st[j] = (f32x4){0.f, 0.f, 0.f, 0.f};
#pragma unroll
        for (int j = 0; j < 9; ++j) { st[j] = mfma16(frag_r(sK, 72, r0 + 16 * j, 0, lane), bq0, st[j]); st[j] = mfma16(frag_r(sK, 72, r0 + 16 * j, 32, lane), bq1, st[j]); }
        const int qpos = 128 + r0 + lc;
        float mx = -3.0e38f;
#pragma unroll
        for (int j = 0; j < 9; ++j)
#pragma unroll
            for (int i = 0; i < 4; ++i) { const int tp = r0 + 16 * j + 4 * g + i; const bool ok = (tp <= qpos) && (qpos - tp < 128) && (nb > 0 || tp >= 128);
                const float v = ok ? st[j][i] * (0.125f * 1.4426950408889634f) : -3.0e38f; st[j][i] = v; mx = fmaxf(mx, v); }
        mx = fmaxf(mx, shfl_xor_f(mx, 16)); mx = fmaxf(mx, shfl_xor_f(mx, 32));
        mx = fmaxf(mx, sink2);
        float sum = 0.f;
#pragma unroll
        for (int j = 0; j < 9; ++j)
#pragma unroll
            for (int i = 0; i < 4; ++i) { const float e = fexp2(st[j][i] - mx); st[j][i] = e; sum += e; }
        sum += shfl_xor_f(sum, 16); sum += shfl_xor_f(sum, 32);
        sum += fexp2(sink2 - mx);
        const float inv = frcp(sum);
        f32x4 o[4];
#pragma unroll
        for (int nt = 0; nt < 4; ++nt) o[nt] = (f32x4){0.f, 0.f, 0.f, 0.f};
        const bf16_t* vb = sV + (r0 + 4 * g + ((lane & 15) >> 2)) * 72 + 4 * (lane & 3);
#pragma unroll
        for (int ks = 0; ks < 5; ++ks) {
            u32x4 pw; pw.x = cvt_pk_bf16(st[2 * ks][0], st[2 * ks][1]); pw.y = cvt_pk_bf16(st[2 * ks][2], st[2 * ks][3]); pw.z = cvt_pk_bf16(st[2 * ks + 1][0], st[2 * ks + 1][1]); pw.w = cvt_pk_bf16(st[2 * ks + 1][2], st[2 * ks + 1][3]);
            const bf16x8 pb = __builtin_bit_cast(bf16x8, pw);
#pragma unroll
            for (int nt = 0; nt < 4; ++nt) { const s16x4 lo = lds_tr4(vb + (32 * ks) * 72 + 16 * nt), hi = lds_tr4(vb + (32 * ks + 16) * 72 + 16 * nt);
                o[nt] = mfma16(__builtin_shufflevector(lo, hi, 0, 1, 2, 3, 4, 5, 6, 7), pb, o[nt]); } }
        const unsigned ooff = (unsigned)(r0 + lc) * 1024u + hq * 64u + 4u * g;
#pragma unroll
        for (int nt = 0; nt < 4; ++nt) { u32x2 ov; ov.x = cvt_pk_bf16(o[nt][0] * inv, o[nt][1] * inv); ov.y = cvt_pk_bf16(o[nt][2] * inv, o[nt][3] * inv); *(u32x2*)(Yd + (ooff + 16u * nt)) = ov; }
    }
    __syncthreads();
}

template <int DQK, bool MLA>
DI void attn_block(const Frame& F, const bf16_t* Qp, int ldq, const bf16_t* Kp, int ldk, const bf16_t* K2p  , const bf16_t* Vp, int ldv, bf16_t* Op, int ldo,
                   int nkt  , int qpos0  , float scale_log2e) {
    constexpr int PQ = DQK + 8, NKR = MLA ? 1 : 0, NKT = DQK / 32;
    int tid_ = F.tid; LAUNDER_V(tid_);
    const int tid = tid_, lane = tid & 63, w = F.wave, g = lane >> 4, lc = lane & 15;
    bf16_t* sK = (bf16_t*)F.lds;
    bf16_t* sV = sK + 2 * 64 * PQ;
    u32x4 kreg[2], rreg[1], vreg[2];
    unsigned koffb[2], voffb[2];
#pragma unroll
    for (int i_ = 0; i_ < 2; ++i_) { const unsigned c_ = tid + i_ * NTHREADS, r_ = c_ >> 4, ch_ = c_ & 15; koffb[i_] = (r_ * (unsigned)ldk + ch_ * 8u) * 2u; voffb[i_] = (r_ * (unsigned)ldv + ch_ * 8u) * 2u; }
    const unsigned roffb = ((tid >> 3) * 64u + (tid & 7) * 8u) * 2u;
#define ATTN_FETCH(t) do { int t_ = (t); LAUNDER_S(t_);     \
        const char* kb_ = (const char*)(Kp + (size_t)t_ * 64 * ldk); const char* vb_ = (const char*)(Vp + (size_t)t_ * 64 * ldv); const char* rb_ = (const char*)(K2p + (size_t)t_ * 64 * 64); \
        _Pragma("unroll") for (int i_ = 0; i_ < 2; ++i_) { kreg[i_] = *(const u32x4*)(kb_ + koffb[i_]); vreg[i_] = *(const u32x4*)(vb_ + voffb[i_]); } \
        _Pragma("unroll") for (int i_ = 0; i_ < NKR; ++i_) { rreg[i_] = *(const u32x4*)(rb_ + roffb); } } while (0)
#define ATTN_STORE(bf) do { bf16_t* k_ = sK + (bf) * 64 * PQ; bf16_t* v_ = sV + (bf) * 64 * 136; \
        _Pragma("unroll") for (int i_ = 0; i_ < 2; ++i_) { const int c_ = tid + i_ * NTHREADS, r_ = c_ >> 4, ch_ = c_ & 15; *(u32x4*)(k_ + r_ * PQ + ch_ * 8) = kreg[i_]; *(u32x4*)(v_ + r_ * 136 + ch_ * 8) = vreg[i_]; } \
        _Pragma("unroll") for (int i_ = 0; i_ < NKR; ++i_) { const int r_ = tid >> 3, ch_ = tid & 7; *(u32x4*)(k_ + r_ * PQ + 128 + ch_ * 8) = rreg[i_]; } } while (0)
    ATTN_FETCH(0);
    bf16x8 bq[2][NKT];
#pragma unroll
    for (int qg = 0; qg < 2; ++qg) { const unsigned qoff = (unsigned)(32 * w + 16 * qg + lc) * (unsigned)ldq + 8u * g;
#pragma unroll
        for (int kt = 0; kt < NKT; ++kt) bq[qg][kt] = *(const bf16x8*)(Qp + (qoff + 32u * kt));
        if constexpr (MLA) {
            const char* rpb = (const char*)F.wp<float>(O_ROPE); const unsigned rpo = 8u * ((unsigned)(qpos0 + 32 * w + 16 * qg + lc) * 32u + 8u * g);
            bf16x8 x1 = bq[qg][4], x2 = bq[qg][5];
#pragma unroll
            for (int j = 0; j < 4; ++j) { const f32x4 cs4 = *(const f32x4*)(rpb + (rpo + 16u * j));
#pragma unroll
              for (int h = 0; h < 2; ++h) { const int jj = 2 * j + h; const float a = bf2f((bf16_t)x1[jj]), c2 = bf2f((bf16_t)x2[jj]), cs = cs4[2 * h], sn = cs4[2 * h + 1];
                x1[jj] = (short)f2bf(a * cs - c2 * sn); x2[jj] = (short)f2bf(c2 * cs + a * sn); } }
#if 0
            for (int j = 0; j < 8; ++j) { const float a = 0, c2 = 0, cs = 0, sn = 0;
                x1[j] = (short)f2bf(a * cs - c2 * sn); x2[j] = (short)f2bf(c2 * cs + a * sn); }
#endif
            bq[qg][4] = x1; bq[qg][5] = x2; }
#pragma unroll
        for (int kt = 0; kt < NKT; ++kt) { bf16x8 x = bq[qg][kt];
#pragma unroll
            for (int j = 0; j < 8; ++j) x[j] = (short)f2bf(bf2f((bf16_t)x[j]) * scale_log2e);
            bq[qg][kt] = x; } }
    __syncthreads();
    ATTN_STORE(0);
    __syncthreads();
    f32x4 o[2][8]; float mrow[2] = {-3.0e38f, -3.0e38f}, lrow[2] = {0.f, 0.f};
#pragma unroll
    for (int qg = 0; qg < 2; ++qg)
#pragma unroll
        for (int nt = 0; nt < 8; ++nt) o[qg][nt] = (f32x4){0.f, 0.f, 0.f, 0.f};
    if (nkt > 1) ATTN_FETCH(1);
    for (int kt0 = 0; kt0 < nkt; ++kt0) {
        const bf16_t* cK = sK + (kt0 & 1) * 64 * PQ; const bf16_t* cV = sV + (kt0 & 1) * 64 * 136;
        if (kt0 + 1 < nkt) ATTN_STORE((kt0 + 1) & 1);
        if (kt0 + 2 < nkt) ATTN_FETCH(kt0 + 2);
        f32x4 st[2][4];
#pragma unroll
        for (int qg = 0; qg < 2; ++qg)
#pragma unroll
            for (int j = 0; j < 4; ++j) st[qg][j] = (f32x4){0.f, 0.f, 0.f, 0.f};
        {
            bf16x8 ak[2][4];
#pragma unroll
            for (int j = 0; j < 4; ++j) ak[0][j] = frag_r(cK, PQ, 16 * j, 0, lane);
#pragma unroll
            for (int kt = 0; kt < NKT; ++kt) {
                if (kt + 1 < NKT) {
#pragma unroll
                    for (int j = 0; j < 4; ++j) ak[(kt + 1) & 1][j] = frag_r(cK, PQ, 16 * j, 32 * (kt + 1), lane); }
#pragma unroll
                for (int j = 0; j < 4; ++j) { st[0][j] = mfma16(ak[kt & 1][j], bq[0][kt], st[0][j]); st[1][j] = mfma16(ak[kt & 1][j], bq[1][kt], st[1][j]); }
                SCHED_BAR(); } }
        const bool need_mask = MLA && (kt0 * 64 + 63 > qpos0 + 32 * w);
        bf16x8 pb[2][2];
        float mxq[2];
#pragma unroll
        for (int qg = 0; qg < 2; ++qg) {
            const int qp = qpos0 + 32 * w + 16 * qg + lc;
            float mx = -3.0e38f;
#pragma unroll
            for (int j = 0; j < 4; ++j)
#pragma unroll
                for (int i = 0; i < 4; ++i) { float v = st[qg][j][i];
                    if (need_mask) { const int kp = kt0 * 64 + 16 * j + 4 * g + i; v = (kp <= qp) ? v : -3.0e38f; }
                    st[qg][j][i] = v; mx = fmaxf(mx, v); }
            mx = fmaxf(mx, shfl_xor_f(mx, 16)); mx = fmaxf(mx, shfl_xor_f(mx, 32));
            mxq[qg] = mx; }
        if (wave_any((mxq[0] - mrow[0] > 8.0f) || (mxq[1] - mrow[1] > 8.0f))) {
#pragma unroll
            for (int qg = 0; qg < 2; ++qg) { const float mnew = fmaxf(mrow[qg], mxq[qg]), alpha = fexp2(mrow[qg] - mnew);
                lrow[qg] *= alpha; mrow[qg] = mnew;
#pragma unroll
                for (int nt = 0; nt < 8; ++nt) o[qg][nt] *= alpha; } }
#pragma unroll
        for (int qg = 0; qg < 2; ++qg) {
            const float mcur = mrow[qg];
            float sum = 0.f;
#pragma unroll
            for (int j = 0; j < 4; ++j)
#pragma unroll
                for (int i = 0; i < 4; ++i) { const float e = fexp2(st[qg][j][i] - mcur); st[qg][j][i] = e; sum += e; }
            sum += shfl_xor_f(sum, 16); sum += shfl_xor_f(sum, 32);
            lrow[qg] += sum;
#pragma unroll
            for (int ks = 0; ks < 2; ++ks) { u32x4 pw; pw.x = cvt_pk_bf16(st[qg][2 * ks][0], st[qg][2 * ks][1]); pw.y = cvt_pk_bf16(st[qg][2 * ks][2], st[qg][2 * ks][3]);
                pw.z = cvt_pk_bf16(st[qg][2 * ks + 1][0], st[qg][2 * ks + 1][1]); pw.w = cvt_pk_bf16(st[qg][2 * ks + 1][2], st[qg][2 * ks + 1][3]); pb[qg][ks] = __builtin_bit_cast(bf16x8, pw); }
        }
        {
            const bf16_t* vb = cV + (4 * g + ((lane & 15) >> 2)) * 136 + 4 * (lane & 3);
            bf16x8 av[2][4];
#define ATTN_LDV(dst, ks_, h_) do { _Pragma("unroll") for (int n_ = 0; n_ < 4; ++n_) { const s16x4 lo_ = lds_tr4(vb + (32 * (ks_)) * 136 + 16 * (4 * (h_) + n_)), hi_ = lds_tr4(vb + (32 * (ks_) + 16) * 136 + 16 * (4 * (h_) + n_)); \
                dst[n_] = __builtin_shufflevector(lo_, hi_, 0, 1, 2, 3, 4, 5, 6, 7); } } while (0)
            ATTN_LDV(av[0], 0, 0);
#pragma unroll
            for (int hs = 0; hs < 4; ++hs) { const int ks = hs >> 1, h = hs & 1;
                if (hs + 1 < 4) ATTN_LDV(av[(hs + 1) & 1], (hs + 1) >> 1, (hs + 1) & 1);
#pragma unroll
                for (int n = 0; n < 4; ++n) { o[0][4 * h + n] = mfma16(av[hs & 1][n], pb[0][ks], o[0][4 * h + n]); o[1][4 * h + n] = mfma16(av[hs & 1][n], pb[1][ks], o[1][4 * h + n]); }
                SCHED_BAR(); }
#undef ATTN_LDV
            PIN_ACC8(o[0]); PIN_ACC8(o[1]);
        }
        __syncthreads();
    }
#undef ATTN_FETCH
#undef ATTN_STORE
#pragma unroll
    for (int qg = 0; qg < 2; ++qg) { const float inv = frcp(lrow[qg]); int lid = lane; LAUNDER_V(lid);
        const unsigned ooff = (unsigned)(32 * w + 16 * qg + (lid & 15)) * (unsigned)ldo + 4u * (lid >> 4);
#pragma unroll
        for (int nt = 0; nt < 8; ++nt) { u32x2 ov; ov.x = cvt_pk_bf16(o[qg][nt][0] * inv, o[qg][nt][1] * inv); ov.y = cvt_pk_bf16(o[qg][nt][2] * inv, o[qg][nt][3] * inv); *(u32x2*)(Op + (ooff + 16u * nt)) = ov; } }
}
constexpr int NQB = SEQ / 256, NQP = (NQB + 1) / 2;
DI void mla_attn_item(const Frame& F, int item) {
    const int pj = item % NQP, hh = (item / NQP) & 7, b = item / (NQP * 8);
    const bf16_t* QF = F.wp<bf16_t>(O_QF); const bf16_t* KVF = F.wp<bf16_t>(O_KVF); const bf16_t* KR = F.wp<bf16_t>(O_KR); bf16_t* Yc = F.wp<bf16_t>(O_Y) + (size_t)2 * NTOK * 1024;
    const size_t rb = (size_t)b * SEQ;
    for (int k = 0; k < 2; ++k) { const int qb = k ? (NQB - 1 - pj) : pj;
        if (k == 1 && qb == pj) break;
        attn_block<192, true>(F, QF + (rb + qb * 256) * 1536 + hh * 192, 1536, KVF + rb * 2048 + hh * 256, 2048, KR + rb * 64, KVF + rb * 2048 + hh * 256 + 128, 2048,
                              Yc + (rb + qb * 256) * 1024 + hh * 128, 1024, (qb + 1) * 4, qb * 256, 0.07216878364870322f * 1.4426950408889634f); }
}
DI void xattn_item(const Frame& F, int item) {
    const int qb = item % NQB, hh = (item / NQB) & 3, b = item / (NQB * 4);
    const bf16_t* XQ = F.wp<bf16_t>(O_XQ); const bf16_t* XKV = F.wp<bf16_t>(O_XKV); bf16_t* XO = F.wp<bf16_t>(O_XO);
    attn_block<128, false>(F, XQ + ((size_t)b * SEQ + qb * 256) * 512 + hh * 128, 512, XKV + (size_t)b * MEMLEN * 1024 + hh * 128, 1024, nullptr,
                           XKV + (size_t)b * MEMLEN * 1024 + 512 + hh * 128, 1024, XO + ((size_t)b * SEQ + qb * 256) * 512 + hh * 128, 512, MEMLEN / 64, 0, 0.08838834764831845f * 1.4426950408889634f);
}

DI void phase_fixup(const Frame& F, int l) {
    const int gw = F.bid * 8 + F.wave, NGW = F.G * 8, lane = F.lane;
    bf16_t* Ya = F.wp<bf16_t>(O_Y); bf16_t* Yb = Ya + (size_t)NTOK * 1024; const bf16_t* U = F.wp<bf16_t>(O_U);
    const float* mlnorm = F.inp(6) + l * 1024; const float* ssnorm = F.inp(12) + l * 1024;
    for (int r = gw; r < NTOK; r += NGW) {
        u32x4 hva[2], hvb[2], ovp[2];
        hva[0] = *(const u32x4*)(Ya + (size_t)r * 1024 + 16 * lane); hva[1] = *(const u32x4*)(Ya + (size_t)r * 1024 + 16 * lane + 8);
        hvb[0] = *(const u32x4*)(Yb + (size_t)r * 1024 + 16 * lane); hvb[1] = *(const u32x4*)(Yb + (size_t)r * 1024 + 16 * lane + 8);
        ovp[0] = *(const u32x4*)(U + (size_t)r * UWP + UC_MLO + 16 * lane); ovp[1] = *(const u32x4*)(U + (size_t)r * UWP + UC_MLO + 16 * lane + 8);
        {   u32x4 hv[2]; float x[16]; float s = 0.f;
            hv[0] = hva[0]; hv[1] = hva[1];
#pragma unroll
            for (int k = 0; k < 2; ++k) { x[8 * k + 0] = bflo(hv[k].x); x[8 * k + 1] = bfhi(hv[k].x); x[8 * k + 2] = bflo(hv[k].y); x[8 * k + 3] = bfhi(hv[k].y); x[8 * k + 4] = bflo(hv[k].z); x[8 * k + 5] = bfhi(hv[k].z); x[8 * k + 6] = bflo(hv[k].w); x[8 * k + 7] = bfhi(hv[k].w); }
#pragma unroll
            for (int i = 0; i < 16; ++i) s += x[i] * x[i];
            s = grp16_sum(s);
            const float rstd = 1.0f / sqrtf(s * (1.0f / 256) + RMS_EPS);
            u32x4 ov[2]; ov[0] = ovp[0]; ov[1] = ovp[1];
            float og[16];
#pragma unroll
            for (int k = 0; k < 2; ++k) { og[8 * k + 0] = bflo(ov[k].x); og[8 * k + 1] = bfhi(ov[k].x); og[8 * k + 2] = bflo(ov[k].y); og[8 * k + 3] = bfhi(ov[k].y); og[8 * k + 4] = bflo(ov[k].z); og[8 * k + 5] = bfhi(ov[k].z); og[8 * k + 6] = bflo(ov[k].w); og[8 * k + 7] = bfhi(ov[k].w); }
            float y[16];
#pragma unroll
            for (int i = 0; i < 16; ++i) y[i] = sigmoidf_(og[i]) * x[i] * rstd * mlnorm[16 * lane + i];
            u32x4 o0, o1; o0.x = cvt_pk_bf16(y[0], y[1]); o0.y = cvt_pk_bf16(y[2], y[3]); o0.z = cvt_pk_bf16(y[4], y[5]); o0.w = cvt_pk_bf16(y[6], y[7]);
            o1.x = cvt_pk_bf16(y[8], y[9]); o1.y = cvt_pk_bf16(y[10], y[11]); o1.z = cvt_pk_bf16(y[12], y[13]); o1.w = cvt_pk_bf16(y[14], y[15]);
            *(u32x4*)(Ya + (size_t)r * 1024 + 16 * lane) = o0; *(u32x4*)(Ya + (size_t)r * 1024 + 16 * lane + 8) = o1; }
        {   u32x4 hv[2]; float x[16]; float s = 0.f;
            hv[0] = hvb[0]; hv[1] = hvb[1];
#pragma unroll
            for (int k = 0; k < 2; ++k) { x[8 * k + 0] = bflo(hv[k].x); x[8 * k + 1] = bfhi(hv[k].x); x[8 * k + 2] = bflo(hv[k].y); x[8 * k + 3] = bfhi(hv[k].y); x[8 * k + 4] = bflo(hv[k].z); x[8 * k + 5] = bfhi(hv[k].z); x[8 * k + 6] = bflo(hv[k].w); x[8 * k + 7] = bfhi(hv[k].w); }
#pragma unroll
            for (int i = 0; i < 16; ++i) s += x[i] * x[i];
            s = grp16_sum(s); s += shfl_xor_f(s, 16);
            const float rstd = 1.0f / sqrtf(s * (1.0f / 512) + RMS_EPS);
            float y[16];
#pragma unroll
            for (int i = 0; i < 16; ++i) y[i] = x[i] * rstd * ssnorm[16 * lane + i];
            u32x4 o0, o1; o0.x = cvt_pk_bf16(y[0], y[1]); o0.y = cvt_pk_bf16(y[2], y[3]); o0.z = cvt_pk_bf16(y[4], y[5]); o0.w = cvt_pk_bf16(y[6], y[7]);
            o1.x = cvt_pk_bf16(y[8], y[9]); o1.y = cvt_pk_bf16(y[10], y[11]); o1.z = cvt_pk_bf16(y[12], y[13]); o1.w = cvt_pk_bf16(y[14], y[15]);
            *(u32x4*)(Yb + (size_t)r * 1024 + 16 * lane) = o0; *(u32x4*)(Yb + (size_t)r * 1024 + 16 * lane + 8) = o1; }
    }
}

#ifndef PHMASK
#define PHMASK 0xFFFFFFFFu
#endif
#define EN(b) (((PHMASK) >> (b)) & 1u)
#ifndef REPMASK
#define REPMASK 0u
#endif
#define RP(b) (((REPMASK) >> (b)) & 1u)
constexpr int PH_PER_LAYER = 16, PH_FINAL = 1 + DEPTH * PH_PER_LAYER, PH_COUNT = PH_FINAL + 1;
#ifndef HOST_EMU
#define GEMM_LDS ((LAS unsigned char*)lds)
__global__ void __launch_bounds__(NTHREADS, 2) mk_fwd(Params P) {
    extern __shared__ __attribute__((aligned(16))) unsigned char lds[];
#else
#define GEMM_LDS (lds)
static void mk_fwd(Params P) {
    unsigned char* lds = emu::B->lds;
#endif
    const int wave0 = rfl((int)threadIdx.x >> 6);
    Frame F; make_frame(F, P, lds, wave0);
    int* misc = (int*)(lds + LDS_MISC);
    if (F.tid < 256) misc[F.tid] = 0;
    __syncthreads();
#ifndef HOST_EMU
    XcdBarrier bar; bar.bar = (unsigned*)(P.ws + O_CTL) + 4096; bar.x = 0; bar.st = nullptr; bar.wave = wave0;
    if (MK_N_LAUNCHES == 1) bar = xcd_barrier_post((unsigned*)(P.ws + O_CTL) + 4096, (volatile LAS unsigned*)(lds + LDS_MISC), wave0);
#define GRID_BAR() xcd_barrier(bar)
#else
#define GRID_BAR() emu::grid_sync()
#endif
    int* tile_e = misc + 16; int* pstart = misc + 16 + 160; int* ntiles = misc + 16 + 160 + 8; int* myoff = misc + 16 + 160 + 16;
    const int lo = P.ph_lo, hi = P.ph_hi;
#define IN(k) (lo <= (k) && (k) < hi)
#define SEAM(k) do { if (IN(k) && IN((k) + 1)) GRID_BAR(); } while (0)
    const int c = F.bid, cr = F.G - 1 - F.bid;

    if (EN(0) && IN(0)) for (int rep_ = 0; rep_ <= (int)RP(0); ++rep_) { REFRAME(); phase_prologue(F); REFRAME(); phase_rmsnorm_x(F, F.inp(0), F.inp(2)); }
    SEAM(0);
    for (int l = 0; l < DEPTH; ++l) {
        const int pb = 1 + l * PH_PER_LAYER;
        const bool moe = (l & 1) != 0;
#define HIN() (F.wp<bf16_t>(O_H))
#define HBUF() (F.wp<bf16_t>(O_H))
        if (l > 0) { if (EN(1) && IN(pb + 0)) for (int rep_ = 0; rep_ <= (int)RP(1); ++rep_) { REFRAME(); phase_rmsnorm(F, HBUF(), F.inp(2) + l * D); }
        SEAM(pb + 0); }
        if (EN(2) && IN(pb + 1)) for (int rep_ = 0; rep_ <= (int)RP(2); ++rep_) { REFRAME();
            pg8::Gemm g{HBUF(), D, F.wp<bf16_t>(O_WIN) + (size_t)l * UW * D, D, D}; pg8::OrdStatic S{NTOK / 256, UC_GATE / 256, F.G, c};
            pg8::EpiU E{F.wp<bf16_t>(O_U), F.wp<float>(O_SM), F.wp<float>(O_RSTD), (LAS float*)(GEMM_LDS + pg8::RS_TAB)};
            pg8::gemm_phase(GEMM_LDS, g, S, E, F.wave);
            {
                REFRAME();
                pg8::Gemm g8{(const bf16_t*)F.wp<unsigned char>(O_XN8), D / 2, (const bf16_t*)(F.wp<unsigned char>(O_WG8) + (size_t)l * 8192 * D), D / 2, D / 2};
                pg8::OrdStatic S8{NTOK / 256, 8192 / (128 * F8_NBJ), F.G, c};
                pg8::EpiGate8 E8{F.wp<unsigned char>(O_G8), 1.0f / (F8_ASCALE * F8_WSCALE)};
                pg8::gemm_phase_f8<pg8::EpiGate8, pg8::OrdStatic, true>(GEMM_LDS, g8, S8, E8, F.wave); }
#ifdef PROBE_NULL_WIN
            { pg8::EpiNull E0{F.wp<float>(O_CTL) + 1024}; pg8::gemm_phase(GEMM_LDS, g, S, E0, F.wave); }
#endif
#ifdef PROBE_L2_WIN
            { pg8::EpiUL2 E0{F.wp<bf16_t>(O_MACC) + (size_t)F.bid * 256 * 256}; pg8::gemm_phase(GEMM_LDS, g, S, E0, F.wave); }
#endif
        }
        SEAM(pb + 1);
        if (EN(3) && IN(pb + 2)) for (int rep_ = 0; rep_ <= (int)RP(3); ++rep_) { REFRAME(); phase_prep(F, l); }
        SEAM(pb + 2);
        if (IN(pb + 3)) {
            if (EN(4)) for (int rep_ = 0; rep_ <= (int)RP(4); ++rep_) { REFRAME(); pg8::Gemm g{F.wp<bf16_t>(O_CQN), 512, F.wp<bf16_t>(O_WUQ) + (size_t)l * 1536 * 512, 512, 512}; pg8::OrdStatic S{NTOK / 256, 1536 / 256, F.G, c};
              pg8::EpiBf16 E{F.wp<bf16_t>(O_QF), 1536}; pg8::gemm_phase(GEMM_LDS, g, S, E, F.wave); }
            if (EN(4)) for (int rep_ = 0; rep_ <= (int)RP(4); ++rep_) { REFRAME(); pg8::Gemm g{F.wp<bf16_t>(O_CKVN), 256, F.wp<bf16_t>(O_WUKV) + (size_t)l * 2048 * 256, 256, 256}; pg8::OrdStatic S{NTOK / 256, 2048 / 256, F.G, cr};
              pg8::EpiBf16 E{F.wp<bf16_t>(O_KVF), 2048}; pg8::gemm_phase(GEMM_LDS, g, S, E, F.wave); }
            __syncthreads();
            REFRAME(); if (EN(5)) for (int rep_ = 0; rep_ <= (int)RP(5); ++rep_) for (int it = c; it < BATCH * 4 * 8; it += F.G) mlstm_item(F, it);
            REFRAME(); if (EN(6)) for (int rep_ = 0; rep_ <= (int)RP(6); ++rep_) for (int it = cr; it < BATCH * 16 * 2; it += F.G) ssd_item(F, it, l);
            REFRAME(); if (EN(7)) for (int rep_ = 0; rep_ <= (int)RP(7); ++rep_) for (int it = c; it < BATCH * 4 * SW_NB; it += F.G) swa_item(F, it, l);
        }
        SEAM(pb + 3);
        if (IN(pb + 4)) {
            if (EN(8)) for (int rep_ = 0; rep_ <= (int)RP(8); ++rep_) for (int it = c; it < BATCH * 8 * NQP; it += F.G) mla_attn_item(F, it);
            REFRAME(); if (EN(9)) phase_fixup(F, l);
        }
        SEAM(pb + 4);
        if (EN(10) && IN(pb + 5)) for (int rep_ = 0; rep_ <= (int)RP(10); ++rep_) { REFRAME();
            pg8::Gemm g{F.wp<bf16_t>(O_Y), 1024, F.wp<bf16_t>(O_WBR) + (size_t)l * 4 * 2048 * 1024, 1024, 1024}; pg8::OrdMerge S{NTOK / 256, D / 256, F.G, c};
            pg8::EpiMerge E{F.wp<unsigned char>(O_G8), F.wp<bf16_t>(O_MERGED)};
            pg8::gemm_phase(GEMM_LDS, g, S, E, F.wave);
        }
        SEAM(pb + 5);
        if (EN(11) && IN(pb + 6)) for (int rep_ = 0; rep_ <= (int)RP(11); ++rep_) { REFRAME();
            pg8::Gemm g{F.wp<bf16_t>(O_MERGED), D, F.wp<bf16_t>(O_WOUT) + (size_t)l * D * D, D, D}; pg8::OrdStatic S{NTOK / 256, D / 256, F.G, c};
            pg8::EpiResidT<true> E{HIN(), HBUF(), F.wp<float>(O_SSQ)};
            pg8::gemm_phase(GEMM_LDS, g, S, E, F.wave);
        }
        SEAM(pb + 6);
        if (EN(12) && IN(pb + 8)) for (int rep_ = 0; rep_ <= (int)RP(12); ++rep_) { REFRAME();
            { pg8::Gemm g{HBUF(), D, F.wp<bf16_t>(O_WXQ) + (size_t)l * 512 * D, D, D}; pg8::OrdStatic S{NTOK / 256, 512 / 256, F.G, c};
              pg8::EpiBf16R E{F.wp<bf16_t>(O_XQ), 512, F.wp<float>(O_SSQ), (LAS float*)(GEMM_LDS + pg8::RS_TAB)}; pg8::gemm_phase(GEMM_LDS, g, S, E, F.wave); }
            { REFRAME(); pg8::Gemm g{F.wp<bf16_t>(O_MEMN) + (size_t)l * NMEM * D, D, F.wp<bf16_t>(O_WXKV) + (size_t)l * 1024 * D, D, D}; pg8::OrdStatic S{NMEM / 256, 1024 / 256, F.G, cr};
              pg8::EpiBf16 E{F.wp<bf16_t>(O_XKV), 1024}; pg8::gemm_phase(GEMM_LDS, g, S, E, F.wave); }
        }
        SEAM(pb + 8);
        if (EN(13) && IN(pb + 9)) for (int rep_ = 0; rep_ <= (int)RP(13); ++rep_) { REFRAME(); for (int it = c; it < BATCH * 4 * NQB; it += F.G) xattn_item(F, it); }
        SEAM(pb + 9);
        if (EN(14) && IN(pb + 10)) for (int rep_ = 0; rep_ <= (int)RP(14); ++rep_) { REFRAME();
            pg8::Gemm g{F.wp<bf16_t>(O_XO), 512, F.wp<bf16_t>(O_WXO) + (size_t)l * D * 512, 512, 512}; pg8::OrdStatic S{NTOK / 256, D / 256, F.G, c};
            if (!moe) { pg8::EpiResidT<true> E{HBUF(), HBUF(), F.wp<float>(O_SSQ)}; pg8::gemm_phase(GEMM_LDS, g, S, E, F.wave); }
            else { pg8::EpiResid E{HBUF(), HBUF(), nullptr}; pg8::gemm_phase(GEMM_LDS, g, S, E, F.wave); }
        }
        SEAM(pb + 10);
        if (!moe) {
            if (EN(15) && IN(pb + 12)) for (int rep_ = 0; rep_ <= (int)RP(15); ++rep_) { REFRAME();
                pg8::Gemm g{HBUF(), D, F.wp<bf16_t>(O_W13), D, D}; pg8::OrdStatic S{NTOK / 256, 2 * FFN / 256, F.G, c};
                pg8::EpiSwiGLUR E{F.wp<bf16_t>(O_ACT), F.wp<float>(O_SSQ), (LAS float*)(GEMM_LDS + pg8::RS_TAB)};
                pg8::gemm_phase(GEMM_LDS, g, S, E, F.wave);
            }
            SEAM(pb + 12);
            if (EN(16) && IN(pb + 13)) for (int rep_ = 0; rep_ <= (int)RP(16); ++rep_) { REFRAME();
                pg8::Gemm g{F.wp<bf16_t>(O_ACT), FFN, F.wp<bf16_t>(O_W2), FFN, FFN}; pg8::OrdStatic S{NTOK / 256, D / 256, F.G, c};
                pg8::EpiResid E{HBUF(), HBUF(), nullptr};
                pg8::gemm_phase(GEMM_LDS, g, S, E, F.wave);
            }
            if (IN(pb + 13) && IN(pb + PH_PER_LAYER)) GRID_BAR();
        } else {
            if (EN(17) && IN(pb + 11)) for (int rep_ = 0; rep_ <= (int)RP(17); ++rep_) { REFRAME(); phase_rmsnorm_route(F, HBUF(), F.inp(25) + l * D, F.inp(28)); }
            SEAM(pb + 11);
            if (EN(18) && IN(pb + 12)) for (int rep_ = 0; rep_ <= (int)RP(18); ++rep_) { REFRAME(); phase_moe_scatter(F, tile_e, pstart, ntiles, myoff); }
            SEAM(pb + 12);
            if (EN(19) && IN(pb + 13)) for (int rep_ = 0; rep_ <= (int)RP(19); ++rep_) { REFRAME();
                if (!IN(pb + 12)) moe_tables(F, tile_e, pstart, ntiles);
                pg8::Gemm g{(const bf16_t*)F.wp<unsigned char>(O_XG), D / 2, (const bf16_t*)F.wp<unsigned char>(O_MW13), D / 2, D / 2}; pg8::OrdMoe S{*ntiles, 2 * FFN / (128 * F8_NBJ), F.G, c, tile_e, 1 << 30};
                pg8::EpiSwiGLU8<F8_NBJ> E{F.wp<unsigned char>(O_ACTM), 1.0f / (F8_ASCALE * F8_WSCALE)};
                pg8::gemm_phase_f8<pg8::EpiSwiGLU8<F8_NBJ>, pg8::OrdMoe, F8_FULL != 0>(GEMM_LDS, g, S, E, F.wave);
            }
            SEAM(pb + 13);
            if (EN(20) && IN(pb + 14)) for (int rep_ = 0; rep_ <= (int)RP(20); ++rep_) { REFRAME();
                if (!IN(pb + 13)) moe_tables(F, tile_e, pstart, ntiles);
                int full, R, sp; pg8::moe_tail_split(*ntiles, F.G, full, R, sp);
                { pg8::Gemm g{(const bf16_t*)F.wp<unsigned char>(O_ACTM), FFN / 2, (const bf16_t*)F.wp<unsigned char>(O_MW2), FFN / 2, FFN / 2}; pg8::OrdMoe S{*ntiles, D / 256, F.G, c, tile_e, full};
                  pg8::EpiBf16S<2> E{F.wp<bf16_t>(O_YG), D, 1.0f / (F8_ASCALE * F8_WSCALE)};
                  pg8::gemm_phase_f8<pg8::EpiBf16S<2>, pg8::OrdMoe, true>(GEMM_LDS, g, S, E, F.wave); }
                if (R > 0) {
                    REFRAME();
                    const int uix = c / sp, kp = c - uix * sp, Kp = FFN / sp;
                    pg8::OrdOne S1; S1.valid = (uix < R); S1.u.pm = 0; S1.u.pn = 0; S1.u.pa = 0; S1.u.pb = 0; S1.u.aux = 0; S1.u.ui = 0;
                    if (S1.valid) { pg8::static_map((long)full * F.G + uix, *ntiles, D / 256, S1.u.pm, S1.u.pn); S1.u.aux = tile_e[S1.u.pm]; S1.u.pa = S1.u.pm; S1.u.pb = S1.u.aux * (D / 256) + S1.u.pn; }
                    pg8::Gemm g1{(const bf16_t*)(F.wp<unsigned char>(O_ACTM) + (size_t)kp * Kp), FFN / 2, (const bf16_t*)(F.wp<unsigned char>(O_MW2) + (size_t)kp * Kp), FFN / 2, Kp / 2};
                    pg8::EpiPart E1{F.wp<float>(O_TAILACC) + (size_t)(S1.valid ? c : 0) * 65536, 1.0f / (F8_ASCALE * F8_WSCALE)};
                    pg8::gemm_phase_f8<pg8::EpiPart, pg8::OrdOne, true>(GEMM_LDS, g1, S1, E1, F.wave);
                }
            }
            if (IN(pb + 14) && IN(pb + PH_PER_LAYER)) GRID_BAR();
        }
    }
    if (EN(21) && IN(PH_FINAL)) for (int rep_ = 0; rep_ <= (int)RP(21); ++rep_) { REFRAME(); if (!IN(PH_FINAL - 2) && (((DEPTH - 1) & 1) != 0)) moe_tables(F, tile_e, pstart, ntiles); phase_final(F, ((DEPTH - 1) & 1) != 0, ntiles, (unsigned char*)(misc + 256)); }
#undef IN
#undef SEAM
}

#ifndef HOST_EMU
extern "C" void kernel_launch(void* const* d_in, const int* in_sizes, int n_in, void* d_out, int out_size, void* d_ws, size_t ws_size, hipStream_t stream) {
    static int grid = 0;
    if (grid == 0) {
        if (n_in != 32 || in_sizes[0] != NTOK * D || out_size != NTOK * D || ws_size < WS_END) {
            fprintf(stderr, "kernel_launch: shape/workspace mismatch: n_in %d in0 %d out %d ws %zu (need %zu)\n", n_in, n_in > 0 ? in_sizes[0] : -1, out_size, ws_size, (size_t)WS_END); grid = -1; return; }
        int dev = 0, cus = 0, per_cu = 0;
        if (hipGetDevice(&dev) != hipSuccess || hipDeviceGetAttribute(&cus, hipDeviceAttributeMultiprocessorCount, dev) != hipSuccess) { grid = -1; return; }
        if (hipFuncSetAttribute((const void*)mk_fwd, hipFuncAttributeMaxDynamicSharedMemorySize, LDS_BYTES) != hipSuccess) { fprintf(stderr, "kernel_launch: hipFuncSetAttribute failed\n"); grid = -1; return; }
        if (hipOccupancyMaxActiveBlocksPerMultiprocessor(&per_cu, (const void*)mk_fwd, NTHREADS, LDS_BYTES) != hipSuccess || per_cu < 1)
            fprintf(stderr, "kernel_launch: occupancy query reports %d workgroups per CU\n", per_cu);
        (void)hipGetLastError();
        grid = cus;
    }
    if (grid < 0) return;
    if (hipMemsetAsync((char*)d_ws + O_CTL, 0, SZ_CTL, stream) != hipSuccess) { fprintf(stderr, "kernel_launch: memset failed\n"); return; }
    Params p{};
    for (int i = 0; i < 32; ++i) p.in[i] = (const float*)d_in[i];
    p.out = (float*)d_out; p.ws = (unsigned char*)d_ws;
    if (MK_N_LAUNCHES == 1) {
        p.ph_lo = 0; p.ph_hi = PH_COUNT;
        hipLaunchKernelGGL(mk_fwd, dim3(grid), dim3(NTHREADS), LDS_BYTES, stream, p);
    } else {
        for (int ph = 0; ph < PH_COUNT; ++ph) {
            const int k = (ph - 1) % PH_PER_LAYER, l = (ph - 1) / PH_PER_LAYER;
            if (ph >= 1 && ph < PH_FINAL && (k == 15 || (k == 14 && (l & 1) == 0) || (k == 0 && l == 0))) continue;
            p.ph_lo = ph; p.ph_hi = ph + 1;
            hipLaunchKernelGGL(mk_fwd, dim3(grid), dim3(NTHREADS), LDS_BYTES, stream, p);
        }
    }
    const hipError_t le = hipPeekAtLastError();
    if (le != hipSuccess) fprintf(stderr, "kernel_launch: launch failed: %s\n", hipGetErrorName(le));
}
#endif
```

```cpp
#ifndef HOST_EMU
#include <hip/hip_runtime.h>
#endif
#include <cstdio>
#include <cstdint>
#include <cstddef>

#ifndef CFG_BATCH
#define CFG_BATCH 8
#endif
#ifndef CFG_SEQ
#define CFG_SEQ 2048
#endif
#ifndef MK_N_LAUNCHES
#define MK_N_LAUNCHES 1
#endif

typedef unsigned short bf16_t;
#ifndef HOST_EMU
#define DI __device__ __forceinline__
#define LAS __attribute__((address_space(3)))
#define GAS __attribute__((address_space(1)))
typedef short bf16x8 __attribute__((ext_vector_type(8)));
typedef short s16x4 __attribute__((ext_vector_type(4)));
typedef float f32x4 __attribute__((ext_vector_type(4)));
typedef float f32x2 __attribute__((ext_vector_type(2)));
typedef unsigned u32x4 __attribute__((ext_vector_type(4)));
typedef unsigned u32x2 __attribute__((ext_vector_type(2)));
DI f32x4 mfma16(bf16x8 a, bf16x8 b, f32x4 c) { return __builtin_amdgcn_mfma_f32_16x16x32_bf16(a, b, c, 0, 0, 0); }
DI s16x4 lds_tr4(const void* p) { return __builtin_amdgcn_ds_read_tr16_b64_v4i16((LAS s16x4*)(p)); }
DI float shfl_xor_f(float v, int m) { return __shfl_xor(v, m); }
DI float shfl_f(float v, int src) { return __shfl(v, src); }
DI int shfl_xor_i(int v, int m) { return __shfl_xor(v, m); }
DI int rfl(int v) { return __builtin_amdgcn_readfirstlane(v); }
DI int lane_id_hw() { return (int)__builtin_amdgcn_mbcnt_hi(~0u, __builtin_amdgcn_mbcnt_lo(~0u, 0u)); }
DI float fexp2(float x) { return __builtin_amdgcn_exp2f(x); }
DI float fexp(float x) { return __expf(x); }
DI float flog(float x) { return __logf(x); }
DI float frcp(float x) { return __builtin_amdgcn_rcpf(x); }
DI float frsqrt(float x) { return __builtin_amdgcn_rsqf(x); }
DI float fsin_rev(float rev) { return __builtin_amdgcn_sinf(rev); }
DI float fcos_rev(float rev) { return __builtin_amdgcn_cosf(rev); }
DI int atomic_add_i(int* p, int v) { return __hip_atomic_fetch_add(p, v, __ATOMIC_RELAXED, __HIP_MEMORY_SCOPE_AGENT); }
DI int lds_atomic_add_i(int* p, int v) { return __hip_atomic_fetch_add(p, v, __ATOMIC_RELAXED, __HIP_MEMORY_SCOPE_WORKGROUP); }
DI void atomic_add_f(float* p, float v) { (void)__hip_atomic_fetch_add(p, v, __ATOMIC_RELAXED, __HIP_MEMORY_SCOPE_AGENT); }
DI unsigned cvt_pk_bf16(float lo, float hi) { unsigned r; asm volatile("s_nop 0\n\tv_cvt_pk_bf16_f32 %0, %1, %2" : "=v"(r) : "v"(lo), "v"(hi)); return r; }
#define WAVE_FENCE() asm volatile("s_waitcnt lgkmcnt(0)" ::: "memory")
#define SCHED_BAR() __builtin_amdgcn_sched_barrier(0)
#define PIN_ACC8(a) asm volatile("" : "+v"((a)[0]), "+v"((a)[1]), "+v"((a)[2]), "+v"((a)[3]), "+v"((a)[4]), "+v"((a)[5]), "+v"((a)[6]), "+v"((a)[7]))
DI float u2f(unsigned u) { return __uint_as_float(u); }
DI unsigned f2u(float f) { return __float_as_uint(f); }
#else
#define DI inline __attribute__((always_inline))
#define WAVE_FENCE() emu::wave_sync()
#define SCHED_BAR()
#define PIN_ACC8(a)
DI float u2f(unsigned u) { float f; memcpy(&f, &u, 4); return f; }
DI unsigned f2u(float f) { unsigned u; memcpy(&u, &f, 4); return u; }
#endif

#ifndef HOST_EMU
#define LAUNDER_V(x) asm volatile("" : "+v"(x))
#define LAUNDER_S(x) asm volatile("" : "+s"(x))
#else
#define LAUNDER_V(x)
#define LAUNDER_S(x)
#endif
#ifndef HOST_EMU
typedef int i32x8 __attribute__((ext_vector_type(8)));
DI unsigned cvt_pk4_fp8(float a, float b, float c, float d) { int v = __builtin_amdgcn_cvt_pk_fp8_f32(a, b, 0, false); v = __builtin_amdgcn_cvt_pk_fp8_f32(c, d, v, true); return (unsigned)v; }
#else
DI unsigned f2fp8_host(float f) {
    unsigned s = f < 0.f ? 0x80u : 0u; float a = fabsf(f); if (!(a == a)) return s | 0x7f; if (a >= 448.f) return s | 0x7e;
    if (a < 0.0009765625f) return s;
    int e; float m = frexpf(a, &e); e -= 1; m *= 2.f;
    if (e < -6) { const float q = a * 512.f; int n = (int)lrintf(q); return s | (unsigned)n; }
    int n = (int)lrintf((m - 1.f) * 8.f); if (n == 8) { n = 0; e += 1; } if (e > 8 || (e == 8 && n > 6)) return s | 0x7e;
    return s | (unsigned)((e + 7) << 3) | (unsigned)n; }
DI unsigned cvt_pk4_fp8(float a, float b, float c, float d) { return f2fp8_host(a) | (f2fp8_host(b) << 8) | (f2fp8_host(c) << 16) | (f2fp8_host(d) << 24); }
DI float fp82f_host(unsigned v) { const unsigned s = v & 0x80u, e = (v >> 3) & 15u, m = v & 7u; float r = e == 0 ? (float)m * 0.001953125f : (1.f + (float)m * 0.125f) * exp2f((float)e - 7.f); return s ? -r : r; }
#endif
constexpr float F8_ASCALE = 16.0f, F8_WSCALE = 1024.0f;
#ifndef F8_FULL
#define F8_FULL 1
#endif
constexpr int F8_NBJ = F8_FULL ? 2 : 1;
DI float bf2f(bf16_t b) { return u2f(((unsigned)b) << 16); }
DI bf16_t f2bf(float f) { unsigned u = f2u(f); return (bf16_t)((u + 0x7fffu + ((u >> 16) & 1u)) >> 16); }
DI float bflo(unsigned w) { return u2f(w << 16); }
DI float bfhi(unsigned w) { return u2f(w & 0xffff0000u); }
DI float wave_sum(float v) {
#pragma unroll
    for (int o = 1; o < 64; o <<= 1) v += shfl_xor_f(v, o);
    return v;
}
#ifndef HOST_EMU
DI bool wave_any(bool p) { return __any(p ? 1 : 0) != 0; }
#else
DI bool wave_any(bool p) { int v = p ? 1 : 0;
    for (int o = 1; o < 64; o <<= 1) v |= shfl_xor_i(v, o);
    return v != 0; }
#endif
DI unsigned vzero() { unsigned z = 0u; LAUNDER_V(z); return z; }
DI float sigmoidf_(float x) { return frcp(1.0f + fexp(-x)); }
DI float siluf_(float x) { return x * frcp(1.0f + fexp(-x)); }

constexpr int BATCH = CFG_BATCH, SEQ = CFG_SEQ, NTOK = BATCH * SEQ, D = 2048, DEPTH = 2, MEMLEN = 256, NMEM = BATCH * MEMLEN;
constexpr int IN_TOTAL = 16216, UW = 16384, UWP = UW + 64;
constexpr float RMS_EPS = 1e-6f;
constexpr int FFN = 7168, NEXP = 8;
constexpr int UC_MLQ = 0, UC_MLK = 512, UC_MLV = 1024, UC_MLO = 2048, UC_SSZ = 3072, UC_XBC = 4096, UC_CQ = 5632, UC_CKV = 6144, UC_SM = 6400,
              UC_SWQ = 6656, UC_SWK = 7680, UC_SWV = 7936, UC_GATE = 8192;
constexpr int SM_TILE = UC_SM / 256;
constexpr int SO_MLI = 3072, SO_SSZ = 3080, SO_XBC = 4104, SO_DT = 5640, SO_CQ = 5656, SO_CKV = 6168, SO_KR = 6424, SO_SWQ = 6488, SO_SWK = 7512, SO_SWV = 7768, SO_GATE = 8024;
constexpr int SLOTS = 2 * NTOK + NEXP * 256;
constexpr int MAXTILES = SLOTS / 256;

constexpr size_t al256(size_t x) { return (x + 255) & ~(size_t)255; }
constexpr size_t O_CTL = 0, SZ_CTL = 1u << 20;
constexpr size_t O_WIN = O_CTL + SZ_CTL;
constexpr size_t O_WUQ = O_WIN + (size_t)DEPTH * UW * D * 2;
constexpr size_t O_WUKV = O_WUQ + (size_t)DEPTH * 1536 * 512 * 2;
constexpr size_t O_WBR = O_WUKV + (size_t)DEPTH * 2048 * 256 * 2;
constexpr size_t O_WOUT = O_WBR + (size_t)DEPTH * 4 * 2048 * 1024 * 2;
constexpr size_t O_WXQ = O_WOUT + (size_t)DEPTH * 2048 * 2048 * 2;
constexpr size_t O_WXKV = O_WXQ + (size_t)DEPTH * 512 * 2048 * 2;
constexpr size_t O_WXO = O_WXKV + (size_t)DEPTH * 1024 * 2048 * 2;
constexpr size_t O_W13 = O_WXO + (size_t)DEPTH * 2048 * 512 * 2;
constexpr size_t O_W2 = O_W13 + (size_t)2 * FFN * D * 2;
constexpr size_t O_MW13 = O_W2 + (size_t)D * FFN * 2;
constexpr size_t O_MW2 = O_MW13 + (size_t)NEXP * 2 * FFN * D * 2;
constexpr size_t O_ROPE = O_MW2 + (size_t)NEXP * D * FFN * 2;
constexpr size_t O_H = al256(O_ROPE + (size_t)SEQ * 64 * 4);
constexpr size_t O_G8 = O_H + (size_t)NTOK * D * 2;
constexpr size_t O_XN = O_H + (size_t)NTOK * D * 4;
constexpr size_t O_MEMN = O_XN + (size_t)NTOK * D * 2;
constexpr size_t O_U = O_MEMN + (size_t)DEPTH * NMEM * D * 2;
constexpr size_t O_SM = O_U + (size_t)NTOK * UWP * 2;
constexpr size_t O_CQN = O_SM + (size_t)NTOK * 256 * 4;
constexpr size_t O_CKVN = O_CQN + (size_t)NTOK * 512 * 2;
constexpr size_t O_KR = O_CKVN + (size_t)NTOK * 256 * 2;
constexpr size_t O_XBC = O_KR + (size_t)NTOK * 64 * 2;
constexpr size_t O_DT = O_XBC + (size_t)NTOK * 1536 * 2;
constexpr size_t O_DA = O_DT + (size_t)NTOK * 16 * 4;
constexpr size_t O_GI = O_DA + (size_t)NTOK * 16 * 4;
constexpr size_t O_LF = O_GI + (size_t)NTOK * 4 * 4;
constexpr size_t O_QF = O_LF + (size_t)NTOK * 4 * 4;
constexpr size_t O_KVF = O_QF + (size_t)NTOK * 1536 * 2;
constexpr size_t O_Y = O_KVF + (size_t)NTOK * 2048 * 2;
constexpr size_t O_MACC = O_Y + (size_t)4 * NTOK * 1024 * 2;
constexpr size_t O_SSQ = O_MACC;
constexpr size_t O_RSTD = O_SSQ + (size_t)NTOK * 32 * 4;
constexpr size_t O_MERGED = O_MACC + (size_t)NTOK * D * 4;
constexpr size_t O_XQ = O_MERGED + (size_t)NTOK * D * 2;
constexpr size_t O_XKV = O_XQ + (size_t)NTOK * 512 * 2;
constexpr size_t O_XO = O_XKV + (size_t)NMEM * 1024 * 2;
constexpr size_t O_ACT = O_XO + (size_t)NTOK * 512 * 2;
constexpr size_t O_XG = O_ACT + (size_t)NTOK * FFN * 2;
constexpr size_t O_YG = O_XG + (size_t)SLOTS * D * 2;
constexpr size_t O_ROUTE = O_YG + (size_t)SLOTS * D * 2;
constexpr size_t O_BLKCNT = O_ROUTE + (size_t)NTOK * 2 * 4 * 3;
constexpr size_t O_TAILACC = al256(O_BLKCNT + 1024 * 8 * 4);
constexpr size_t O_XN8 = al256(O_TAILACC + (size_t)256 * 65536 * 4);
constexpr size_t O_WG8 = O_XN8 + (size_t)NTOK * D;
constexpr size_t O_ACTM = al256(O_WG8 + (size_t)DEPTH * 8192 * D);
constexpr size_t WS_END = O_ACTM + (size_t)SLOTS * FFN * 2;

constexpr int LDS_BYTES = 147456;
constexpr int LDS_MISC = 143360;
constexpr int NTHREADS = 512;

struct Params { const float* in[32]; float* out; unsigned char* ws; int ph_lo, ph_hi, flags, pad; };

#ifndef HOST_EMU
#define XB_TMO      128
#define XB_XCNT(j)  (256  + 64 * (j))
#define XB_XSUB(j)  (1280 + 64 * (j))
#define XB_XGEN(j)  (2304 + 64 * (j))
#define XB_TOP      3328
#define XB_TOPGEN   3392
#define XCD_BAR_WORDS 3456
#define XB_SPIN_CAP (1u << 22)
__device__ __forceinline__ unsigned xb_ld(unsigned* p)              { return __hip_atomic_load(p, __ATOMIC_RELAXED, __HIP_MEMORY_SCOPE_AGENT); }
__device__ __forceinline__ unsigned xb_add(unsigned* p, unsigned v) { return __hip_atomic_fetch_add(p, v, __ATOMIC_RELAXED, __HIP_MEMORY_SCOPE_AGENT); }
__device__ __forceinline__ unsigned xb_xcc_id() { return (unsigned)__builtin_amdgcn_s_getreg((3 << 11) | 20) & 0xFu; }
#define XB_SPIN(cond, bar) do { unsigned _sp = 0; while (cond) { __builtin_amdgcn_s_sleep(1); \
    if ((++_sp & 255u) == 0u) { if (xb_ld(&(bar)[XB_TMO])) break; if (_sp > XB_SPIN_CAP) { atomicAdd(&(bar)[XB_TMO], 1u); break; } } } } while (0)
struct XcdBarrier { unsigned* bar; unsigned x; volatile LAS unsigned* st; int wave; };
__device__ __forceinline__ bool xb_thread0(int wave) { return wave == 0 && lane_id_hw() == 0; }
__device__ __forceinline__ XcdBarrier xcd_barrier_post(unsigned* bar, volatile LAS unsigned* st, int wave) {
    XcdBarrier b; b.bar = bar; b.x = xb_xcc_id(); b.st = st; b.wave = wave;
    if (xb_thread0(wave)) (void)xb_add(&bar[XB_XCNT(b.x)], 1u);
    return b;
}
__device__ __forceinline__ void xcd_barrier_complete(unsigned* bar, unsigned x, unsigned& nloc, unsigned& nx) {
    const unsigned G = gridDim.x * gridDim.y * gridDim.z;
    unsigned sum, cnt, mine, sp = 0u;
    for (;;) {
        sum = 0u; cnt = 0u; mine = 0u;
#pragma unroll
        for (unsigned j = 0; j < 16; ++j) { const unsigned c = xb_ld(&bar[XB_XCNT(j)]); sum += c; cnt += (c > 0u) ? 1u : 0u; mine = (j == x) ? c : mine; }
        if (sum == G) break;
        __builtin_amdgcn_s_sleep(1);
        if ((++sp & 255u) == 0u) { if (xb_ld(&bar[XB_TMO])) break; if (sp > XB_SPIN_CAP) { atomicAdd(&bar[XB_TMO], 1u); break; } }
    }
    nloc = mine > 0u ? mine : 1u; nx = cnt > 0u ? cnt : 1u;
}
__device__ __forceinline__ void xcd_barrier(const XcdBarrier& b) {
    asm volatile("s_waitcnt vmcnt(0)" ::: "memory");
    __syncthreads();
    if (xb_thread0(b.wave)) {
        unsigned* bar = b.bar;
        __builtin_amdgcn_s_waitcnt(0);
        unsigned nloc = b.st[0], nx = b.st[1];
        if (nloc == 0u) { xcd_barrier_complete(bar, b.x, nloc, nx); b.st[0] = nloc; b.st[1] = nx; }
        const unsigned old = xb_add(&bar[XB_XSUB(b.x)], 1u);
        const unsigned gen = old / nloc;
        if (old + 1u == (gen + 1u) * nloc) {
            __builtin_amdgcn_fence(__ATOMIC_RELEASE, "agent");
            asm volatile("s_waitcnt vmcnt(0)" ::: "memory");
            const unsigned og = xb_add(&bar[XB_TOP], 1u);
            const unsigned tg = og / nx;
            if (og + 1u == (tg + 1u) * nx) xb_add(&bar[XB_TOPGEN], 1u);
            else XB_SPIN(xb_ld(&bar[XB_TOPGEN]) == tg, bar);
            __builtin_amdgcn_fence(__ATOMIC_ACQUIRE, "agent");
            xb_add(&bar[XB_XGEN(b.x)], 1u);
            asm volatile("s_waitcnt vmcnt(0)" ::: "memory");
        } else {
            XB_SPIN(xb_ld(&bar[XB_XGEN(b.x)]) == gen, bar);
            __builtin_amdgcn_fence(__ATOMIC_ACQUIRE, "agent");
            asm volatile("s_waitcnt vmcnt(0)" ::: "memory");
        }
    }
    __syncthreads();
}
#endif

namespace pg8 {
constexpr int BM = 256, BK = 64, HALF = 128, HTB = HALF * BK * 2, STAGE_BYTES = 8 * HTB, NXCD = 8, WGM = 4;
DI int lds_byte(int r, int c) { const int st = (r >> 4) * 2 + (c >> 5), rr = r & 15, cc = c & 31, ob = rr * 64 + cc * 2; return st * 1024 + (ob ^ (((ob >> 9) & 1) << 5)); }
DI void stage_rc(int b, int& R, int& C) { const int st = b / 1024, sb = b % 1024, swz = sb ^ (((sb >> 9) & 1) << 5); R = (st >> 1) * 16 + swz / 64; C = (st & 1) * 32 + (swz % 64) / 2; }
DI int perm32(int rho) { const int n = rho >> 4, i = rho & 15; return 8 * (i >> 2) + 4 * n + (i & 3); }
struct Unit { int pa, pb, pm, pn, aux, ui; };
struct Gemm { const bf16_t* A; int lda; const bf16_t* Bt; int ldb; int K; };
DI bool static_map(long L, int nM, int nN, int& pm, int& pn) {
    const int nwg = nM * nN; if (L >= nwg) return false;
    int wgid = (int)L; { const int q = nwg / NXCD, r = nwg % NXCD, xcd = wgid % NXCD, off = wgid / NXCD; wgid = (xcd < r ? xcd * (q + 1) : r * (q + 1) + (xcd - r) * q) + off; }
    const int nig = WGM * nN, gid = wgid / nig, fm = gid * WGM, gsz = (nM - fm) < WGM ? (nM - fm) : WGM;
    pm = fm + ((wgid % nig) % gsz); pn = (wgid % nig) / gsz; return true;
}
struct OrdStatic { int nM, nN, G, c;
    DI bool next(int i, Unit& u) const { if (!static_map((long)i * G + c, nM, nN, u.pm, u.pn)) return false; u.pa = u.pm; u.pb = u.pn; u.aux = 0; u.ui = i; return true; } };
struct OrdMerge { int nM, nN, G, c;
    DI bool next(int i, Unit& u) const { if (!static_map((long)(i >> 2) * G + c, nM, nN, u.pm, u.pn)) return false; u.aux = i & 3; u.pa = u.aux * nM + u.pm; u.pb = u.aux * nN + u.pn; u.ui = i; return true; } };
struct OrdMoe { int nM, nN, G, c; const int* tile_e; int imax;
    DI bool next(int i, Unit& u) const { if (i >= imax || !static_map((long)i * G + c, nM, nN, u.pm, u.pn)) return false; u.aux = tile_e[u.pm]; u.pa = u.pm; u.pb = u.aux * nN + u.pn; u.ui = i; return true; } };
struct OrdOne { Unit u; bool valid;
    DI bool next(int i, Unit& o) const { if (i != 0 || !valid) return false; o = u; return true; } };
DI void moe_tail_split(int ntiles, int G, int& full, int& R, int& sp) {
    const int units = ntiles * 8; full = units / G; R = units - full * G; sp = 0;
    if (R > 0) { sp = 1; if (R * 2 <= G) sp = 2; if (R * 4 <= G) sp = 4; if (R * 7 <= G) sp = 7; }
}

#ifndef HOST_EMU
template <class Epi, class Sched>
__device__ __forceinline__ void gemm_phase(LAS unsigned char* lds, const Gemm g, const Sched& S, const Epi& E, int wave_id) {
    int lane_ = lane_id_hw(); asm volatile("" : "+v"(lane_)); int wid_ = wave_id; asm volatile("" : "+s"(wid_));
    const int tid = wid_ * 64 + lane_, wid = wid_, lane = tid & 63, wr = wid >> 2, wc = wid & 3, fr = lane & 15, fq = lane >> 4;
    const int K = g.K, nt = K / BK;
    unsigned voffA[2], voffB[2];
#pragma unroll
    for (int i = 0; i < 2; ++i) { int R, C; stage_rc(tid * 16 + i * 8192, R, C); const int Rb = Epi::PERM ? ((R & ~31) + perm32(R & 31)) : R;
        voffA[i] = (unsigned)(R * g.lda + C) * 2u; voffB[i] = (unsigned)(Rb * g.ldb + C) * 2u; }
    const size_t kstep = (size_t)(BK * 2);
    const size_t hstepA = (size_t)HALF * g.lda * 2, hstepB = (size_t)HALF * g.ldb * 2;
    const size_t tstepA = 2 * hstepA, tstepB = 2 * hstepB;
    const unsigned ldsw = (unsigned)wid * 1024u;
    const int aoff = lds_byte(wr * 64 + fr, fq * 8), boff = lds_byte(wc * 32 + fr, fq * 8);
#define PG8_SA(b, h) (((b) * 2 + (h)) * HTB)
#define PG8_SB(b, h) ((4 + (b) * 2 + (h)) * HTB)
#define PG8_STAGE(bufoff, gbase, voff) do { _Pragma("unroll") for (int _i = 0; _i < 2; ++_i) \
        __builtin_amdgcn_global_load_lds((const unsigned*)((const char*)(gbase) + (voff)[_i]), (LAS unsigned*)(lds + (bufoff) + ldsw + _i * 8192), 16, 0, 0); } while (0)
#define PG8_LDA(dst, b, h) do { _Pragma("unroll") for (int m = 0; m < 4; ++m) _Pragma("unroll") for (int k = 0; k < 2; ++k) dst[m][k] = *(const LAS bf16x8*)(lds + PG8_SA(b, h) + aoff + m * 2048 + k * 1024); } while (0)
#define PG8_LDB(dst, b, h) do { _Pragma("unroll") for (int n = 0; n < 2; ++n) _Pragma("unroll") for (int k = 0; k < 2; ++k) dst[n][k] = *(const LAS bf16x8*)(lds + PG8_SB(b, h) + boff + n * 2048 + k * 1024); } while (0)
#define PG8_MMA(ai, bj, At, Bt) do { __builtin_amdgcn_s_setprio(1); _Pragma("unroll") for (int m = 0; m < 4; ++m) _Pragma("unroll") for (int n = 0; n < 2; ++n) _Pragma("unroll") for (int k = 0; k < 2; ++k) \
        acc[ai][bj][m][n] = __builtin_amdgcn_mfma_f32_16x16x32_bf16(Bt[n][k], At[m][k], acc[ai][bj][m][n], 0, 0, 0); __builtin_amdgcn_s_setprio(0); } while (0)
#define PG8_WAIT_V(n) asm volatile("s_waitcnt vmcnt(" #n ")" ::: "memory")
#define PG8_WAIT_L(n) asm volatile("s_waitcnt lgkmcnt(" #n ")" ::: "memory")
#define PG8_BAR __builtin_amdgcn_s_barrier()
#define PG8_SCHED __builtin_amdgcn_sched_barrier(0)
    Unit cur, nxt; int ui = 0;
    if (!S.next(0, cur)) return;
    if constexpr (Epi::HAS_PREP) E.prep(cur, tid);
    f32x4 acc[2][2][4][2];
#pragma unroll
    for (int a = 0; a < 2; ++a)
#pragma unroll
        for (int b = 0; b < 2; ++b)
#pragma unroll
            for (int m = 0; m < 4; ++m)
#pragma unroll
                for (int n = 0; n < 2; ++n) acc[a][b][m][n] = (f32x4){0.f, 0.f, 0.f, 0.f};
    bf16x8 At[4][2], B0[2][2], B1[2][2];
    const char* cA = (const char*)g.A + (size_t)cur.pa * tstepA; const char* cB = (const char*)g.Bt + (size_t)cur.pb * tstepB;
    PG8_STAGE(PG8_SB(0, 0), cB, voffB); PG8_STAGE(PG8_SB(0, 1), cB + hstepB, voffB); PG8_STAGE(PG8_SA(0, 0), cA, voffA); PG8_STAGE(PG8_SA(0, 1), cA + hstepA, voffA);
    if (wr == 1) PG8_BAR;
    PG8_WAIT_V(2); PG8_BAR;
    PG8_STAGE(PG8_SB(1, 0), cB + kstep, voffB); PG8_STAGE(PG8_SA(1, 0), cA + kstep, voffA); PG8_STAGE(PG8_SB(1, 1), cB + hstepB + kstep, voffB);
    PG8_WAIT_V(6); PG8_BAR;
    for (;;) {
        const bool has_next = S.next(ui + 1, nxt);
        const char* nA = has_next ? (const char*)g.A + (size_t)nxt.pa * tstepA : cA; const char* nB = has_next ? (const char*)g.Bt + (size_t)nxt.pb * tstepB : cB;
        for (int t = 0; t < nt; t += 2) {
            const bool last = (t == nt - 2);
            const char* a1 = cA + (size_t)(t + 1) * kstep;
            const char* a2 = last ? nA : cA + (size_t)(t + 2) * kstep; const char* b2 = last ? nB : cB + (size_t)(t + 2) * kstep;
            const char* a3 = a2 + kstep; const char* b3 = b2 + kstep;
            PG8_LDB(B0, 0, 0); PG8_LDB(B1, 0, 1); PG8_SCHED; PG8_LDA(At, 0, 0); PG8_STAGE(PG8_SA(1, 1), a1 + hstepA, voffA);
            PG8_WAIT_V(8); PG8_WAIT_L(0); PG8_BAR; PG8_MMA(0, 0, At, B0); PG8_MMA(0, 1, At, B1); PG8_BAR; PG8_SCHED;
            PG8_LDA(At, 0, 1); PG8_STAGE(PG8_SB(0, 0), b2, voffB); PG8_STAGE(PG8_SB(0, 1), b2 + hstepB, voffB); PG8_STAGE(PG8_SA(0, 0), a2, voffA);
            PG8_WAIT_V(8); PG8_WAIT_L(0); PG8_BAR; PG8_MMA(1, 0, At, B0); PG8_MMA(1, 1, At, B1); PG8_BAR; PG8_SCHED;
            PG8_LDB(B0, 1, 0); PG8_LDB(B1, 1, 1); PG8_SCHED; PG8_LDA(At, 1, 0); PG8_STAGE(PG8_SA(0, 1), a2 + hstepA, voffA);
            PG8_WAIT_V(8); PG8_WAIT_L(0); PG8_BAR; PG8_MMA(0, 0, At, B0); PG8_MMA(0, 1, At, B1); PG8_BAR; PG8_SCHED;
            PG8_LDA(At, 1, 1); PG8_STAGE(PG8_SB(1, 0), b3, voffB); PG8_STAGE(PG8_SB(1, 1), b3 + hstepB, voffB); PG8_STAGE(PG8_SA(1, 0), a3, voffA);
            PG8_WAIT_V(8); PG8_WAIT_L(0); PG8_BAR; PG8_MMA(1, 0, At, B0); PG8_MMA(1, 1, At, B1); PG8_BAR; PG8_SCHED;
        }
        if (wr == 0) PG8_BAR;
        E(acc, cur, wr, wc, fr, fq);
        if (!has_next) break;
        if constexpr (Epi::HAS_PREP) E.prep(nxt, tid);
#pragma unroll
        for (int a = 0; a < 2; ++a)
#pragma unroll
            for (int b = 0; b < 2; ++b)
#pragma unroll
                for (int m = 0; m < 4; ++m)
#pragma unroll
                    for (int n = 0; n < 2; ++n) acc[a][b][m][n] = (f32x4){0.f, 0.f, 0.f, 0.f};
        cur = nxt; cA = nA; cB = nB; ++ui;
        if (wr == 1) PG8_BAR;
    }
    PG8_WAIT_V(0);
    PG8_BAR;
#undef PG8_SA
#undef PG8_SB
#undef PG8_STAGE
#undef PG8_LDA
#undef PG8_LDB
#undef PG8_MMA
#undef PG8_WAIT_V
#undef PG8_WAIT_L
#undef PG8_BAR
#undef PG8_SCHED
}
template <class Epi, class Sched, bool FULLN = false>
__device__ __forceinline__ void gemm_phase_f8(LAS unsigned char* lds, const Gemm g, const Sched& S, const Epi& E, int wave_id) {
    int lane_ = lane_id_hw(); asm volatile("" : "+v"(lane_)); int wid_ = wave_id; asm volatile("" : "+s"(wid_));
    const int tid = wid_ * 64 + lane_, wid = wid_, lane = tid & 63, wr = wid >> 2, wc = wid & 3, fr = lane & 15, fq = lane >> 4;
    const int K = g.K, nt = K / BK;
    unsigned voffA[2], voffB[2];
#pragma unroll
    for (int i = 0; i < 2; ++i) { int R, C; stage_rc(tid * 16 + i * 8192, R, C); const int Rb = Epi::PERM ? ((R & ~31) + perm32(R & 31)) : R;
        voffA[i] = (unsigned)(R * g.lda + C) * 2u; voffB[i] = (unsigned)(Rb * g.ldb + C) * 2u; }
    const size_t kstep = (size_t)(BK * 2);
    const size_t hstepA = (size_t)HALF * g.lda * 2, hstepB = (size_t)HALF * g.ldb * 2;
    const size_t tstepA = 2 * hstepA, tstepB = 2 * hstepB;
    const unsigned ldsw = (unsigned)wid * 1024u;
    const int aoff0 = lds_byte(wr * 64 + fr, ((2 * fq) & 3) * 8) + (fq >> 1) * 1024, aoff1 = lds_byte(wr * 64 + fr, ((2 * fq + 1) & 3) * 8) + (fq >> 1) * 1024;
    const int boff0 = lds_byte(wc * 32 + fr, ((2 * fq) & 3) * 8) + (fq >> 1) * 1024, boff1 = lds_byte(wc * 32 + fr, ((2 * fq + 1) & 3) * 8) + (fq >> 1) * 1024;
#define PG8_SA(b, h) (((b) * 2 + (h)) * HTB)
#define PG8_SB(b, h) ((4 + (b) * 2 + (h)) * HTB)
#define PG8_STAGE(bufoff, gbase, voff) do { _Pragma("unroll") for (int _i = 0; _i < 2; ++_i) \
        __builtin_amdgcn_global_load_lds((const unsigned*)((const char*)(gbase) + (voff)[_i]), (LAS unsigned*)(lds + (bufoff) + ldsw + _i * 8192), 16, 0, 0); } while (0)
#define PG8_LDA(dst, b, h) do { _Pragma("unroll") for (int m = 0; m < 4; ++m) { dst[m][0] = *(const LAS u32x4*)(lds + PG8_SA(b, h) + aoff0 + m * 2048); dst[m][1] = *(const LAS u32x4*)(lds + PG8_SA(b, h) + aoff1 + m * 2048); } } while (0)
#define PG8_LDB(dst, b, h) do { _Pragma("unroll") for (int n = 0; n < 2; ++n) { dst[n][0] = *(const LAS u32x4*)(lds + PG8_SB(b, h) + boff0 + n * 2048); dst[n][1] = *(const LAS u32x4*)(lds + PG8_SB(b, h) + boff1 + n * 2048); } } while (0)
#define PG8_F8OP(x) __builtin_shufflevector(__builtin_bit_cast(i32x4_, (x)[0]), __builtin_bit_cast(i32x4_, (x)[1]), 0, 1, 2, 3, 4, 5, 6, 7)
#define PG8_MMA(ai, bj, At, Bt) do { __builtin_amdgcn_s_setprio(1); _Pragma("unroll") for (int m = 0; m < 4; ++m) _Pragma("unroll") for (int n = 0; n < 2; ++n) { \
        const i32x8 a8_ = PG8_F8OP(Bt[n]), b8_ = PG8_F8OP(At[m]); \
        asm volatile("v_mfma_scale_f32_16x16x128_f8f6f4 %0, %1, %2, %0, %3, %3 op_sel_hi:[0,0,0]" : "+v"(acc[ai][bj][m][n]) : "v"(a8_), "v"(b8_), "v"(f8one)); } \
        __builtin_amdgcn_s_setprio(0); } while (0)
#define PG8_WAIT_V(n) asm volatile("s_waitcnt vmcnt(" #n ")" ::: "memory")
#define PG8_WAIT_L(n) asm volatile("s_waitcnt lgkmcnt(" #n ")" ::: "memory")
#define PG8_BAR __builtin_amdgcn_s_barrier()
#define PG8_SCHED __builtin_amdgcn_sched_barrier(0)
    Unit cur, nxt; int ui = 0;
    if (!S.next(0, cur)) return;
    f32x4 acc[2][2][4][2];
#pragma unroll
    for (int a = 0; a < 2; ++a)
#pragma unroll
        for (int b = 0; b < 2; ++b)
#pragma unroll
            for (int m = 0; m < 4; ++m)
#pragma unroll
                for (int n = 0; n < 2; ++n) acc[a][b][m][n] = (f32x4){0.f, 0.f, 0.f, 0.f};
    typedef int i32x4_ __attribute__((ext_vector_type(4)));
    int f8one = 0x7F7F7F7F; asm volatile("" : "+v"(f8one));
    u32x4 At[4][2], B0[2][2], B1[2][2];
    const char* cA = (const char*)g.A + (size_t)cur.pa * tstepA; const char* cB = (const char*)g.Bt + (size_t)cur.pb * (FULLN ? tstepB : hstepB);
    PG8_STAGE(PG8_SB(0, 0), cB, voffB); PG8_STAGE(PG8_SB(0, 1), cB + hstepB, voffB); PG8_STAGE(PG8_SA(0, 0), cA, voffA); PG8_STAGE(PG8_SA(0, 1), cA + hstepA, voffA);
    if (wr == 1) PG8_BAR;
    PG8_WAIT_V(2); PG8_BAR;
    PG8_STAGE(PG8_SB(1, 0), cB + kstep, voffB); PG8_STAGE(PG8_SA(1, 0), cA + kstep, voffA); PG8_STAGE(PG8_SB(1, 1), cB + hstepB + kstep, voffB);
    PG8_WAIT_V(6); PG8_BAR;
    for (;;) {
        const bool has_next = S.next(ui + 1, nxt);
        const char* nA = has_next ? (const char*)g.A + (size_t)nxt.pa * tstepA : cA; const char* nB = has_next ? (const char*)g.Bt + (size_t)nxt.pb * (FULLN ? tstepB : hstepB) : cB;
        for (int t = 0; t < nt; t += 2) {
            const bool last = (t == nt - 2);
            const char* a1 = cA + (size_t)(t + 1) * kstep;
            const char* a2 = last ? nA : cA + (size_t)(t + 2) * kstep; const char* b2 = last ? nB : cB + (size_t)(t + 2) * kstep;
            const char* a3 = a2 + kstep; const char* b3 = b2 + kstep;
            PG8_LDB(B0, 0, 0); if constexpr (FULLN) PG8_LDB(B1, 0, 1); PG8_SCHED; PG8_LDA(At, 0, 0); PG8_STAGE(PG8_SA(1, 1), a1 + hstepA, voffA);
            PG8_WAIT_V(8); PG8_WAIT_L(0); PG8_BAR; PG8_MMA(0, 0, At, B0); if constexpr (FULLN) PG8_MMA(0, 1, At, B1); PG8_BAR; PG8_SCHED;
            PG8_LDA(At, 0, 1); PG8_STAGE(PG8_SB(0, 0), b2, voffB); PG8_STAGE(PG8_SB(0, 1), b2 + hstepB, voffB); PG8_STAGE(PG8_SA(0, 0), a2, voffA);
            PG8_WAIT_V(8); PG8_WAIT_L(0); PG8_BAR; PG8_MMA(1, 0, At, B0); if constexpr (FULLN) PG8_MMA(1, 1, At, B1); PG8_BAR; PG8_SCHED;
            PG8_LDB(B0, 1, 0); if constexpr (FULLN) PG8_LDB(B1, 1, 1); PG8_SCHED; PG8_LDA(At, 1, 0); PG8_STAGE(PG8_SA(0, 1), a2 + hstepA, voffA);
            PG8_WAIT_V(8); PG8_WAIT_L(0); PG8_BAR; PG8_MMA(0, 0, At, B0); if constexpr (FULLN) PG8_MMA(0, 1, At, B1); PG8_BAR; PG8_SCHED;
            PG8_LDA(At, 1, 1); PG8_STAGE(PG8_SB(1, 0), b3, voffB); PG8_STAGE(PG8_SB(1, 1), b3 + hstepB, voffB); PG8_STAGE(PG8_SA(1, 0), a3, voffA);
            PG8_WAIT_V(8); PG8_WAIT_L(0); PG8_BAR; PG8_MMA(1, 0, At, B0); if constexpr (FULLN) PG8_MMA(1, 1, At, B1); PG8_BAR; PG8_SCHED;
        }
        if (wr == 0) PG8_BAR;
        asm volatile("s_nop 15\n\ts_nop 15" : "+v"(acc[0][0][0][0]), "+v"(acc[0][0][0][1]), "+v"(acc[0][0][1][0]), "+v"(acc[0][0][1][1]), "+v"(acc[0][0][2][0]), "+v"(acc[0][0][2][1]), "+v"(acc[0][0][3][0]), "+v"(acc[0][0][3][1]) :: "memory");
        PIN_ACC8(&acc[0][1][0][0]); PIN_ACC8(&acc[1][0][0][0]); PIN_ACC8(&acc[1][1][0][0]);
        E(acc, cur, wr, wc, fr, fq);
        if (!has_next) break;
#pragma unroll
        for (int a = 0; a < 2; ++a)
#pragma unroll
            for (int b = 0; b < 2; ++b)
#pragma unroll
                for (int m = 0; m < 4; ++m)
#pragma unroll
                    for (int n = 0; n < 2; ++n) acc[a][b][m][n] = (f32x4){0.f, 0.f, 0.f, 0.f};
        cur = nxt; cA = nA; cB = nB; ++ui;
        if (wr == 1) PG8_BAR;
    }
    PG8_WAIT_V(0);
    PG8_BAR;
#undef PG8_SA
#undef PG8_SB
#undef PG8_STAGE
#undef PG8_LDA
#undef PG8_LDB
#undef PG8_MMA
#undef PG8_F8OP
#undef PG8_WAIT_V
#undef PG8_WAIT_L
#undef PG8_BAR
#undef PG8_SCHED
}
#else
template <class Epi, class Sched>
static void gemm_phase(unsigned char* lds, const Gemm g, const Sched& S, const Epi& E, int wave_id) {
    const int tid = threadIdx.x, wid = tid >> 6, lane = tid & 63, wr = wid >> 2, wc = wid & 3, fr = lane & 15, fq = lane >> 4;
    static thread_local float* Cbuf = nullptr; static thread_local float* Af = nullptr; static thread_local float* Bf = nullptr;
    Unit u;
    for (int i = 0; S.next(i, u); ++i) {
        __syncthreads();
        if constexpr (Epi::HAS_PREP) E.prep(u, tid);
        if (tid == 0) {
            if (!Cbuf) { Cbuf = (float*)malloc(256 * 256 * 4); Af = (float*)malloc((size_t)256 * 8192 * 4); Bf = (float*)malloc((size_t)256 * 8192 * 4); }
            const int K = g.K;
            for (int r = 0; r < 256; ++r) for (int k = 0; k < K; ++k) { Af[(size_t)r * K + k] = bf2f(g.A[((size_t)u.pa * 256 + r) * g.lda + k]); Bf[(size_t)r * K + k] = bf2f(g.Bt[((size_t)u.pb * 256 + r) * g.ldb + k]); }
            for (int r = 0; r < 256; ++r) for (int c = 0; c < 256; ++c) { const float* a = Af + (size_t)r * K; const float* b = Bf + (size_t)c * K; float s = 0.f;
                for (int k = 0; k < K; ++k) s += a[k] * b[k]; Cbuf[r * 256 + c] = s; }
        }
        __syncthreads();
        f32x4 acc[2][2][4][2];
        for (int ai = 0; ai < 2; ++ai) for (int bj = 0; bj < 2; ++bj) for (int m = 0; m < 4; ++m) for (int n = 0; n < 2; ++n) for (int j = 0; j < 4; ++j) {
            const int r = 128 * ai + 64 * wr + 16 * m + fr;
            const int c = Epi::PERM ? (128 * bj + 32 * wc + 8 * fq + 4 * n + j) : (128 * bj + 32 * wc + 16 * n + 4 * fq + j);
            acc[ai][bj][m][n][j] = Cbuf[r * 256 + c]; }
        E(acc, u, wr, wc, fr, fq);
    }
    __syncthreads();
}
#endif

typedef const f32x4 (&AccRef)[2][2][4][2];
struct EpiBf16 {
    static constexpr bool PERM = true; static constexpr bool HAS_PREP = false;
    bf16_t* O; int ldc;
    DI void operator()(AccRef acc, const Unit& u, int wr, int wc, int fr, int fq) const {
        const int row0 = u.pm * BM + wr * 64 + fr, col0 = u.pn * BM + wc * 32 + 8 * fq;
        float one = 1.0f; LAUNDER_S(one);
#pragma unroll
        for (int ai = 0; ai < 2; ++ai)
#pragma unroll
            for (int m = 0; m < 4; ++m) { bf16_t* rowp = O + (size_t)(row0 + ai * HALF + m * 16) * ldc + col0;
#pragma unroll
                for (int bj = 0; bj < 2; ++bj) { const f32x4 v0 = acc[ai][bj][m][0] * one, v1 = acc[ai][bj][m][1] * one;
                    u32x4 w; w.x = cvt_pk_bf16(v0[0], v0[1]); w.y = cvt_pk_bf16(v0[2], v0[3]); w.z = cvt_pk_bf16(v1[0], v1[1]); w.w = cvt_pk_bf16(v1[2], v1[3]);
                    *(u32x4*)(rowp + bj * HALF) = w; } }
    }
};
template <int NBJ, bool SIGM = false> struct EpiBf16S {
    static constexpr bool PERM = true; static constexpr bool HAS_PREP = false;
    bf16_t* O; int ldc; float scale;
    DI void operator()(AccRef acc, const Unit& u, int wr, int wc, int fr, int fq) const {
        const int row0 = u.pm * BM + wr * 64 + fr, col0 = u.pn * (HALF * NBJ) + wc * 32 + 8 * fq;
#pragma unroll
        for (int ai = 0; ai < 2; ++ai)
#pragma unroll
            for (int m = 0; m < 4; ++m) { bf16_t* rowp = O + (size_t)(row0 + ai * HALF + m * 16) * ldc + col0;
#pragma unroll
                for (int bj = 0; bj < NBJ; ++bj) { f32x4 v0 = acc[ai][bj][m][0] * scale, v1 = acc[ai][bj][m][1] * scale;
                    if constexpr (SIGM) {
#pragma unroll
                        for (int q = 0; q < 4; ++q) { v0[q] = frcp(1.0f + fexp2(v0[q] * -1.4426950408889634f)); v1[q] = frcp(1.0f + fexp2(v1[q] * -1.4426950408889634f)); } }
                    u32x4 w; w.x = cvt_pk_bf16(v0[0], v0[1]); w.y = cvt_pk_bf16(v0[2], v0[3]); w.z = cvt_pk_bf16(v1[0], v1[1]); w.w = cvt_pk_bf16(v1[2], v1[3]);
                    *(u32x4*)(rowp + bj * HALF) = w; } }
    }
};
struct EpiGate8 {
    static constexpr bool PERM = true; static constexpr bool HAS_PREP = false;
    unsigned char* G; float scale;
    DI void operator()(AccRef acc, const Unit& u, int wr, int wc, int fr, int fq) const {
        const int row0 = u.pm * BM + wr * 64 + fr, col0 = u.pn * BM + wc * 32 + 8 * fq;
#pragma unroll
        for (int ai = 0; ai < 2; ++ai)
#pragma unroll
            for (int m = 0; m < 4; ++m) { unsigned char* rowp = G + (size_t)(row0 + ai * HALF + m * 16) * (4 * D) + col0;
#pragma unroll
                for (int bj = 0; bj < 2; ++bj) { const f32x4 v0 = acc[ai][bj][m][0] * scale, v1 = acc[ai][bj][m][1] * scale; unsigned b[8];
#pragma unroll
                    for (int q = 0; q < 4; ++q) { b[q] = (unsigned)(frcp(1.0f + fexp2(v0[q] * -1.4426950408889634f)) * 255.0f + 0.5f); b[4 + q] = (unsigned)(frcp(1.0f + fexp2(v1[q] * -1.4426950408889634f)) * 255.0f + 0.5f); }
                    u32x2 w; w.x = b[0] | (b[1] << 8) | (b[2] << 16) | (b[3] << 24); w.y = b[4] | (b[5] << 8) | (b[6] << 16) | (b[7] << 24);
                    *(u32x2*)(rowp + bj * HALF) = w; } }
    }
};
template <int NBJ> struct EpiSwiGLU8 {
    static constexpr bool PERM = true; static constexpr bool HAS_PREP = false;
    unsigned char* act8; float scale;
    DI void operator()(AccRef acc, const Unit& u, int wr, int wc, int fr, int fq) const {
        const int row0 = u.pm * BM + wr * 64 + fr;
#pragma unroll
        for (int ai = 0; ai < 2; ++ai)
#pragma unroll
            for (int m = 0; m < 4; ++m)
#pragma unroll
                for (int bj = 0; bj < NBJ; ++bj) { const int col0 = (u.pn * NBJ + bj) * 64 + 4 * (4 * wc + fq);
                    const f32x4 a = acc[ai][bj][m][0] * scale, b = acc[ai][bj][m][1] * scale; float o[4];
#pragma unroll
                    for (int j = 0; j < 4; ++j) o[j] = siluf_(a[j]) * b[j] * F8_ASCALE;
                    *(unsigned*)(act8 + (size_t)(row0 + ai * HALF + m * 16) * FFN + col0) = cvt_pk4_fp8(o[0], o[1], o[2], o[3]); }
    }
};
struct EpiU {
    static constexpr bool PERM = true; static constexpr bool HAS_PREP = true;
    bf16_t* U; float* SM; const float* rstd; LAS float* tab;
    DI void prep(const Unit& u, int tid) const { if (tid < 256) tab[(u.ui & 1) * 256 + tid] = rstd[u.pm * BM + tid]; }
    DI void operator()(AccRef acc, const Unit& u, int wr, int wc, int fr, int fq) const {
        const int row0 = u.pm * BM + wr * 64 + fr;
        const LAS float* tb = tab + (u.ui & 1) * 256 + wr * 64 + fr;
        if (u.pn == SM_TILE) {
#pragma unroll
            for (int ai = 0; ai < 2; ++ai)
#pragma unroll
                for (int m = 0; m < 4; ++m) { float* rowp = SM + (size_t)(row0 + ai * HALF + m * 16) * 256 + wc * 32 + 8 * fq; const float rs = tb[ai * HALF + m * 16];
#pragma unroll
                    for (int bj = 0; bj < 2; ++bj) { *(f32x4*)(rowp + bj * HALF) = acc[ai][bj][m][0] * rs; *(f32x4*)(rowp + bj * HALF + 4) = acc[ai][bj][m][1] * rs; } }
        } else {
            const int col0 = u.pn * BM + wc * 32 + 8 * fq;
#pragma unroll
            for (int ai = 0; ai < 2; ++ai)
#pragma unroll
                for (int m = 0; m < 4; ++m) { bf16_t* rowp = U + (size_t)(row0 + ai * HALF + m * 16) * UWP + col0; const float rs = tb[ai * HALF + m * 16];
#pragma unroll
                    for (int bj = 0; bj < 2; ++bj) { const f32x4 v0 = acc[ai][bj][m][0] * rs, v1 = acc[ai][bj][m][1] * rs;
                        u32x4 w; w.x = cvt_pk_bf16(v0[0], v0[1]); w.y = cvt_pk_bf16(v0[2], v0[3]); w.z = cvt_pk_bf16(v1[0], v1[1]); w.w = cvt_pk_bf16(v1[2], v1[3]);
                        *(u32x4*)(rowp + bj * HALF) = w; } }
        }
    }
};
struct EpiPart {
    static constexpr bool PERM = true; static constexpr bool HAS_PREP = false;
    float* dst; float scale;
    DI void operator()(AccRef a, const Unit& u, int wr, int wc, int fr, int fq) const {
        const int row0 = wr * 64 + fr, col0 = wc * 32 + 8 * fq;
#pragma unroll
        for (int ai = 0; ai < 2; ++ai)
#pragma unroll
            for (int m = 0; m < 4; ++m) { float* rowp = dst + (row0 + ai * HALF + m * 16) * 256 + col0;
#pragma unroll
                for (int bj = 0; bj < 2; ++bj) { *(f32x4*)(rowp + bj * HALF) = a[ai][bj][m][0] * scale; *(f32x4*)(rowp + bj * HALF + 4) = a[ai][bj][m][1] * scale; } }
    }
};
struct EpiNull {
    static constexpr bool PERM = true; static constexpr bool HAS_PREP = false;
    float* sink;
    DI void operator()(AccRef acc, const Unit& u, int wr, int wc, int fr, int fq) const {
        f32x4 s = {0.f, 0.f, 0.f, 0.f};
#pragma unroll
        for (int ai = 0; ai < 2; ++ai)
#pragma unroll
            for (int bj = 0; bj < 2; ++bj)
#pragma unroll
                for (int m = 0; m < 4; ++m)
#pragma unroll
                    for (int n = 0; n < 2; ++n) s += acc[ai][bj][m][n];
        if (s[0] + s[1] + s[2] + s[3] == 123456.789f) sink[0] = s[0];
    }
};
struct EpiUL2 {
    static constexpr bool PERM = true; static constexpr bool HAS_PREP = false;
    bf16_t* T;
    DI void operator()(AccRef acc, const Unit& u, int wr, int wc, int fr, int fq) const {
        const int row0 = wr * 64 + fr, col0 = wc * 32 + 8 * fq;
#pragma unroll
        for (int ai = 0; ai < 2; ++ai)
#pragma unroll
            for (int m = 0; m < 4; ++m) { bf16_t* rowp = T + (size_t)(row0 + ai * HALF + m * 16) * 256 + col0;
#pragma unroll
                for (int bj = 0; bj < 2; ++bj) { const f32x4 v0 = acc[ai][bj][m][0], v1 = acc[ai][bj][m][1];
                    u32x4 w; w.x = cvt_pk_bf16(v0[0], v0[1]); w.y = cvt_pk_bf16(v0[2], v0[3]); w.z = cvt_pk_bf16(v1[0], v1[1]); w.w = cvt_pk_bf16(v1[2], v1[3]);
                    *(u32x4*)(rowp + bj * HALF) = w; } }
    }
};
template <bool SSQ> struct EpiResidT {
    static constexpr bool PERM = true; static constexpr bool HAS_PREP = false;
    const bf16_t* base; bf16_t* out; float* ssq;
    DI void operator()(AccRef acc, const Unit& u, int wr, int wc, int fr, int fq) const {
        const int row0 = u.pm * BM + wr * 64 + fr, col0 = u.pn * BM + wc * 32 + 8 * fq;
        u32x4 bv[4][2];
#define ER_LOAD(slot, rg) do { const size_t off_ = (size_t)(row0 + ((rg) >> 2) * HALF + ((rg) & 3) * 16) * D + col0; \
        _Pragma("unroll") for (int bj_ = 0; bj_ < 2; ++bj_) bv[slot][bj_] = *(const u32x4*)(base + off_ + bj_ * HALF); } while (0)
        ER_LOAD(0, 0); ER_LOAD(1, 1); ER_LOAD(2, 2);
#pragma unroll
        for (int rg = 0; rg < 8; ++rg) { const int ai = rg >> 2, m = rg & 3; const size_t off = (size_t)(row0 + ai * HALF + m * 16) * D + col0;
            if (rg + 3 < 8) ER_LOAD((rg + 3) & 3, rg + 3);
            asm volatile("" ::: "memory");
            float sq = 0.f;
#pragma unroll
            for (int bj = 0; bj < 2; ++bj) { const u32x4 b = bv[rg & 3][bj];
                const f32x4 v0 = (f32x4){bflo(b.x), bfhi(b.x), bflo(b.y), bfhi(b.y)} + acc[ai][bj][m][0], v1 = (f32x4){bflo(b.z), bfhi(b.z), bflo(b.w), bfhi(b.w)} + acc[ai][bj][m][1];
                if constexpr (SSQ) sq += (v0[0] * v0[0] + v0[1] * v0[1]) + (v0[2] * v0[2] + v0[3] * v0[3]) + (v1[0] * v1[0] + v1[1] * v1[1]) + (v1[2] * v1[2] + v1[3] * v1[3]);
                u32x4 w; w.x = cvt_pk_bf16(v0[0], v0[1]); w.y = cvt_pk_bf16(v0[2], v0[3]); w.z = cvt_pk_bf16(v1[0], v1[1]); w.w = cvt_pk_bf16(v1[2], v1[3]);
                *(u32x4*)(out + off + bj * HALF) = w; }
            if constexpr (SSQ) { sq += shfl_xor_f(sq, 16); sq += shfl_xor_f(sq, 32);
                if (fq == 0) ssq[(size_t)(row0 + ai * HALF + m * 16) * 32 + u.pn * 4 + wc] = sq; } }
#undef ER_LOAD
    }
};
typedef EpiResidT<false> EpiResid;
constexpr int RS_TAB = STAGE_BYTES;
DI float row_rstd(const float* ssq, int row) { const f32x4* p = (const f32x4*)(ssq + (size_t)row * 32); f32x4 t = p[0];
#pragma unroll
    for (int j = 1; j < 8; ++j) t += p[j];
    return 1.0f / sqrtf(((t[0] + t[1]) + (t[2] + t[3])) * (1.0f / D) + RMS_EPS); }
struct EpiBf16R {
    static constexpr bool PERM = true; static constexpr bool HAS_PREP = true;
    bf16_t* O; int ldc; const float* ssq; LAS float* tab;
    DI void prep(const Unit& u, int tid) const { if (tid < 256) tab[(u.ui & 1) * 256 + tid] = row_rstd(ssq, u.pm * BM + tid); }
    DI void operator()(AccRef acc, const Unit& u, int wr, int wc, int fr, int fq) const {
        const int row0 = u.pm * BM + wr * 64 + fr, col0 = u.pn * BM + wc * 32 + 8 * fq;
        const LAS float* tb = tab + (u.ui & 1) * 256 + wr * 64 + fr;
#pragma unroll
        for (int ai = 0; ai < 2; ++ai)
#pragma unroll
            for (int m = 0; m < 4; ++m) { bf16_t* rowp = O + (size_t)(row0 + ai * HALF + m * 16) * ldc + col0; const float rs = tb[ai * HALF + m * 16];
#pragma unroll
                for (int bj = 0; bj < 2; ++bj) { const f32x4 v0 = acc[ai][bj][m][0] * rs, v1 = acc[ai][bj][m][1] * rs;
                    u32x4 w; w.x = cvt_pk_bf16(v0[0], v0[1]); w.y = cvt_pk_bf16(v0[2], v0[3]); w.z = cvt_pk_bf16(v1[0], v1[1]); w.w = cvt_pk_bf16(v1[2], v1[3]);
                    *(u32x4*)(rowp + bj * HALF) = w; } }
    }
};
struct EpiMerge {
    static constexpr bool PERM = true; static constexpr bool HAS_PREP = false;
    const unsigned char* G; bf16_t* merged;
    DI void operator()(AccRef acc, const Unit& u, int wr, int wc, int fr, int fq) const {
        const int row0 = u.pm * BM + wr * 64 + fr, col0 = u.pn * BM + wc * 32 + 8 * fq, n_br = u.aux;
        u32x2 gv[8][2]; u32x4 pv[4][2];
#define EM_LOAD(slot, rg) do { const size_t row_ = (size_t)(row0 + ((rg) >> 2) * HALF + ((rg) & 3) * 16); \
        _Pragma("unroll") for (int bj_ = 0; bj_ < 2; ++bj_) {             if (n_br > 0) pv[slot][bj_] = *(const u32x4*)(merged + row_ * D + col0 + bj_ * HALF); } } while (0)
#pragma unroll
        for (int rg_ = 0; rg_ < 8; ++rg_) { const size_t row_ = (size_t)(row0 + (rg_ >> 2) * HALF + (rg_ & 3) * 16);
#pragma unroll
            for (int bj_ = 0; bj_ < 2; ++bj_) gv[rg_][bj_] = *(const u32x2*)(G + row_ * (4 * D) + n_br * D + col0 + bj_ * HALF); }
        EM_LOAD(0, 0); EM_LOAD(1, 1); EM_LOAD(2, 2);
#pragma unroll
        for (int rg = 0; rg < 8; ++rg) { const int ai = rg >> 2, m = rg & 3; const size_t row = (size_t)(row0 + ai * HALF + m * 16);
            if (rg + 3 < 8) EM_LOAD((rg + 3) & 3, rg + 3);
            asm volatile("" ::: "memory");
#pragma unroll
            for (int bj = 0; bj < 2; ++bj) { const int c = col0 + bj * HALF; const u32x2 gw = gv[rg][bj];
                f32x4 v0 = acc[ai][bj][m][0], v1 = acc[ai][bj][m][1];
                {
                    const float k = 1.0f / 255.0f;
                    v0[0] *= (float)(gw.x & 255u) * k; v0[1] *= (float)((gw.x >> 8) & 255u) * k; v0[2] *= (float)((gw.x >> 16) & 255u) * k; v0[3] *= (float)(gw.x >> 24) * k;
                    v1[0] *= (float)(gw.y & 255u) * k; v1[1] *= (float)((gw.y >> 8) & 255u) * k; v1[2] *= (float)((gw.y >> 16) & 255u) * k; v1[3] *= (float)(gw.y >> 24) * k; }
                if (n_br > 0) { const u32x4 pw = pv[rg & 3][bj];
                    v0[0] += bflo(pw.x); v0[1] += bfhi(pw.x); v0[2] += bflo(pw.y); v0[3] += bfhi(pw.y); v1[0] += bflo(pw.z); v1[1] += bfhi(pw.z); v1[2] += bflo(pw.w); v1[3] += bfhi(pw.w); }
                u32x4 w; w.x = cvt_pk_bf16(v0[0], v0[1]); w.y = cvt_pk_bf16(v0[2], v0[3]); w.z = cvt_pk_bf16(v1[0], v1[1]); w.w = cvt_pk_bf16(v1[2], v1[3]);
                *(u32x4*)(merged + row * D + c) = w; } }
#undef EM_LOAD
    }
};
struct EpiSwiGLU {
    static constexpr bool PERM = true; static constexpr bool HAS_PREP = false;
    bf16_t* act;
    DI void operator()(AccRef acc, const Unit& u, int wr, int wc, int fr, int fq) const {
        const int row0 = u.pm * BM + wr * 64 + fr, col0 = u.pn * HALF + wc * 32 + 8 * fq;
#pragma unroll
        for (int ai = 0; ai < 2; ++ai)
#pragma unroll
            for (int m = 0; m < 4; ++m) { bf16_t* rowp = act + (size_t)(row0 + ai * HALF + m * 16) * FFN + col0;
                float o[8];
#pragma unroll
                for (int n = 0; n < 2; ++n)
#pragma unroll
                    for (int jp = 0; jp < 2; ++jp) {
                        const f32x2 a = {acc[ai][0][m][n][2 * jp], acc[ai][0][m][n][2 * jp + 1]}, b = {acc[ai][1][m][n][2 * jp], acc[ai][1][m][n][2 * jp + 1]};
                        const f32x2 t = a * (-1.4426950408889634f); f32x2 e; e.x = fexp2(t.x); e.y = fexp2(t.y);
                        const f32x2 d = e + 1.0f; f32x2 r; r.x = frcp(d.x); r.y = frcp(d.y);
                        const f32x2 y = (a * b) * r; o[4 * n + 2 * jp] = y.x; o[4 * n + 2 * jp + 1] = y.y; }
                u32x4 w; w.x = cvt_pk_bf16(o[0], o[1]); w.y = cvt_pk_bf16(o[2], o[3]); w.z = cvt_pk_bf16(o[4], o[5]); w.w = cvt_pk_bf16(o[6], o[7]);
                *(u32x4*)rowp = w; asm volatile("" ::: "memory"); }
    }
};
struct EpiSwiGLUR {
    static constexpr bool PERM = true; static constexpr bool HAS_PREP = true;
    bf16_t* act; const float* ssq; LAS float* tab;
    DI void prep(const Unit& u, int tid) const { if (tid < 256) tab[(u.ui & 1) * 256 + tid] = row_rstd(ssq, u.pm * BM + tid); }
    DI void operator()(AccRef acc, const Unit& u, int wr, int wc, int fr, int fq) const {
        const int row0 = u.pm * BM + wr * 64 + fr, col0 = u.pn * HALF + wc * 32 + 8 * fq;
        const LAS float* tb = tab + (u.ui & 1) * 256 + wr * 64 + fr;
#pragma unroll
        for (int ai = 0; ai < 2; ++ai)
#pragma unroll
            for (int m = 0; m < 4; ++m) { bf16_t* rowp = act + (size_t)(row0 + ai * HALF + m * 16) * FFN + col0; const float rs = tb[ai * HALF + m * 16];
                float o[8];
#pragma unroll
                for (int n = 0; n < 2; ++n)
#pragma unroll
                    for (int jp = 0; jp < 2; ++jp) {
                        const f32x2 a = (f32x2){acc[ai][0][m][n][2 * jp], acc[ai][0][m][n][2 * jp + 1]} * rs, b = (f32x2){acc[ai][1][m][n][2 * jp], acc[ai][1][m][n][2 * jp + 1]} * rs;
                        const f32x2 t = a * (-1.4426950408889634f); f32x2 e; e.x = fexp2(t.x); e.y = fexp2(t.y);
                        const f32x2 d = e + 1.0f; f32x2 r; r.x = frcp(d.x); r.y = frcp(d.y);
                        const f32x2 y = (a * b) * r; o[4 * n + 2 * jp] = y.x; o[4 * n + 2 * jp + 1] = y.y; }
                u32x4 w; w.x = cvt_pk_bf16(o[0], o[1]); w.y = cvt_pk_bf16(o[2], o[3]); w.z = cvt_pk_bf16(o[4], o[5]); w.w = cvt_pk_bf16(o[6], o[7]);
                *(u32x4*)rowp = w; asm volatile("" ::: "memory"); }
    }
};
#ifdef HOST_EMU
template <class Epi, class Sched, bool FULLN = false>
static void gemm_phase_f8(unsigned char* lds, const Gemm g, const Sched& S, const Epi& E, int wave_id) {
    const int tid = threadIdx.x, wid = tid >> 6, lane = tid & 63, wr = wid >> 2, wc = wid & 3, fr = lane & 15, fq = lane >> 4;
    static thread_local float* Cbuf = nullptr; static thread_local float* Af = nullptr; static thread_local float* Bf = nullptr;
    Unit u;
    for (int i = 0; S.next(i, u); ++i) {
        __syncthreads();
        if (tid == 0) {
            if (!Cbuf) { Cbuf = (float*)malloc(256 * 256 * 4); Af = (float*)malloc((size_t)256 * 8192 * 4); Bf = (float*)malloc((size_t)256 * 8192 * 4); }
            const int K = 2 * g.K; const unsigned char* A8 = (const unsigned char*)g.A; const unsigned char* B8 = (const unsigned char*)g.Bt;
            for (int r = 0; r < 256; ++r) for (int k = 0; k < K; ++k) { Af[(size_t)r * K + k] = fp82f_host(A8[((size_t)u.pa * 256 + r) * 2 * g.lda + k]); Bf[(size_t)r * K + k] = (FULLN || r < 128) ? fp82f_host(B8[((size_t)u.pb * (FULLN ? 256 : 128) + r) * 2 * g.ldb + k]) : 0.f; }
            for (int r = 0; r < 256; ++r) for (int c = 0; c < 256; ++c) { const float* a = Af + (size_t)r * K; const float* b = Bf + (size_t)c * K; float sum = 0.f;
                for (int k = 0; k < K; ++k) sum += a[k] * b[k]; Cbuf[r * 256 + c] = sum; }
        }
        __syncthreads();
        f32x4 acc[2][2][4][2];
        for (int ai = 0; ai < 2; ++ai) for (int bj = 0; bj < 2; ++bj) for (int m = 0; m < 4; ++m) for (int n = 0; n < 2; ++n) for (int j = 0; j < 4; ++j) {
            const int r = 128 * ai + 64 * wr + 16 * m + fr;
            const int c = 128 * bj + 32 * wc + 8 * fq + 4 * n + j;
            acc[ai][bj][m][n][j] = Cbuf[r * 256 + c]; }
        E(acc, u, wr, wc, fr, fq);
    }
    __syncthreads();
}
#endif
}

struct Frame {
    unsigned char* lds; int tid, lane, wave, G, bid, flags;
    const float* const* in; float* out; unsigned char* ws;
#ifndef HOST_EMU
    template <class T> DI T* wp(size_t off) const { return (T*)(GAS T*)(ws + off); }
    DI const float* inp(int i) const { return (const float*)(GAS const float*)in[i]; }
    DI float* outp() const { return (float*)(GAS float*)out; }
#else
    template <class T> DI T* wp(size_t off) const { return (T*)(ws + off); }
    DI const float* inp(int i) const { return in[i]; }
    DI float* outp() const { return out; }
#endif
};

DI void make_frame(Frame& F, const Params& P, unsigned char* lds, int wave0) {
#ifndef HOST_EMU
    int wv = wave0; LAUNDER_S(wv); int ln = lane_id_hw(); LAUNDER_V(ln); int tid = wv * 64 + ln;
#else
    int tid = threadIdx.x;
#endif
    size_t wz = 0; LAUNDER_S(wz); unsigned char* ws = P.ws + wz;
    F.lds = lds; F.tid = tid; F.lane = tid & 63; F.wave = tid >> 6;
#ifndef HOST_EMU
    F.wave = wv;
#endif
    F.G = gridDim.x; F.bid = blockIdx.x;
    F.in = P.in; F.out = P.out; F.ws = ws; F.flags = P.flags;
}
#define REFRAME() make_frame(F, P, lds, wave0)
DI bf16x8 frag_r(const bf16_t* T, int pitch, int r0, int k0, int lane) { return *(const bf16x8*)(T + (r0 + (lane & 15)) * pitch + k0 + 8 * (lane >> 4)); }
DI bf16x8 frag_k(const bf16_t* T, int pitch, int k0, int n0, int lane) {
    const int g = lane >> 4, q = (lane & 15) >> 2, p = lane & 3;
    const bf16_t* p0 = T + (k0 + 8 * g + q) * pitch + n0 + 4 * p;
    const s16x4 lo = lds_tr4(p0), hi = lds_tr4(p0 + 4 * pitch);
    return __builtin_shufflevector(lo, hi, 0, 1, 2, 3, 4, 5, 6, 7);
}
#ifndef HOST_EMU
template <int CTRL> DI float dppf(float v) { return __builtin_bit_cast(float, __builtin_amdgcn_update_dpp(0, __builtin_bit_cast(int, v), CTRL, 0xF, 0xF, true)); }
DI float grp16_max(float v) { v = fmaxf(v, dppf<0xB1>(v)); v = fmaxf(v, dppf<0x4E>(v)); v = fmaxf(v, dppf<0x141>(v)); v = fmaxf(v, dppf<0x140>(v)); return v; }
DI float grp16_sum(float v) { v += dppf<0xB1>(v); v += dppf<0x4E>(v); v += dppf<0x141>(v); v += dppf<0x140>(v); return v; }
#else
DI float grp16_max(float v) { v = fmaxf(v, shfl_xor_f(v, 1)); v = fmaxf(v, shfl_xor_f(v, 2)); v = fmaxf(v, shfl_xor_f(v, 4)); v = fmaxf(v, shfl_xor_f(v, 8)); return v; }
DI float grp16_sum(float v) { v += shfl_xor_f(v, 1); v += shfl_xor_f(v, 2); v += shfl_xor_f(v, 4); v += shfl_xor_f(v, 8); return v; }
#endif

template <class ColMap>
DI void tr_load(const float* W, int ldw, const ColMap& cm, int item, int nblk  , int lane, f32x4 (&v)[16]) {
    const int kb = item / nblk, nb = item - kb * nblk, k0 = 64 * kb, n0 = 64 * nb;
    const int col = cm(n0 + 4 * (lane & 15)), rq = lane >> 4;
#pragma unroll
    for (int i = 0; i < 16; ++i) v[i] = (f32x4){0.f, 0.f, 0.f, 0.f};
    if (col >= 0) {
        const float* src = W + (size_t)(k0 + rq) * ldw + col;
#pragma unroll
        for (int i = 0; i < 16; ++i) v[i] = *(const f32x4*)(src + (size_t)(4 * i) * ldw);
    }
}
DI void tr_store(int K, bf16_t* WT, bf16_t* scr  , int item, int nblk, int lane, const f32x4 (&v)[16], const float* ks  ) {
    const int kb = item / nblk, nb = item - kb * nblk, k0 = 64 * kb, n0 = 64 * nb, rq = lane >> 4;
#pragma unroll
    for (int i = 0; i < 16; ++i) { f32x4 x = v[i]; if (ks) x *= ks[k0 + rq + 4 * i];
        u32x2 o; o.x = cvt_pk_bf16(x[0], x[1]); o.y = cvt_pk_bf16(x[2], x[3]); *(u32x2*)(scr + (rq + 4 * i) * 72 + 4 * (lane & 15)) = o; }
    WAVE_FENCE();
#pragma unroll
    for (int kq = 0; kq < 2; ++kq)
#pragma unroll
        for (int nq = 0; nq < 4; ++nq) { const bf16x8 f = frag_k(scr, 72, 32 * kq, 16 * nq, lane);
            *(bf16x8*)(WT + (size_t)(n0 + 16 * nq + (lane & 15)) * K + k0 + 32 * kq + 8 * (lane >> 4)) = f; }
    WAVE_FENCE();
}
DI void tr_store_f8(int K, unsigned char* WT8, bf16_t* scr, int item, int nblk, int lane, const f32x4 (&v)[16], float wscale) {
    const int kb = item / nblk, nb = item - kb * nblk, k0 = 64 * kb, n0 = 64 * nb, rq = lane >> 4;
#pragma unroll
    for (int i = 0; i < 16; ++i) { u32x2 o; o.x = cvt_pk_bf16(v[i][0] * wscale, v[i][1] * wscale); o.y = cvt_pk_bf16(v[i][2] * wscale, v[i][3] * wscale); *(u32x2*)(scr + (rq + 4 * i) * 72 + 4 * (lane & 15)) = o; }
    WAVE_FENCE();
#pragma unroll
    for (int kq = 0; kq < 2; ++kq)
#pragma unroll
        for (int nq = 0; nq < 4; ++nq) { const bf16x8 f = frag_k(scr, 72, 32 * kq, 16 * nq, lane);
            u32x2 o; o.x = cvt_pk4_fp8(bf2f((bf16_t)f[0]), bf2f((bf16_t)f[1]), bf2f((bf16_t)f[2]), bf2f((bf16_t)f[3])); o.y = cvt_pk4_fp8(bf2f((bf16_t)f[4]), bf2f((bf16_t)f[5]), bf2f((bf16_t)f[6]), bf2f((bf16_t)f[7]));
            *(u32x2*)(WT8 + (size_t)(n0 + 16 * nq + (lane & 15)) * K + k0 + 32 * kq + 8 * (lane >> 4)) = o; }
    WAVE_FENCE();
}
struct CmGate { DI int operator()(int n) const { return SO_GATE + n; } };
struct CmW13F8 { DI int operator()(int r) const { const int pn = r >> 7, c = r & 127, q = c >> 3, n = (c >> 2) & 1, j = c & 3; return (n ? FFN : 0) + 64 * pn + 4 * q + j; } };
struct CmIdent { DI int operator()(int n) const { return n; } };
struct CmWin { DI int operator()(int r) const {
    if (r < 3072) return r;
    if (r < 4096) return SO_SSZ + (r - 3072);
    if (r < 5632) return SO_XBC + (r - 4096);
    if (r < 6144) return SO_CQ + (r - 5632);
    if (r < 6400) return SO_CKV + (r - 6144);
    if (r < 6656) { const int j = r - 6400; if (j < 64) return SO_KR + j; if (j < 72) return SO_MLI + (j - 64); if (j < 88) return SO_DT + (j - 72); return -1; }
    if (r < 7680) return SO_SWQ + (r - 6656);
    if (r < 7936) return SO_SWK + (r - 7680);
    if (r < 8192) return SO_SWV + (r - 7936);
    return SO_GATE + (r - 8192); } };
struct CmW13 { DI int operator()(int r) const { const int pn = r >> 8, rr = r & 255; return rr < 128 ? 128 * pn + rr : FFN + 128 * pn + (rr - 128); } };
template <class ColMap>
DI void convert_weight_f8(const Frame& F, const float* W, int ldw, int K, int N, unsigned char* WT8, const ColMap& cm, float wscale, int& rot) {
    bf16_t* scr = (bf16_t*)(F.lds + F.wave * 16384);
    const int NGW = F.G * 8, nblk = N / 64, items = (K / 64) * nblk;
    int gw = F.bid * 8 + F.wave - rot; if (gw < 0) gw += NGW;
    rot = (rot + items) % NGW;
    if (gw < items) {
        f32x4 v[16]; tr_load(W, ldw, cm, gw, nblk, F.lane, v);
        for (int it = gw;;) { const int nx = it + NGW; f32x4 vn[16];
            if (nx < items) tr_load(W, ldw, cm, nx, nblk, F.lane, vn);
            tr_store_f8(K, WT8, scr, it, nblk, F.lane, v, wscale);
            if (nx >= items) break;
#pragma unroll
            for (int i = 0; i < 16; ++i) v[i] = vn[i];
            it = nx; }
    }
}
template <class ColMap>
DI void convert_weight(const Frame& F, const float* W, int ldw, int K, int N, bf16_t* WT, const ColMap& cm, int& rot, const float* ks = nullptr) {
    bf16_t* scr = (bf16_t*)(F.lds + F.wave * 16384);
    const int NGW = F.G * 8, nblk = N / 64, items = (K / 64) * nblk;
    int gw = F.bid * 8 + F.wave - rot; if (gw < 0) gw += NGW;
    rot = (rot + items) % NGW;
    if (gw < items) {
        f32x4 v[16]; tr_load(W, ldw, cm, gw, nblk, F.lane, v);
        for (int it = gw;;) { const int nx = it + NGW; f32x4 vn[16];
            if (nx < items) tr_load(W, ldw, cm, nx, nblk, F.lane, vn);
            tr_store(K, WT, scr, it, nblk, F.lane, v, ks);
            if (nx >= items) break;
#pragma unroll
            for (int i = 0; i < 16; ++i) v[i] = vn[i];
            it = nx; }
    }
}
DI void rms_row_to_bf16(const float* xrow, const float* w, bf16_t* orow, int lane, unsigned char* o8 = nullptr, bf16_t* h16 = nullptr, float* rs_out = nullptr) {
    f32x4 v[8]; float s = 0.f;
#pragma unroll
    for (int j = 0; j < 8; ++j) { v[j] = *(const f32x4*)(xrow + 4 * (lane + 64 * j)); s += (v[j][0] * v[j][0] + v[j][1] * v[j][1]) + (v[j][2] * v[j][2] + v[j][3] * v[j][3]);
        if (h16) { u32x2 hc; hc.x = cvt_pk_bf16(v[j][0], v[j][1]); hc.y = cvt_pk_bf16(v[j][2], v[j][3]); *(u32x2*)(h16 + 4 * (lane + 64 * j)) = hc; } }
    const float rstd = 1.0f / sqrtf(wave_sum(s) * (1.0f / D) + RMS_EPS);
    if (rs_out && lane == 0) *rs_out = rstd;
#pragma unroll
    for (int j = 0; j < 8; ++j) { const f32x4 ww = *(const f32x4*)(w + 4 * (lane + 64 * j));
        const float y0 = v[j][0] * rstd * ww[0], y1 = v[j][1] * rstd * ww[1], y2 = v[j][2] * rstd * ww[2], y3 = v[j][3] * rstd * ww[3];
        u32x2 o; o.x = cvt_pk_bf16(y0, y1); o.y = cvt_pk_bf16(y2, y3);
        if (orow) *(u32x2*)(orow + 4 * (lane + 64 * j)) = o;
        if (o8) *(unsigned*)(o8 + 4 * (lane + 64 * j)) = cvt_pk4_fp8(y0 * F8_ASCALE, y1 * F8_ASCALE, y2 * F8_ASCALE, y3 * F8_ASCALE); }
}
DI void rms_row16_to_bf16(const bf16_t* xrow, const float* w, bf16_t* orow, int lane, unsigned char* o8 = nullptr, float* rs_out = nullptr) {
    f32x4 v[8]; float s = 0.f;
#pragma unroll
    for (int j = 0; j < 8; ++j) { const u32x2 a = *(const u32x2*)(xrow + 4 * (lane + 64 * j)); v[j] = (f32x4){bflo(a.x), bfhi(a.x), bflo(a.y), bfhi(a.y)};
        s += (v[j][0] * v[j][0] + v[j][1] * v[j][1]) + (v[j][2] * v[j][2] + v[j][3] * v[j][3]); }
    const float rstd = 1.0f / sqrtf(wave_sum(s) * (1.0f / D) + RMS_EPS);
    if (rs_out && lane == 0) *rs_out = rstd;
#pragma unroll
    for (int j = 0; j < 8; ++j) { const f32x4 ww = *(const f32x4*)(w + 4 * (lane + 64 * j));
        const float y0 = v[j][0] * rstd * ww[0], y1 = v[j][1] * rstd * ww[1], y2 = v[j][2] * rstd * ww[2], y3 = v[j][3] * rstd * ww[3];
        u32x2 o; o.x = cvt_pk_bf16(y0, y1); o.y = cvt_pk_bf16(y2, y3);
        if (orow) *(u32x2*)(orow + 4 * (lane + 64 * j)) = o;
        if (o8) *(unsigned*)(o8 + 4 * (lane + 64 * j)) = cvt_pk4_fp8(y0 * F8_ASCALE, y1 * F8_ASCALE, y2 * F8_ASCALE, y3 * F8_ASCALE); }
}
DI void phase_prologue(const Frame& F) {
    CmIdent id; int rot = 0;
    for (int l = 0; l < DEPTH; ++l) {
        if (!(F.flags & 4)) { convert_weight(F, F.inp(3) + (size_t)l * D * IN_TOTAL, IN_TOTAL, D, UC_GATE, F.wp<bf16_t>(O_WIN) + (size_t)l * UW * D, CmWin(), rot, F.inp(2) + (size_t)l * D);
            convert_weight_f8(F, F.inp(3) + (size_t)l * D * IN_TOTAL, IN_TOTAL, D, 8192, F.wp<unsigned char>(O_WG8) + (size_t)l * 8192 * D, CmGate(), F8_WSCALE, rot); }
        convert_weight(F, F.inp(14) + (size_t)l * 512 * 1536, 1536, 512, 1536, F.wp<bf16_t>(O_WUQ) + (size_t)l * 1536 * 512, id, rot);
        convert_weight(F, F.inp(16) + (size_t)l * 256 * 2048, 2048, 256, 2048, F.wp<bf16_t>(O_WUKV) + (size_t)l * 2048 * 256, id, rot);
        for (int n = 0; n < 4; ++n)
            convert_weight(F, F.inp(18) + ((size_t)l * 4 + n) * 1024 * 2048, 2048, 1024, 2048, F.wp<bf16_t>(O_WBR) + ((size_t)l * 4 + n) * 2048 * 1024, id, rot);
        convert_weight(F, F.inp(19) + (size_t)l * D * D, D, D, D, F.wp<bf16_t>(O_WOUT) + (size_t)l * D * D, id, rot);
        convert_weight(F, F.inp(22) + (size_t)l * D * 512, 512, D, 512, F.wp<bf16_t>(O_WXQ) + (size_t)l * 512 * D, id, rot, F.inp(20) + (size_t)l * D);
        convert_weight(F, F.inp(23) + (size_t)l * D * 1024, 1024, D, 1024, F.wp<bf16_t>(O_WXKV) + (size_t)l * 1024 * D, id, rot);
        convert_weight(F, F.inp(24) + (size_t)l * 512 * D, D, 512, D, F.wp<bf16_t>(O_WXO) + (size_t)l * D * 512, id, rot);
    }
    if (!(F.flags & 2)) { convert_weight(F, F.inp(26), 2 * FFN, D, 2 * FFN, F.wp<bf16_t>(O_W13), CmW13(), rot, F.inp(25));
    convert_weight(F, F.inp(27), D, FFN, D, F.wp<bf16_t>(O_W2), id, rot); }
    if (!(F.flags & 1)) for (int e = 0; e < NEXP; ++e) {
        convert_weight_f8(F, F.inp(29) + (size_t)e * D * 2 * FFN, 2 * FFN, D, 2 * FFN, F.wp<unsigned char>(O_MW13) + (size_t)e * 2 * FFN * D, CmW13F8(), F8_WSCALE, rot);
        convert_weight_f8(F, F.inp(30) + (size_t)e * FFN * D, D, FFN, D, F.wp<unsigned char>(O_MW2) + (size_t)e * D * FFN, id, F8_WSCALE, rot);
    }
    float* rope = F.wp<float>(O_ROPE);
    for (int idx = F.bid * NTHREADS + F.tid; idx < SEQ * 32; idx += F.G * NTHREADS) {
        const int t = idx >> 5, i = idx & 31;
        const float inv_freq = fexp2(-(float)i * (13.287712379549449f / 32.0f));
        const float ang = (float)t * inv_freq;
        const double rev = (double)ang * 0.15915494309189535; const float fr = (float)(rev - (double)(long long)rev);
        rope[2 * idx] = fcos_rev(fr); rope[2 * idx + 1] = fsin_rev(fr);
    }
    const int gw = F.bid * 8 + F.wave, NGW = F.G * 8;
    for (int r = gw; r < DEPTH * NMEM; r += NGW) { const int l = r / NMEM, m = r % NMEM;
        rms_row_to_bf16(F.inp(1) + (size_t)m * D, F.inp(21) + (size_t)l * D, F.wp<bf16_t>(O_MEMN) + (size_t)r * D, F.lane); }
}

DI void phase_rmsnorm_x(const Frame& F, const float* src, const float* w) {
    const int gw = F.bid * 8 + F.wave, NGW = F.G * 8;
    unsigned char* x8 = F.wp<unsigned char>(O_XN8);
    for (int r = gw; r < NTOK; r += NGW) rms_row_to_bf16(src + (size_t)r * D, w, nullptr, F.lane, x8 + (size_t)r * D, F.wp<bf16_t>(O_H) + (size_t)r * D, F.wp<float>(O_RSTD) + r);
}
DI void phase_rmsnorm(const Frame& F, const bf16_t* src, const float* w) {
    const int gw = F.bid * 8 + F.wave, NGW = F.G * 8;
    unsigned char* x8 = F.wp<unsigned char>(O_XN8);
    const int lane = F.lane; float* rsd = F.wp<float>(O_RSTD);
    for (int r = gw; r < NTOK; r += 2 * NGW) { const int r2 = r + NGW;
        if (r2 >= NTOK) { rms_row16_to_bf16(src + (size_t)r * D, w, nullptr, lane, x8 + (size_t)r * D, rsd + r); break; }
        u32x2 a[8], b[8];
#pragma unroll
        for (int j = 0; j < 8; ++j) { a[j] = *(const u32x2*)(src + (size_t)r * D + 4 * (lane + 64 * j)); b[j] = *(const u32x2*)(src + (size_t)r2 * D + 4 * (lane + 64 * j)); }
        float sa = 0.f, sb = 0.f;
#pragma unroll
        for (int j = 0; j < 8; ++j) { sa += (bflo(a[j].x) * bflo(a[j].x) + bfhi(a[j].x) * bfhi(a[j].x)) + (bflo(a[j].y) * bflo(a[j].y) + bfhi(a[j].y) * bfhi(a[j].y));
            sb += (bflo(b[j].x) * bflo(b[j].x) + bfhi(b[j].x) * bfhi(b[j].x)) + (bflo(b[j].y) * bflo(b[j].y) + bfhi(b[j].y) * bfhi(b[j].y)); }
        const float ra = 1.0f / sqrtf(wave_sum(sa) * (1.0f / D) + RMS_EPS), rb = 1.0f / sqrtf(wave_sum(sb) * (1.0f / D) + RMS_EPS);
        if (lane == 0) { rsd[r] = ra; rsd[r2] = rb; }
#pragma unroll
        for (int j = 0; j < 8; ++j) { const int c0 = 4 * (lane + 64 * j); const f32x4 ww = *(const f32x4*)(w + c0);
            *(unsigned*)(x8 + (size_t)r * D + c0) = cvt_pk4_fp8(bflo(a[j].x) * ra * ww[0] * F8_ASCALE, bfhi(a[j].x) * ra * ww[1] * F8_ASCALE, bflo(a[j].y) * ra * ww[2] * F8_ASCALE, bfhi(a[j].y) * ra * ww[3] * F8_ASCALE);
            *(unsigned*)(x8 + (size_t)r2 * D + c0) = cvt_pk4_fp8(bflo(b[j].x) * rb * ww[0] * F8_ASCALE, bfhi(b[j].x) * rb * ww[1] * F8_ASCALE, bflo(b[j].y) * rb * ww[2] * F8_ASCALE, bfhi(b[j].y) * rb * ww[3] * F8_ASCALE); }
    }
}
DI void block_rows(const Frame& F, int& r0, int& r1) { r0 = (int)(((long)NTOK * F.bid) / F.G); r1 = (int)(((long)NTOK * (F.bid + 1)) / F.G); }
DI void phase_rmsnorm_route(const Frame& F, const bf16_t* src, const float* w, const float* router) {
    int* cnt = (int*)(F.lds);
    float* RT = (float*)(F.lds + 1024);
    if (F.tid < 8) cnt[F.tid] = 0;
    for (int c = F.tid; c < D; c += NTHREADS) { const f32x4 ra = *(const f32x4*)(router + (size_t)c * 8), rb = *(const f32x4*)(router + (size_t)c * 8 + 4);
        RT[c] = ra[0]; RT[D + c] = ra[1]; RT[2 * D + c] = ra[2]; RT[3 * D + c] = ra[3]; RT[4 * D + c] = rb[0]; RT[5 * D + c] = rb[1]; RT[6 * D + c] = rb[2]; RT[7 * D + c] = rb[3]; }
    __syncthreads();
    int r0, r1; block_rows(F, r0, r1);
    int* r_e = F.wp<int>(O_ROUTE); float* r_g = (float*)(r_e + 2 * NTOK);
    u32x2 nx[8];
    if (r0 + F.wave < r1) {
#pragma unroll
        for (int j = 0; j < 8; ++j) nx[j] = *(const u32x2*)(src + (size_t)(r0 + F.wave) * D + 4 * (F.lane + 64 * j)); }
    for (int r = r0 + F.wave; r < r1; r += 8) {
        const int lane = F.lane;
        u32x2 cur[8];
#pragma unroll
        for (int j = 0; j < 8; ++j) cur[j] = nx[j];
        if (r + 8 < r1) {
#pragma unroll
            for (int j = 0; j < 8; ++j) nx[j] = *(const u32x2*)(src + (size_t)(r + 8) * D + 4 * (lane + 64 * j)); }
        f32x4 v[8]; float s = 0.f;
#pragma unroll
        for (int j = 0; j < 8; ++j) { const u32x2 a_ = cur[j]; v[j] = (f32x4){bflo(a_.x), bfhi(a_.x), bflo(a_.y), bfhi(a_.y)}; s += (v[j][0] * v[j][0] + v[j][1] * v[j][1]) + (v[j][2] * v[j][2] + v[j][3] * v[j][3]); }
        const float rstd = 1.0f / sqrtf(wave_sum(s) * (1.0f / D) + RMS_EPS);
        float lg[8];
#pragma unroll
        for (int e = 0; e < 8; ++e) lg[e] = 0.f;
        unsigned char* orow = F.wp<unsigned char>(O_XN8) + (size_t)r * D;
#pragma unroll
        for (int j = 0; j < 8; ++j) { const int c0 = 4 * (lane + 64 * j); const f32x4 ww = *(const f32x4*)(w + c0);
            const f32x4 y = {v[j][0] * rstd * ww[0], v[j][1] * rstd * ww[1], v[j][2] * rstd * ww[2], v[j][3] * rstd * ww[3]};
            *(unsigned*)(orow + c0) = cvt_pk4_fp8(y[0] * F8_ASCALE, y[1] * F8_ASCALE, y[2] * F8_ASCALE, y[3] * F8_ASCALE);
#pragma unroll
            for (int e = 0; e < 8; ++e) { const f32x4 rw = *(const f32x4*)(RT + e * D + c0); lg[e] += (y[0] * rw[0] + y[1] * rw[1]) + (y[2] * rw[2] + y[3] * rw[3]); }
            SCHED_BAR(); }
#pragma unroll
        for (int e = 0; e < 8; ++e) lg[e] = wave_sum(lg[e]);
        int i0 = 0; float v0 = lg[0];
#pragma unroll
        for (int e = 1; e < 8; ++e) if (lg[e] > v0) { v0 = lg[e]; i0 = e; }
        int i1 = -1; float v1 = -3.0e38f;
#pragma unroll
        for (int e = 0; e < 8; ++e) if (e != i0 && lg[e] > v1) { v1 = lg[e]; i1 = e; }
        const float e1 = fexp(v1 - v0), g0 = 1.0f / (1.0f + e1), g1 = e1 * g0;
        if (lane == 0) { r_e[2 * r] = i0; r_e[2 * r + 1] = i1; r_g[2 * r] = g0; r_g[2 * r + 1] = g1; lds_atomic_add_i(&cnt[i0], 1); lds_atomic_add_i(&cnt[i1], 1); }
    }
    __syncthreads();
    if (F.tid < 8) F.wp<int>(O_BLKCNT)[F.bid * 8 + F.tid] = cnt[F.tid];
}
DI void moe_tables(const Frame& F, int* tile_e, int* pstart, int* ntiles_out) {
    const int* bc = F.wp<int>(O_BLKCNT);
    if (F.tid == 0) {
        int tot[8];
        for (int e = 0; e < 8; ++e) tot[e] = 0;
        for (int b = 0; b < F.G; ++b) for (int e = 0; e < 8; ++e) tot[e] += bc[b * 8 + e];
        int ps = 0, nt = 0;
        for (int e = 0; e < 8; ++e) { pstart[e] = ps; const int t = (tot[e] + 255) >> 8;
_Pragma("clang loop vectorize(disable) unroll(disable)")
            for (int j = 0; j < t; ++j) tile_e[nt + j] = e;
            nt += t; ps += t * 256; }
        *ntiles_out = nt;
    }
    __syncthreads();
}
DI void phase_moe_scatter(const Frame& F, int* tile_e, int* pstart, int* ntiles, int* myoff  ) {
    moe_tables(F, tile_e, pstart, ntiles);
    const int* bc = F.wp<int>(O_BLKCNT);
    int r0, r1; block_rows(F, r0, r1);
    int* r_e = F.wp<int>(O_ROUTE); int* r_s = r_e + 4 * NTOK;
    if (F.tid < 8) { int s = 0; for (int b = 0; b < F.bid; ++b) s += bc[b * 8 + F.tid]; myoff[F.tid] = pstart[F.tid] + s; }
    __syncthreads();
    {
        int* es = (int*)F.lds; const int np = 2 * (r1 - r0);
        for (int p = F.tid; p < np; p += NTHREADS) es[p] = r_e[2 * r0 + p];
        __syncthreads();
        for (int p = F.tid; p < np; p += NTHREADS) { const int e = es[p]; int before = 0;
            for (int q = 0; q < p; ++q) before += (es[q] == e) ? 1 : 0;
            r_s[2 * r0 + p] = myoff[e] + before; }
    }
    __syncthreads();
    asm volatile("" ::: "memory");
    const unsigned char* xn8 = F.wp<unsigned char>(O_XN8); unsigned char* xg8 = F.wp<unsigned char>(O_XG);
    for (int i = 2 * r0 + F.wave; i < 2 * r1; i += 32) {
        u32x4 v[4][2]; int slot[4];
#pragma unroll
        for (int q = 0; q < 4; ++q) { const int ii = i + 8 * q; const bool ok = ii < 2 * r1; const int ic = ok ? ii : i; slot[q] = ok ? r_s[ic] : -1;
            const u32x4* sp_ = (const u32x4*)(xn8 + (size_t)(ic >> 1) * D); v[q][0] = sp_[F.lane]; v[q][1] = sp_[F.lane + 64]; }
#pragma unroll
        for (int q = 0; q < 4; ++q) if (slot[q] >= 0) { u32x4* dp_ = (u32x4*)(xg8 + (size_t)slot[q] * D); dp_[F.lane] = v[q][0]; dp_[F.lane + 64] = v[q][1]; } }
}
DI void phase_final(const Frame& F, bool moe_last, const int* ntiles_p, unsigned char* tail_of  ) {
    const int gw = F.bid * 8 + F.wave, NGW = F.G * 8, lane = F.lane;
    const bf16_t* H = F.wp<bf16_t>(O_H); const bf16_t* yg = F.wp<bf16_t>(O_YG); const float* w = F.inp(31); const float* tacc = F.wp<float>(O_TAILACC);
    const int* r_e = F.wp<int>(O_ROUTE); const float* r_g = (const float*)(r_e + 2 * NTOK); const int* r_s = r_e + 4 * NTOK;
    int full = 0, R = 0, sp = 0;
    if (moe_last) {
        pg8::moe_tail_split(*ntiles_p, F.G, full, R, sp);
_Pragma("clang loop vectorize(disable) unroll(disable)")
        for (int i = F.tid; i < MAXTILES * 8; i += NTHREADS) tail_of[i] = 0;
        __syncthreads();
        for (int u = F.tid; u < R; u += NTHREADS) { int pm, pn; pg8::static_map((long)full * F.G + u, *ntiles_p, D / 256, pm, pn); tail_of[pm * 8 + pn] = (unsigned char)(u + 1); }
        __syncthreads();
    }
    for (int r = gw; r < NTOK; r += NGW) {
        f32x4 v[8]; float s = 0.f;
        float g0 = 0.f, g1 = 0.f; int s0 = 0, s1 = 0;
        if (moe_last) { g0 = r_g[2 * r]; g1 = r_g[2 * r + 1]; s0 = r_s[2 * r]; s1 = r_s[2 * r + 1]; }
#pragma unroll
        for (int j = 0; j < 8; ++j) { const int c0 = 4 * (lane + 64 * j); { const u32x2 a_ = *(const u32x2*)(H + (size_t)r * D + c0); v[j] = (f32x4){bflo(a_.x), bfhi(a_.x), bflo(a_.y), bfhi(a_.y)}; }
            if (moe_last) {
                f32x4 ya, yb;
                const int t0 = tail_of[(s0 >> 8) * 8 + j], t1 = tail_of[(s1 >> 8) * 8 + j];
                if (t0) { ya = (f32x4){0.f, 0.f, 0.f, 0.f}; for (int p = 0; p < sp; ++p) ya += *(const f32x4*)(tacc + (size_t)((t0 - 1) * sp + p) * 65536 + (s0 & 255) * 256 + 4 * lane); }
                else { const u32x2 a = *(const u32x2*)(yg + (size_t)s0 * D + c0); ya = (f32x4){bflo(a.x), bfhi(a.x), bflo(a.y), bfhi(a.y)}; }
                if (t1) { yb = (f32x4){0.f, 0.f, 0.f, 0.f}; for (int p = 0; p < sp; ++p) yb += *(const f32x4*)(tacc + (size_t)((t1 - 1) * sp + p) * 65536 + (s1 & 255) * 256 + 4 * lane); }
                else { const u32x2 bb = *(const u32x2*)(yg + (size_t)s1 * D + c0); yb = (f32x4){bflo(bb.x), bfhi(bb.x), bflo(bb.y), bfhi(bb.y)}; }
                v[j] += g0 * ya + g1 * yb; }
            s += (v[j][0] * v[j][0] + v[j][1] * v[j][1]) + (v[j][2] * v[j][2] + v[j][3] * v[j][3]); }
        const float rstd = 1.0f / sqrtf(wave_sum(s) * (1.0f / D) + RMS_EPS);
#pragma unroll
        for (int j = 0; j < 8; ++j) { const int c0 = 4 * (lane + 64 * j); const f32x4 ww = *(const f32x4*)(w + c0);
            *(f32x4*)(F.outp() + (size_t)r * D + c0) = (f32x4){v[j][0] * rstd * ww[0], v[j][1] * rstd * ww[1], v[j][2] * rstd * ww[2], v[j][3] * rstd * ww[3]}; }
    }
}

DI float log_sigmoid_(float x) { return fminf(x, 0.f) - log1pf(expf(-fabsf(x))); }
DI float softplus_(float x) { return fmaxf(x, 0.f) + log1pf(expf(-fabsf(x))); }
DI void phase_prep(const Frame& F, int l) {
    const int gw = F.bid * 8 + F.wave, NGW = F.G * 8, lane = F.lane;
    const bf16_t* U = F.wp<bf16_t>(O_U); const float* SM = F.wp<float>(O_SM); const float* rope = F.wp<float>(O_ROPE);
    const float* qnorm = F.inp(13) + l * 512; const float* kvnorm = F.inp(15) + l * 256;
    const float* convw = F.inp(7) + (size_t)l * 4 * 1536; const float* convb = F.inp(8) + l * 1536;
    for (int r = gw; r < NTOK; r += NGW) {
        const int t = r % SEQ; const bf16_t* urow = U + (size_t)r * UWP; const float* smrow = SM + (size_t)r * 256;
        const int ckc = 8 * (lane & 31);
        const u32x4 wq = *(const u32x4*)(urow + UC_CQ + 8 * lane), wkv = *(const u32x4*)(urow + UC_CKV + ckc);
        const float sm_x1 = smrow[lane & 31], sm_x2 = smrow[32 + (lane & 31)], sm_gi = smrow[64 + (lane & 3)], sm_gf = smrow[68 + (lane & 3)], sm_dt = smrow[72 + (lane & 15)];
        const float rp_c = rope[2 * (t * 32 + (lane & 31))], rp_s = rope[2 * (t * 32 + (lane & 31)) + 1];
        u32x4 xw[3][4];
#pragma unroll
        for (int j = 0; j < 3; ++j)
#pragma unroll
            for (int tap = 0; tap < 4; ++tap) { const bool ok = (t - 3 + tap) >= 0;
                const u32x4 w = *(const u32x4*)(urow + (ok ? (long)(tap - 3) * UWP : 0l) + UC_XBC + 8 * lane + 512 * j);
                xw[j][tap].x = ok ? w.x : 0u; xw[j][tap].y = ok ? w.y : 0u; xw[j][tap].z = ok ? w.z : 0u; xw[j][tap].w = ok ? w.w : 0u; }
        {
            const u32x4 w = wq;
            float x[8] = {bflo(w.x), bfhi(w.x), bflo(w.y), bfhi(w.y), bflo(w.z), bfhi(w.z), bflo(w.w), bfhi(w.w)}; float s = 0.f;
#pragma unroll
            for (int i = 0; i < 8; ++i) s += x[i] * x[i];
            const float rstd = 1.0f / sqrtf(wave_sum(s) * (1.0f / 512) + RMS_EPS);
            const f32x4 n0 = *(const f32x4*)(qnorm + 8 * lane), n1 = *(const f32x4*)(qnorm + 8 * lane + 4);
            u32x4 o; o.x = cvt_pk_bf16(x[0] * rstd * n0[0], x[1] * rstd * n0[1]); o.y = cvt_pk_bf16(x[2] * rstd * n0[2], x[3] * rstd * n0[3]);
            o.z = cvt_pk_bf16(x[4] * rstd * n1[0], x[5] * rstd * n1[1]); o.w = cvt_pk_bf16(x[6] * rstd * n1[2], x[7] * rstd * n1[3]);
            *(u32x4*)(F.wp<bf16_t>(O_CQN) + (size_t)r * 512 + 8 * lane) = o;
        }
        {
            const int c = ckc;
            const u32x4 w = wkv;
            float x[8] = {bflo(w.x), bfhi(w.x), bflo(w.y), bfhi(w.y), bflo(w.z), bfhi(w.z), bflo(w.w), bfhi(w.w)}; float s = 0.f;
#pragma unroll
            for (int i = 0; i < 8; ++i) s += x[i] * x[i];
            if (lane >= 32) s = 0.f;
            const float rstd = 1.0f / sqrtf(wave_sum(s) * (1.0f / 256) + RMS_EPS);
            const f32x4 n0 = *(const f32x4*)(kvnorm + c), n1 = *(const f32x4*)(kvnorm + c + 4);
            u32x4 o; o.x = cvt_pk_bf16(x[0] * rstd * n0[0], x[1] * rstd * n0[1]); o.y = cvt_pk_bf16(x[2] * rstd * n0[2], x[3] * rstd * n0[3]);
            o.z = cvt_pk_bf16(x[4] * rstd * n1[0], x[5] * rstd * n1[1]); o.w = cvt_pk_bf16(x[6] * rstd * n1[2], x[7] * rstd * n1[3]);
            if (lane < 32) *(u32x4*)(F.wp<bf16_t>(O_CKVN) + (size_t)r * 256 + c) = o;
        }
        if (lane < 32) {
            const float x1 = sm_x1, x2 = sm_x2, cs = rp_c, sn = rp_s;
            bf16_t* kr = F.wp<bf16_t>(O_KR) + (size_t)r * 64;
            kr[lane] = f2bf(x1 * cs - x2 * sn); kr[32 + lane] = f2bf(x2 * cs + x1 * sn);
        }
        if (lane < 4) {
            F.wp<float>(O_GI)[(size_t)r * 4 + lane] = sm_gi + F.inp(4)[l * 4 + lane];
            F.wp<float>(O_LF)[(size_t)r * 4 + lane] = log_sigmoid_(sm_gf + F.inp(5)[l * 4 + lane]);
        }
        if (lane < 16) {
            const float dtv = softplus_(sm_dt + F.inp(9)[l * 16 + lane]);
            F.wp<float>(O_DT)[(size_t)r * 16 + lane] = dtv;
            F.wp<float>(O_DA)[(size_t)r * 16 + lane] = -dtv * expf(F.inp(10)[l * 16 + lane]);
        }
#pragma unroll
        for (int j = 0; j < 3; ++j) { const int c0 = 8 * lane + 512 * j;
            float y[8];
            { const f32x4 b0 = *(const f32x4*)(convb + c0), b1 = *(const f32x4*)(convb + c0 + 4); y[0] = b0[0]; y[1] = b0[1]; y[2] = b0[2]; y[3] = b0[3]; y[4] = b1[0]; y[5] = b1[1]; y[6] = b1[2]; y[7] = b1[3]; }
#pragma unroll
            for (int tap = 0; tap < 4; ++tap) { const u32x4 w = xw[j][tap];
                const f32x4 w0 = *(const f32x4*)(convw + tap * 1536 + c0), w1 = *(const f32x4*)(convw + tap * 1536 + c0 + 4);
                y[0] += bflo(w.x) * w0[0]; y[1] += bfhi(w.x) * w0[1]; y[2] += bflo(w.y) * w0[2]; y[3] += bfhi(w.y) * w0[3];
                y[4] += bflo(w.z) * w1[0]; y[5] += bfhi(w.z) * w1[1]; y[6] += bflo(w.w) * w1[2]; y[7] += bfhi(w.w) * w1[3]; }
            u32x4 o; o.x = cvt_pk_bf16(siluf_(y[0]), siluf_(y[1])); o.y = cvt_pk_bf16(siluf_(y[2]), siluf_(y[3])); o.z = cvt_pk_bf16(siluf_(y[4]), siluf_(y[5])); o.w = cvt_pk_bf16(siluf_(y[6]), siluf_(y[7]));
            *(u32x4*)(F.wp<bf16_t>(O_XBC) + (size_t)r * 1536 + c0) = o; }
    }
}

constexpr int ML_NC = SEQ / 64;
DI void mlstm_item(const Frame& F, int item) {
    const int vs = item & 7, hh = (item >> 3) & 3, b = item >> 5;
    int tid_ = F.tid; LAUNDER_V(tid_);
    const int tid = tid_, lane = tid & 63, w = F.wave, g = lane >> 4, lc = lane & 15;
    float* s_bb = (float*)F.lds; float* s_dd = s_bb + SEQ; float* s_cm = s_dd + SEQ; float* s_ch = s_cm + SEQ;
    bf16_t* sQ = (bf16_t*)(s_ch + 4 * ML_NC);
    bf16_t* sK = sQ + 64 * 136;
    bf16_t* sV = sK + 64 * 136;
    bf16_t* sVw = sV + 64 * 56;
    bf16_t* sCb = sVw + 64 * 56;
    const bf16_t* U = F.wp<bf16_t>(O_U); const float* GI = F.wp<float>(O_GI); const float* LF = F.wp<float>(O_LF);
    bf16_t* Ya = F.wp<bf16_t>(O_Y);
    const float scale = 0.08838834764831845f;
    const unsigned z0 = vzero();
    for (int i = tid; i < SEQ; i += NTHREADS) { const size_t row = (size_t)b * SEQ + i; s_dd[i] = GI[row * 4 + hh]; s_bb[i] = LF[row * 4 + hh]; }
    for (int i = tid; i < 48 * 136 / 2; i += NTHREADS) ((unsigned*)sCb)[i] = z0;
    __syncthreads();
    if (tid < ML_NC) { float acc = 0.f, cm = -3.0e38f;
        for (int t = 0; t < 64; ++t) { const int i = tid * 64 + t; acc += s_bb[i]; s_bb[i] = acc; const float d = s_dd[i] - acc; s_dd[i] = d; cm = fmaxf(cm, d); s_cm[i] = cm; } }
    __syncthreads();
    if (tid == 0) { float m = 0.f;
        for (int c = 0; c < ML_NC; ++c) { const float btot = s_bb[c * 64 + 63], cmL = s_cm[c * 64 + 63], mloc = btot + cmL, mnew = fmaxf(btot + m, mloc);
            s_ch[c] = m; s_ch[ML_NC + c] = fexp(btot + m - mnew); s_ch[2 * ML_NC + c] = fexp(mloc - mnew); s_ch[3 * ML_NC + c] = cmL; m = mnew; } }
    __syncthreads();
    f32x4 Cst[3][2];
#pragma unroll
    for (int a = 0; a < 3; ++a)
#pragma unroll
        for (int c = 0; c < 2; ++c) Cst[a][c] = (f32x4){0.f, 0.f, 0.f, 0.f};
    const bf16_t* Ub = U + (size_t)b * SEQ * UWP;
    u32x4 qr[2], kr[2], vr = {z0, z0, z0, z0};
#define ML_FETCH(c_) do { const bf16_t* ub_ = Ub + (size_t)(c_) * 64 * UWP; \
        _Pragma("unroll") for (int i_ = 0; i_ < 2; ++i_) { const unsigned ch_ = tid + i_ * NTHREADS, r_ = ch_ >> 4, cc_ = (ch_ & 15) * 8; \
            qr[i_] = *(const u32x4*)(ub_ + (r_ * (unsigned)UWP + UC_MLQ + hh * 128u + cc_)); kr[i_] = *(const u32x4*)(ub_ + (r_ * (unsigned)UWP + UC_MLK + hh * 128u + cc_)); } \
        if (tid < 256) { const unsigned r_ = tid >> 2, cc_ = (tid & 3) * 8; vr = *(const u32x4*)(ub_ + (r_ * (unsigned)UWP + UC_MLV + hh * 256u + vs * 32u + cc_)); } } while (0)
    ML_FETCH(0);
    for (int c = 0; c < ML_NC; ++c) {
        const float m_prev = s_ch[c], da = s_ch[ML_NC + c], db = s_ch[2 * ML_NC + c], cmL = s_ch[3 * ML_NC + c];
        const size_t row0 = (size_t)b * SEQ + c * 64;
#pragma unroll
        for (int i = 0; i < 2; ++i) { const int ch = tid + i * NTHREADS, r = ch >> 4, cc = (ch & 15) * 8;
            *(u32x4*)(sQ + r * 136 + cc) = qr[i]; *(u32x4*)(sK + r * 136 + cc) = kr[i]; }
        if (tid < 256) { const int r = tid >> 2, cc = (tid & 3) * 8;
            const u32x4 v = vr;
            *(u32x4*)(sV + r * 56 + cc) = v;
            const float wt = db * fexp(s_dd[c * 64 + r] - cmL) * scale;
            u32x4 o; o.x = cvt_pk_bf16(bflo(v.x) * wt, bfhi(v.x) * wt); o.y = cvt_pk_bf16(bflo(v.y) * wt, bfhi(v.y) * wt); o.z = cvt_pk_bf16(bflo(v.z) * wt, bfhi(v.z) * wt); o.w = cvt_pk_bf16(bflo(v.w) * wt, bfhi(v.w) * wt);
            *(u32x4*)(sVw + r * 56 + cc) = o;
        } else if (tid < 320) { const int r = tid - 256;
            const float wt = db * fexp(s_dd[c * 64 + r] - cmL) * scale;
            *(u32x4*)(sV + r * 56 + 32) = (u32x4){0x3F80u | z0, z0, z0, z0}; *(u32x4*)(sV + r * 56 + 40) = (u32x4){z0, z0, z0, z0};
            *(u32x4*)(sVw + r * 56 + 32) = (u32x4){(unsigned)f2bf(wt), z0, z0, z0}; *(u32x4*)(sVw + r * 56 + 40) = (u32x4){z0, z0, z0, z0};
        }
        __syncthreads();
        if (c + 1 < ML_NC) ML_FETCH(c + 1);
        if (w < 4) {
            const int sl = 16 * w + lc; const float mx = fmaxf(m_prev, s_cm[c * 64 + sl]), inter = fexp(m_prev - mx);
            bf16x8 bq[4];
#pragma unroll
            for (int kt = 0; kt < 4; ++kt) bq[kt] = frag_r(sQ, 136, 16 * w, 32 * kt, lane);
            f32x4 st[4];
#pragma unroll
            for (int j = 0; j < 4; ++j) st[j] = (f32x4){0.f, 0.f, 0.f, 0.f};
#pragma unroll
            for (int j = 0; j < 4; ++j) if (j <= w) {
#pragma unroll
                for (int kt = 0; kt < 4; ++kt) st[j] = mfma16(frag_r(sK, 136, 16 * j, 32 * kt, lane), bq[kt], st[j]);
                const f32x4 d4 = *(const f32x4*)(s_dd + c * 64 + 16 * j + 4 * g);
#pragma unroll
                for (int i = 0; i < 4; ++i) { const int t = 16 * j + 4 * g + i; st[j][i] = (t <= sl) ? fexp(d4[i] - mx) * st[j][i] * scale : 0.f; } }
            f32x4 n1[3], n2[3];
#pragma unroll
            for (int vt = 0; vt < 3; ++vt) { n1[vt] = (f32x4){0.f, 0.f, 0.f, 0.f}; n2[vt] = (f32x4){0.f, 0.f, 0.f, 0.f}; }
            const bf16_t* vb = sV + (4 * g + ((lane & 15) >> 2)) * 56 + 4 * (lane & 3);
#pragma unroll
            for (int ks = 0; ks < 2; ++ks) if (2 * ks <= w) {
                u32x4 pw; pw.x = cvt_pk_bf16(st[2 * ks][0], st[2 * ks][1]); pw.y = cvt_pk_bf16(st[2 * ks][2], st[2 * ks][3]); pw.z = cvt_pk_bf16(st[2 * ks + 1][0], st[2 * ks + 1][1]); pw.w = cvt_pk_bf16(st[2 * ks + 1][2], st[2 * ks + 1][3]);
                const bf16x8 pb = __builtin_bit_cast(bf16x8, pw);
#pragma unroll
                for (int vt = 0; vt < 3; ++vt) { const s16x4 lo = lds_tr4(vb + (32 * ks) * 56 + 16 * vt), hi = lds_tr4(vb + (32 * ks + 16) * 56 + 16 * vt);
                    n1[vt] = mfma16(__builtin_shufflevector(lo, hi, 0, 1, 2, 3, 4, 5, 6, 7), pb, n1[vt]); } }
#pragma unroll
            for (int kt = 0; kt < 4; ++kt)
#pragma unroll
                for (int vt = 0; vt < 3; ++vt) n2[vt] = mfma16(frag_r(sCb, 136, 16 * vt, 32 * kt, lane), bq[kt], n2[vt]);
            const float den = shfl_f(n1[2][0] + inter * n2[2][0], lc);
            const float inv = frcp(fmaxf(fabsf(den), fexp(-(s_bb[c * 64 + sl] + mx))));
#pragma unroll
            for (int vt = 0; vt < 2; ++vt) { u32x2 ov; ov.x = cvt_pk_bf16((n1[vt][0] + inter * n2[vt][0]) * inv, (n1[vt][1] + inter * n2[vt][1]) * inv);
                ov.y = cvt_pk_bf16((n1[vt][2] + inter * n2[vt][2]) * inv, (n1[vt][3] + inter * n2[vt][3]) * inv);
                *(u32x2*)(Ya + ((row0 + sl) * 1024 + hh * 256 + vs * 32 + 16 * vt + 4 * g)) = ov; }
        } else {
            const int j = w - 4;
#pragma unroll
            for (int mt = 0; mt < 3; ++mt)
#pragma unroll
                for (int nl = 0; nl < 2; ++nl) Cst[mt][nl] *= da;
#pragma unroll
            for (int kt = 0; kt < 2; ++kt) {
                bf16x8 bk[2];
#pragma unroll
                for (int nl = 0; nl < 2; ++nl) bk[nl] = frag_k(sK, 136, 32 * kt, 16 * (2 * j + nl), lane);
#pragma unroll
                for (int mt = 0; mt < 3; ++mt) { const bf16x8 a = frag_k(sVw, 56, 32 * kt, 16 * mt, lane);
#pragma unroll
                    for (int nl = 0; nl < 2; ++nl) Cst[mt][nl] = mfma16(a, bk[nl], Cst[mt][nl]); } }
        }
        __syncthreads();
        if (w >= 4) { const int j = w - 4;
#pragma unroll
            for (int mt = 0; mt < 3; ++mt)
#pragma unroll
                for (int nl = 0; nl < 2; ++nl)
#pragma unroll
                    for (int i = 0; i < 4; ++i) sCb[(16 * mt + 4 * g + i) * 136 + 16 * (2 * j + nl) + lc] = f2bf(Cst[mt][nl][i]); }
    }
#undef ML_FETCH
    __syncthreads();
}

constexpr int SS_NC = SEQ / 128;
DI void ssd_item(const Frame& F, int item, int l) {
    const int ps = item & 1, hd = (item >> 1) & 15, b = item >> 5, grp = hd >> 3;
    int tid_ = F.tid; LAUNDER_V(tid_);
    const int tid = tid_, lane = tid & 63, w = F.wave, g = lane >> 4, lc = lane & 15;
    float* s_acs = (float*)F.lds; float* s_dt = s_acs + 256;
    bf16_t* sC = (bf16_t*)(s_dt + 256);
    bf16_t* sB = sC + 128 * 136;
    bf16_t* sX = sB + 128 * 136;
    bf16_t* sXw = sX + 128 * 40;
    bf16_t* sHb = sXw + 128 * 40;
    const bf16_t* XBC = F.wp<bf16_t>(O_XBC) + (size_t)b * SEQ * 1536; const bf16_t* Uz = F.wp<bf16_t>(O_U) + (size_t)b * SEQ * UWP + UC_SSZ + hd * 64 + ps * 32;
    const float* DT = F.wp<float>(O_DT) + (size_t)b * SEQ * 16 + hd; const float* DA = F.wp<float>(O_DA) + (size_t)b * SEQ * 16 + hd;
    bf16_t* Yb = F.wp<bf16_t>(O_Y) + (size_t)NTOK * 1024 + (size_t)b * SEQ * 1024 + hd * 64 + ps * 32;
    const float Dh = F.inp(11)[l * 16 + hd];
    const unsigned z0 = vzero();
    for (int i = tid; i < 32 * 136 / 2; i += NTHREADS) ((unsigned*)sHb)[i] = z0;
    f32x4 Hst[2];
    Hst[0] = (f32x4){0.f, 0.f, 0.f, 0.f}; Hst[1] = (f32x4){0.f, 0.f, 0.f, 0.f};
    u32x4 cr[4], br[4], xr; float da0 = 0.f, da1 = 0.f, dtv = 0.f;
#define SSD_FETCH(c_) do { const bf16_t* xb_ = XBC + (size_t)(c_) * 128 * 1536; \
        _Pragma("unroll") for (int i_ = 0; i_ < 4; ++i_) { const unsigned ch_ = tid + i_ * NTHREADS, r_ = ch_ >> 4, cc_ = (ch_ & 15) * 8; \
            cr[i_] = *(const u32x4*)(xb_ + (r_ * 1536u + 1280u + grp * 128u + cc_)); br[i_] = *(const u32x4*)(xb_ + (r_ * 1536u + 1024u + grp * 128u + cc_)); } \
        { const unsigned r_ = tid >> 2, cc_ = (tid & 3) * 8; xr = *(const u32x4*)(xb_ + (r_ * 1536u + hd * 64u + ps * 32u + cc_)); } \
        if (w == 0) { da0 = DA[((c_) * 128 + 2 * lane) * 16]; da1 = DA[((c_) * 128 + 2 * lane + 1) * 16]; } else if (w < 3) dtv = DT[((c_) * 128 + tid - 64) * 16]; } while (0)
#define SSD_SCAN(nb_) do { if (w == 0) { float p_ = da0 + da1; \
            _Pragma("unroll") for (int off_ = 1; off_ < 64; off_ <<= 1) { const float t_ = shfl_f(p_, (lane - off_) & 63); if (lane >= off_) p_ += t_; } \
            s_acs[(nb_) * 128 + 2 * lane + 1] = p_; s_acs[(nb_) * 128 + 2 * lane] = p_ - da1; } \
        else if (w < 3) s_dt[(nb_) * 128 + tid - 64] = dtv; } while (0)
    SSD_FETCH(0);
    SSD_SCAN(0);
    __syncthreads();
    for (int c = 0; c < SS_NC; ++c) {
        const int row0 = c * 128; const float* acs = s_acs + (c & 1) * 128; const float* dtc = s_dt + (c & 1) * 128;
        const float acsL = acs[127];
#pragma unroll
        for (int i = 0; i < 4; ++i) { const int ch = tid + i * NTHREADS, r = ch >> 4, cc = (ch & 15) * 8; *(u32x4*)(sC + r * 136 + cc) = cr[i]; *(u32x4*)(sB + r * 136 + cc) = br[i]; }
        { const int r = tid >> 2, cc = (tid & 3) * 8; const u32x4 v = xr;
            *(u32x4*)(sX + r * 40 + cc) = v;
            const float wt = dtc[r] * fexp(acsL - acs[r]);
            u32x4 o; o.x = cvt_pk_bf16(bflo(v.x) * wt, bfhi(v.x) * wt); o.y = cvt_pk_bf16(bflo(v.y) * wt, bfhi(v.y) * wt); o.z = cvt_pk_bf16(bflo(v.z) * wt, bfhi(v.z) * wt); o.w = cvt_pk_bf16(bflo(v.w) * wt, bfhi(v.w) * wt);
            *(u32x4*)(sXw + r * 40 + cc) = o; }
        __syncthreads();
        u32x2 zr[2];
#pragma unroll
        for (int pt = 0; pt < 2; ++pt) zr[pt] = *(const u32x2*)(Uz + ((unsigned)(row0 + 16 * w + lc) * (unsigned)UWP + 16u * pt + 4u * g));
        if (c + 1 < SS_NC) SSD_FETCH(c + 1);
        {
            const int sl = 16 * w + lc; const float as = acs[sl];
            bf16x8 bq[4];
#pragma unroll
            for (int kt = 0; kt < 4; ++kt) bq[kt] = frag_r(sC, 136, 16 * w, 32 * kt, lane);
            f32x4 ct[8];
#pragma unroll
            for (int j = 0; j < 8; ++j) ct[j] = (f32x4){0.f, 0.f, 0.f, 0.f};
#pragma unroll
            for (int j = 0; j < 8; ++j) if (j <= w) {
#pragma unroll
                for (int kt = 0; kt < 4; ++kt) ct[j] = mfma16(frag_r(sB, 136, 16 * j, 32 * kt, lane), bq[kt], ct[j]);
                const f32x4 a4 = *(const f32x4*)(acs + 16 * j + 4 * g), d4 = *(const f32x4*)(dtc + 16 * j + 4 * g);
#pragma unroll
                for (int i = 0; i < 4; ++i) { const int t = 16 * j + 4 * g + i; ct[j][i] = (t <= sl) ? ct[j][i] * fexp(as - a4[i]) * d4[i] : 0.f; } }
            f32x4 y1[2], y2[2];
#pragma unroll
            for (int pt = 0; pt < 2; ++pt) { y1[pt] = (f32x4){0.f, 0.f, 0.f, 0.f}; y2[pt] = (f32x4){0.f, 0.f, 0.f, 0.f}; }
            const bf16_t* xb = sX + (4 * g + ((lane & 15) >> 2)) * 40 + 4 * (lane & 3);
#pragma unroll
            for (int ks = 0; ks < 4; ++ks) if (2 * ks <= w) {
                u32x4 pw; pw.x = cvt_pk_bf16(ct[2 * ks][0], ct[2 * ks][1]); pw.y = cvt_pk_bf16(ct[2 * ks][2], ct[2 * ks][3]); pw.z = cvt_pk_bf16(ct[2 * ks + 1][0], ct[2 * ks + 1][1]); pw.w = cvt_pk_bf16(ct[2 * ks + 1][2], ct[2 * ks + 1][3]);
                const bf16x8 pb = __builtin_bit_cast(bf16x8, pw);
#pragma unroll
                for (int pt = 0; pt < 2; ++pt) { const s16x4 lo = lds_tr4(xb + (32 * ks) * 40 + 16 * pt), hi = lds_tr4(xb + (32 * ks + 16) * 40 + 16 * pt);
                    y1[pt] = mfma16(__builtin_shufflevector(lo, hi, 0, 1, 2, 3, 4, 5, 6, 7), pb, y1[pt]); } }
#pragma unroll
            for (int kt = 0; kt < 4; ++kt)
#pragma unroll
                for (int pt = 0; pt < 2; ++pt) y2[pt] = mfma16(frag_r(sHb, 136, 16 * pt, 32 * kt, lane), bq[kt], y2[pt]);
            const float ea = fexp(as);
#pragma unroll
            for (int pt = 0; pt < 2; ++pt) { const u32x2 xw = *(const u32x2*)(sX + sl * 40 + 16 * pt + 4 * g);
                const float x0 = bflo(xw.x), x1 = bfhi(xw.x), x2 = bflo(xw.y), x3 = bfhi(xw.y), z0f = bflo(zr[pt].x), z1f = bfhi(zr[pt].x), z2f = bflo(zr[pt].y), z3f = bfhi(zr[pt].y);
                u32x2 ov; ov.x = cvt_pk_bf16((y1[pt][0] + ea * y2[pt][0] + x0 * Dh) * siluf_(z0f), (y1[pt][1] + ea * y2[pt][1] + x1 * Dh) * siluf_(z1f));
                ov.y = cvt_pk_bf16((y1[pt][2] + ea * y2[pt][2] + x2 * Dh) * siluf_(z2f), (y1[pt][3] + ea * y2[pt][3] + x3 * Dh) * siluf_(z3f));
                *(u32x2*)(Yb + ((unsigned)(row0 + sl) * 1024u + 16u * pt + 4u * g)) = ov; }
            const float cd = fexp(acsL);
            Hst[0] *= cd; Hst[1] *= cd;
#pragma unroll
            for (int kt = 0; kt < 4; ++kt) { const bf16x8 bb = frag_k(sB, 136, 32 * kt, 16 * w, lane);
#pragma unroll
                for (int mt2 = 0; mt2 < 2; ++mt2) Hst[mt2] = mfma16(frag_k(sXw, 40, 32 * kt, 16 * mt2, lane), bb, Hst[mt2]); }
        }
        if (c + 1 < SS_NC) SSD_SCAN((c + 1) & 1);
        __syncthreads();
#pragma unroll
        for (int mt2 = 0; mt2 < 2; ++mt2)
#pragma unroll
            for (int i = 0; i < 4; ++i) sHb[(16 * mt2 + 4 * g + i) * 136 + 16 * w + lc] = f2bf(Hst[mt2][i]);
    }
#undef SSD_FETCH
#undef SSD_SCAN
    __syncthreads();
}

constexpr int SW_NB = SEQ / 128;
DI void swa_item(const Frame& F, int item, int l) {
    const int nb = item % SW_NB, kvh = (item / SW_NB) & 3, b = item / (SW_NB * 4);
    int tid_ = F.tid; LAUNDER_V(tid_);
    const int tid = tid_, lane = tid & 63, w = F.wave, g = lane >> 4, lc = lane & 15;
    bf16_t* sK = (bf16_t*)F.lds;
    bf16_t* sV = sK + 256 * 72;
    const long rowb = (long)b * SEQ + (long)nb * 128 - 128;
    const bf16_t* Ub = F.wp<bf16_t>(O_U) + rowb * UWP; bf16_t* Yd = F.wp<bf16_t>(O_Y) + (size_t)3 * NTOK * 1024 + (rowb + 128) * 1024;
    const unsigned z0 = vzero();
#pragma unroll
    for (int i = 0; i < 4; ++i) { const unsigned ch = tid + i * NTHREADS, r = ch >> 3, cc = (ch & 7) * 8;
        u32x4 kv = {z0, z0, z0, z0}, vv = {z0, z0, z0, z0};
        if (nb > 0 || r >= 128) { kv = *(const u32x4*)(Ub + (r * (unsigned)UWP + UC_SWK + kvh * 64u + cc)); vv = *(const u32x4*)(Ub + (r * (unsigned)UWP + UC_SWV + kvh * 64u + cc)); }
        *(u32x4*)(sK + r * 72 + cc) = kv; *(u32x4*)(sV + r * 72 + cc) = vv; }
    if (tid < 128) { const int r = 256 + (tid >> 3), cc = (tid & 7) * 8; *(u32x4*)(sV + r * 72 + cc) = (u32x4){z0, z0, z0, z0}; }
    __syncthreads();
    const int hq = kvh * 4 + (w >> 1);
    const float sink2 = F.inp(17)[l * 16 + hq] * 1.4426950408889634f;
    for (int gi = 0; gi < 4; ++gi) {
        const int r0 = 64 * (w & 1) + 16 * gi;
        const unsigned qoff = (unsigned)(128 + r0 + lc) * (unsigned)UWP + UC_SWQ + hq * 64u + 8u * g;
        const bf16x8 bq0 = *(const bf16x8*)(Ub + qoff), bq1 = *(const bf16x8*)(Ub + (qoff + 32u));
        f32x4 st[10];
#pragma unroll
        for (int j = 0; j < 10; ++j) st[j] = (f32x4){0.f, 0.f, 0.f, 0.f};
#pragma unroll
        for (int j = 0; j < 9; ++j) { st[j] = mfma16(frag_r(sK, 72, r0 + 16 * j, 0, lane), bq0, st[j]); st[j] = mfma16(frag_r(sK, 72, r0 + 16 * j, 32, lane), bq1, st[j]); }
        const int qpos = 128 + r0 + lc;
        float mx = -3.0e38f;
#pragma unroll
        for (int j = 0; j < 9; ++j)
#pragma unroll
            for (int i = 0; i < 4; ++i) { const int tp = r0 + 16 * j + 4 * g + i; const bool ok = (tp <= qpos) && (qpos - tp < 128) && (nb > 0 || tp >= 128);
                const float v = ok ? st[j][i] * (0.125f * 1.4426950408889634f) : -3.0e38f; st[j][i] = v; mx = fmaxf(mx, v); }
        mx = fmaxf(mx, shfl_xor_f(mx, 16)); mx = fmaxf(mx, shfl_xor_f(mx, 32));
        mx = fmaxf(mx, sink2);
        float sum = 0.f;
#pragma unroll
        for (int j = 0; j < 9; ++j)
#pragma unroll
            for (int i = 0; i < 4; ++i) { const float e = fexp2(st[j][i] - mx); st[j][i] = e; sum += e; }
        sum += shfl_xor_f(sum, 16); sum += shfl_xor_f(sum, 32);
        sum += fexp2(sink2 - mx);
        const float inv = frcp(sum);
        f32x4 o[4];
#pragma unroll
        for (int nt = 0; nt < 4; ++nt) o[nt] = (f32x4){0.f, 0.f, 0.f, 0.f};
        const bf16_t* vb = sV + (r0 + 4 * g + ((lane & 15) >> 2)) * 72 + 4 * (lane & 3);
#pragma unroll
        for (int ks = 0; ks < 5; ++ks) {
            u32x4 pw; pw.x = cvt_pk_bf16(st[2 * ks][0], st[2 * ks][1]); pw.y = cvt_pk_bf16(st[2 * ks][2], st[2 * ks][3]); pw.z = cvt_pk_bf16(st[2 * ks + 1][0], st[2 * ks + 1][1]); pw.w = cvt_pk_bf16(st[2 * ks + 1][2], st[2 * ks + 1][3]);
            const bf16x8 pb = __builtin_bit_cast(bf16x8, pw);
#pragma unroll
            for (int nt = 0; nt < 4; ++nt) { const s16x4 lo = lds_tr4(vb + (32 * ks) * 72 + 16 * nt), hi = lds_tr4(vb + (32 * ks + 16) * 72 + 16 * nt);
                o[nt] = mfma16(__builtin_shufflevector(lo, hi, 0, 1, 2, 3, 4, 5, 6, 7), pb, o[nt]); } }
        const unsigned ooff = (unsigned)(r0 + lc) * 1024u + hq * 64u + 4u * g;
#pragma unroll
        for (int nt = 0; nt < 4; ++nt) { u32x2 ov; ov.x = cvt_pk_bf16(o[nt][0] * inv, o[nt][1] * inv); ov.y = cvt_pk_bf16(o[nt][2] * inv, o[nt][3] * inv); *(u32x2*)(Yd + (ooff + 16u * nt)) = ov; }
    }
    __syncthreads();
}

template <int DQK, bool MLA>
DI void attn_block(const Frame& F, const bf16_t* Qp, int ldq, const bf16_t* Kp, int ldk, const bf16_t* K2p  , const bf16_t* Vp, int ldv, bf16_t* Op, int ldo,
                   int nkt  , int qpos0  , float scale_log2e) {
    constexpr int PQ = DQK + 8, NKR = MLA ? 1 : 0, NKT = DQK / 32;
    int tid_ = F.tid; LAUNDER_V(tid_);
    const int tid = tid_, lane = tid & 63, w = F.wave, g = lane >> 4, lc = lane & 15;
    bf16_t* sK = (bf16_t*)F.lds;
    bf16_t* sV = sK + 2 * 64 * PQ;
    u32x4 kreg[2], rreg[1], vreg[2];
    unsigned koffb[2], voffb[2];
#pragma unroll
    for (int i_ = 0; i_ < 2; ++i_) { const unsigned c_ = tid + i_ * NTHREADS, r_ = c_ >> 4, ch_ = c_ & 15; koffb[i_] = (r_ * (unsigned)ldk + ch_ * 8u) * 2u; voffb[i_] = (r_ * (unsigned)ldv + ch_ * 8u) * 2u; }
    const unsigned roffb = ((tid >> 3) * 64u + (tid & 7) * 8u) * 2u;
#define ATTN_FETCH(t) do { int t_ = (t); LAUNDER_S(t_);     \
        const char* kb_ = (const char*)(Kp + (size_t)t_ * 64 * ldk); const char* vb_ = (const char*)(Vp + (size_t)t_ * 64 * ldv); const char* rb_ = (const char*)(K2p + (size_t)t_ * 64 * 64); \
        _Pragma("unroll") for (int i_ = 0; i_ < 2; ++i_) { kreg[i_] = *(const u32x4*)(kb_ + koffb[i_]); vreg[i_] = *(const u32x4*)(vb_ + voffb[i_]); } \
        _Pragma("unroll") for (int i_ = 0; i_ < NKR; ++i_) { rreg[i_] = *(const u32x4*)(rb_ + roffb); } } while (0)
#define ATTN_STORE(bf) do { bf16_t* k_ = sK + (bf) * 64 * PQ; bf16_t* v_ = sV + (bf) * 64 * 136; \
        _Pragma("unroll") for (int i_ = 0; i_ < 2; ++i_) { const int c_ = tid + i_ * NTHREADS, r_ = c_ >> 4, ch_ = c_ & 15; *(u32x4*)(k_ + r_ * PQ + ch_ * 8) = kreg[i_]; *(u32x4*)(v_ + r_ * 136 + ch_ * 8) = vreg[i_]; } \
        _Pragma("unroll") for (int i_ = 0; i_ < NKR; ++i_) { const int r_ = tid >> 3, ch_ = tid & 7; *(u32x4*)(k_ + r_ * PQ + 128 + ch_ * 8) = rreg[i_]; } } while (0)
    ATTN_FETCH(0);
    bf16x8 bq[2][NKT];
#pragma unroll
    for (int qg = 0; qg < 2; ++qg) { const unsigned qoff = (unsigned)(32 * w + 16 * qg + lc) * (unsigned)ldq + 8u * g;
#pragma unroll
        for (int kt = 0; kt < NKT; ++kt) bq[qg][kt] = *(const bf16x8*)(Qp + (qoff + 32u * kt));
        if constexpr (MLA) {
            const char* rpb = (const char*)F.wp<float>(O_ROPE); const unsigned rpo = 8u * ((unsigned)(qpos0 + 32 * w + 16 * qg + lc) * 32u + 8u * g);
            bf16x8 x1 = bq[qg][4], x2 = bq[qg][5];
#pragma unroll
            for (int j = 0; j < 4; ++j) { const f32x4 cs4 = *(const f32x4*)(rpb + (rpo + 16u * j));
#pragma unroll
              for (int h = 0; h < 2; ++h) { const int jj = 2 * j + h; const float a = bf2f((bf16_t)x1[jj]), c2 = bf2f((bf16_t)x2[jj]), cs = cs4[2 * h], sn = cs4[2 * h + 1];
                x1[jj] = (short)f2bf(a * cs - c2 * sn); x2[jj] = (short)f2bf(c2 * cs + a * sn); } }
#if 0
            for (int j = 0; j < 8; ++j) { const float a = 0, c2 = 0, cs = 0, sn = 0;
                x1[j] = (short)f2bf(a * cs - c2 * sn); x2[j] = (short)f2bf(c2 * cs + a * sn); }
#endif
            bq[qg][4] = x1; bq[qg][5] = x2; } }
    __syncthreads();
    ATTN_STORE(0);
    __syncthreads();
    f32x4 o[2][8]; float mrow[2] = {-3.0e38f, -3.0e38f}, lrow[2] = {0.f, 0.f};
#pragma unroll
    for (int qg = 0; qg < 2; ++qg)
#pragma unroll
        for (int nt = 0; nt < 8; ++nt) o[qg][nt] = (f32x4){0.f, 0.f, 0.f, 0.f};
    if (nkt > 1) ATTN_FETCH(1);
    for (int kt0 = 0; kt0 < nkt; ++kt0) {
        const bf16_t* cK = sK + (kt0 & 1) * 64 * PQ; const bf16_t* cV = sV + (kt0 & 1) * 64 * 136;
        if (kt0 + 1 < nkt) ATTN_STORE((kt0 + 1) & 1);
        if (kt0 + 2 < nkt) ATTN_FETCH(kt0 + 2);
        f32x4 st[2][4];
#pragma unroll
        for (int qg = 0; qg < 2; ++qg)
#pragma unroll
            for (int j = 0; j < 4; ++j) st[qg][j] = (f32x4){0.f, 0.f, 0.f, 0.f};
        {
            bf16x8 ak[2][4];
#pragma unroll
            for (int j = 0; j < 4; ++j) ak[0][j] = frag_r(cK, PQ, 16 * j, 0, lane);
#pragma unroll
            for (int kt = 0; kt < NKT; ++kt) {
                if (kt + 1 < NKT) {
#pragma unroll
                    for (int j = 0; j < 4; ++j) ak[(kt + 1) & 1][j] = frag_r(cK, PQ, 16 * j, 32 * (kt + 1), lane); }
#pragma unroll
                for (int j = 0; j < 4; ++j) { st[0][j] = mfma16(ak[kt & 1][j], bq[0][kt], st[0][j]); st[1][j] = mfma16(ak[kt & 1][j], bq[1][kt], st[1][j]); }
                SCHED_BAR(); } }
        const bool need_mask = MLA && (kt0 * 64 + 63 > qpos0 + 32 * w);
        bf16x8 pb[2][2];
        float mxq[2];
#pragma unroll
        for (int qg = 0; qg < 2; ++qg) {
            const int qp = qpos0 + 32 * w + 16 * qg + lc;
            float mx = -3.0e38f;
#pragma unroll
            for (int j = 0; j < 4; ++j)
#pragma unroll
                for (int i = 0; i < 4; ++i) { float v = st[qg][j][i] * scale_log2e;
                    if (need_mask) { const int kp = kt0 * 64 + 16 * j + 4 * g + i; v = (kp <= qp) ? v : -3.0e38f; }
                    st[qg][j][i] = v; mx = fmaxf(mx, v); }
            mx = fmaxf(mx, shfl_xor_f(mx, 16)); mx = fmaxf(mx, shfl_xor_f(mx, 32));
            mxq[qg] = mx; }
        if (wave_any((mxq[0] - mrow[0] > 8.0f) || (mxq[1] - mrow[1] > 8.0f))) {
#pragma unroll
            for (int qg = 0; qg < 2; ++qg) { const float mnew = fmaxf(mrow[qg], mxq[qg]), alpha = fexp2(mrow[qg] - mnew);
                lrow[qg] *= alpha; mrow[qg] = mnew;
#pragma unroll
                for (int nt = 0; nt < 8; ++nt) o[qg][nt] *= alpha; } }
#pragma unroll
        for (int qg = 0; qg < 2; ++qg) {
            const float mcur = mrow[qg];
            float sum = 0.f;
#pragma unroll
            for (int j = 0; j < 4; ++j)
#pragma unroll
                for (int i = 0; i < 4; ++i) { const float e = fexp2(st[qg][j][i] - mcur); st[qg][j][i] = e; sum += e; }
            sum += shfl_xor_f(sum, 16); sum += shfl_xor_f(sum, 32);
            lrow[qg] += sum;
#pragma unroll
            for (int ks = 0; ks < 2; ++ks) { u32x4 pw; pw.x = cvt_pk_bf16(st[qg][2 * ks][0], st[qg][2 * ks][1]); pw.y = cvt_pk_bf16(st[qg][2 * ks][2], st[qg][2 * ks][3]);
                pw.z = cvt_pk_bf16(st[qg][2 * ks + 1][0], st[qg][2 * ks + 1][1]); pw.w = cvt_pk_bf16(st[qg][2 * ks + 1][2], st[qg][2 * ks + 1][3]); pb[qg][ks] = __builtin_bit_cast(bf16x8, pw); }
        }
        {
            const bf16_t* vb = cV + (4 * g + ((lane & 15) >> 2)) * 136 + 4 * (lane & 3);
            bf16x8 av[2][4];
#define ATTN_LDV(dst, ks_, h_) do { _Pragma("unroll") for (int n_ = 0; n_ < 4; ++n_) { const s16x4 lo_ = lds_tr4(vb + (32 * (ks_)) * 136 + 16 * (4 * (h_) + n_)), hi_ = lds_tr4(vb + (32 * (ks_) + 16) * 136 + 16 * (4 * (h_) + n_)); \
                dst[n_] = __builtin_shufflevector(lo_, hi_, 0, 1, 2, 3, 4, 5, 6, 7); } } while (0)
            ATTN_LDV(av[0], 0, 0);
#pragma unroll
            for (int hs = 0; hs < 4; ++hs) { const int ks = hs >> 1, h = hs & 1;
                if (hs + 1 < 4) ATTN_LDV(av[(hs + 1) & 1], (hs + 1) >> 1, (hs + 1) & 1);
#pragma unroll
                for (int n = 0; n < 4; ++n) { o[0][4 * h + n] = mfma16(av[hs & 1][n], pb[0][ks], o[0][4 * h + n]); o[1][4 * h + n] = mfma16(av[hs & 1][n], pb[1][ks], o[1][4 * h + n]); }
                SCHED_BAR(); }
#undef ATTN_LDV
            PIN_ACC8(o[0]); PIN_ACC8(o[1]);
        }
        __syncthreads();
    }
#undef ATTN_FETCH
#undef ATTN_STORE
#pragma unroll
    for (int qg = 0; qg < 2; ++qg) { const float inv = frcp(lrow[qg]); int lid = lane; LAUNDER_V(lid);
        const unsigned ooff = (unsigned)(32 * w + 16 * qg + (lid & 15)) * (unsigned)ldo + 4u * (lid >> 4);
#pragma unroll
        for (int nt = 0; nt < 8; ++nt) { u32x2 ov; ov.x = cvt_pk_bf16(o[qg][nt][0] * inv, o[qg][nt][1] * inv); ov.y = cvt_pk_bf16(o[qg][nt][2] * inv, o[qg][nt][3] * inv); *(u32x2*)(Op + (ooff + 16u * nt)) = ov; } }
}
constexpr int NQB = SEQ / 256, NQP = (NQB + 1) / 2;
DI void mla_attn_item(const Frame& F, int item) {
    const int pj = item % NQP, hh = (item / NQP) & 7, b = item / (NQP * 8);
    const bf16_t* QF = F.wp<bf16_t>(O_QF); const bf16_t* KVF = F.wp<bf16_t>(O_KVF); const bf16_t* KR = F.wp<bf16_t>(O_KR); bf16_t* Yc = F.wp<bf16_t>(O_Y) + (size_t)2 * NTOK * 1024;
    const size_t rb = (size_t)b * SEQ;
    for (int k = 0; k < 2; ++k) { const int qb = k ? (NQB - 1 - pj) : pj;
        if (k == 1 && qb == pj) break;
        attn_block<192, true>(F, QF + (rb + qb * 256) * 1536 + hh * 192, 1536, KVF + rb * 2048 + hh * 256, 2048, KR + rb * 64, KVF + rb * 2048 + hh * 256 + 128, 2048,
                              Yc + (rb + qb * 256) * 1024 + hh * 128, 1024, (qb + 1) * 4, qb * 256, 0.07216878364870322f * 1.4426950408889634f); }
}
DI void xattn_item(const Frame& F, int item) {
    const int qb = item % NQB, hh = (item / NQB) & 3, b = item / (NQB * 4);
    const bf16_t* XQ = F.wp<bf16_t>(O_XQ); const bf16_t* XKV = F.wp<bf16_t>(O_XKV); bf16_t* XO = F.wp<bf16_t>(O_XO);
    attn_block<128, false>(F, XQ + ((size_t)b * SEQ + qb * 256) * 512 + hh * 128, 512, XKV + (size_t)b * MEMLEN * 1024 + hh * 128, 1024, nullptr,
                           XKV + (size_t)b * MEMLEN * 1024 + 512 + hh * 128, 1024, XO + ((size_t)b * SEQ + qb * 256) * 512 + hh * 128, 512, MEMLEN / 64, 0, 0.08838834764831845f * 1.4426950408889634f);
}

DI void phase_fixup(const Frame& F, int l) {
    const int gw = F.bid * 8 + F.wave, NGW = F.G * 8, lane = F.lane;
    bf16_t* Ya = F.wp<bf16_t>(O_Y); bf16_t* Yb = Ya + (size_t)NTOK * 1024; const bf16_t* U = F.wp<bf16_t>(O_U);
    const float* mlnorm = F.inp(6) + l * 1024; const float* ssnorm = F.inp(12) + l * 1024;
    for (int r = gw; r < NTOK; r += NGW) {
        u32x4 hva[2], hvb[2], ovp[2];
        hva[0] = *(const u32x4*)(Ya + (size_t)r * 1024 + 16 * lane); hva[1] = *(const u32x4*)(Ya + (size_t)r * 1024 + 16 * lane + 8);
        hvb[0] = *(const u32x4*)(Yb + (size_t)r * 1024 + 16 * lane); hvb[1] = *(const u32x4*)(Yb + (size_t)r * 1024 + 16 * lane + 8);
        ovp[0] = *(const u32x4*)(U + (size_t)r * UWP + UC_MLO + 16 * lane); ovp[1] = *(const u32x4*)(U + (size_t)r * UWP + UC_MLO + 16 * lane + 8);
        {   u32x4 hv[2]; float x[16]; float s = 0.f;
            hv[0] = hva[0]; hv[1] = hva[1];
#pragma unroll
            for (int k = 0; k < 2; ++k) { x[8 * k + 0] = bflo(hv[k].x); x[8 * k + 1] = bfhi(hv[k].x); x[8 * k + 2] = bflo(hv[k].y); x[8 * k + 3] = bfhi(hv[k].y); x[8 * k + 4] = bflo(hv[k].z); x[8 * k + 5] = bfhi(hv[k].z); x[8 * k + 6] = bflo(hv[k].w); x[8 * k + 7] = bfhi(hv[k].w); }
#pragma unroll
            for (int i = 0; i < 16; ++i) s += x[i] * x[i];
            s = grp16_sum(s);
            const float rstd = 1.0f / sqrtf(s * (1.0f / 256) + RMS_EPS);
            u32x4 ov[2]; ov[0] = ovp[0]; ov[1] = ovp[1];
            float og[16];
#pragma unroll
            for (int k = 0; k < 2; ++k) { og[8 * k + 0] = bflo(ov[k].x); og[8 * k + 1] = bfhi(ov[k].x); og[8 * k + 2] = bflo(ov[k].y); og[8 * k + 3] = bfhi(ov[k].y); og[8 * k + 4] = bflo(ov[k].z); og[8 * k + 5] = bfhi(ov[k].z); og[8 * k + 6] = bflo(ov[k].w); og[8 * k + 7] = bfhi(ov[k].w); }
            float y[16];
#pragma unroll
            for (int i = 0; i < 16; ++i) y[i] = sigmoidf_(og[i]) * x[i] * rstd * mlnorm[16 * lane + i];
            u32x4 o0, o1; o0.x = cvt_pk_bf16(y[0], y[1]); o0.y = cvt_pk_bf16(y[2], y[3]); o0.z = cvt_pk_bf16(y[4], y[5]); o0.w = cvt_pk_bf16(y[6], y[7]);
            o1.x = cvt_pk_bf16(y[8], y[9]); o1.y = cvt_pk_bf16(y[10], y[11]); o1.z = cvt_pk_bf16(y[12], y[13]); o1.w = cvt_pk_bf16(y[14], y[15]);
            *(u32x4*)(Ya + (size_t)r * 1024 + 16 * lane) = o0; *(u32x4*)(Ya + (size_t)r * 1024 + 16 * lane + 8) = o1; }
        {   u32x4 hv[2]; float x[16]; float s = 0.f;
            hv[0] = hvb[0]; hv[1] = hvb[1];
#pragma unroll
            for (int k = 0; k < 2; ++k) { x[8 * k + 0] = bflo(hv[k].x); x[8 * k + 1] = bfhi(hv[k].x); x[8 * k + 2] = bflo(hv[k].y); x[8 * k + 3] = bfhi(hv[k].y); x[8 * k + 4] = bflo(hv[k].z); x[8 * k + 5] = bfhi(hv[k].z); x[8 * k + 6] = bflo(hv[k].w); x[8 * k + 7] = bfhi(hv[k].w); }
#pragma unroll
            for (int i = 0; i < 16; ++i) s += x[i] * x[i];
            s = grp16_sum(s); s += shfl_xor_f(s, 16);
            const float rstd = 1.0f / sqrtf(s * (1.0f / 512) + RMS_EPS);
            float y[16];
#pragma unroll
            for (int i = 0; i < 16; ++i) y[i] = x[i] * rstd * ssnorm[16 * lane + i];
            u32x4 o0, o1; o0.x = cvt_pk_bf16(y[0], y[1]); o0.y = cvt_pk_bf16(y[2], y[3]); o0.z = cvt_pk_bf16(y[4], y[5]); o0.w = cvt_pk_bf16(y[6], y[7]);
            o1.x = cvt_pk_bf16(y[8], y[9]); o1.y = cvt_pk_bf16(y[10], y[11]); o1.z = cvt_pk_bf16(y[12], y[13]); o1.w = cvt_pk_bf16(y[14], y[15]);
            *(u32x4*)(Yb + (size_t)r * 1024 + 16 * lane) = o0; *(u32x4*)(Yb + (size_t)r * 1024 + 16 * lane + 8) = o1; }
    }
}

#ifndef PHMASK
#define PHMASK 0xFFFFFFFFu
#endif
#define EN(b) (((PHMASK) >> (b)) & 1u)
#ifndef REPMASK
#define REPMASK 0u
#endif
#define RP(b) (((REPMASK) >> (b)) & 1u)
constexpr int PH_PER_LAYER = 16, PH_FINAL = 1 + DEPTH * PH_PER_LAYER, PH_COUNT = PH_FINAL + 1;
#ifndef HOST_EMU
#define GEMM_LDS ((LAS unsigned char*)lds)
__global__ void __launch_bounds__(NTHREADS, 2) mk_fwd(Params P) {
    extern __shared__ __attribute__((aligned(16))) unsigned char lds[];
#else
#define GEMM_LDS (lds)
static void mk_fwd(Params P) {
    unsigned char* lds = emu::B->lds;
#endif
    const int wave0 = rfl((int)threadIdx.x >> 6);
    Frame F; make_frame(F, P, lds, wave0);
    int* misc = (int*)(lds + LDS_MISC);
    if (F.tid < 256) misc[F.tid] = 0;
    __syncthreads();
#ifndef HOST_EMU
    XcdBarrier bar; bar.bar = (unsigned*)(P.ws + O_CTL) + 4096; bar.x = 0; bar.st = nullptr; bar.wave = wave0;
    if (MK_N_LAUNCHES == 1) bar = xcd_barrier_post((unsigned*)(P.ws + O_CTL) + 4096, (volatile LAS unsigned*)(lds + LDS_MISC), wave0);
#define GRID_BAR() xcd_barrier(bar)
#else
#define GRID_BAR() emu::grid_sync()
#endif
    int* tile_e = misc + 16; int* pstart = misc + 16 + 160; int* ntiles = misc + 16 + 160 + 8; int* myoff = misc + 16 + 160 + 16;
    const int lo = P.ph_lo, hi = P.ph_hi;
#define IN(k) (lo <= (k) && (k) < hi)
#define SEAM(k) do { if (IN(k) && IN((k) + 1)) GRID_BAR(); } while (0)
    const int c = F.bid, cr = F.G - 1 - F.bid;

    if (EN(0) && IN(0)) for (int rep_ = 0; rep_ <= (int)RP(0); ++rep_) { REFRAME(); phase_prologue(F); REFRAME(); phase_rmsnorm_x(F, F.inp(0), F.inp(2)); }
    SEAM(0);
    for (int l = 0; l < DEPTH; ++l) {
        const int pb = 1 + l * PH_PER_LAYER;
        const bool moe = (l & 1) != 0;
#define HIN() (F.wp<bf16_t>(O_H))
#define HBUF() (F.wp<bf16_t>(O_H))
        if (l > 0) { if (EN(1) && IN(pb + 0)) for (int rep_ = 0; rep_ <= (int)RP(1); ++rep_) { REFRAME(); phase_rmsnorm(F, HBUF(), F.inp(2) + l * D); }
        SEAM(pb + 0); }
        if (EN(2) && IN(pb + 1)) for (int rep_ = 0; rep_ <= (int)RP(2); ++rep_) { REFRAME();
            pg8::Gemm g{HBUF(), D, F.wp<bf16_t>(O_WIN) + (size_t)l * UW * D, D, D}; pg8::OrdStatic S{NTOK / 256, UC_GATE / 256, F.G, c};
            pg8::EpiU E{F.wp<bf16_t>(O_U), F.wp<float>(O_SM), F.wp<float>(O_RSTD), (LAS float*)(GEMM_LDS + pg8::RS_TAB)};
            pg8::gemm_phase(GEMM_LDS, g, S, E, F.wave);
            {
                REFRAME();
                pg8::Gemm g8{(const bf16_t*)F.wp<unsigned char>(O_XN8), D / 2, (const bf16_t*)(F.wp<unsigned char>(O_WG8) + (size_t)l * 8192 * D), D / 2, D / 2};
                pg8::OrdStatic S8{NTOK / 256, 8192 / (128 * F8_NBJ), F.G, c};
                pg8::EpiGate8 E8{F.wp<unsigned char>(O_G8), 1.0f / (F8_ASCALE * F8_WSCALE)};
                pg8::gemm_phase_f8<pg8::EpiGate8, pg8::OrdStatic, true>(GEMM_LDS, g8, S8, E8, F.wave); }
#ifdef PROBE_NULL_WIN
            { pg8::EpiNull E0{F.wp<float>(O_CTL) + 1024}; pg8::gemm_phase(GEMM_LDS, g, S, E0, F.wave); }
#endif
#ifdef PROBE_L2_WIN
            { pg8::EpiUL2 E0{F.wp<bf16_t>(O_MACC) + (size_t)F.bid * 256 * 256}; pg8::gemm_phase(GEMM_LDS, g, S, E0, F.wave); }
#endif
        }
        SEAM(pb + 1);
        if (EN(3) && IN(pb + 2)) for (int rep_ = 0; rep_ <= (int)RP(3); ++rep_) { REFRAME(); phase_prep(F, l); }
        SEAM(pb + 2);
        if (IN(pb + 3)) {
            if (EN(4)) for (int rep_ = 0; rep_ <= (int)RP(4); ++rep_) { REFRAME(); pg8::Gemm g{F.wp<bf16_t>(O_CQN), 512, F.wp<bf16_t>(O_WUQ) + (size_t)l * 1536 * 512, 512, 512}; pg8::OrdStatic S{NTOK / 256, 1536 / 256, F.G, c};
              pg8::EpiBf16 E{F.wp<bf16_t>(O_QF), 1536}; pg8::gemm_phase(GEMM_LDS, g, S, E, F.wave); }
            if (EN(4)) for (int rep_ = 0; rep_ <= (int)RP(4); ++rep_) { REFRAME(); pg8::Gemm g{F.wp<bf16_t>(O_CKVN), 256, F.wp<bf16_t>(O_WUKV) + (size_t)l * 2048 * 256, 256, 256}; pg8::OrdStatic S{NTOK / 256, 2048 / 256, F.G, cr};
              pg8::EpiBf16 E{F.wp<bf16_t>(O_KVF), 2048}; pg8::gemm_phase(GEMM_LDS, g, S, E, F.wave); }
            __syncthreads();
            REFRAME(); if (EN(5)) for (int rep_ = 0; rep_ <= (int)RP(5); ++rep_) for (int it = c; it < BATCH * 4 * 8; it += F.G) mlstm_item(F, it);
            REFRAME(); if (EN(6)) for (int rep_ = 0; rep_ <= (int)RP(6); ++rep_) for (int it = cr; it < BATCH * 16 * 2; it += F.G) ssd_item(F, it, l);
            REFRAME(); if (EN(7)) for (int rep_ = 0; rep_ <= (int)RP(7); ++rep_) for (int it = c; it < BATCH * 4 * SW_NB; it += F.G) swa_item(F, it, l);
        }
        SEAM(pb + 3);
        if (IN(pb + 4)) {
            if (EN(8)) for (int rep_ = 0; rep_ <= (int)RP(8); ++rep_) for (int it = c; it < BATCH * 8 * NQP; it += F.G) mla_attn_item(F, it);
            REFRAME(); if (EN(9)) phase_fixup(F, l);
        }
        SEAM(pb + 4);
        if (EN(10) && IN(pb + 5)) for (int rep_ = 0; rep_ <= (int)RP(10); ++rep_) { REFRAME();
            pg8::Gemm g{F.wp<bf16_t>(O_Y), 1024, F.wp<bf16_t>(O_WBR) + (size_t)l * 4 * 2048 * 1024, 1024, 1024}; pg8::OrdMerge S{NTOK / 256, D / 256, F.G, c};
            pg8::EpiMerge E{F.wp<unsigned char>(O_G8), F.wp<bf16_t>(O_MERGED)};
            pg8::gemm_phase(GEMM_LDS, g, S, E, F.wave);
        }
        SEAM(pb + 5);
        if (EN(11) && IN(pb + 6)) for (int rep_ = 0; rep_ <= (int)RP(11); ++rep_) { REFRAME();
            pg8::Gemm g{F.wp<bf16_t>(O_MERGED), D, F.wp<bf16_t>(O_WOUT) + (size_t)l * D * D, D, D}; pg8::OrdStatic S{NTOK / 256, D / 256, F.G, c};
            pg8::EpiResidT<true> E{HIN(), HBUF(), F.wp<float>(O_SSQ)};
            pg8::gemm_phase(GEMM_LDS, g, S, E, F.wave);
        }
        SEAM(pb + 6);
        if (EN(12) && IN(pb + 8)) for (int rep_ = 0; rep_ <= (int)RP(12); ++rep_) { REFRAME();
            { pg8::Gemm g{HBUF(), D, F.wp<bf16_t>(O_WXQ) + (size_t)l * 512 * D, D, D}; pg8::OrdStatic S{NTOK / 256, 512 / 256, F.G, c};
              pg8::EpiBf16R E{F.wp<bf16_t>(O_XQ), 512, F.wp<float>(O_SSQ), (LAS float*)(GEMM_LDS + pg8::RS_TAB)}; pg8::gemm_phase(GEMM_LDS, g, S, E, F.wave); }
            { REFRAME(); pg8::Gemm g{F.wp<bf16_t>(O_MEMN) + (size_t)l * NMEM * D, D, F.wp<bf16_t>(O_WXKV) + (size_t)l * 1024 * D, D, D}; pg8::OrdStatic S{NMEM / 256, 1024 / 256, F.G, cr};
              pg8::EpiBf16 E{F.wp<bf16_t>(O_XKV), 1024}; pg8::gemm_phase(GEMM_LDS, g, S, E, F.wave); }
        }
        SEAM(pb + 8);
        if (EN(13) && IN(pb + 9)) for (int rep_ = 0; rep_ <= (int)RP(13); ++rep_) { REFRAME(); for (int it = c; it < BATCH * 4 * NQB; it += F.G) xattn_item(F, it); }
        SEAM(pb + 9);
        if (EN(14) && IN(pb + 10)) for (int rep_ = 0; rep_ <= (int)RP(14); ++rep_) { REFRAME();
            pg8::Gemm g{F.wp<bf16_t>(O_XO), 512, F.wp<bf16_t>(O_WXO) + (size_t)l * D * 512, 512, 512}; pg8::OrdStatic S{NTOK / 256, D / 256, F.G, c};
            if (!moe) { pg8::EpiResidT<true> E{HBUF(), HBUF(), F.wp<float>(O_SSQ)}; pg8::gemm_phase(GEMM_LDS, g, S, E, F.wave); }
            else { pg8::EpiResid E{HBUF(), HBUF(), nullptr}; pg8::gemm_phase(GEMM_LDS, g, S, E, F.wave); }
        }
        SEAM(pb + 10);
        if (!moe) {
            if (EN(15) && IN(pb + 12)) for (int rep_ = 0; rep_ <= (int)RP(15); ++rep_) { REFRAME();
                pg8::Gemm g{HBUF(), D, F.wp<bf16_t>(O_W13), D, D}; pg8::OrdStatic S{NTOK / 256, 2 * FFN / 256, F.G, c};
                pg8::EpiSwiGLUR E{F.wp<bf16_t>(O_ACT), F.wp<float>(O_SSQ), (LAS float*)(GEMM_LDS + pg8::RS_TAB)};
                pg8::gemm_phase(GEMM_LDS, g, S, E, F.wave);
            }
            SEAM(pb + 12);
            if (EN(16) && IN(pb + 13)) for (int rep_ = 0; rep_ <= (int)RP(16); ++rep_) { REFRAME();
                pg8::Gemm g{F.wp<bf16_t>(O_ACT), FFN, F.wp<bf16_t>(O_W2), FFN, FFN}; pg8::OrdStatic S{NTOK / 256, D / 256, F.G, c};
                pg8::EpiResid E{HBUF(), HBUF(), nullptr};
                pg8::gemm_phase(GEMM_LDS, g, S, E, F.wave);
            }
            if (IN(pb + 13) && IN(pb + PH_PER_LAYER)) GRID_BAR();
        } else {
            if (EN(17) && IN(pb + 11)) for (int rep_ = 0; rep_ <= (int)RP(17); ++rep_) { REFRAME(); phase_rmsnorm_route(F, HBUF(), F.inp(25) + l * D, F.inp(28)); }
            SEAM(pb + 11);
            if (EN(18) && IN(pb + 12)) for (int rep_ = 0; rep_ <= (int)RP(18); ++rep_) { REFRAME(); phase_moe_scatter(F, tile_e, pstart, ntiles, myoff); }
            SEAM(pb + 12);
            if (EN(19) && IN(pb + 13)) for (int rep_ = 0; rep_ <= (int)RP(19); ++rep_) { REFRAME();
                if (!IN(pb + 12)) moe_tables(F, tile_e, pstart, ntiles);
                pg8::Gemm g{(const bf16_t*)F.wp<unsigned char>(O_XG), D / 2, (const bf16_t*)F.wp<unsigned char>(O_MW13), D / 2, D / 2}; pg8::OrdMoe S{*ntiles, 2 * FFN / (128 * F8_NBJ), F.G, c, tile_e, 1 << 30};
                pg8::EpiSwiGLU8<F8_NBJ> E{F.wp<unsigned char>(O_ACTM), 1.0f / (F8_ASCALE * F8_WSCALE)};
                pg8::gemm_phase_f8<pg8::EpiSwiGLU8<F8_NBJ>, pg8::OrdMoe, F8_FULL != 0>(GEMM_LDS, g, S, E, F.wave);
            }
            SEAM(pb + 13);
            if (EN(20) && IN(pb + 14)) for (int rep_ = 0; rep_ <= (int)RP(20); ++rep_) { REFRAME();
                if (!IN(pb + 13)) moe_tables(F, tile_e, pstart, ntiles);
                int full, R, sp; pg8::moe_tail_split(*ntiles, F.G, full, R, sp);
                { pg8::Gemm g{(const bf16_t*)F.wp<unsigned char>(O_ACTM), FFN / 2, (const bf16_t*)F.wp<unsigned char>(O_MW2), FFN / 2, FFN / 2}; pg8::OrdMoe S{*ntiles, D / 256, F.G, c, tile_e, full};
                  pg8::EpiBf16S<2> E{F.wp<bf16_t>(O_YG), D, 1.0f / (F8_ASCALE * F8_WSCALE)};
                  pg8::gemm_phase_f8<pg8::EpiBf16S<2>, pg8::OrdMoe, true>(GEMM_LDS, g, S, E, F.wave); }
                if (R > 0) {
                    REFRAME();
                    const int uix = c / sp, kp = c - uix * sp, Kp = FFN / sp;
                    pg8::OrdOne S1; S1.valid = (uix < R); S1.u.pm = 0; S1.u.pn = 0; S1.u.pa = 0; S1.u.pb = 0; S1.u.aux = 0; S1.u.ui = 0;
                    if (S1.valid) { pg8::static_map((long)full * F.G + uix, *ntiles, D / 256, S1.u.pm, S1.u.pn); S1.u.aux = tile_e[S1.u.pm]; S1.u.pa = S1.u.pm; S1.u.pb = S1.u.aux * (D / 256) + S1.u.pn; }
                    pg8::Gemm g1{(const bf16_t*)(F.wp<unsigned char>(O_ACTM) + (size_t)kp * Kp), FFN / 2, (const bf16_t*)(F.wp<unsigned char>(O_MW2) + (size_t)kp * Kp), FFN / 2, Kp / 2};
                    pg8::EpiPart E1{F.wp<float>(O_TAILACC) + (size_t)(S1.valid ? c : 0) * 65536, 1.0f / (F8_ASCALE * F8_WSCALE)};
                    pg8::gemm_phase_f8<pg8::EpiPart, pg8::OrdOne, true>(GEMM_LDS, g1, S1, E1, F.wave);
                }
            }
            if (IN(pb + 14) && IN(pb + PH_PER_LAYER)) GRID_BAR();
        }
    }
    if (EN(21) && IN(PH_FINAL)) for (int rep_ = 0; rep_ <= (int)RP(21); ++rep_) { REFRAME(); if (!IN(PH_FINAL - 2) && (((DEPTH - 1) & 1) != 0)) moe_tables(F, tile_e, pstart, ntiles); phase_final(F, ((DEPTH - 1) & 1) != 0, ntiles, (unsigned char*)(misc + 256)); }
#undef IN
#undef SEAM
}

#ifndef HOST_EMU
extern "C" void kernel_launch(void* const* d_in, const int* in_sizes, int n_in, void* d_out, int out_size, void* d_ws, size_t ws_size, hipStream_t stream) {
    static int grid = 0;
    if (grid == 0) {
        if (n_in != 32 || in_sizes[0] != NTOK * D || out_size != NTOK * D || ws_size < WS_END) {
            fprintf(stderr, "kernel_launch: shape/workspace mismatch: n_in %d in0 %d out %d ws %zu (need %zu)\n", n_in, n_in > 0 ? in_sizes[0] : -1, out_size, ws_size, (size_t)WS_END); grid = -1; return; }
        int dev = 0, cus = 0, per_cu = 0;
        if (hipGetDevice(&dev) != hipSuccess || hipDeviceGetAttribute(&cus, hipDeviceAttributeMultiprocessorCount, dev) != hipSuccess) { grid = -1; return; }
        if (hipFuncSetAttribute((const void*)mk_fwd, hipFuncAttributeMaxDynamicSharedMemorySize, LDS_BYTES) != hipSuccess) { fprintf(stderr, "kernel_launch: hipFuncSetAttribute failed\n"); grid = -1; return; }
        if (hipOccupancyMaxActiveBlocksPerMultiprocessor(&per_cu, (const void*)mk_fwd, NTHREADS, LDS_BYTES) != hipSuccess || per_cu < 1)
            fprintf(stderr, "kernel_launch: occupancy query reports %d workgroups per CU\n", per_cu);
        (void)hipGetLastError();
        grid = cus;
    }
    if (grid < 0) return;
    if (hipMemsetAsync((char*)d_ws + O_CTL, 0, SZ_CTL, stream) != hipSuccess) { fprintf(stderr, "kernel_launch: memset failed\n"); return; }
    Params p{};
    for (int i = 0; i < 32; ++i) p.in[i] = (const float*)d_in[i];
    p.out = (float*)d_out; p.ws = (unsigned char*)d_ws;
    if (MK_N_LAUNCHES == 1) {
        p.ph_lo = 0; p.ph_hi = PH_COUNT;
        hipLaunchKernelGGL(mk_fwd, dim3(grid), dim3(NTHREADS), LDS_BYTES, stream, p);
    } else {
        for (int ph = 0; ph < PH_COUNT; ++ph) {
            const int k = (ph - 1) % PH_PER_LAYER, l = (ph - 1) / PH_PER_LAYER;
            if (ph >= 1 && ph < PH_FINAL && (k == 15 || (k == 14 && (l & 1) == 0) || (k == 0 && l == 0))) continue;
            p.ph_lo = ph; p.ph_hi = ph + 1;
            hipLaunchKernelGGL(mk_fwd, dim3(grid), dim3(NTHREADS), LDS_BYTES, stream, p);
        }
    }
    const hipError_t le = hipPeekAtLastError();
    if (le != hipSuccess) fprintf(stderr, "kernel_launch: launch failed: %s\n", hipGetErrorName(le));
}
#endif
```

```cpp
#ifndef HOST_EMU
#include <hip/hip_runtime.h>
#endif
#include <cstdio>
#include <cstdint>
#include <cstddef>

#ifndef CFG_BATCH
#define CFG_BATCH 8
#endif
#ifndef CFG_SEQ
#define CFG_SEQ 2048
#endif
#ifndef MK_N_LAUNCHES
#define MK_N_LAUNCHES 1
#endif

typedef unsigned short bf16_t;
#ifndef HOST_EMU
#define DI __device__ __forceinline__
#define LAS __attribute__((address_space(3)))
#define GAS __attribute__((address_space(1)))
typedef short bf16x8 __attribute__((ext_vector_type(8)));
typedef short s16x4 __attribute__((ext_vector_type(4)));
typedef float f32x4 __attribute__((ext_vector_type(4)));
typedef float f32x2 __attribute__((ext_vector_type(2)));
typedef unsigned u32x4 __attribute__((ext_vector_type(4)));
typedef unsigned u32x2 __attribute__((ext_vector_type(2)));
DI f32x4 mfma16(bf16x8 a, bf16x8 b, f32x4 c) { return __builtin_amdgcn_mfma_f32_16x16x32_bf16(a, b, c, 0, 0, 0); }
DI s16x4 lds_tr4(const void* p) { return __builtin_amdgcn_ds_read_tr16_b64_v4i16((LAS s16x4*)(p)); }
DI float shfl_xor_f(float v, int m) { return __shfl_xor(v, m); }
DI float shfl_f(float v, int src) { return __shfl(v, src); }
DI int shfl_xor_i(int v, int m) { return __shfl_xor(v, m); }
DI int rfl(int v) { return __builtin_amdgcn_readfirstlane(v); }
DI int lane_id_hw() { return (int)__builtin_amdgcn_mbcnt_hi(~0u, __builtin_amdgcn_mbcnt_lo(~0u, 0u)); }
DI float fexp2(float x) { return __builtin_amdgcn_exp2f(x); }
DI float fexp(float x) { return __expf(x); }
DI float flog(float x) { return __logf(x); }
DI float frcp(float x) { return __builtin_amdgcn_rcpf(x); }
DI float frsqrt(float x) { return __builtin_amdgcn_rsqf(x); }
DI float fsin_rev(float rev) { return __builtin_amdgcn_sinf(rev); }
DI float fcos_rev(float rev) { return __builtin_amdgcn_cosf(rev); }
DI int atomic_add_i(int* p, int v) { return __hip_atomic_fetch_add(p, v, __ATOMIC_RELAXED, __HIP_MEMORY_SCOPE_AGENT); }
DI int lds_atomic_add_i(int* p, int v) { return __hip_atomic_fetch_add(p, v, __ATOMIC_RELAXED, __HIP_MEMORY_SCOPE_WORKGROUP); }
DI void atomic_add_f(float* p, float v) { (void)__hip_atomic_fetch_add(p, v, __ATOMIC_RELAXED, __HIP_MEMORY_SCOPE_AGENT); }
DI unsigned cvt_pk_bf16(float lo, float hi) { unsigned r; asm volatile("s_nop 0\n\tv_cvt_pk_bf16_f32 %0, %1, %2" : "=v"(r) : "v"(lo), "v"(hi)); return r; }
#define WAVE_FENCE() asm volatile("s_waitcnt lgkmcnt(0)" ::: "memory")
#define SCHED_BAR() __builtin_amdgcn_sched_barrier(0)
#define PIN_ACC8(a) asm volatile("" : "+v"((a)[0]), "+v"((a)[1]), "+v"((a)[2]), "+v"((a)[3]), "+v"((a)[4]), "+v"((a)[5]), "+v"((a)[6]), "+v"((a)[7]))
DI float u2f(unsigned u) { return __uint_as_float(u); }
DI unsigned f2u(float f) { return __float_as_uint(f); }
#else
#define DI inline __attribute__((always_inline))
#define WAVE_FENCE() emu::wave_sync()
#define SCHED_BAR()
#define PIN_ACC8(a)
DI float u2f(unsigned u) { float f; memcpy(&f, &u, 4); return f; }
DI unsigned f2u(float f) { unsigned u; memcpy(&u, &f, 4); return u; }
#endif

#ifndef HOST_EMU
#define LAUNDER_V(x) asm volatile("" : "+v"(x))
#define LAUNDER_S(x) asm volatile("" : "+s"(x))
#else
#define LAUNDER_V(x)
#define LAUNDER_S(x)
#endif
#ifndef HOST_EMU
typedef int i32x8 __attribute__((ext_vector_type(8)));
DI unsigned cvt_pk4_fp8(float a, float b, float c, float d) { int v = __builtin_amdgcn_cvt_pk_fp8_f32(a, b, 0, false); v = __builtin_amdgcn_cvt_pk_fp8_f32(c, d, v, true); return (unsigned)v; }
#else
DI unsigned f2fp8_host(float f) {
    unsigned s = f < 0.f ? 0x80u : 0u; float a = fabsf(f); if (!(a == a)) return s | 0x7f; if (a >= 448.f) return s | 0x7e;
    if (a < 0.0009765625f) return s;
    int e; float m = frexpf(a, &e); e -= 1; m *= 2.f;
    if (e < -6) { const float q = a * 512.f; int n = (int)lrintf(q); return s | (unsigned)n; }
    int n = (int)lrintf((m - 1.f) * 8.f); if (n == 8) { n = 0; e += 1; } if (e > 8 || (e == 8 && n > 6)) return s | 0x7e;
    return s | (unsigned)((e + 7) << 3) | (unsigned)n; }
DI unsigned cvt_pk4_fp8(float a, float b, float c, float d) { return f2fp8_host(a) | (f2fp8_host(b) << 8) | (f2fp8_host(c) << 16) | (f2fp8_host(d) << 24); }
DI float fp82f_host(unsigned v) { const unsigned s = v & 0x80u, e = (v >> 3) & 15u, m = v & 7u; float r = e == 0 ? (float)m * 0.001953125f : (1.f + (float)m * 0.125f) * exp2f((float)e - 7.f); return s ? -r : r; }
#endif
constexpr float F8_ASCALE = 16.0f, F8_WSCALE = 1024.0f;
#ifndef F8_FULL
#define F8_FULL 1
#endif
constexpr int F8_NBJ = F8_FULL ? 2 : 1;
DI float bf2f(bf16_t b) { return u2f(((unsigned)b) << 16); }
DI bf16_t f2bf(float f) { unsigned u = f2u(f); return (bf16_t)((u + 0x7fffu + ((u >> 16) & 1u)) >> 16); }
DI float bflo(unsigned w) { return u2f(w << 16); }
DI float bfhi(unsigned w) { return u2f(w & 0xffff0000u); }
DI float wave_sum(float v) {
#pragma unroll
    for (int o = 1; o < 64; o <<= 1) v += shfl_xor_f(v, o);
    return v;
}
#ifndef HOST_EMU
DI bool wave_any(bool p) { return __any(p ? 1 : 0) != 0; }
#else
DI bool wave_any(bool p) { int v = p ? 1 : 0;
    for (int o = 1; o < 64; o <<= 1) v |= shfl_xor_i(v, o);
    return v != 0; }
#endif
DI unsigned vzero() { unsigned z = 0u; LAUNDER_V(z); return z; }
DI float sigmoidf_(float x) { return frcp(1.0f + fexp(-x)); }
DI float siluf_(float x) { return x * frcp(1.0f + fexp(-x)); }

constexpr int BATCH = CFG_BATCH, SEQ = CFG_SEQ, NTOK = BATCH * SEQ, D = 2048, DEPTH = 2, MEMLEN = 256, NMEM = BATCH * MEMLEN;
constexpr int IN_TOTAL = 16216, UW = 16384, UWP = UW + 64;
constexpr float RMS_EPS = 1e-6f;
constexpr int FFN = 7168, NEXP = 8;
constexpr int UC_MLQ = 0, UC_MLK = 512, UC_MLV = 1024, UC_MLO = 2048, UC_SSZ = 3072, UC_XBC = 4096, UC_CQ = 5632, UC_CKV = 6144, UC_SM = 6400,
              UC_SWQ = 6656, UC_SWK = 7680, UC_SWV = 7936, UC_GATE = 8192;
constexpr int SM_TILE = UC_SM / 256;
constexpr int SO_MLI = 3072, SO_SSZ = 3080, SO_XBC = 4104, SO_DT = 5640, SO_CQ = 5656, SO_CKV = 6168, SO_KR = 6424, SO_SWQ = 6488, SO_SWK = 7512, SO_SWV = 7768, SO_GATE = 8024;
constexpr int SLOTS = 2 * NTOK + NEXP * 256;
constexpr int MAXTILES = SLOTS / 256;

constexpr size_t al256(size_t x) { return (x + 255) & ~(size_t)255; }
constexpr size_t O_CTL = 0, SZ_CTL = 1u << 20;
constexpr size_t O_WIN = O_CTL + SZ_CTL;
constexpr size_t O_WUQ = O_WIN + (size_t)DEPTH * UW * D * 2;
constexpr size_t O_WUKV = O_WUQ + (size_t)DEPTH * 1536 * 512 * 2;
constexpr size_t O_WBR = O_WUKV + (size_t)DEPTH * 2048 * 256 * 2;
constexpr size_t O_WOUT = O_WBR + (size_t)DEPTH * 4 * 2048 * 1024 * 2;
constexpr size_t O_WXQ = O_WOUT + (size_t)DEPTH * 2048 * 2048 * 2;
constexpr size_t O_WXKV = O_WXQ + (size_t)DEPTH * 512 * 2048 * 2;
constexpr size_t O_WXO = O_WXKV + (size_t)DEPTH * 1024 * 2048 * 2;
constexpr size_t O_W13 = O_WXO + (size_t)DEPTH * 2048 * 512 * 2;
constexpr size_t O_W2 = O_W13 + (size_t)2 * FFN * D * 2;
constexpr size_t O_MW13 = O_W2 + (size_t)D * FFN * 2;
constexpr size_t O_MW2 = O_MW13 + (size_t)NEXP * 2 * FFN * D * 2;
constexpr size_t O_ROPE = O_MW2 + (size_t)NEXP * D * FFN * 2;
constexpr size_t O_H = al256(O_ROPE + (size_t)SEQ * 64 * 4);
constexpr size_t O_G8 = O_H + (size_t)NTOK * D * 2;
constexpr size_t O_XN = O_H + (size_t)NTOK * D * 4;
constexpr size_t O_MEMN = O_XN + (size_t)NTOK * D * 2;
constexpr size_t O_U = O_MEMN + (size_t)DEPTH * NMEM * D * 2;
constexpr size_t O_SM = O_U + (size_t)NTOK * UWP * 2;
constexpr size_t O_CQN = O_SM + (size_t)NTOK * 256 * 4;
constexpr size_t O_CKVN = O_CQN + (size_t)NTOK * 512 * 2;
constexpr size_t O_KR = O_CKVN + (size_t)NTOK * 256 * 2;
constexpr size_t O_XBC = O_KR + (size_t)NTOK * 64 * 2;
constexpr size_t O_DT = O_XBC + (size_t)NTOK * 1536 * 2;
constexpr size_t O_DA = O_DT + (size_t)NTOK * 16 * 4;
constexpr size_t O_GI = O_DA + (size_t)NTOK * 16 * 4;
constexpr size_t O_LF = O_GI + (size_t)NTOK * 4 * 4;
constexpr size_t O_QF = O_LF + (size_t)NTOK * 4 * 4;
constexpr size_t O_KVF = O_QF + (size_t)NTOK * 1536 * 2;
constexpr size_t O_Y = O_KVF + (size_t)NTOK * 2048 * 2;
constexpr size_t O_MACC = O_Y + (size_t)4 * NTOK * 1024 * 2;
constexpr size_t O_SSQ = O_MACC;
constexpr size_t O_RSTD = O_SSQ + (size_t)NTOK * 32 * 4;
constexpr size_t O_MERGED = O_MACC + (size_t)NTOK * D * 4;
constexpr size_t O_XQ = O_MERGED + (size_t)NTOK * D * 2;
constexpr size_t O_XKV = O_XQ + (size_t)NTOK * 512 * 2;
constexpr size_t O_XO = O_XKV + (size_t)NMEM * 1024 * 2;
constexpr size_t O_ACT = O_XO + (size_t)NTOK * 512 * 2;
constexpr size_t O_XG = O_ACT + (size_t)NTOK * FFN * 2;
constexpr size_t O_YG = O_XG + (size_t)SLOTS * D * 2;
constexpr size_t O_ROUTE = O_YG + (size_t)SLOTS * D * 2;
constexpr size_t O_BLKCNT = O_ROUTE + (size_t)NTOK * 2 * 4 * 3;
constexpr size_t O_TAILACC = al256(O_BLKCNT + 1024 * 8 * 4);
constexpr size_t O_XN8 = al256(O_TAILACC + (size_t)256 * 65536 * 4);
constexpr size_t O_WG8 = O_XN8 + (size_t)NTOK * D;
constexpr size_t O_ACTM = al256(O_WG8 + (size_t)DEPTH * 8192 * D);
constexpr size_t WS_END = O_ACTM + (size_t)SLOTS * FFN * 2;

constexpr int LDS_BYTES = 147456;
constexpr int LDS_MISC = 143360;
constexpr int NTHREADS = 512;

struct Params { const float* in[32]; float* out; unsigned char* ws; int ph_lo, ph_hi, flags, pad; };

#ifndef HOST_EMU
#define XB_TMO      128
#define XB_XCNT(j)  (256  + 64 * (j))
#define XB_XSUB(j)  (1280 + 64 * (j))
#define XB_XGEN(j)  (2304 + 64 * (j))
#define XB_TOP      3328
#define XB_TOPGEN   3392
#define XCD_BAR_WORDS 3456
#define XB_SPIN_CAP (1u << 22)
__device__ __forceinline__ unsigned xb_ld(unsigned* p)              { return __hip_atomic_load(p, __ATOMIC_RELAXED, __HIP_MEMORY_SCOPE_AGENT); }
__device__ __forceinline__ unsigned xb_add(unsigned* p, unsigned v) { return __hip_atomic_fetch_add(p, v, __ATOMIC_RELAXED, __HIP_MEMORY_SCOPE_AGENT); }
__device__ __forceinline__ unsigned xb_xcc_id() { return (unsigned)__builtin_amdgcn_s_getreg((3 << 11) | 20) & 0xFu; }
#define XB_SPIN(cond, bar) do { unsigned _sp = 0; while (cond) { __builtin_amdgcn_s_sleep(1); \
    if ((++_sp & 255u) == 0u) { if (xb_ld(&(bar)[XB_TMO])) break; if (_sp > XB_SPIN_CAP) { atomicAdd(&(bar)[XB_TMO], 1u); break; } } } } while (0)
struct XcdBarrier { unsigned* bar; unsigned x; volatile LAS unsigned* st; int wave; };
__device__ __forceinline__ bool xb_thread0(int wave) { return wave == 0 && lane_id_hw() == 0; }
__device__ __forceinline__ XcdBarrier xcd_barrier_post(unsigned* bar, volatile LAS unsigned* st, int wave) {
    XcdBarrier b; b.bar = bar; b.x = xb_xcc_id(); b.st = st; b.wave = wave;
    if (xb_thread0(wave)) (void)xb_add(&bar[XB_XCNT(b.x)], 1u);
    return b;
}
__device__ __forceinline__ void xcd_barrier_complete(unsigned* bar, unsigned x, unsigned& nloc, unsigned& nx) {
    const unsigned G = gridDim.x * gridDim.y * gridDim.z;
    unsigned sum, cnt, mine, sp = 0u;
    for (;;) {
        sum = 0u; cnt = 0u; mine = 0u;
#pragma unroll
        for (unsigned j = 0; j < 16; ++j) { const unsigned c = xb_ld(&bar[XB_XCNT(j)]); sum += c; cnt += (c > 0u) ? 1u : 0u; mine = (j == x) ? c : mine; }
        if (sum == G) break;
        __builtin_amdgcn_s_sleep(1);
        if ((++sp & 255u) == 0u) { if (xb_ld(&bar[XB_TMO])) break; if (sp > XB_SPIN_CAP) { atomicAdd(&bar[XB_TMO], 1u); break; } }
    }
    nloc = mine > 0u ? mine : 1u; nx = cnt > 0u ? cnt : 1u;
}
__device__ __forceinline__ void xcd_barrier(const XcdBarrier& b) {
    asm volatile("s_waitcnt vmcnt(0)" ::: "memory");
    __syncthreads();
    if (xb_thread0(b.wave)) {
        unsigned* bar = b.bar;
        __builtin_amdgcn_s_waitcnt(0);
        unsigned nloc = b.st[0], nx = b.st[1];
        if (nloc == 0u) { xcd_barrier_complete(bar, b.x, nloc, nx); b.st[0] = nloc; b.st[1] = nx; }
        const unsigned old = xb_add(&bar[XB_XSUB(b.x)], 1u);
        const unsigned gen = old / nloc;
        if (old + 1u == (gen + 1u) * nloc) {
            __builtin_amdgcn_fence(__ATOMIC_RELEASE, "agent");
            asm volatile("s_waitcnt vmcnt(0)" ::: "memory");
            const unsigned og = xb_add(&bar[XB_TOP], 1u);
            const unsigned tg = og / nx;
            if (og + 1u == (tg + 1u) * nx) xb_add(&bar[XB_TOPGEN], 1u);
            else XB_SPIN(xb_ld(&bar[XB_TOPGEN]) == tg, bar);
            __builtin_amdgcn_fence(__ATOMIC_ACQUIRE, "agent");
            xb_add(&bar[XB_XGEN(b.x)], 1u);
            asm volatile("s_waitcnt vmcnt(0)" ::: "memory");
        } else {
            XB_SPIN(xb_ld(&bar[XB_XGEN(b.x)]) == gen, bar);
            __builtin_amdgcn_fence(__ATOMIC_ACQUIRE, "agent");
            asm volatile("s_waitcnt vmcnt(0)" ::: "memory");
        }
    }
    __syncthreads();
}
#endif

namespace pg8 {
constexpr int BM = 256, BK = 64, HALF = 128, HTB = HALF * BK * 2, STAGE_BYTES = 8 * HTB, NXCD = 8, WGM = 4;
DI int lds_byte(int r, int c) { const int st = (r >> 4) * 2 + (c >> 5), rr = r & 15, cc = c & 31, ob = rr * 64 + cc * 2; return st * 1024 + (ob ^ (((ob >> 9) & 1) << 5)); }
DI void stage_rc(int b, int& R, int& C) { const int st = b / 1024, sb = b % 1024, swz = sb ^ (((sb >> 9) & 1) << 5); R = (st >> 1) * 16 + swz / 64; C = (st & 1) * 32 + (swz % 64) / 2; }
DI int perm32(int rho) { const int n = rho >> 4, i = rho & 15; return 8 * (i >> 2) + 4 * n + (i & 3); }
struct Unit { int pa, pb, pm, pn, aux, ui; };
struct Gemm { const bf16_t* A; int lda; const bf16_t* Bt; int ldb; int K; };
DI bool static_map(long L, int nM, int nN, int& pm, int& pn) {
    const int nwg = nM * nN; if (L >= nwg) return false;
    int wgid = (int)L; { const int q = nwg / NXCD, r = nwg % NXCD, xcd = wgid % NXCD, off = wgid / NXCD; wgid = (xcd < r ? xcd * (q + 1) : r * (q + 1) + (xcd - r) * q) + off; }
    const int nig = WGM * nN, gid = wgid / nig, fm = gid * WGM, gsz = (nM - fm) < WGM ? (nM - fm) : WGM;
    pm = fm + ((wgid % nig) % gsz); pn = (wgid % nig) / gsz; return true;
}
struct OrdStatic { int nM, nN, G, c;
    DI bool next(int i, Unit& u) const { if (!static_map((long)i * G + c, nM, nN, u.pm, u.pn)) return false; u.pa = u.pm; u.pb = u.pn; u.aux = 0; u.ui = i; return true; } };
struct OrdMerge { int nM, nN, G, c;
    DI bool next(int i, Unit& u) const { if (!static_map((long)(i >> 2) * G + c, nM, nN, u.pm, u.pn)) return false; u.aux = i & 3; u.pa = u.aux * nM + u.pm; u.pb = u.aux * nN + u.pn; u.ui = i; return true; } };
struct OrdMoe { int nM, nN, G, c; const int* tile_e; int imax;
    DI bool next(int i, Unit& u) const { if (i >= imax || !static_map((long)i * G + c, nM, nN, u.pm, u.pn)) return false; u.aux = tile_e[u.pm]; u.pa = u.pm; u.pb = u.aux * nN + u.pn; u.ui = i; return true; } };
struct OrdOne { Unit u; bool valid;
    DI bool next(int i, Unit& o) const { if (i != 0 || !valid) return false; o = u; return true; } };
DI void moe_tail_split(int ntiles, int G, int& full, int& R, int& sp) {
    const int units = ntiles * 8; full = units / G; R = units - full * G; sp = 0;
    if (R > 0) { sp = 1; if (R * 2 <= G) sp = 2; if (R * 4 <= G) sp = 4; if (R * 7 <= G) sp = 7; }
}

#ifndef HOST_EMU
template <class Epi, class Sched>
__device__ __forceinline__ void gemm_phase(LAS unsigned char* lds, const Gemm g, const Sched& S, const Epi& E, int wave_id) {
    int lane_ = lane_id_hw(); asm volatile("" : "+v"(lane_)); int wid_ = wave_id; asm volatile("" : "+s"(wid_));
    const int tid = wid_ * 64 + lane_, wid = wid_, lane = tid & 63, wr = wid >> 2, wc = wid & 3, fr = lane & 15, fq = lane >> 4;
    const int K = g.K, nt = K / BK;
    unsigned voffA[2], voffB[2];
#pragma unroll
    for (int i = 0; i < 2; ++i) { int R, C; stage_rc(tid * 16 + i * 8192, R, C); const int Rb = Epi::PERM ? ((R & ~31) + perm32(R & 31)) : R;
        voffA[i] = (unsigned)(R * g.lda + C) * 2u; voffB[i] = (unsigned)(Rb * g.ldb + C) * 2u; }
    const size_t kstep = (size_t)(BK * 2);
    const size_t hstepA = (size_t)HALF * g.lda * 2, hstepB = (size_t)HALF * g.ldb * 2;
    const size_t tstepA = 2 * hstepA, tstepB = 2 * hstepB;
    const unsigned ldsw = (unsigned)wid * 1024u;
    const int aoff = lds_byte(wr * 64 + fr, fq * 8), boff = lds_byte(wc * 32 + fr, fq * 8);
#define PG8_SA(b, h) (((b) * 2 + (h)) * HTB)
#define PG8_SB(b, h) ((4 + (b) * 2 + (h)) * HTB)
#define PG8_STAGE(bufoff, gbase, voff) do { _Pragma("unroll") for (int _i = 0; _i < 2; ++_i) \
        __builtin_amdgcn_global_load_lds((const unsigned*)((const char*)(gbase) + (voff)[_i]), (LAS unsigned*)(lds + (bufoff) + ldsw + _i * 8192), 16, 0, 0); } while (0)
#define PG8_LDA(dst, b, h) do { _Pragma("unroll") for (int m = 0; m < 4; ++m) _Pragma("unroll") for (int k = 0; k < 2; ++k) dst[m][k] = *(const LAS bf16x8*)(lds + PG8_SA(b, h) + aoff + m * 2048 + k * 1024); } while (0)
#define PG8_LDB(dst, b, h) do { _Pragma("unroll") for (int n = 0; n < 2; ++n) _Pragma("unroll") for (int k = 0; k < 2; ++k) dst[n][k] = *(const LAS bf16x8*)(lds + PG8_SB(b, h) + boff + n * 2048 + k * 1024); } while (0)
#define PG8_MMA(ai, bj, At, Bt) do { __builtin_amdgcn_s_setprio(1); _Pragma("unroll") for (int m = 0; m < 4; ++m) _Pragma("unroll") for (int n = 0; n < 2; ++n) _Pragma("unroll") for (int k = 0; k < 2; ++k) \
        acc[ai][bj][m][n] = __builtin_amdgcn_mfma_f32_16x16x32_bf16(Bt[n][k], At[m][k], acc[ai][bj][m][n], 0, 0, 0); __builtin_amdgcn_s_setprio(0); } while (0)
#define PG8_WAIT_V(n) asm volatile("s_waitcnt vmcnt(" #n ")" ::: "memory")
#define PG8_WAIT_L(n) asm volatile("s_waitcnt lgkmcnt(" #n ")" ::: "memory")
#define PG8_BAR __builtin_amdgcn_s_barrier()
#define PG8_SCHED __builtin_amdgcn_sched_barrier(0)
    Unit cur, nxt; int ui = 0;
    if (!S.next(0, cur)) return;
    if constexpr (Epi::HAS_PREP) E.prep(cur, tid);
    f32x4 acc[2][2][4][2];
#pragma unroll
    for (int a = 0; a < 2; ++a)
#pragma unroll
        for (int b = 0; b < 2; ++b)
#pragma unroll
            for (int m = 0; m < 4; ++m)
#pragma unroll
                for (int n = 0; n < 2; ++n) acc[a][b][m][n] = (f32x4){0.f, 0.f, 0.f, 0.f};
    bf16x8 At[4][2], B0[2][2], B1[2][2];
    const char* cA = (const char*)g.A + (size_t)cur.pa * tstepA; const char* cB = (const char*)g.Bt + (size_t)cur.pb * tstepB;
    PG8_STAGE(PG8_SB(0, 0), cB, voffB); PG8_STAGE(PG8_SB(0, 1), cB + hstepB, voffB); PG8_STAGE(PG8_SA(0, 0), cA, voffA); PG8_STAGE(PG8_SA(0, 1), cA + hstepA, voffA);
    if (wr == 1) PG8_BAR;
    PG8_WAIT_V(2); PG8_BAR;
    PG8_STAGE(PG8_SB(1, 0), cB + kstep, voffB); PG8_STAGE(PG8_SA(1, 0), cA + kstep, voffA); PG8_STAGE(PG8_SB(1, 1), cB + hstepB + kstep, voffB);
    PG8_WAIT_V(6); PG8_BAR;
    for (;;) {
        const bool has_next = S.next(ui + 1, nxt);
        const char* nA = has_next ? (const char*)g.A + (size_t)nxt.pa * tstepA : cA; const char* nB = has_next ? (const char*)g.Bt + (size_t)nxt.pb * tstepB : cB;
        for (int t = 0; t < nt; t += 2) {
            const bool last = (t == nt - 2);
            const char* a1 = cA + (size_t)(t + 1) * kstep;
            const char* a2 = last ? nA : cA + (size_t)(t + 2) * kstep; const char* b2 = last ? nB : cB + (size_t)(t + 2) * kstep;
            const char* a3 = a2 + kstep; const char* b3 = b2 + kstep;
            PG8_LDB(B0, 0, 0); PG8_LDB(B1, 0, 1); PG8_SCHED; PG8_LDA(At, 0, 0); PG8_STAGE(PG8_SA(1, 1), a1 + hstepA, voffA);
            PG8_WAIT_V(8); PG8_WAIT_L(0); PG8_BAR; PG8_MMA(0, 0, At, B0); PG8_MMA(0, 1, At, B1); PG8_BAR; PG8_SCHED;
            PG8_LDA(At, 0, 1); PG8_STAGE(PG8_SB(0, 0), b2, voffB); PG8_STAGE(PG8_SB(0, 1), b2 + hstepB, voffB); PG8_STAGE(PG8_SA(0, 0), a2, voffA);
            PG8_WAIT_V(8); PG8_WAIT_L(0); PG8_BAR; PG8_MMA(1, 0, At, B0); PG8_MMA(1, 1, At, B1); PG8_BAR; PG8_SCHED;
            PG8_LDB(B0, 1, 0); PG8_LDB(B1, 1, 1); PG8_SCHED; PG8_LDA(At, 1, 0); PG8_STAGE(PG8_SA(0, 1), a2 + hstepA, voffA);
            PG8_WAIT_V(8); PG8_WAIT_L(0); PG8_BAR; PG8_MMA(0, 0, At, B0); PG8_MMA(0, 1, At, B1); PG8_BAR; PG8_SCHED;
            PG8_LDA(At, 1, 1); PG8_STAGE(PG8_SB(1, 0), b3, voffB); PG8_STAGE(PG8_SB(1, 1), b3 + hstepB, voffB); PG8_STAGE(PG8_SA(1, 0), a3, voffA);
            PG8_WAIT_V(8); PG8_WAIT_L(0); PG8_BAR; PG8_MMA(1, 0, At, B0); PG8_MMA(1, 1, At, B1); PG8_BAR; PG8_SCHED;
        }
        if (wr == 0) PG8_BAR;
        E(acc, cur, wr, wc, fr, fq);
        if (!has_next) break;
        if constexpr (Epi::HAS_PREP) E.prep(nxt, tid);
#pragma unroll
        for (int a = 0; a < 2; ++a)
#pragma unroll
            for (int b = 0; b < 2; ++b)
#pragma unroll
                for (int m = 0; m < 4; ++m)
#pragma unroll
                    for (int n = 0; n < 2; ++n) acc[a][b][m][n] = (f32x4){0.f, 0.f, 0.f, 0.f};
        cur = nxt; cA = nA; cB = nB; ++ui;
        if (wr == 1) PG8_BAR;
    }
    PG8_WAIT_V(0);
    PG8_BAR;
#undef PG8_SA
#undef PG8_SB
#undef PG8_STAGE
#undef PG8_LDA
#undef PG8_LDB
#undef PG8_MMA
#undef PG8_WAIT_V
#undef PG8_WAIT_L
#undef PG8_BAR
#undef PG8_SCHED
}
template <class Epi, class Sched, bool FULLN = false>
__device__ __forceinline__ void gemm_phase_f8(LAS unsigned char* lds, const Gemm g, const Sched& S, const Epi& E, int wave_id) {
    int lane_ = lane_id_hw(); asm volatile("" : "+v"(lane_)); int wid_ = wave_id; asm volatile("" : "+s"(wid_));
    const int tid = wid_ * 64 + lane_, wid = wid_, lane = tid & 63, wr = wid >> 2, wc = wid & 3, fr = lane & 15, fq = lane >> 4;
    const int K = g.K, nt = K / BK;
    unsigned voffA[2], voffB[2];
#pragma unroll
    for (int i = 0; i < 2; ++i) { int R, C; stage_rc(tid * 16 + i * 8192, R, C); const int Rb = Epi::PERM ? ((R & ~31) + perm32(R & 31)) : R;
        voffA[i] = (unsigned)(R * g.lda + C) * 2u; voffB[i] = (unsigned)(Rb * g.ldb + C) * 2u; }
    const size_t kstep = (size_t)(BK * 2);
    const size_t hstepA = (size_t)HALF * g.lda * 2, hstepB = (size_t)HALF * g.ldb * 2;
    const size_t tstepA = 2 * hstepA, tstepB = 2 * hstepB;
    const unsigned ldsw = (unsigned)wid * 1024u;
    const int aoff0 = lds_byte(wr * 64 + fr, ((2 * fq) & 3) * 8) + (fq >> 1) * 1024, aoff1 = lds_byte(wr * 64 + fr, ((2 * fq + 1) & 3) * 8) + (fq >> 1) * 1024;
    const int boff0 = lds_byte(wc * 32 + fr, ((2 * fq) & 3) * 8) + (fq >> 1) * 1024, boff1 = lds_byte(wc * 32 + fr, ((2 * fq + 1) & 3) * 8) + (fq >> 1) * 1024;
#define PG8_SA(b, h) (((b) * 2 + (h)) * HTB)
#define PG8_SB(b, h) ((4 + (b) * 2 + (h)) * HTB)
#define PG8_STAGE(bufoff, gbase, voff) do { _Pragma("unroll") for (int _i = 0; _i < 2; ++_i) \
        __builtin_amdgcn_global_load_lds((const unsigned*)((const char*)(gbase) + (voff)[_i]), (LAS unsigned*)(lds + (bufoff) + ldsw + _i * 8192), 16, 0, 0); } while (0)
#define PG8_LDA(dst, b, h) do { _Pragma("unroll") for (int m = 0; m < 4; ++m) { dst[m][0] = *(const LAS u32x4*)(lds + PG8_SA(b, h) + aoff0 + m * 2048); dst[m][1] = *(const LAS u32x4*)(lds + PG8_SA(b, h) + aoff1 + m * 2048); } } while (0)
#define PG8_LDB(dst, b, h) do { _Pragma("unroll") for (int n = 0; n < 2; ++n) { dst[n][0] = *(const LAS u32x4*)(lds + PG8_SB(b, h) + boff0 + n * 2048); dst[n][1] = *(const LAS u32x4*)(lds + PG8_SB(b, h) + boff1 + n * 2048); } } while (0)
#define PG8_F8OP(x) __builtin_shufflevector(__builtin_bit_cast(i32x4_, (x)[0]), __builtin_bit_cast(i32x4_, (x)[1]), 0, 1, 2, 3, 4, 5, 6, 7)
#define PG8_MMA(ai, bj, At, Bt) do { __builtin_amdgcn_s_setprio(1); _Pragma("unroll") for (int m = 0; m < 4; ++m) _Pragma("unroll") for (int n = 0; n < 2; ++n) { \
        const i32x8 a8_ = PG8_F8OP(Bt[n]), b8_ = PG8_F8OP(At[m]); \
        asm volatile("v_mfma_scale_f32_16x16x128_f8f6f4 %0, %1, %2, %0, %3, %3 op_sel_hi:[0,0,0]" : "+v"(acc[ai][bj][m][n]) : "v"(a8_), "v"(b8_), "v"(f8one)); } \
        __builtin_amdgcn_s_setprio(0); } while (0)
#define PG8_WAIT_V(n) asm volatile("s_waitcnt vmcnt(" #n ")" ::: "memory")
#define PG8_WAIT_L(n) asm volatile("s_waitcnt lgkmcnt(" #n ")" ::: "memory")
#define PG8_BAR __builtin_amdgcn_s_barrier()
#define PG8_SCHED __builtin_amdgcn_sched_barrier(0)
    Unit cur, nxt; int ui = 0;
    if (!S.next(0, cur)) return;
    f32x4 acc[2][2][4][2];
#pragma unroll
    for (int a = 0; a < 2; ++a)
#pragma unroll
        for (int b = 0; b < 2; ++b)
#pragma unroll
            for (int m = 0; m < 4; ++m)
#pragma unroll
                for (int n = 0; n < 2; ++n) acc[a][b][m][n] = (f32x4){0.f, 0.f, 0.f, 0.f};
    typedef int i32x4_ __attribute__((ext_vector_type(4)));
    int f8one = 0x7F7F7F7F; asm volatile("" : "+v"(f8one));
    u32x4 At[4][2], B0[2][2], B1[2][2];
    const char* cA = (const char*)g.A + (size_t)cur.pa * tstepA; const char* cB = (const char*)g.Bt + (size_t)cur.pb * (FULLN ? tstepB : hstepB);
    PG8_STAGE(PG8_SB(0, 0), cB, voffB); PG8_STAGE(PG8_SB(0, 1), cB + hstepB, voffB); PG8_STAGE(PG8_SA(0, 0), cA, voffA); PG8_STAGE(PG8_SA(0, 1), cA + hstepA, voffA);
    if (wr == 1) PG8_BAR;
    PG8_WAIT_V(2); PG8_BAR;
    PG8_STAGE(PG8_SB(1, 0), cB + kstep, voffB); PG8_STAGE(PG8_SA(1, 0), cA + kstep, voffA); PG8_STAGE(PG8_SB(1, 1), cB + hstepB + kstep, voffB);
    PG8_WAIT_V(6); PG8_BAR;
    for (;;) {
        const bool has_next = S.next(ui + 1, nxt);
        const char* nA = has_next ? (const char*)g.A + (size_t)nxt.pa * tstepA : cA; const char* nB = has_next ? (const char*)g.Bt + (size_t)nxt.pb * (FULLN ? tstepB : hstepB) : cB;
        for (int t = 0; t < nt; t += 2) {
            const bool last = (t == nt - 2);
            const char* a1 = cA + (size_t)(t + 1) * kstep;
            const char* a2 = last ? nA : cA + (size_t)(t + 2) * kstep; const char* b2 = last ? nB : cB + (size_t)(t + 2) * kstep;
            const char* a3 = a2 + kstep; const char* b3 = b2 + kstep;
            PG8_LDB(B0, 0, 0); if constexpr (FULLN) PG8_LDB(B1, 0, 1); PG8_SCHED; PG8_LDA(At, 0, 0); PG8_STAGE(PG8_SA(1, 1), a1 + hstepA, voffA);
            PG8_WAIT_V(8); PG8_WAIT_L(0); PG8_BAR; PG8_MMA(0, 0, At, B0); if constexpr (FULLN) PG8_MMA(0, 1, At, B1); PG8_BAR; PG8_SCHED;
            PG8_LDA(At, 0, 1); PG8_STAGE(PG8_SB(0, 0), b2, voffB); PG8_STAGE(PG8_SB(0, 1), b2 + hstepB, voffB); PG8_STAGE(PG8_SA(0, 0), a2, voffA);
            PG8_WAIT_V(8); PG8_WAIT_L(0); PG8_BAR; PG8_MMA(1, 0, At, B0); if constexpr (FULLN) PG8_MMA(1, 1, At, B1); PG8_BAR; PG8_SCHED;
            PG8_LDB(B0, 1, 0); if constexpr (FULLN) PG8_LDB(B1, 1, 1); PG8_SCHED; PG8_LDA(At, 1, 0); PG8_STAGE(PG8_SA(0, 1), a2 + hstepA, voffA);
            PG8_WAIT_V(8); PG8_WAIT_L(0); PG8_BAR; PG8_MMA(0, 0, At, B0); if constexpr (FULLN) PG8_MMA(0, 1, At, B1); PG8_BAR; PG8_SCHED;
            PG8_LDA(At, 1, 1); PG8_STAGE(PG8_SB(1, 0), b3, voffB); PG8_STAGE(PG8_SB(1, 1), b3 + hstepB, voffB); PG8_STAGE(PG8_SA(1, 0), a3, voffA);
            PG8_WAIT_V(8); PG8_WAIT_L(0); PG8_BAR; PG8_MMA(1, 0, At, B0); if constexpr (FULLN) PG8_MMA(1, 1, At, B1); PG8_BAR; PG8_SCHED;
        }
        if (wr == 0) PG8_BAR;
        asm volatile("s_nop 15\n\ts_nop 15" : "+v"(acc[0][0][0][0]), "+v"(acc[0][0][0][1]), "+v"(acc[0][0][1][0]), "+v"(acc[0][0][1][1]), "+v"(acc[0][0][2][0]), "+v"(acc[0][0][2][1]), "+v"(acc[0][0][3][0]), "+v"(acc[0][0][3][1]) :: "memory");
        PIN_ACC8(&acc[0][1][0][0]); PIN_ACC8(&acc[1][0][0][0]); PIN_ACC8(&acc[1][1][0][0]);
        E(acc, cur, wr, wc, fr, fq);
        if (!has_next) break;
#pragma unroll
        for (int a = 0; a < 2; ++a)
#pragma unroll
            for (int b = 0; b < 2; ++b)
#pragma unroll
                for (int m = 0; m < 4; ++m)
#pragma unroll
                    for (int n = 0; n < 2; ++n) acc[a][b][m][n] = (f32x4){0.f, 0.f, 0.f, 0.f};
        cur = nxt; cA = nA; cB = nB; ++ui;
        if (wr == 1) PG8_BAR;
    }
    PG8_WAIT_V(0);
    PG8_BAR;
#undef PG8_SA
#undef PG8_SB
#undef PG8_STAGE
#undef PG8_LDA
#undef PG8_LDB
#undef PG8_MMA
#undef PG8_F8OP
#undef PG8_WAIT_V
#undef PG8_WAIT_L
#undef PG8_BAR
#undef PG8_SCHED
}
#else
template <class Epi, class Sched>
static void gemm_phase(unsigned char* lds, const Gemm g, const Sched& S, const Epi& E, int wave_id) {
    const int tid = threadIdx.x, wid = tid >> 6, lane = tid & 63, wr = wid >> 2, wc = wid & 3, fr = lane & 15, fq = lane >> 4;
    static thread_local float* Cbuf = nullptr; static thread_local float* Af = nullptr; static thread_local float* Bf = nullptr;
    Unit u;
    for (int i = 0; S.next(i, u); ++i) {
        __syncthreads();
        if constexpr (Epi::HAS_PREP) E.prep(u, tid);
        if (tid == 0) {
            if (!Cbuf) { Cbuf = (float*)malloc(256 * 256 * 4); Af = (float*)malloc((size_t)256 * 8192 * 4); Bf = (float*)malloc((size_t)256 * 8192 * 4); }
            const int K = g.K;
            for (int r = 0; r < 256; ++r) for (int k = 0; k < K; ++k) { Af[(size_t)r * K + k] = bf2f(g.A[((size_t)u.pa * 256 + r) * g.lda + k]); Bf[(size_t)r * K + k] = bf2f(g.Bt[((size_t)u.pb * 256 + r) * g.ldb + k]); }
            for (int r = 0; r < 256; ++r) for (int c = 0; c < 256; ++c) { const float* a = Af + (size_t)r * K; const float* b = Bf + (size_t)c * K; float s = 0.f;
                for (int k = 0; k < K; ++k) s += a[k] * b[k]; Cbuf[r * 256 + c] = s; }
        }
        __syncthreads();
        f32x4 acc[2][2][4][2];
        for (int ai = 0; ai < 2; ++ai) for (int bj = 0; bj < 2; ++bj) for (int m = 0; m < 4; ++m) for (int n = 0; n < 2; ++n) for (int j = 0; j < 4; ++j) {
            const int r = 128 * ai + 64 * wr + 16 * m + fr;
            const int c = Epi::PERM ? (128 * bj + 32 * wc + 8 * fq + 4 * n + j) : (128 * bj + 32 * wc + 16 * n + 4 * fq + j);
            acc[ai][bj][m][n][j] = Cbuf[r * 256 + c]; }
        E(acc, u, wr, wc, fr, fq);
    }
    __syncthreads();
}
#endif

typedef const f32x4 (&AccRef)[2][2][4][2];
struct EpiBf16 {
    static constexpr bool PERM = true; static constexpr bool HAS_PREP = false;
    bf16_t* O; int ldc;
    DI void operator()(AccRef acc, const Unit& u, int wr, int wc, int fr, int fq) const {
        const int row0 = u.pm * BM + wr * 64 + fr, col0 = u.pn * BM + wc * 32 + 8 * fq;
        float one = 1.0f; LAUNDER_S(one);
#pragma unroll
        for (int ai = 0; ai < 2; ++ai)
#pragma unroll
            for (int m = 0; m < 4; ++m) { bf16_t* rowp = O + (size_t)(row0 + ai * HALF + m * 16) * ldc + col0;
#pragma unroll
                for (int bj = 0; bj < 2; ++bj) { const f32x4 v0 = acc[ai][bj][m][0] * one, v1 = acc[ai][bj][m][1] * one;
                    u32x4 w; w.x = cvt_pk_bf16(v0[0], v0[1]); w.y = cvt_pk_bf16(v0[2], v0[3]); w.z = cvt_pk_bf16(v1[0], v1[1]); w.w = cvt_pk_bf16(v1[2], v1[3]);
                    *(u32x4*)(rowp + bj * HALF) = w; } }
    }
};
template <int NBJ, bool SIGM = false> struct EpiBf16S {
    static constexpr bool PERM = true; static constexpr bool HAS_PREP = false;
    bf16_t* O; int ldc; float scale;
    DI void operator()(AccRef acc, const Unit& u, int wr, int wc, int fr, int fq) const {
        const int row0 = u.pm * BM + wr * 64 + fr, col0 = u.pn * (HALF * NBJ) + wc * 32 + 8 * fq;
#pragma unroll
        for (int ai = 0; ai < 2; ++ai)
#pragma unroll
            for (int m = 0; m < 4; ++m) { bf16_t* rowp = O + (size_t)(row0 + ai * HALF + m * 16) * ldc + col0;
#pragma unroll
                for (int bj = 0; bj < NBJ; ++bj) { f32x4 v0 = acc[ai][bj][m][0] * scale, v1 = acc[ai][bj][m][1] * scale;
                    if constexpr (SIGM) {
#pragma unroll
                        for (int q = 0; q < 4; ++q) { v0[q] = frcp(1.0f + fexp2(v0[q] * -1.4426950408889634f)); v1[q] = frcp(1.0f + fexp2(v1[q] * -1.4426950408889634f)); } }
                    u32x4 w; w.x = cvt_pk_bf16(v0[0], v0[1]); w.y = cvt_pk_bf16(v0[2], v0[3]); w.z = cvt_pk_bf16(v1[0], v1[1]); w.w = cvt_pk_bf16(v1[2], v1[3]);
                    *(u32x4*)(rowp + bj * HALF) = w; } }
    }
};
struct EpiGate8 {
    static constexpr bool PERM = true; static constexpr bool HAS_PREP = false;
    unsigned char* G; float scale;
    DI void operator()(AccRef acc, const Unit& u, int wr, int wc, int fr, int fq) const {
        const int row0 = u.pm * BM + wr * 64 + fr, col0 = u.pn * BM + wc * 32 + 8 * fq;
#pragma unroll
        for (int ai = 0; ai < 2; ++ai)
#pragma unroll
            for (int m = 0; m < 4; ++m) { unsigned char* rowp = G + (size_t)(row0 + ai * HALF + m * 16) * (4 * D) + col0;
#pragma unroll
                for (int bj = 0; bj < 2; ++bj) { const f32x4 v0 = acc[ai][bj][m][0] * scale, v1 = acc[ai][bj][m][1] * scale; unsigned b[8];
#pragma unroll
                    for (int q = 0; q < 4; ++q) { b[q] = (unsigned)(frcp(1.0f + fexp2(v0[q] * -1.4426950408889634f)) * 255.0f + 0.5f); b[4 + q] = (unsigned)(frcp(1.0f + fexp2(v1[q] * -1.4426950408889634f)) * 255.0f + 0.5f); }
                    u32x2 w; w.x = b[0] | (b[1] << 8) | (b[2] << 16) | (b[3] << 24); w.y = b[4] | (b[5] << 8) | (b[6] << 16) | (b[7] << 24);
                    *(u32x2*)(rowp + bj * HALF) = w; } }
    }
};
template <int NBJ> struct EpiSwiGLU8 {
    static constexpr bool PERM = true; static constexpr bool HAS_PREP = false;
    unsigned char* act8; float scale;
    DI void operator()(AccRef acc, const Unit& u, int wr, int wc, int fr, int fq) const {
        const int row0 = u.pm * BM + wr * 64 + fr;
#pragma unroll
        for (int ai = 0; ai < 2; ++ai)
#pragma unroll
            for (int m = 0; m < 4; ++m)
#pragma unroll
                for (int bj = 0; bj < NBJ; ++bj) { const int col0 = (u.pn * NBJ + bj) * 64 + 4 * (4 * wc + fq);
                    const f32x4 a = acc[ai][bj][m][0] * scale, b = acc[ai][bj][m][1] * scale; float o[4];
#pragma unroll
                    for (int j = 0; j < 4; ++j) o[j] = siluf_(a[j]) * b[j] * F8_ASCALE;
                    *(unsigned*)(act8 + (size_t)(row0 + ai * HALF + m * 16) * FFN + col0) = cvt_pk4_fp8(o[0], o[1], o[2], o[3]); }
    }
};
struct EpiU {
    static constexpr bool PERM = true; static constexpr bool HAS_PREP = true;
    bf16_t* U; float* SM; const float* rstd; LAS float* tab;
    DI void prep(const Unit& u, int tid) const { if (tid < 256) tab[(u.ui & 1) * 256 + tid] = rstd[u.pm * BM + tid]; }
    DI void operator()(AccRef acc, const Unit& u, int wr, int wc, int fr, int fq) const {
        const int row0 = u.pm * BM + wr * 64 + fr;
        const LAS float* tb = tab + (u.ui & 1) * 256 + wr * 64 + fr;
        if (u.pn == SM_TILE) {
#pragma unroll
            for (int ai = 0; ai < 2; ++ai)
#pragma unroll
                for (int m = 0; m < 4; ++m) { float* rowp = SM + (size_t)(row0 + ai * HALF + m * 16) * 256 + wc * 32 + 8 * fq; const float rs = tb[ai * HALF + m * 16];
#pragma unroll
                    for (int bj = 0; bj < 2; ++bj) { *(f32x4*)(rowp + bj * HALF) = acc[ai][bj][m][0] * rs; *(f32x4*)(rowp + bj * HALF + 4) = acc[ai][bj][m][1] * rs; } }
        } else {
            const int col0 = u.pn * BM + wc * 32 + 8 * fq;
#pragma unroll
            for (int ai = 0; ai < 2; ++ai)
#pragma unroll
                for (int m = 0; m < 4; ++m) { bf16_t* rowp = U + (size_t)(row0 + ai * HALF + m * 16) * UWP + col0; const float rs = tb[ai * HALF + m * 16];
#pragma unroll
                    for (int bj = 0; bj < 2; ++bj) { const f32x4 v0 = acc[ai][bj][m][0] * rs, v1 = acc[ai][bj][m][1] * rs;
                        u32x4 w; w.x = cvt_pk_bf16(v0[0], v0[1]); w.y = cvt_pk_bf16(v0[2], v0[3]); w.z = cvt_pk_bf16(v1[0], v1[1]); w.w = cvt_pk_bf16(v1[2], v1[3]);
                        *(u32x4*)(rowp + bj * HALF) = w; } }
        }
    }
};
struct EpiPart {
    static constexpr bool PERM = true; static constexpr bool HAS_PREP = false;
    float* dst; float scale;
    DI void operator()(AccRef a, const Unit& u, int wr, int wc, int fr, int fq) const {
        const int row0 = wr * 64 + fr, col0 = wc * 32 + 8 * fq;
#pragma unroll
        for (int ai = 0; ai < 2; ++ai)
#pragma unroll
            for (int m = 0; m < 4; ++m) { float* rowp = dst + (row0 + ai * HALF + m * 16) * 256 + col0;
#pragma unroll
                for (int bj = 0; bj < 2; ++bj) { *(f32x4*)(rowp + bj * HALF) = a[ai][bj][m][0] * scale; *(f32x4*)(rowp + bj * HALF + 4) = a[ai][bj][m][1] * scale; } }
    }
};
struct EpiNull {
    static constexpr bool PERM = true; static constexpr bool HAS_PREP = false;
    float* sink;
    DI void operator()(AccRef acc, const Unit& u, int wr, int wc, int fr, int fq) const {
        f32x4 s = {0.f, 0.f, 0.f, 0.f};
#pragma unroll
        for (int ai = 0; ai < 2; ++ai)
#pragma unroll
            for (int bj = 0; bj < 2; ++bj)
#pragma unroll
                for (int m = 0; m < 4; ++m)
#pragma unroll
                    for (int n = 0; n < 2; ++n) s += acc[ai][bj][m][n];
        if (s[0] + s[1] + s[2] + s[3] == 123456.789f) sink[0] = s[0];
    }
};
struct EpiUL2 {
    static constexpr bool PERM = true; static constexpr bool HAS_PREP = false;
    bf16_t* T;
    DI void operator()(AccRef acc, const Unit& u, int wr, int wc, int fr, int fq) const {
        const int row0 = wr * 64 + fr, col0 = wc * 32 + 8 * fq;
#pragma unroll
        for (int ai = 0; ai < 2; ++ai)
#pragma unroll
            for (int m = 0; m < 4; ++m) { bf16_t* rowp = T + (size_t)(row0 + ai * HALF + m * 16) * 256 + col0;
#pragma unroll
                for (int bj = 0; bj < 2; ++bj) { const f32x4 v0 = acc[ai][bj][m][0], v1 = acc[ai][bj][m][1];
                    u32x4 w; w.x = cvt_pk_bf16(v0[0], v0[1]); w.y = cvt_pk_bf16(v0[2], v0[3]); w.z = cvt_pk_bf16(v1[0], v1[1]); w.w = cvt_pk_bf16(v1[2], v1[3]);
                    *(u32x4*)(rowp + bj * HALF) = w; } }
    }
};
template <bool SSQ> struct EpiResidT {
    static constexpr bool PERM = true; static constexpr bool HAS_PREP = false;
    const bf16_t* base; bf16_t* out; float* ssq;
    DI void operator()(AccRef acc, const Unit& u, int wr, int wc, int fr, int fq) const {
        const int row0 = u.pm * BM + wr * 64 + fr, col0 = u.pn * BM + wc * 32 + 8 * fq;
        u32x4 bv[4][2];
#define ER_LOAD(slot, rg) do { const size_t off_ = (size_t)(row0 + ((rg) >> 2) * HALF + ((rg) & 3) * 16) * D + col0; \
        _Pragma("unroll") for (int bj_ = 0; bj_ < 2; ++bj_) bv[slot][bj_] = *(const u32x4*)(base + off_ + bj_ * HALF); } while (0)
        ER_LOAD(0, 0); ER_LOAD(1, 1); ER_LOAD(2, 2);
#pragma unroll
        for (int rg = 0; rg < 8; ++rg) { const int ai = rg >> 2, m = rg & 3; const size_t off = (size_t)(row0 + ai * HALF + m * 16) * D + col0;
            if (rg + 3 < 8) ER_LOAD((rg + 3) & 3, rg + 3);
            asm volatile("" ::: "memory");
            float sq = 0.f;
#pragma unroll
            for (int bj = 0; bj < 2; ++bj) { const u32x4 b = bv[rg & 3][bj];
                const f32x4 v0 = (f32x4){bflo(b.x), bfhi(b.x), bflo(b.y), bfhi(b.y)} + acc[ai][bj][m][0], v1 = (f32x4){bflo(b.z), bfhi(b.z), bflo(b.w), bfhi(b.w)} + acc[ai][bj][m][1];
                if constexpr (SSQ) sq += (v0[0] * v0[0] + v0[1] * v0[1]) + (v0[2] * v0[2] + v0[3] * v0[3]) + (v1[0] * v1[0] + v1[1] * v1[1]) + (v1[2] * v1[2] + v1[3] * v1[3]);
                u32x4 w; w.x = cvt_pk_bf16(v0[0], v0[1]); w.y = cvt_pk_bf16(v0[2], v0[3]); w.z = cvt_pk_bf16(v1[0], v1[1]); w.w = cvt_pk_bf16(v1[2], v1[3]);
                *(u32x4*)(out + off + bj * HALF) = w; }
            if constexpr (SSQ) { sq += shfl_xor_f(sq, 16); sq += shfl_xor_f(sq, 32);
                if (fq == 0) ssq[(size_t)(row0 + ai * HALF + m * 16) * 32 + u.pn * 4 + wc] = sq; } }
#undef ER_LOAD
    }
};
typedef EpiResidT<false> EpiResid;
constexpr int RS_TAB = STAGE_BYTES;
DI float row_rstd(const float* ssq, int row) { const f32x4* p = (const f32x4*)(ssq + (size_t)row * 32); f32x4 t = p[0];
#pragma unroll
    for (int j = 1; j < 8; ++j) t += p[j];
    return 1.0f / sqrtf(((t[0] + t[1]) + (t[2] + t[3])) * (1.0f / D) + RMS_EPS); }
struct EpiBf16R {
    static constexpr bool PERM = true; static constexpr bool HAS_PREP = true;
    bf16_t* O; int ldc; const float* ssq; LAS float* tab;
    DI void prep(const Unit& u, int tid) const { if (tid < 256) tab[(u.ui & 1) * 256 + tid] = row_rstd(ssq, u.pm * BM + tid); }
    DI void operator()(AccRef acc, const Unit& u, int wr, int wc, int fr, int fq) const {
        const int row0 = u.pm * BM + wr * 64 + fr, col0 = u.pn * BM + wc * 32 + 8 * fq;
        const LAS float* tb = tab + (u.ui & 1) * 256 + wr * 64 + fr;
#pragma unroll
        for (int ai = 0; ai < 2; ++ai)
#pragma unroll
            for (int m = 0; m < 4; ++m) { bf16_t* rowp = O + (size_t)(row0 + ai * HALF + m * 16) * ldc + col0; const float rs = tb[ai * HALF + m * 16];
#pragma unroll
                for (int bj = 0; bj < 2; ++bj) { const f32x4 v0 = acc[ai][bj][m][0] * rs, v1 = acc[ai][bj][m][1] * rs;
                    u32x4 w; w.x = cvt_pk_bf16(v0[0], v0[1]); w.y = cvt_pk_bf16(v0[2], v0[3]); w.z = cvt_pk_bf16(v1[0], v1[1]); w.w = cvt_pk_bf16(v1[2], v1[3]);
                    *(u32x4*)(rowp + bj * HALF) = w; } }
    }
};
struct EpiMerge {
    static constexpr bool PERM = true; static constexpr bool HAS_PREP = false;
    const unsigned char* G; bf16_t* merged;
    DI void operator()(AccRef acc, const Unit& u, int wr, int wc, int fr, int fq) const {
        const int row0 = u.pm * BM + wr * 64 + fr, col0 = u.pn * BM + wc * 32 + 8 * fq, n_br = u.aux;
        u32x2 gv[4][2]; u32x4 pv[4][2];
#define EM_LOAD(slot, rg) do { const size_t row_ = (size_t)(row0 + ((rg) >> 2) * HALF + ((rg) & 3) * 16); \
        _Pragma("unroll") for (int bj_ = 0; bj_ < 2; ++bj_) { gv[slot][bj_] = *(const u32x2*)(G + row_ * (4 * D) + n_br * D + col0 + bj_ * HALF); \
            if (n_br > 0) pv[slot][bj_] = *(const u32x4*)(merged + row_ * D + col0 + bj_ * HALF); } } while (0)
        EM_LOAD(0, 0); EM_LOAD(1, 1); EM_LOAD(2, 2);
#pragma unroll
        for (int rg = 0; rg < 8; ++rg) { const int ai = rg >> 2, m = rg & 3; const size_t row = (size_t)(row0 + ai * HALF + m * 16);
            if (rg + 3 < 8) EM_LOAD((rg + 3) & 3, rg + 3);
            asm volatile("" ::: "memory");
#pragma unroll
            for (int bj = 0; bj < 2; ++bj) { const int c = col0 + bj * HALF; const u32x2 gw = gv[rg & 3][bj];
                f32x4 v0 = acc[ai][bj][m][0], v1 = acc[ai][bj][m][1];
                {
                    const float k = 1.0f / 255.0f;
                    v0[0] *= (float)(gw.x & 255u) * k; v0[1] *= (float)((gw.x >> 8) & 255u) * k; v0[2] *= (float)((gw.x >> 16) & 255u) * k; v0[3] *= (float)(gw.x >> 24) * k;
                    v1[0] *= (float)(gw.y & 255u) * k; v1[1] *= (float)((gw.y >> 8) & 255u) * k; v1[2] *= (float)((gw.y >> 16) & 255u) * k; v1[3] *= (float)(gw.y >> 24) * k; }
                if (n_br > 0) { const u32x4 pw = pv[rg & 3][bj];
                    v0[0] += bflo(pw.x); v0[1] += bfhi(pw.x); v0[2] += bflo(pw.y); v0[3] += bfhi(pw.y); v1[0] += bflo(pw.z); v1[1] += bfhi(pw.z); v1[2] += bflo(pw.w); v1[3] += bfhi(pw.w); }
                u32x4 w; w.x = cvt_pk_bf16(v0[0], v0[1]); w.y = cvt_pk_bf16(v0[2], v0[3]); w.z = cvt_pk_bf16(v1[0], v1[1]); w.w = cvt_pk_bf16(v1[2], v1[3]);
                *(u32x4*)(merged + row * D + c) = w; } }
#undef EM_LOAD
    }
};
struct EpiSwiGLU {
    static constexpr bool PERM = true; static constexpr bool HAS_PREP = false;
    bf16_t* act;
    DI void operator()(AccRef acc, const Unit& u, int wr, int wc, int fr, int fq) const {
        const int row0 = u.pm * BM + wr * 64 + fr, col0 = u.pn * HALF + wc * 32 + 8 * fq;
#pragma unroll
        for (int ai = 0; ai < 2; ++ai)
#pragma unroll
            for (int m = 0; m < 4; ++m) { bf16_t* rowp = act + (size_t)(row0 + ai * HALF + m * 16) * FFN + col0;
                float o[8];
#pragma unroll
                for (int n = 0; n < 2; ++n)
#pragma unroll
                    for (int jp = 0; jp < 2; ++jp) {
                        const f32x2 a = {acc[ai][0][m][n][2 * jp], acc[ai][0][m][n][2 * jp + 1]}, b = {acc[ai][1][m][n][2 * jp], acc[ai][1][m][n][2 * jp + 1]};
                        const f32x2 t = a * (-1.4426950408889634f); f32x2 e; e.x = fexp2(t.x); e.y = fexp2(t.y);
                        const f32x2 d = e + 1.0f; f32x2 r; r.x = frcp(d.x); r.y = frcp(d.y);
                        const f32x2 y = (a * b) * r; o[4 * n + 2 * jp] = y.x; o[4 * n + 2 * jp + 1] = y.y; }
                u32x4 w; w.x = cvt_pk_bf16(o[0], o[1]); w.y = cvt_pk_bf16(o[2], o[3]); w.z = cvt_pk_bf16(o[4], o[5]); w.w = cvt_pk_bf16(o[6], o[7]);
                *(u32x4*)rowp = w; asm volatile("" ::: "memory"); }
    }
};
struct EpiSwiGLUR {
    static constexpr bool PERM = true; static constexpr bool HAS_PREP = true;
    bf16_t* act; const float* ssq; LAS float* tab;
    DI void prep(const Unit& u, int tid) const { if (tid < 256) tab[(u.ui & 1) * 256 + tid] = row_rstd(ssq, u.pm * BM + tid); }
    DI void operator()(AccRef acc, const Unit& u, int wr, int wc, int fr, int fq) const {
        const int row0 = u.pm * BM + wr * 64 + fr, col0 = u.pn * HALF + wc * 32 + 8 * fq;
        const LAS float* tb = tab + (u.ui & 1) * 256 + wr * 64 + fr;
#pragma unroll
        for (int ai = 0; ai < 2; ++ai)
#pragma unroll
            for (int m = 0; m < 4; ++m) { bf16_t* rowp = act + (size_t)(row0 + ai * HALF + m * 16) * FFN + col0; const float rs = tb[ai * HALF + m * 16];
                float o[8];
#pragma unroll
                for (int n = 0; n < 2; ++n)
#pragma unroll
                    for (int jp = 0; jp < 2; ++jp) {
                        const f32x2 a = (f32x2){acc[ai][0][m][n][2 * jp], acc[ai][0][m][n][2 * jp + 1]} * rs, b = (f32x2){acc[ai][1][m][n][2 * jp], acc[ai][1][m][n][2 * jp + 1]} * rs;
                        const f32x2 t = a * (-1.4426950408889634f); f32x2 e; e.x = fexp2(t.x); e.y = fexp2(t.y);
                        const f32x2 d = e + 1.0f; f32x2 r; r.x = frcp(d.x); r.y = frcp(d.y);
                        const f32x2 y = (a * b) * r; o[4 * n + 2 * jp] = y.x; o[4 * n + 2 * jp + 1] = y.y; }
                u32x4 w; w.x = cvt_pk_bf16(o[0], o[1]); w.y = cvt_pk_bf16(o[2], o[3]); w.z = cvt_pk_bf16(o[4], o[5]); w.w = cvt_pk_bf16(o[6], o[7]);
                *(u32x4*)rowp = w; asm volatile("" ::: "memory"); }
    }
};
#ifdef HOST_EMU
template <class Epi, class Sched, bool FULLN = false>
static void gemm_phase_f8(unsigned char* lds, const Gemm g, const Sched& S, const Epi& E, int wave_id) {
    const int tid = threadIdx.x, wid = tid >> 6, lane = tid & 63, wr = wid >> 2, wc = wid & 3, fr = lane & 15, fq = lane >> 4;
    static thread_local float* Cbuf = nullptr; static thread_local float* Af = nullptr; static thread_local float* Bf = nullptr;
    Unit u;
    for (int i = 0; S.next(i, u); ++i) {
        __syncthreads();
        if (tid == 0) {
            if (!Cbuf) { Cbuf = (float*)malloc(256 * 256 * 4); Af = (float*)malloc((size_t)256 * 8192 * 4); Bf = (float*)malloc((size_t)256 * 8192 * 4); }
            const int K = 2 * g.K; const unsigned char* A8 = (const unsigned char*)g.A; const unsigned char* B8 = (const unsigned char*)g.Bt;
            for (int r = 0; r < 256; ++r) for (int k = 0; k < K; ++k) { Af[(size_t)r * K + k] = fp82f_host(A8[((size_t)u.pa * 256 + r) * 2 * g.lda + k]); Bf[(size_t)r * K + k] = (FULLN || r < 128) ? fp82f_host(B8[((size_t)u.pb * (FULLN ? 256 : 128) + r) * 2 * g.ldb + k]) : 0.f; }
            for (int r = 0; r < 256; ++r) for (int c = 0; c < 256; ++c) { const float* a = Af + (size_t)r * K; const float* b = Bf + (size_t)c * K; float sum = 0.f;
                for (int k = 0; k < K; ++k) sum += a[k] * b[k]; Cbuf[r * 256 + c] = sum; }
        }
        __syncthreads();
        f32x4 acc[2][2][4][2];
        for (int ai = 0; ai < 2; ++ai) for (int bj = 0; bj < 2; ++bj) for (int m = 0; m < 4; ++m) for (int n = 0; n < 2; ++n) for (int j = 0; j < 4; ++j) {
            const int r = 128 * ai + 64 * wr + 16 * m + fr;
            const int c = 128 * bj + 32 * wc + 8 * fq + 4 * n + j;
            acc[ai][bj][m][n][j] = Cbuf[r * 256 + c]; }
        E(acc, u, wr, wc, fr, fq);
    }
    __syncthreads();
}
#endif
}

struct Frame {
    unsigned char* lds; int tid, lane, wave, G, bid, flags;
    const float* const* in; float* out; unsigned char* ws;
#ifndef HOST_EMU
    template <class T> DI T* wp(size_t off) const { return (T*)(GAS T*)(ws + off); }
    DI const float* inp(int i) const { return (const float*)(GAS const float*)in[i]; }
    DI float* outp() const { return (float*)(GAS float*)out; }
#else
    template <class T> DI T* wp(size_t off) const { return (T*)(ws + off); }
    DI const float* inp(int i) const { return in[i]; }
    DI float* outp() const { return out; }
#endif
};

DI void make_frame(Frame& F, const Params& P, unsigned char* lds, int wave0) {
#ifndef HOST_EMU
    int wv = wave0; LAUNDER_S(wv); int ln = lane_id_hw(); LAUNDER_V(ln); int tid = wv * 64 + ln;
#else
    int tid = threadIdx.x;
#endif
    size_t wz = 0; LAUNDER_S(wz); unsigned char* ws = P.ws + wz;
    F.lds = lds; F.tid = tid; F.lane = tid & 63; F.wave = tid >> 6;
#ifndef HOST_EMU
    F.wave = wv;
#endif
    F.G = gridDim.x; F.bid = blockIdx.x;
    F.in = P.in; F.out = P.out; F.ws = ws; F.flags = P.flags;
}
#define REFRAME() make_frame(F, P, lds, wave0)
DI bf16x8 frag_r(const bf16_t* T, int pitch, int r0, int k0, int lane) { return *(const bf16x8*)(T + (r0 + (lane & 15)) * pitch + k0 + 8 * (lane >> 4)); }
DI bf16x8 frag_k(const bf16_t* T, int pitch, int k0, int n0, int lane) {
    const int g = lane >> 4, q = (lane & 15) >> 2, p = lane & 3;
    const bf16_t* p0 = T + (k0 + 8 * g + q) * pitch + n0 + 4 * p;
    const s16x4 lo = lds_tr4(p0), hi = lds_tr4(p0 + 4 * pitch);
    return __builtin_shufflevector(lo, hi, 0, 1, 2, 3, 4, 5, 6, 7);
}
#ifndef HOST_EMU
template <int CTRL> DI float dppf(float v) { return __builtin_bit_cast(float, __builtin_amdgcn_update_dpp(0, __builtin_bit_cast(int, v), CTRL, 0xF, 0xF, true)); }
DI float grp16_max(float v) { v = fmaxf(v, dppf<0xB1>(v)); v = fmaxf(v, dppf<0x4E>(v)); v = fmaxf(v, dppf<0x141>(v)); v = fmaxf(v, dppf<0x140>(v)); return v; }
DI float grp16_sum(float v) { v += dppf<0xB1>(v); v += dppf<0x4E>(v); v += dppf<0x141>(v); v += dppf<0x140>(v); return v; }
#else
DI float grp16_max(float v) { v = fmaxf(v, shfl_xor_f(v, 1)); v = fmaxf(v, shfl_xor_f(v, 2)); v = fmaxf(v, shfl_xor_f(v, 4)); v = fmaxf(v, shfl_xor_f(v, 8)); return v; }
DI float grp16_sum(float v) { v += shfl_xor_f(v, 1); v += shfl_xor_f(v, 2); v += shfl_xor_f(v, 4); v += shfl_xor_f(v, 8); return v; }
#endif

template <class ColMap>
DI void tr_load(const float* W, int ldw, const ColMap& cm, int item, int nblk  , int lane, f32x4 (&v)[16]) {
    const int kb = item / nblk, nb = item - kb * nblk, k0 = 64 * kb, n0 = 64 * nb;
    const int col = cm(n0 + 4 * (lane & 15)), rq = lane >> 4;
#pragma unroll
    for (int i = 0; i < 16; ++i) v[i] = (f32x4){0.f, 0.f, 0.f, 0.f};
    if (col >= 0) {
        const float* src = W + (size_t)(k0 + rq) * ldw + col;
#pragma unroll
        for (int i = 0; i < 16; ++i) v[i] = *(const f32x4*)(src + (size_t)(4 * i) * ldw);
    }
}
DI void tr_store(int K, bf16_t* WT, bf16_t* scr  , int item, int nblk, int lane, const f32x4 (&v)[16], const float* ks  ) {
    const int kb = item / nblk, nb = item - kb * nblk, k0 = 64 * kb, n0 = 64 * nb, rq = lane >> 4;
#pragma unroll
    for (int i = 0; i < 16; ++i) { f32x4 x = v[i]; if (ks) x *= ks[k0 + rq + 4 * i];
        u32x2 o; o.x = cvt_pk_bf16(x[0], x[1]); o.y = cvt_pk_bf16(x[2], x[3]); *(u32x2*)(scr + (rq + 4 * i) * 72 + 4 * (lane & 15)) = o; }
    WAVE_FENCE();
#pragma unroll
    for (int kq = 0; kq < 2; ++kq)
#pragma unroll
        for (int nq = 0; nq < 4; ++nq) { const bf16x8 f = frag_k(scr, 72, 32 * kq, 16 * nq, lane);
            *(bf16x8*)(WT + (size_t)(n0 + 16 * nq + (lane & 15)) * K + k0 + 32 * kq + 8 * (lane >> 4)) = f; }
    WAVE_FENCE();
}
DI void tr_store_f8(int K, unsigned char* WT8, bf16_t* scr, int item, int nblk, int lane, const f32x4 (&v)[16], float wscale) {
    const int kb = item / nblk, nb = item - kb * nblk, k0 = 64 * kb, n0 = 64 * nb, rq = lane >> 4;
#pragma unroll
    for (int i = 0; i < 16; ++i) { u32x2 o; o.x = cvt_pk_bf16(v[i][0] * wscale, v[i][1] * wscale); o.y = cvt_pk_bf16(v[i][2] * wscale, v[i][3] * wscale); *(u32x2*)(scr + (rq + 4 * i) * 72 + 4 * (lane & 15)) = o; }
    WAVE_FENCE();
#pragma unroll
    for (int kq = 0; kq < 2; ++kq)
#pragma unroll
        for (int nq = 0; nq < 4; ++nq) { const bf16x8 f = frag_k(scr, 72, 32 * kq, 16 * nq, lane);
            u32x2 o; o.x = cvt_pk4_fp8(bf2f((bf16_t)f[0]), bf2f((bf16_t)f[1]), bf2f((bf16_t)f[2]), bf2f((bf16_t)f[3])); o.y = cvt_pk4_fp8(bf2f((bf16_t)f[4]), bf2f((bf16_t)f[5]), bf2f((bf16_t)f[6]), bf2f((bf16_t)f[7]));
            *(u32x2*)(WT8 + (size_t)(n0 + 16 * nq + (lane & 15)) * K + k0 + 32 * kq + 8 * (lane >> 4)) = o; }
    WAVE_FENCE();
}
struct CmGate { DI int operator()(int n) const { return SO_GATE + n; } };
struct CmW13F8 { DI int operator()(int r) const { const int pn = r >> 7, c = r & 127, q = c >> 3, n = (c >> 2) & 1, j = c & 3; return (n ? FFN : 0) + 64 * pn + 4 * q + j; } };
struct CmIdent { DI int operator()(int n) const { return n; } };
struct CmWin { DI int operator()(int r) const {
    if (r < 3072) return r;
    if (r < 4096) return SO_SSZ + (r - 3072);
    if (r < 5632) return SO_XBC + (r - 4096);
    if (r < 6144) return SO_CQ + (r - 5632);
    if (r < 6400) return SO_CKV + (r - 6144);
    if (r < 6656) { const int j = r - 6400; if (j < 64) return SO_KR + j; if (j < 72) return SO_MLI + (j - 64); if (j < 88) return SO_DT + (j - 72); return -1; }
    if (r < 7680) return SO_SWQ + (r - 6656);
    if (r < 7936) return SO_SWK + (r - 7680);
    if (r < 8192) return SO_SWV + (r - 7936);
    return SO_GATE + (r - 8192); } };
struct CmW13 { DI int operator()(int r) const { const int pn = r >> 8, rr = r & 255; return rr < 128 ? 128 * pn + rr : FFN + 128 * pn + (rr - 128); } };
template <class ColMap>
DI void convert_weight_f8(const Frame& F, const float* W, int ldw, int K, int N, unsigned char* WT8, const ColMap& cm, float wscale, int& rot) {
    bf16_t* scr = (bf16_t*)(F.lds + F.wave * 16384);
    const int NGW = F.G * 8, nblk = N / 64, items = (K / 64) * nblk;
    int gw = F.bid * 8 + F.wave - rot; if (gw < 0) gw += NGW;
    rot = (rot + items) % NGW;
    if (gw < items) {
        f32x4 v[16]; tr_load(W, ldw, cm, gw, nblk, F.lane, v);
        for (int it = gw;;) { const int nx = it + NGW; f32x4 vn[16];
            if (nx < items) tr_load(W, ldw, cm, nx, nblk, F.lane, vn);
            tr_store_f8(K, WT8, scr, it, nblk, F.lane, v, wscale);
            if (nx >= items) break;
#pragma unroll
            for (int i = 0; i < 16; ++i) v[i] = vn[i];
            it = nx; }
    }
}
template <class ColMap>
DI void convert_weight(const Frame& F, const float* W, int ldw, int K, int N, bf16_t* WT, const ColMap& cm, int& rot, const float* ks = nullptr) {
    bf16_t* scr = (bf16_t*)(F.lds + F.wave * 16384);
    const int NGW = F.G * 8, nblk = N / 64, items = (K / 64) * nblk;
    int gw = F.bid * 8 + F.wave - rot; if (gw < 0) gw += NGW;
    rot = (rot + items) % NGW;
    if (gw < items) {
        f32x4 v[16]; tr_load(W, ldw, cm, gw, nblk, F.lane, v);
        for (int it = gw;;) { const int nx = it + NGW; f32x4 vn[16];
            if (nx < items) tr_load(W, ldw, cm, nx, nblk, F.lane, vn);
            tr_store(K, WT, scr, it, nblk, F.lane, v, ks);
            if (nx >= items) break;
#pragma unroll
            for (int i = 0; i < 16; ++i) v[i] = vn[i];
            it = nx; }
    }
}
DI void rms_row_to_bf16(const float* xrow, const float* w, bf16_t* orow, int lane, unsigned char* o8 = nullptr, bf16_t* h16 = nullptr, float* rs_out = nullptr) {
    f32x4 v[8]; float s = 0.f;
#pragma unroll
    for (int j = 0; j < 8; ++j) { v[j] = *(const f32x4*)(xrow + 4 * (lane + 64 * j)); s += (v[j][0] * v[j][0] + v[j][1] * v[j][1]) + (v[j][2] * v[j][2] + v[j][3] * v[j][3]);
        if (h16) { u32x2 hc; hc.x = cvt_pk_bf16(v[j][0], v[j][1]); hc.y = cvt_pk_bf16(v[j][2], v[j][3]); *(u32x2*)(h16 + 4 * (lane + 64 * j)) = hc; } }
    const float rstd = 1.0f / sqrtf(wave_sum(s) * (1.0f / D) + RMS_EPS);
    if (rs_out && lane == 0) *rs_out = rstd;
#pragma unroll
    for (int j = 0; j < 8; ++j) { const f32x4 ww = *(const f32x4*)(w + 4 * (lane + 64 * j));
        const float y0 = v[j][0] * rstd * ww[0], y1 = v[j][1] * rstd * ww[1], y2 = v[j][2] * rstd * ww[2], y3 = v[j][3] * rstd * ww[3];
        u32x2 o; o.x = cvt_pk_bf16(y0, y1); o.y = cvt_pk_bf16(y2, y3);
        if (orow) *(u32x2*)(orow + 4 * (lane + 64 * j)) = o;
        if (o8) *(unsigned*)(o8 + 4 * (lane + 64 * j)) = cvt_pk4_fp8(y0 * F8_ASCALE, y1 * F8_ASCALE, y2 * F8_ASCALE, y3 * F8_ASCALE); }
}
DI void rms_row16_to_bf16(const bf16_t* xrow, const float* w, bf16_t* orow, int lane, unsigned char* o8 = nullptr, float* rs_out = nullptr) {
    f32x4 v[8]; float s = 0.f;
#pragma unroll
    for (int j = 0; j < 8; ++j) { const u32x2 a = *(const u32x2*)(xrow + 4 * (lane + 64 * j)); v[j] = (f32x4){bflo(a.x), bfhi(a.x), bflo(a.y), bfhi(a.y)};
        s += (v[j][0] * v[j][0] + v[j][1] * v[j][1]) + (v[j][2] * v[j][2] + v[j][3] * v[j][3]); }
    const float rstd = 1.0f / sqrtf(wave_sum(s) * (1.0f / D) + RMS_EPS);
    if (rs_out && lane == 0) *rs_out = rstd;
#pragma unroll
    for (int j = 0; j < 8; ++j) { const f32x4 ww = *(const f32x4*)(w + 4 * (lane + 64 * j));
        const float y0 = v[j][0] * rstd * ww[0], y1 = v[j][1] * rstd * ww[1], y2 = v[j][2] * rstd * ww[2], y3 = v[j][3] * rstd * ww[3];
        u32x2 o; o.x = cvt_pk_bf16(y0, y1); o.y = cvt_pk_bf16(y2, y3);
        if (orow) *(u32x2*)(orow + 4 * (lane + 64 * j)) = o;
        if (o8) *(unsigned*)(o8 + 4 * (lane + 64 * j)) = cvt_pk4_fp8(y0 * F8_ASCALE, y1 * F8_ASCALE, y2 * F8_ASCALE, y3 * F8_ASCALE); }
}
DI void phase_prologue(const Frame& F) {
    CmIdent id; int rot = 0;
    for (int l = 0; l < DEPTH; ++l) {
        if (!(F.flags & 4)) { convert_weight(F, F.inp(3) + (size_t)l * D * IN_TOTAL, IN_TOTAL, D, UC_GATE, F.wp<bf16_t>(O_WIN) + (size_t)l * UW * D, CmWin(), rot, F.inp(2) + (size_t)l * D);
            convert_weight_f8(F, F.inp(3) + (size_t)l * D * IN_TOTAL, IN_TOTAL, D, 8192, F.wp<unsigned char>(O_WG8) + (size_t)l * 8192 * D, CmGate(), F8_WSCALE, rot); }
        convert_weight(F, F.inp(14) + (size_t)l * 512 * 1536, 1536, 512, 1536, F.wp<bf16_t>(O_WUQ) + (size_t)l * 1536 * 512, id, rot);
        convert_weight(F, F.inp(16) + (size_t)l * 256 * 2048, 2048, 256, 2048, F.wp<bf16_t>(O_WUKV) + (size_t)l * 2048 * 256, id, rot);
        for (int n = 0; n < 4; ++n)
            convert_weight(F, F.inp(18) + ((size_t)l * 4 + n) * 1024 * 2048, 2048, 1024, 2048, F.wp<bf16_t>(O_WBR) + ((size_t)l * 4 + n) * 2048 * 1024, id, rot);
        convert_weight(F, F.inp(19) + (size_t)l * D * D, D, D, D, F.wp<bf16_t>(O_WOUT) + (size_t)l * D * D, id, rot);
        convert_weight(F, F.inp(22) + (size_t)l * D * 512, 512, D, 512, F.wp<bf16_t>(O_WXQ) + (size_t)l * 512 * D, id, rot, F.inp(20) + (size_t)l * D);
        convert_weight(F, F.inp(23) + (size_t)l * D * 1024, 1024, D, 1024, F.wp<bf16_t>(O_WXKV) + (size_t)l * 1024 * D, id, rot);
        convert_weight(F, F.inp(24) + (size_t)l * 512 * D, D, 512, D, F.wp<bf16_t>(O_WXO) + (size_t)l * D * 512, id, rot);
    }
    if (!(F.flags & 2)) { convert_weight(F, F.inp(26), 2 * FFN, D, 2 * FFN, F.wp<bf16_t>(O_W13), CmW13(), rot, F.inp(25));
    convert_weight(F, F.inp(27), D, FFN, D, F.wp<bf16_t>(O_W2), id, rot); }
    if (!(F.flags & 1)) for (int e = 0; e < NEXP; ++e) {
        convert_weight_f8(F, F.inp(29) + (size_t)e * D * 2 * FFN, 2 * FFN, D, 2 * FFN, F.wp<unsigned char>(O_MW13) + (size_t)e * 2 * FFN * D, CmW13F8(), F8_WSCALE, rot);
        convert_weight_f8(F, F.inp(30) + (size_t)e * FFN * D, D, FFN, D, F.wp<unsigned char>(O_MW2) + (size_t)e * D * FFN, id, F8_WSCALE, rot);
    }
    float* rope = F.wp<float>(O_ROPE);
    for (int idx = F.bid * NTHREADS + F.tid; idx < SEQ * 32; idx += F.G * NTHREADS) {
        const int t = idx >> 5, i = idx & 31;
        const float inv_freq = fexp2(-(float)i * (13.287712379549449f / 32.0f));
        const float ang = (float)t * inv_freq;
        const double rev = (double)ang * 0.15915494309189535; const float fr = (float)(rev - (double)(long long)rev);
        rope[2 * idx] = fcos_rev(fr); rope[2 * idx + 1] = fsin_rev(fr);
    }
    const int gw = F.bid * 8 + F.wave, NGW = F.G * 8;
    for (int r = gw; r < DEPTH * NMEM; r += NGW) { const int l = r / NMEM, m = r % NMEM;
        rms_row_to_bf16(F.inp(1) + (size_t)m * D, F.inp(21) + (size_t)l * D, F.wp<bf16_t>(O_MEMN) + (size_t)r * D, F.lane); }
}

DI void phase_rmsnorm_x(const Frame& F, const float* src, const float* w) {
    const int gw = F.bid * 8 + F.wave, NGW = F.G * 8;
    unsigned char* x8 = F.wp<unsigned char>(O_XN8);
    for (int r = gw; r < NTOK; r += NGW) rms_row_to_bf16(src + (size_t)r * D, w, nullptr, F.lane, x8 + (size_t)r * D, F.wp<bf16_t>(O_H) + (size_t)r * D, F.wp<float>(O_RSTD) + r);
}
DI void phase_rmsnorm(const Frame& F, const bf16_t* src, const float* w) {
    const int gw = F.bid * 8 + F.wave, NGW = F.G * 8;
    unsigned char* x8 = F.wp<unsigned char>(O_XN8);
    const int lane = F.lane; float* rsd = F.wp<float>(O_RSTD);
    for (int r = gw; r < NTOK; r += 2 * NGW) { const int r2 = r + NGW;
        if (r2 >= NTOK) { rms_row16_to_bf16(src + (size_t)r * D, w, nullptr, lane, x8 + (size_t)r * D, rsd + r); break; }
        u32x2 a[8], b[8];
#pragma unroll
        for (int j = 0; j < 8; ++j) { a[j] = *(const u32x2*)(src + (size_t)r * D + 4 * (lane + 64 * j)); b[j] = *(const u32x2*)(src + (size_t)r2 * D + 4 * (lane + 64 * j)); }
        float sa = 0.f, sb = 0.f;
#pragma unroll
        for (int j = 0; j < 8; ++j) { sa += (bflo(a[j].x) * bflo(a[j].x) + bfhi(a[j].x) * bfhi(a[j].x)) + (bflo(a[j].y) * bflo(a[j].y) + bfhi(a[j].y) * bfhi(a[j].y));
            sb += (bflo(b[j].x) * bflo(b[j].x) + bfhi(b[j].x) * bfhi(b[j].x)) + (bflo(b[j].y) * bflo(b[j].y) + bfhi(b[j].y) * bfhi(b[j].y)); }
        const float ra = 1.0f / sqrtf(wave_sum(sa) * (1.0f / D) + RMS_EPS), rb = 1.0f / sqrtf(wave_sum(sb) * (1.0f / D) + RMS_EPS);
        if (lane == 0) { rsd[r] = ra; rsd[r2] = rb; }
#pragma unroll
        for (int j = 0; j < 8; ++j) { const int c0 = 4 * (lane + 64 * j); const f32x4 ww = *(const f32x4*)(w + c0);
            *(unsigned*)(x8 + (size_t)r * D + c0) = cvt_pk4_fp8(bflo(a[j].x) * ra * ww[0] * F8_ASCALE, bfhi(a[j].x) * ra * ww[1] * F8_ASCALE, bflo(a[j].y) * ra * ww[2] * F8_ASCALE, bfhi(a[j].y) * ra * ww[3] * F8_ASCALE);
            *(unsigned*)(x8 + (size_t)r2 * D + c0) = cvt_pk4_fp8(bflo(b[j].x) * rb * ww[0] * F8_ASCALE, bfhi(b[j].x) * rb * ww[1] * F8_ASCALE, bflo(b[j].y) * rb * ww[2] * F8_ASCALE, bfhi(b[j].y) * rb * ww[3] * F8_ASCALE); }
    }
}
DI void block_rows(const Frame& F, int& r0, int& r1) { r0 = (int)(((long)NTOK * F.bid) / F.G); r1 = (int)(((long)NTOK * (F.bid + 1)) / F.G); }
DI void phase_rmsnorm_route(const Frame& F, const bf16_t* src, const float* w, const float* router) {
    int* cnt = (int*)(F.lds);
    float* RT = (float*)(F.lds + 1024);
    if (F.tid < 8) cnt[F.tid] = 0;
    for (int c = F.tid; c < D; c += NTHREADS) { const f32x4 ra = *(const f32x4*)(router + (size_t)c * 8), rb = *(const f32x4*)(router + (size_t)c * 8 + 4);
        RT[c] = ra[0]; RT[D + c] = ra[1]; RT[2 * D + c] = ra[2]; RT[3 * D + c] = ra[3]; RT[4 * D + c] = rb[0]; RT[5 * D + c] = rb[1]; RT[6 * D + c] = rb[2]; RT[7 * D + c] = rb[3]; }
    __syncthreads();
    int r0, r1; block_rows(F, r0, r1);
    int* r_e = F.wp<int>(O_ROUTE); float* r_g = (float*)(r_e + 2 * NTOK);
    u32x2 nx[8];
    if (r0 + F.wave < r1) {
#pragma unroll
        for (int j = 0; j < 8; ++j) nx[j] = *(const u32x2*)(src + (size_t)(r0 + F.wave) * D + 4 * (F.lane + 64 * j)); }
    for (int r = r0 + F.wave; r < r1; r += 8) {
        const int lane = F.lane;
        u32x2 cur[8];
#pragma unroll
        for (int j = 0; j < 8; ++j) cur[j] = nx[j];
        if (r + 8 < r1) {
#pragma unroll
            for (int j = 0; j < 8; ++j) nx[j] = *(const u32x2*)(src + (size_t)(r + 8) * D + 4 * (lane + 64 * j)); }
        f32x4 v[8]; float s = 0.f;
#pragma unroll
        for (int j = 0; j < 8; ++j) { const u32x2 a_ = cur[j]; v[j] = (f32x4){bflo(a_.x), bfhi(a_.x), bflo(a_.y), bfhi(a_.y)}; s += (v[j][0] * v[j][0] + v[j][1] * v[j][1]) + (v[j][2] * v[j][2] + v[j][3] * v[j][3]); }
        const float rstd = 1.0f / sqrtf(wave_sum(s) * (1.0f / D) + RMS_EPS);
        float lg[8];
#pragma unroll
        for (int e = 0; e < 8; ++e) lg[e] = 0.f;
        unsigned char* orow = F.wp<unsigned char>(O_XN8) + (size_t)r * D;
#pragma unroll
        for (int j = 0; j < 8; ++j) { const int c0 = 4 * (lane + 64 * j); const f32x4 ww = *(const f32x4*)(w + c0);
            const f32x4 y = {v[j][0] * rstd * ww[0], v[j][1] * rstd * ww[1], v[j][2] * rstd * ww[2], v[j][3] * rstd * ww[3]};
            *(unsigned*)(orow + c0) = cvt_pk4_fp8(y[0] * F8_ASCALE, y[1] * F8_ASCALE, y[2] * F8_ASCALE, y[3] * F8_ASCALE);
#pragma unroll
            for (int e = 0; e < 8; ++e) { const f32x4 rw = *(const f32x4*)(RT + e * D + c0); lg[e] += (y[0] * rw[0] + y[1] * rw[1]) + (y[2] * rw[2] + y[3] * rw[3]); }
            SCHED_BAR(); }
#pragma unroll
        for (int e = 0; e < 8; ++e) lg[e] = wave_sum(lg[e]);
        int i0 = 0; float v0 = lg[0];
#pragma unroll
        for (int e = 1; e < 8; ++e) if (lg[e] > v0) { v0 = lg[e]; i0 = e; }
        int i1 = -1; float v1 = -3.0e38f;
#pragma unroll
        for (int e = 0; e < 8; ++e) if (e != i0 && lg[e] > v1) { v1 = lg[e]; i1 = e; }
        const float e1 = fexp(v1 - v0), g0 = 1.0f / (1.0f + e1), g1 = e1 * g0;
        if (lane == 0) { r_e[2 * r] = i0; r_e[2 * r + 1] = i1; r_g[2 * r] = g0; r_g[2 * r + 1] = g1; lds_atomic_add_i(&cnt[i0], 1); lds_atomic_add_i(&cnt[i1], 1); }
    }
    __syncthreads();
    if (F.tid < 8) F.wp<int>(O_BLKCNT)[F.bid * 8 + F.tid] = cnt[F.tid];
}
DI void moe_tables(const Frame& F, int* tile_e, int* pstart, int* ntiles_out) {
    const int* bc = F.wp<int>(O_BLKCNT);
    if (F.tid == 0) {
        int tot[8];
        for (int e = 0; e < 8; ++e) tot[e] = 0;
        for (int b = 0; b < F.G; ++b) for (int e = 0; e < 8; ++e) tot[e] += bc[b * 8 + e];
        int ps = 0, nt = 0;
        for (int e = 0; e < 8; ++e) { pstart[e] = ps; const int t = (tot[e] + 255) >> 8;
_Pragma("clang loop vectorize(disable) unroll(disable)")
            for (int j = 0; j < t; ++j) tile_e[nt + j] = e;
            nt += t; ps += t * 256; }
        *ntiles_out = nt;
    }
    __syncthreads();
}
DI void phase_moe_scatter(const Frame& F, int* tile_e, int* pstart, int* ntiles, int* myoff  ) {
    moe_tables(F, tile_e, pstart, ntiles);
    const int* bc = F.wp<int>(O_BLKCNT);
    int r0, r1; block_rows(F, r0, r1);
    int* r_e = F.wp<int>(O_ROUTE); int* r_s = r_e + 4 * NTOK;
    if (F.tid < 8) { int s = 0; for (int b = 0; b < F.bid; ++b) s += bc[b * 8 + F.tid]; myoff[F.tid] = pstart[F.tid] + s; }
    __syncthreads();
    {
        int* es = (int*)F.lds; const int np = 2 * (r1 - r0);
        for (int p = F.tid; p < np; p += NTHREADS) es[p] = r_e[2 * r0 + p];
        __syncthreads();
        for (int p = F.tid; p < np; p += NTHREADS) { const int e = es[p]; int before = 0;
            for (int q = 0; q < p; ++q) before += (es[q] == e) ? 1 : 0;
            r_s[2 * r0 + p] = myoff[e] + before; }
    }
    __syncthreads();
    asm volatile("" ::: "memory");
    const unsigned char* xn8 = F.wp<unsigned char>(O_XN8); unsigned char* xg8 = F.wp<unsigned char>(O_XG);
    for (int i = 2 * r0 + F.wave; i < 2 * r1; i += 32) {
        u32x4 v[4][2]; int slot[4];
#pragma unroll
        for (int q = 0; q < 4; ++q) { const int ii = i + 8 * q; const bool ok = ii < 2 * r1; const int ic = ok ? ii : i; slot[q] = ok ? r_s[ic] : -1;
            const u32x4* sp_ = (const u32x4*)(xn8 + (size_t)(ic >> 1) * D); v[q][0] = sp_[F.lane]; v[q][1] = sp_[F.lane + 64]; }
#pragma unroll
        for (int q = 0; q < 4; ++q) if (slot[q] >= 0) { u32x4* dp_ = (u32x4*)(xg8 + (size_t)slot[q] * D); dp_[F.lane] = v[q][0]; dp_[F.lane + 64] = v[q][1]; } }
}
DI void phase_final(const Frame& F, bool moe_last, const int* ntiles_p, unsigned char* tail_of  ) {
    const int gw = F.bid * 8 + F.wave, NGW = F.G * 8, lane = F.lane;
    const bf16_t* H = F.wp<bf16_t>(O_H); const bf16_t* yg = F.wp<bf16_t>(O_YG); const float* w = F.inp(31); const float* tacc = F.wp<float>(O_TAILACC);
    const int* r_e = F.wp<int>(O_ROUTE); const float* r_g = (const float*)(r_e + 2 * NTOK); const int* r_s = r_e + 4 * NTOK;
    int full = 0, R = 0, sp = 0;
    if (moe_last) {
        pg8::moe_tail_split(*ntiles_p, F.G, full, R, sp);
_Pragma("clang loop vectorize(disable) unroll(disable)")
        for (int i = F.tid; i < MAXTILES * 8; i += NTHREADS) tail_of[i] = 0;
        __syncthreads();
        for (int u = F.tid; u < R; u += NTHREADS) { int pm, pn; pg8::static_map((long)full * F.G + u, *ntiles_p, D / 256, pm, pn); tail_of[pm * 8 + pn] = (unsigned char)(u + 1); }
        __syncthreads();
    }
    for (int r = gw; r < NTOK; r += NGW) {
        f32x4 v[8]; float s = 0.f;
        float g0 = 0.f, g1 = 0.f; int s0 = 0, s1 = 0;
        if (moe_last) { g0 = r_g[2 * r]; g1 = r_g[2 * r + 1]; s0 = r_s[2 * r]; s1 = r_s[2 * r + 1]; }
#pragma unroll
        for (int j = 0; j < 8; ++j) { const int c0 = 4 * (lane + 64 * j); { const u32x2 a_ = *(const u32x2*)(H + (size_t)r * D + c0); v[j] = (f32x4){bflo(a_.x), bfhi(a_.x), bflo(a_.y), bfhi(a_.y)}; }
            if (moe_last) {
                f32x4 ya, yb;
                const int t0 = tail_of[(s0 >> 8) * 8 + j], t1 = tail_of[(s1 >> 8) * 8 + j];
                if (t0) { ya = (f32x4){0.f, 0.f, 0.f, 0.f}; for (int p = 0; p < sp; ++p) ya += *(const f32x4*)(tacc + (size_t)((t0 - 1) * sp + p) * 65536 + (s0 & 255) * 256 + 4 * lane); }
                else { const u32x2 a = *(const u32x2*)(yg + (size_t)s0 * D + c0); ya = (f32x4){bflo(a.x), bfhi(a.x), bflo(a.y), bfhi(a.y)}; }
                if (t1) { yb = (f32x4){0.f, 0.f, 0.f, 0.f}; for (int p = 0; p < sp; ++p) yb += *(const f32x4*)(tacc + (size_t)((t1 - 1) * sp + p) * 65536 + (s1 & 255) * 256 + 4 * lane); }
                else { const u32x2 bb = *(const u32x2*)(yg + (size_t)s1 * D + c0); yb = (f32x4){bflo(bb.x), bfhi(bb.x), bflo(bb.y), bfhi(bb.y)}; }
                v[j] += g0 * ya + g1 * yb; }
            s += (v[j][0] * v[j][0] + v[j][1] * v[j][1]) + (v[j][2] * v[j][2] + v[j][3] * v[j][3]); }
        const float rstd = 1.0f / sqrtf(wave_sum(s) * (1.0f / D) + RMS_EPS);
#pragma unroll
        for (int j = 0; j < 8; ++j) { const int c0 = 4 * (lane + 64 * j); const f32x4 ww = *(const f32x4*)(w + c0);
            *(f32x4*)(F.outp() + (size_t)r * D + c0) = (f32x4){v[j][0] * rstd * ww[0], v[j][1] * rstd * ww[1], v[j][2] * rstd * ww[2], v[j][3] * rstd * ww[3]}; }
    }
}

DI float log_sigmoid_(float x) { return fminf(x, 0.f) - log1pf(expf(-fabsf(x))); }
DI float softplus_(float x) { return fmaxf(x, 0.f) + log1pf(expf(-fabsf(x))); }
DI void phase_prep(const Frame& F, int l) {
    const int gw = F.bid * 8 + F.wave, NGW = F.G * 8, lane = F.lane;
    const bf16_t* U = F.wp<bf16_t>(O_U); const float* SM = F.wp<float>(O_SM); const float* rope = F.wp<float>(O_ROPE);
    const float* qnorm = F.inp(13) + l * 512; const float* kvnorm = F.inp(15) + l * 256;
    const float* convw = F.inp(7) + (size_t)l * 4 * 1536; const float* convb = F.inp(8) + l * 1536;
    for (int r = gw; r < NTOK; r += NGW) {
        const int t = r % SEQ; const bf16_t* urow = U + (size_t)r * UWP; const float* smrow = SM + (size_t)r * 256;
        const int ckc = 8 * (lane & 31);
        const u32x4 wq = *(const u32x4*)(urow + UC_CQ + 8 * lane), wkv = *(const u32x4*)(urow + UC_CKV + ckc);
        const float sm_x1 = smrow[lane & 31], sm_x2 = smrow[32 + (lane & 31)], sm_gi = smrow[64 + (lane & 3)], sm_gf = smrow[68 + (lane & 3)], sm_dt = smrow[72 + (lane & 15)];
        const float rp_c = rope[2 * (t * 32 + (lane & 31))], rp_s = rope[2 * (t * 32 + (lane & 31)) + 1];
        u32x4 xw[3][4];
#pragma unroll
        for (int j = 0; j < 3; ++j)
#pragma unroll
            for (int tap = 0; tap < 4; ++tap) { const bool ok = (t - 3 + tap) >= 0;
                const u32x4 w = *(const u32x4*)(urow + (ok ? (long)(tap - 3) * UWP : 0l) + UC_XBC + 8 * lane + 512 * j);
                xw[j][tap].x = ok ? w.x : 0u; xw[j][tap].y = ok ? w.y : 0u; xw[j][tap].z = ok ? w.z : 0u; xw[j][tap].w = ok ? w.w : 0u; }
        {
            const u32x4 w = wq;
            float x[8] = {bflo(w.x), bfhi(w.x), bflo(w.y), bfhi(w.y), bflo(w.z), bfhi(w.z), bflo(w.w), bfhi(w.w)}; float s = 0.f;
#pragma unroll
            for (int i = 0; i < 8; ++i) s += x[i] * x[i];
            const float rstd = 1.0f / sqrtf(wave_sum(s) * (1.0f / 512) + RMS_EPS);
            const f32x4 n0 = *(const f32x4*)(qnorm + 8 * lane), n1 = *(const f32x4*)(qnorm + 8 * lane + 4);
            u32x4 o; o.x = cvt_pk_bf16(x[0] * rstd * n0[0], x[1] * rstd * n0[1]); o.y = cvt_pk_bf16(x[2] * rstd * n0[2], x[3] * rstd * n0[3]);
            o.z = cvt_pk_bf16(x[4] * rstd * n1[0], x[5] * rstd * n1[1]); o.w = cvt_pk_bf16(x[6] * rstd * n1[2], x[7] * rstd * n1[3]);
            *(u32x4*)(F.wp<bf16_t>(O_CQN) + (size_t)r * 512 + 8 * lane) = o;
        }
        {
            const int c = ckc;
            const u32x4 w = wkv;
            float x[8] = {bflo(w.x), bfhi(w.x), bflo(w.y), bfhi(w.y), bflo(w.z), bfhi(w.z), bflo(w.w), bfhi(w.w)}; float s = 0.f;
#pragma unroll
            for (int i = 0; i < 8; ++i) s += x[i] * x[i];
            if (lane >= 32) s = 0.f;
            const float rstd = 1.0f / sqrtf(wave_sum(s) * (1.0f / 256) + RMS_EPS);
            const f32x4 n0 = *(const f32x4*)(kvnorm + c), n1 = *(const f32x4*)(kvnorm + c + 4);
            u32x4 o; o.x = cvt_pk_bf16(x[0] * rstd * n0[0], x[1] * rstd * n0[1]); o.y = cvt_pk_bf16(x[2] * rstd * n0[2], x[3] * rstd * n0[3]);
            o.z = cvt_pk_bf16(x[4] * rstd * n1[0], x[5] * rstd * n1[1]); o.w = cvt_pk_bf16(x[6] * rstd * n1[2], x[7] * rstd * n1[3]);
            if (lane < 32) *(u32x4*)(F.wp<bf16_t>(O_CKVN) + (size_t)r * 256 + c) = o;
        }
        if (lane < 32) {
            const float x1 = sm_x1, x2 = sm_x2, cs = rp_c, sn = rp_s;
            bf16_t* kr = F.wp<bf16_t>(O_KR) + (size_t)r * 64;
            kr[lane] = f2bf(x1 * cs - x2 * sn); kr[32 + lane] = f2bf(x2 * cs + x1 * sn);
        }
        if (lane < 4) {
            F.wp<float>(O_GI)[(size_t)r * 4 + lane] = sm_gi + F.inp(4)[l * 4 + lane];
            F.wp<float>(O_LF)[(size_t)r * 4 + lane] = log_sigmoid_(sm_gf + F.inp(5)[l * 4 + lane]);
        }
        if (lane < 16) {
            const float dtv = softplus_(sm_dt + F.inp(9)[l * 16 + lane]);
            F.wp<float>(O_DT)[(size_t)r * 16 + lane] = dtv;
            F.wp<float>(O_DA)[(size_t)r * 16 + lane] = -dtv * expf(F.inp(10)[l * 16 + lane]);
        }
#pragma unroll
        for (int j = 0; j < 3; ++j) { const int c0 = 8 * lane + 512 * j;
            float y[8];
            { const f32x4 b0 = *(const f32x4*)(convb + c0), b1 = *(const f32x4*)(convb + c0 + 4); y[0] = b0[0]; y[1] = b0[1]; y[2] = b0[2]; y[3] = b0[3]; y[4] = b1[0]; y[5] = b1[1]; y[6] = b1[2]; y[7] = b1[3]; }
#pragma unroll
            for (int tap = 0; tap < 4; ++tap) { const u32x4 w = xw[j][tap];
                const f32x4 w0 = *(const f32x4*)(convw + tap * 1536 + c0), w1 = *(const f32x4*)(convw + tap * 1536 + c0 + 4);
                y[0] += bflo(w.x) * w0[0]; y[1] += bfhi(w.x) * w0[1]; y[2] += bflo(w.y) * w0[2]; y[3] += bfhi(w.y) * w0[3];
                y[4] += bflo(w.z) * w1[0]; y[5] += bfhi(w.z) * w1[1]; y[6] += bflo(w.w) * w1[2]; y[7] += bfhi(w.w) * w1[3]; }
            u32x4 o; o.x = cvt_pk_bf16(siluf_(y[0]), siluf_(y[1])); o.y = cvt_pk_bf16(siluf_(y[2]), siluf_(y[3])); o.z = cvt_pk_bf16(siluf_(y[4]), siluf_(y[5])); o.w = cvt_pk_bf16(siluf_(y[6]), siluf_(y[7]));
            *(u32x4*)(F.wp<bf16_t>(O_XBC) + (size_t)r * 1536 + c0) = o; }
    }
}

constexpr int ML_NC = SEQ / 64;
DI void mlstm_item(const Frame& F, int item) {
    const int vs = item & 7, hh = (item >> 3) & 3, b = item >> 5;
    int tid_ = F.tid; LAUNDER_V(tid_);
    const int tid = tid_, lane = tid & 63, w = F.wave, g = lane >> 4, lc = lane & 15;
    float* s_bb = (float*)F.lds; float* s_dd = s_bb + SEQ; float* s_cm = s_dd + SEQ; float* s_ch = s_cm + SEQ;
    bf16_t* sQ = (bf16_t*)(s_ch + 4 * ML_NC);
    bf16_t* sK = sQ + 64 * 136;
    bf16_t* sV = sK + 64 * 136;
    bf16_t* sVw = sV + 64 * 56;
    bf16_t* sCb = sVw + 64 * 56;
    const bf16_t* U = F.wp<bf16_t>(O_U); const float* GI = F.wp<float>(O_GI); const float* LF = F.wp<float>(O_LF);
    bf16_t* Ya = F.wp<bf16_t>(O_Y);
    const float scale = 0.08838834764831845f;
    const unsigned z0 = vzero();
    for (int i = tid; i < SEQ; i += NTHREADS) { const size_t row = (size_t)b * SEQ + i; s_dd[i] = GI[row * 4 + hh]; s_bb[i] = LF[row * 4 + hh]; }
    for (int i = tid; i < 48 * 136 / 2; i += NTHREADS) ((unsigned*)sCb)[i] = z0;
    __syncthreads();
    if (tid < ML_NC) { float acc = 0.f, cm = -3.0e38f;
        for (int t = 0; t < 64; ++t) { const int i = tid * 64 + t; acc += s_bb[i]; s_bb[i] = acc; const float d = s_dd[i] - acc; s_dd[i] = d; cm = fmaxf(cm, d); s_cm[i] = cm; } }
    __syncthreads();
    if (tid == 0) { float m = 0.f;
        for (int c = 0; c < ML_NC; ++c) { const float btot = s_bb[c * 64 + 63], cmL = s_cm[c * 64 + 63], mloc = btot + cmL, mnew = fmaxf(btot + m, mloc);
            s_ch[c] = m; s_ch[ML_NC + c] = fexp(btot + m - mnew); s_ch[2 * ML_NC + c] = fexp(mloc - mnew); s_ch[3 * ML_NC + c] = cmL; m = mnew; } }
    __syncthreads();
    f32x4 Cst[3][2];
#pragma unroll
    for (int a = 0; a < 3; ++a)
#pragma unroll
        for (int c = 0; c < 2; ++c) Cst[a][c] = (f32x4){0.f, 0.f, 0.f, 0.f};
    const bf16_t* Ub = U + (size_t)b * SEQ * UWP;
    u32x4 qr[2], kr[2], vr = {z0, z0, z0, z0};
#define ML_FETCH(c_) do { const bf16_t* ub_ = Ub + (size_t)(c_) * 64 * UWP; \
        _Pragma("unroll") for (int i_ = 0; i_ < 2; ++i_) { const unsigned ch_ = tid + i_ * NTHREADS, r_ = ch_ >> 4, cc_ = (ch_ & 15) * 8; \
            qr[i_] = *(const u32x4*)(ub_ + (r_ * (unsigned)UWP + UC_MLQ + hh * 128u + cc_)); kr[i_] = *(const u32x4*)(ub_ + (r_ * (unsigned)UWP + UC_MLK + hh * 128u + cc_)); } \
        if (tid < 256) { const unsigned r_ = tid >> 2, cc_ = (tid & 3) * 8; vr = *(const u32x4*)(ub_ + (r_ * (unsigned)UWP + UC_MLV + hh * 256u + vs * 32u + cc_)); } } while (0)
    ML_FETCH(0);
    for (int c = 0; c < ML_NC; ++c) {
        const float m_prev = s_ch[c], da = s_ch[ML_NC + c], db = s_ch[2 * ML_NC + c], cmL = s_ch[3 * ML_NC + c];
        const size_t row0 = (size_t)b * SEQ + c * 64;
#pragma unroll
        for (int i = 0; i < 2; ++i) { const int ch = tid + i * NTHREADS, r = ch >> 4, cc = (ch & 15) * 8;
            *(u32x4*)(sQ + r * 136 + cc) = qr[i]; *(u32x4*)(sK + r * 136 + cc) = kr[i]; }
        if (tid < 256) { const int r = tid >> 2, cc = (tid & 3) * 8;
            const u32x4 v = vr;
            *(u32x4*)(sV + r * 56 + cc) = v;
            const float wt = db * fexp(s_dd[c * 64 + r] - cmL) * scale;
            u32x4 o; o.x = cvt_pk_bf16(bflo(v.x) * wt, bfhi(v.x) * wt); o.y = cvt_pk_bf16(bflo(v.y) * wt, bfhi(v.y) * wt); o.z = cvt_pk_bf16(bflo(v.z) * wt, bfhi(v.z) * wt); o.w = cvt_pk_bf16(bflo(v.w) * wt, bfhi(v.w) * wt);
            *(u32x4*)(sVw + r * 56 + cc) = o;
        } else if (tid < 320) { const int r = tid - 256;
            const float wt = db * fexp(s_dd[c * 64 + r] - cmL) * scale;
            *(u32x4*)(sV + r * 56 + 32) = (u32x4){0x3F80u | z0, z0, z0, z0}; *(u32x4*)(sV + r * 56 + 40) = (u32x4){z0, z0, z0, z0};
            *(u32x4*)(sVw + r * 56 + 32) = (u32x4){(unsigned)f2bf(wt), z0, z0, z0}; *(u32x4*)(sVw + r * 56 + 40) = (u32x4){z0, z0, z0, z0};
        }
        __syncthreads();
        if (c + 1 < ML_NC) ML_FETCH(c + 1);
        if (w < 4) {
            const int sl = 16 * w + lc; const float mx = fmaxf(m_prev, s_cm[c * 64 + sl]), inter = fexp(m_prev - mx);
            bf16x8 bq[4];
#pragma unroll
            for (int kt = 0; kt < 4; ++kt) bq[kt] = frag_r(sQ, 136, 16 * w, 32 * kt, lane);
            f32x4 st[4];
#pragma unroll
            for (int j = 0; j < 4; ++j) st[j] = (f32x4){0.f, 0.f, 0.f, 0.f};
#pragma unroll
            for (int j = 0; j < 4; ++j) if (j <= w) {
#pragma unroll
                for (int kt = 0; kt < 4; ++kt) st[j] = mfma16(frag_r(sK, 136, 16 * j, 32 * kt, lane), bq[kt], st[j]);
                const f32x4 d4 = *(const f32x4*)(s_dd + c * 64 + 16 * j + 4 * g);
#pragma unroll
                for (int i = 0; i < 4; ++i) { const int t = 16 * j + 4 * g + i; st[j][i] = (t <= sl) ? fexp(d4[i] - mx) * st[j][i] * scale : 0.f; } }
            f32x4 n1[3], n2[3];
#pragma unroll
            for (int vt = 0; vt < 3; ++vt) { n1[vt] = (f32x4){0.f, 0.f, 0.f, 0.f}; n2[vt] = (f32x4){0.f, 0.f, 0.f, 0.f}; }
            const bf16_t* vb = sV + (4 * g + ((lane & 15) >> 2)) * 56 + 4 * (lane & 3);
#pragma unroll
            for (int ks = 0; ks < 2; ++ks) if (2 * ks <= w) {
                u32x4 pw; pw.x = cvt_pk_bf16(st[2 * ks][0], st[2 * ks][1]); pw.y = cvt_pk_bf16(st[2 * ks][2], st[2 * ks][3]); pw.z = cvt_pk_bf16(st[2 * ks + 1][0], st[2 * ks + 1][1]); pw.w = cvt_pk_bf16(st[2 * ks + 1][2], st[2 * ks + 1][3]);
                const bf16x8 pb = __builtin_bit_cast(bf16x8, pw);
#pragma unroll
                for (int vt = 0; vt < 3; ++vt) { const s16x4 lo = lds_tr4(vb + (32 * ks) * 56 + 16 * vt), hi = lds_tr4(vb + (32 * ks + 16) * 56 + 16 * vt);
                    n1[vt] = mfma16(__builtin_shufflevector(lo, hi, 0, 1, 2, 3, 4, 5, 6, 7), pb, n1[vt]); } }
#pragma unroll
            for (int kt = 0; kt < 4; ++kt)
#pragma unroll
                for (int vt = 0; vt < 3; ++vt) n2[vt] = mfma16(frag_r(sCb, 136, 16 * vt, 32 * kt, lane), bq[kt], n2[vt]);
            const float den = shfl_f(n1[2][0] + inter * n2[2][0], lc);
            const float inv = frcp(fmaxf(fabsf(den), fexp(-(s_bb[c * 64 + sl] + mx))));
#pragma unroll
            for (int vt = 0; vt < 2; ++vt) { u32x2 ov; ov.x = cvt_pk_bf16((n1[vt][0] + inter * n2[vt][0]) * inv, (n1[vt][1] + inter * n2[vt][1]) * inv);
                ov.y = cvt_pk_bf16((n1[vt][2] + inter * n2[vt][2]) * inv, (n1[vt][3] + inter * n2[vt][3]) * inv);
                *(u32x2*)(Ya + ((row0 + sl) * 1024 + hh * 256 + vs * 32 + 16 * vt + 4 * g)) = ov; }
        } else {
            const int j = w - 4;
#pragma unroll
            for (int mt = 0; mt < 3; ++mt)
#pragma unroll
                for (int nl = 0; nl < 2; ++nl) Cst[mt][nl] *= da;
#pragma unroll
            for (int kt = 0; kt < 2; ++kt) {
                bf16x8 bk[2];
#pragma unroll
                for (int nl = 0; nl < 2; ++nl) bk[nl] = frag_k(sK, 136, 32 * kt, 16 * (2 * j + nl), lane);
#pragma unroll
                for (int mt = 0; mt < 3; ++mt) { const bf16x8 a = frag_k(sVw, 56, 32 * kt, 16 * mt, lane);
#pragma unroll
                    for (int nl = 0; nl < 2; ++nl) Cst[mt][nl] = mfma16(a, bk[nl], Cst[mt][nl]); } }
        }
        __syncthreads();
        if (w >= 4) { const int j = w - 4;
#pragma unroll
            for (int mt = 0; mt < 3; ++mt)
#pragma unroll
                for (int nl = 0; nl < 2; ++nl)
#pragma unroll
                    for (int i = 0; i < 4; ++i) sCb[(16 * mt + 4 * g + i) * 136 + 16 * (2 * j + nl) + lc] = f2bf(Cst[mt][nl][i]); }
    }
#undef ML_FETCH
    __syncthreads();
}

constexpr int SS_NC = SEQ / 128;
DI void ssd_item(const Frame& F, int item, int l) {
    const int ps = item & 1, hd = (item >> 1) & 15, b = item >> 5, grp = hd >> 3;
    int tid_ = F.tid; LAUNDER_V(tid_);
    const int tid = tid_, lane = tid & 63, w = F.wave, g = lane >> 4, lc = lane & 15;
    float* s_acs = (float*)F.lds; float* s_dt = s_acs + 256;
    bf16_t* sC = (bf16_t*)(s_dt + 256);
    bf16_t* sB = sC + 128 * 136;
    bf16_t* sX = sB + 128 * 136;
    bf16_t* sXw = sX + 128 * 40;
    bf16_t* sHb = sXw + 128 * 40;
    const bf16_t* XBC = F.wp<bf16_t>(O_XBC) + (size_t)b * SEQ * 1536; const bf16_t* Uz = F.wp<bf16_t>(O_U) + (size_t)b * SEQ * UWP + UC_SSZ + hd * 64 + ps * 32;
    const float* DT = F.wp<float>(O_DT) + (size_t)b * SEQ * 16 + hd; const float* DA = F.wp<float>(O_DA) + (size_t)b * SEQ * 16 + hd;
    bf16_t* Yb = F.wp<bf16_t>(O_Y) + (size_t)NTOK * 1024 + (size_t)b * SEQ * 1024 + hd * 64 + ps * 32;
    const float Dh = F.inp(11)[l * 16 + hd];
    const unsigned z0 = vzero();
    for (int i = tid; i < 32 * 136 / 2; i += NTHREADS) ((unsigned*)sHb)[i] = z0;
    f32x4 Hst[2];
    Hst[0] = (f32x4){0.f, 0.f, 0.f, 0.f}; Hst[1] = (f32x4){0.f, 0.f, 0.f, 0.f};
    u32x4 cr[4], br[4], xr; float da0 = 0.f, da1 = 0.f, dtv = 0.f;
#define SSD_FETCH(c_) do { const bf16_t* xb_ = XBC + (size_t)(c_) * 128 * 1536; \
        _Pragma("unroll") for (int i_ = 0; i_ < 4; ++i_) { const unsigned ch_ = tid + i_ * NTHREADS, r_ = ch_ >> 4, cc_ = (ch_ & 15) * 8; \
            cr[i_] = *(const u32x4*)(xb_ + (r_ * 1536u + 1280u + grp * 128u + cc_)); br[i_] = *(const u32x4*)(xb_ + (r_ * 1536u + 1024u + grp * 128u + cc_)); } \
        { const unsigned r_ = tid >> 2, cc_ = (tid & 3) * 8; xr = *(const u32x4*)(xb_ + (r_ * 1536u + hd * 64u + ps * 32u + cc_)); } \
        if (w == 0) { da0 = DA[((c_) * 128 + 2 * lane) * 16]; da1 = DA[((c_) * 128 + 2 * lane + 1) * 16]; } else if (w < 3) dtv = DT[((c_) * 128 + tid - 64) * 16]; } while (0)
#define SSD_SCAN(nb_) do { if (w == 0) { float p_ = da0 + da1; \
            _Pragma("unroll") for (int off_ = 1; off_ < 64; off_ <<= 1) { const float t_ = shfl_f(p_, (lane - off_) & 63); if (lane >= off_) p_ += t_; } \
            s_acs[(nb_) * 128 + 2 * lane + 1] = p_; s_acs[(nb_) * 128 + 2 * lane] = p_ - da1; } \
        else if (w < 3) s_dt[(nb_) * 128 + tid - 64] = dtv; } while (0)
    SSD_FETCH(0);
    SSD_SCAN(0);
    __syncthreads();
    for (int c = 0; c < SS_NC; ++c) {
        const int row0 = c * 128; const float* acs = s_acs + (c & 1) * 128; const float* dtc = s_dt + (c & 1) * 128;
        const float acsL = acs[127];
#pragma unroll
        for (int i = 0; i < 4; ++i) { const int ch = tid + i * NTHREADS, r = ch >> 4, cc = (ch & 15) * 8; *(u32x4*)(sC + r * 136 + cc) = cr[i]; *(u32x4*)(sB + r * 136 + cc) = br[i]; }
        { const int r = tid >> 2, cc = (tid & 3) * 8; const u32x4 v = xr;
            *(u32x4*)(sX + r * 40 + cc) = v;
            const float wt = dtc[r] * fexp(acsL - acs[r]);
            u32x4 o; o.x = cvt_pk_bf16(bflo(v.x) * wt, bfhi(v.x) * wt); o.y = cvt_pk_bf16(bflo(v.y) * wt, bfhi(v.y) * wt); o.z = cvt_pk_bf16(bflo(v.z) * wt, bfhi(v.z) * wt); o.w = cvt_pk_bf16(bflo(v.w) * wt, bfhi(v.w) * wt);
            *(u32x4*)(sXw + r * 40 + cc) = o; }
        __syncthreads();
        u32x2 zr[2];
#pragma unroll
        for (int pt = 0; pt < 2; ++pt) zr[pt] = *(const u32x2*)(Uz + ((unsigned)(row0 + 16 * w + lc) * (unsigned)UWP + 16u * pt + 4u * g));
        if (c + 1 < SS_NC) SSD_FETCH(c + 1);
        {
            const int sl = 16 * w + lc; const float as = acs[sl];
            bf16x8 bq[4];
#pragma unroll
            for (int kt = 0; kt < 4; ++kt) bq[kt] = frag_r(sC, 136, 16 * w, 32 * kt, lane);
            f32x4 ct[8];
#pragma unroll
            for (int j = 0; j < 8; ++j) ct[j] = (f32x4){0.f, 0.f, 0.f, 0.f};
#pragma unroll
            for (int j = 0; j < 8; ++j) if (j <= w) {
#pragma unroll
                for (int kt = 0; kt < 4; ++kt) ct[j] = mfma16(frag_r(sB, 136, 16 * j, 32 * kt, lane), bq[kt], ct[j]);
                const f32x4 a4 = *(const f32x4*)(acs + 16 * j + 4 * g), d4 = *(const f32x4*)(dtc + 16 * j + 4 * g);
#pragma unroll
                for (int i = 0; i < 4; ++i) { const int t = 16 * j + 4 * g + i; ct[j][i] = (t <= sl) ? ct[j][i] * fexp(as - a4[i]) * d4[i] : 0.f; } }
            f32x4 y1[2], y2[2];
#pragma unroll
            for (int pt = 0; pt < 2; ++pt) { y1[pt] = (f32x4){0.f, 0.f, 0.f, 0.f}; y2[pt] = (f32x4){0.f, 0.f, 0.f, 0.f}; }
            const bf16_t* xb = sX + (4 * g + ((lane & 15) >> 2)) * 40 + 4 * (lane & 3);
#pragma unroll
            for (int ks = 0; ks < 4; ++ks) if (2 * ks <= w) {
                u32x4 pw; pw.x = cvt_pk_bf16(ct[2 * ks][0], ct[2 * ks][1]); pw.y = cvt_pk_bf16(ct[2 * ks][2], ct[2 * ks][3]); pw.z = cvt_pk_bf16(ct[2 * ks + 1][0], ct[2 * ks + 1][1]); pw.w = cvt_pk_bf16(ct[2 * ks + 1][2], ct[2 * ks + 1][3]);
                const bf16x8 pb = __builtin_bit_cast(bf16x8, pw);
#pragma unroll
                for (int pt = 0; pt < 2; ++pt) { const s16x4 lo = lds_tr4(xb + (32 * ks) * 40 + 16 * pt), hi = lds_tr4(xb + (32 * ks + 16) * 40 + 16 * pt);
                    y1[pt] = mfma16(__builtin_shufflevector(lo, hi, 0, 1, 2, 3, 4, 5, 6, 7), pb, y1[pt]); } }
#pragma unroll
            for (int kt = 0; kt < 4; ++kt)
#pragma unroll
                for (int pt = 0; pt < 2; ++pt) y2[pt] = mfma16(frag_r(sHb, 136, 16 * pt, 32 * kt, lane), bq[kt], y2[pt]);
            const float ea = fexp(as);
#pragma unroll
            for (int pt = 0; pt < 2; ++pt) { const u32x2 xw = *(const u32x2*)(sX + sl * 40 + 16 * pt + 4 * g);
                const float x0 = bflo(xw.x), x1 = bfhi(xw.x), x2 = bflo(xw.y), x3 = bfhi(xw.y), z0f = bflo(zr[pt].x), z1f = bfhi(zr[pt].x), z2f = bflo(zr[pt].y), z3f = bfhi(zr[pt].y);
                u32x2 ov; ov.x = cvt_pk_bf16((y1[pt][0] + ea * y2[pt][0] + x0 * Dh) * siluf_(z0f), (y1[pt][1] + ea * y2[pt][1] + x1 * Dh) * siluf_(z1f));
                ov.y = cvt_pk_bf16((y1[pt][2] + ea * y2[pt][2] + x2 * Dh) * siluf_(z2f), (y1[pt][3] + ea * y2[pt][3] + x3 * Dh) * siluf_(z3f));
                *(u32x2*)(Yb + ((unsigned)(row0 + sl) * 1024u + 16u * pt + 4u * g)) = ov; }
            const float cd = fexp(acsL);
            Hst[0] *= cd; Hst[1] *= cd;
#pragma unroll
            for (int kt = 0; kt < 4; ++kt) { const bf16x8 bb = frag_k(sB, 136, 32 * kt, 16 * w, lane);
#pragma unroll
                for (int mt2 = 0; mt2 < 2; ++mt2) Hst[mt2] = mfma16(frag_k(sXw, 40, 32 * kt, 16 * mt2, lane), bb, Hst[mt2]); }
        }
        if (c + 1 < SS_NC) SSD_SCAN((c + 1) & 1);
        __syncthreads();
#pragma unroll
        for (int mt2 = 0; mt2 < 2; ++mt2)
#pragma unroll
            for (int i = 0; i < 4; ++i) sHb[(16 * mt2 + 4 * g + i) * 136 + 16 * w + lc] = f2bf(Hst[mt2][i]);
    }
#undef SSD_FETCH
#undef SSD_SCAN
    __syncthreads();
}

constexpr int SW_NB = SEQ / 128;
DI void swa_item(const Frame& F, int item, int l) {
    const int nb = item % SW_NB, kvh = (item / SW_NB) & 3, b = item / (SW_NB * 4);
    int tid_ = F.tid; LAUNDER_V(tid_);
    const int tid = tid_, lane = tid & 63, w = F.wave, g = lane >> 4, lc = lane & 15;
    bf16_t* sK = (bf16_t*)F.lds;
    bf16_t* sV = sK + 256 * 72;
    const long rowb = (long)b * SEQ + (long)nb * 128 - 128;
    const bf16_t* Ub = F.wp<bf16_t>(O_U) + rowb * UWP; bf16_t* Yd = F.wp<bf16_t>(O_Y) + (size_t)3 * NTOK * 1024 + (rowb + 128) * 1024;
    const unsigned z0 = vzero();
#pragma unroll
    for (int i = 0; i < 4; ++i) { const unsigned ch = tid + i * NTHREADS, r = ch >> 3, cc = (ch & 7) * 8;
        u32x4 kv = {z0, z0, z0, z0}, vv = {z0, z0, z0, z0};
        if (nb > 0 || r >= 128) { kv = *(const u32x4*)(Ub + (r * (unsigned)UWP + UC_SWK + kvh * 64u + cc)); vv = *(const u32x4*)(Ub + (r * (unsigned)UWP + UC_SWV + kvh * 64u + cc)); }
        *(u32x4*)(sK + r * 72 + cc) = kv; *(u32x4*)(sV + r * 72 + cc) = vv; }
    if (tid < 128) { const int r = 256 + (tid >> 3), cc = (tid & 7) * 8; *(u32x4*)(sV + r * 72 + cc) = (u32x4){z0, z0, z0, z0}; }
    __syncthreads();
    const int hq = kvh * 4 + (w >> 1);
    const float sink2 = F.inp(17)[l * 16 + hq] * 1.4426950408889634f;
    for (int gi = 0; gi < 4; ++gi) {
        const int r0 = 64 * (w & 1) + 16 * gi;
        const unsigned qoff = (unsigned)(128 + r0 + lc) * (unsigned)UWP + UC_SWQ + hq * 64u + 8u * g;
        const bf16x8 bq0 = *(const bf16x8*)(Ub + qoff), bq1 = *(const bf16x8*)(Ub + (qoff + 32u));
        f32x4 st[10];
#pragma unroll
        for (int j = 0; j < 10; ++j) st[j] = (f32x4){0.f, 0.f, 0.f, 0.f};
#pragma unroll
        for (int j = 0; j < 9; ++j) { st[j] = mfma16(frag_r(sK, 72, r0 + 16 * j, 0, lane), bq0, st[j]); st[j] = mfma16(frag_r(sK, 72, r0 + 16 * j, 32, lane), bq1, st[j]); }
        const int qpos = 128 + r0 + lc;
        float mx = -3.0e38f;
#pragma unroll
        for (int j = 0; j < 9; ++j)
#pragma unroll
            for (int i = 0; i < 4; ++i) { const int tp = r0 + 16 * j + 4 * g + i; const bool ok = (tp <= qpos) && (qpos - tp < 128) && (nb > 0 || tp >= 128);
                const float v = ok ? st[j][i] * (0.125f * 1.4426950408889634f) : -3.0e38f; st[j][i] = v; mx = fmaxf(mx, v); }
        mx = fmaxf(mx, shfl_xor_f(mx, 16)); mx = fmaxf(mx, shfl_xor_f(mx, 32));
        mx = fmaxf(mx, sink2);
        float sum = 0.f;
#pragma unroll
        for (int j = 0; j < 9; ++j)
#pragma unroll
            for (int i = 0; i < 4; ++i) { const float e = fexp2(st[j][i] - mx); st[j][i] = e; sum += e; }
        sum += shfl_xor_f(sum, 16); sum += shfl_xor_f(sum, 32);
        sum += fexp2(sink2 - mx);
        const float inv = frcp(sum);
        f32x4 o[4];
#pragma unroll
        for (int nt = 0; nt < 4; ++nt) o[nt] = (f32x4){0.f, 0.f, 0.f, 0.f};
        const bf16_t* vb = sV + (r0 + 4 * g + ((lane & 15) >> 2)) * 72 + 4 * (lane & 3);
#pragma unroll
        for (int ks = 0; ks < 5; ++ks) {
            u32x4 pw; pw.x = cvt_pk_bf16(st[2 * ks][0], st[2 * ks][1]); pw.y = cvt_pk_bf16(st[2 * ks][2], st[2 * ks][3]); pw.z = cvt_pk_bf16(st[2 * ks + 1][0], st[2 * ks + 1][1]); pw.w = cvt_pk_bf16(st[2 * ks + 1][2], st[2 * ks + 1][3]);
            const bf16x8 pb = __builtin_bit_cast(bf16x8, pw);
#pragma unroll
            for (int nt = 0; nt < 4; ++nt) { const s16x4 lo = lds_tr4(vb + (32 * ks) * 72 + 16 * nt), hi = lds_tr4(vb + (32 * ks + 16) * 72 + 16 * nt);
                o[nt] = mfma16(__builtin_shufflevector(lo, hi, 0, 1, 2, 3, 4, 5, 6, 7), pb, o[nt]); } }
        const unsigned ooff = (unsigned)(r0 + lc) * 1024u + hq * 64u + 4u * g;
#pragma unroll
        for (int nt = 0; nt < 4; ++nt) { u32x2 ov; ov.x = cvt_pk_bf16(o[nt][0] * inv, o[nt][1] * inv); ov.y = cvt_pk_bf16(o[nt][2] * inv, o[nt][3] * inv); *(u32x2*)(Yd + (ooff + 16u * nt)) = ov; }
    }
    __syncthreads();
}

template <int DQK, bool MLA>
DI void attn_block(const Frame& F, const bf16_t* Qp, int ldq, const bf16_t* Kp, int ldk, const bf16_t* K2p  , const bf16_t* Vp, int ldv, bf16_t* Op, int ldo,
                   int nkt  , int qpos0  , float scale_log2e) {
    constexpr int PQ = DQK + 8, NKR = MLA ? 1 : 0, NKT = DQK / 32;
    int tid_ = F.tid; LAUNDER_V(tid_);
    const int tid = tid_, lane = tid & 63, w = F.wave, g = lane >> 4, lc = lane & 15;
    bf16_t* sK = (bf16_t*)F.lds;
    bf16_t* sV = sK + 2 * 64 * PQ;
    u32x4 kreg[2], rreg[1], vreg[2];
    unsigned koffb[2], voffb[2];
#pragma unroll
    for (int i_ = 0; i_ < 2; ++i_) { const unsigned c_ = tid + i_ * NTHREADS, r_ = c_ >> 4, ch_ = c_ & 15; koffb[i_] = (r_ * (unsigned)ldk + ch_ * 8u) * 2u; voffb[i_] = (r_ * (unsigned)ldv + ch_ * 8u) * 2u; }
    const unsigned roffb = ((tid >> 3) * 64u + (tid & 7) * 8u) * 2u;
#define ATTN_FETCH(t) do { int t_ = (t); LAUNDER_S(t_);     \
        const char* kb_ = (const char*)(Kp + (size_t)t_ * 64 * ldk); const char* vb_ = (const char*)(Vp + (size_t)t_ * 64 * ldv); const char* rb_ = (const char*)(K2p + (size_t)t_ * 64 * 64); \
        _Pragma("unroll") for (int i_ = 0; i_ < 2; ++i_) { kreg[i_] = *(const u32x4*)(kb_ + koffb[i_]); vreg[i_] = *(const u32x4*)(vb_ + voffb[i_]); } \
        _Pragma("unroll") for (int i_ = 0; i_ < NKR; ++i_) { rreg[i_] = *(const u32x4*)(rb_ + roffb); } } while (0)
#define ATTN_STORE(bf) do { bf16_t* k_ = sK + (bf) * 64 * PQ; bf16_t* v_ = sV + (bf) * 64 * 136; \
        _Pragma("unroll") for (int i_ = 0; i_ < 2; ++i_) { const int c_ = tid + i_ * NTHREADS, r_ = c_ >> 4, ch_ = c_ & 15; *(u32x4*)(k_ + r_ * PQ + ch_ * 8) = kreg[i_]; *(u32x4*)(v_ + r_ * 136 + ch_ * 8) = vreg[i_]; } \
        _Pragma("unroll") for (int i_ = 0; i_ < NKR; ++i_) { const int r_ = tid >> 3, ch_ = tid & 7; *(u32x4*)(k_ + r_ * PQ + 128 + ch_ * 8) = rreg[i_]; } } while (0)
    ATTN_FETCH(0);
    bf16x8 bq[2][NKT];
#pragma unroll
    for (int qg = 0; qg < 2; ++qg) { const unsigned qoff = (unsigned)(32 * w + 16 * qg + lc) * (unsigned)ldq + 8u * g;
#pragma unroll
        for (int kt = 0; kt < NKT; ++kt) bq[qg][kt] = *(const bf16x8*)(Qp + (qoff + 32u * kt));
        if constexpr (MLA) {
            const char* rpb = (const char*)F.wp<float>(O_ROPE); const unsigned rpo = 8u * ((unsigned)(qpos0 + 32 * w + 16 * qg + lc) * 32u + 8u * g);
            bf16x8 x1 = bq[qg][4], x2 = bq[qg][5];
#pragma unroll
            for (int j = 0; j < 4; ++j) { const f32x4 cs4 = *(const f32x4*)(rpb + (rpo + 16u * j));
#pragma unroll
              for (int h = 0; h < 2; ++h) { const int jj = 2 * j + h; const float a = bf2f((bf16_t)x1[jj]), c2 = bf2f((bf16_t)x2[jj]), cs = cs4[2 * h], sn = cs4[2 * h + 1];
                x1[jj] = (short)f2bf(a * cs - c2 * sn); x2[jj] = (short)f2bf(c2 * cs + a * sn); } }
#if 0
            for (int j = 0; j < 8; ++j) { const float a = 0, c2 = 0, cs = 0, sn = 0;
                x1[j] = (short)f2bf(a * cs - c2 * sn); x2[j] = (short)f2bf(c2 * cs + a * sn); }
#endif
            bq[qg][4] = x1; bq[qg][5] = x2; } }
    __syncthreads();
    ATTN_STORE(0);
    __syncthreads();
    f32x4 o[2][8]; float mrow[2] = {-3.0e38f, -3.0e38f}, lrow[2] = {0.f, 0.f};
#pragma unroll
    for (int qg = 0; qg < 2; ++qg)
#pragma unroll
        for (int nt = 0; nt < 8; ++nt) o[qg][nt] = (f32x4){0.f, 0.f, 0.f, 0.f};
    if (nkt > 1) ATTN_FETCH(1);
    for (int kt0 = 0; kt0 < nkt; ++kt0) {
        const bf16_t* cK = sK + (kt0 & 1) * 64 * PQ; const bf16_t* cV = sV + (kt0 & 1) * 64 * 136;
        if (kt0 + 1 < nkt) ATTN_STORE((kt0 + 1) & 1);
        if (kt0 + 2 < nkt) ATTN_FETCH(kt0 + 2);
        f32x4 st[2][4];
#pragma unroll
        for (int qg = 0; qg < 2; ++qg)
#pragma unroll
            for (int j = 0; j < 4; ++j) st[qg][j] = (f32x4){0.f, 0.f, 0.f, 0.f};
        {
            bf16x8 ak[2][4];
#pragma unroll
            for (int j = 0; j < 4; ++j) ak[0][j] = frag_r(cK, PQ, 16 * j, 0, lane);
#pragma unroll
            for (int kt = 0; kt < NKT; ++kt) {
                if (kt + 1 < NKT) {
#pragma unroll
                    for (int j = 0; j < 4; ++j) ak[(kt + 1) & 1][j] = frag_r(cK, PQ, 16 * j, 32 * (kt + 1), lane); }
#pragma unroll
                for (int j = 0; j < 4; ++j) { st[0][j] = mfma16(ak[kt & 1][j], bq[0][kt], st[0][j]); st[1][j] = mfma16(ak[kt & 1][j], bq[1][kt], st[1][j]); }
                SCHED_BAR(); } }
        const bool need_mask = MLA && (kt0 * 64 + 63 > qpos0 + 32 * w);
        bf16x8 pb[2][2];
        float mxq[2];
#pragma unroll
        for (int qg = 0; qg < 2; ++qg) {
            const int qp = qpos0 + 32 * w + 16 * qg + lc;
            float mx = -3.0e38f;
#pragma unroll
            for (int j = 0; j < 4; ++j)
#pragma unroll
                for (int i = 0; i < 4; ++i) { float v = st[qg][j][i] * scale_log2e;
                    if (need_mask) { const int kp = kt0 * 64 + 16 * j + 4 * g + i; v = (kp <= qp) ? v : -3.0e38f; }
                    st[qg][j][i] = v; mx = fmaxf(mx, v); }
            mx = fmaxf(mx, shfl_xor_f(mx, 16)); mx = fmaxf(mx, shfl_xor_f(mx, 32));
            mxq[qg] = mx; }
        if (wave_any((mxq[0] - mrow[0] > 8.0f) || (mxq[1] - mrow[1] > 8.0f))) {
#pragma unroll
            for (int qg = 0; qg < 2; ++qg) { const float mnew = fmaxf(mrow[qg], mxq[qg]), alpha = fexp2(mrow[qg] - mnew);
                lrow[qg] *= alpha; mrow[qg] = mnew;
#pragma unroll
                for (int nt = 0; nt < 8; ++nt) o[qg][nt] *= alpha; } }
#pragma unroll
        for (int qg = 0; qg < 2; ++qg) {
            const float mcur = mrow[qg];
            float sum = 0.f;
#pragma unroll
            for (int j = 0; j < 4; ++j)
#pragma unroll
                for (int i = 0; i < 4; ++i) { const float e = fexp2(st[qg][j][i] - mcur); st[qg][j][i] = e; sum += e; }
            lrow[qg] += sum;
#pragma unroll
            for (int ks = 0; ks < 2; ++ks) { u32x4 pw; pw.x = cvt_pk_bf16(st[qg][2 * ks][0], st[qg][2 * ks][1]); pw.y = cvt_pk_bf16(st[qg][2 * ks][2], st[qg][2 * ks][3]);
                pw.z = cvt_pk_bf16(st[qg][2 * ks + 1][0], st[qg][2 * ks + 1][1]); pw.w = cvt_pk_bf16(st[qg][2 * ks + 1][2], st[qg][2 * ks + 1][3]); pb[qg][ks] = __builtin_bit_cast(bf16x8, pw); }
        }
        {
            const bf16_t* vb = cV + (4 * g + ((lane & 15) >> 2)) * 136 + 4 * (lane & 3);
            bf16x8 av[2][4];
#define ATTN_LDV(dst, ks_, h_) do { _Pragma("unroll") for (int n_ = 0; n_ < 4; ++n_) { const s16x4 lo_ = lds_tr4(vb + (32 * (ks_)) * 136 + 16 * (4 * (h_) + n_)), hi_ = lds_tr4(vb + (32 * (ks_) + 16) * 136 + 16 * (4 * (h_) + n_)); \
                dst[n_] = __builtin_shufflevector(lo_, hi_, 0, 1, 2, 3, 4, 5, 6, 7); } } while (0)
            ATTN_LDV(av[0], 0, 0);
#pragma unroll
            for (int hs = 0; hs < 4; ++hs) { const int ks = hs >> 1, h = hs & 1;
                if (hs + 1 < 4) ATTN_LDV(av[(hs + 1) & 1], (hs + 1) >> 1, (hs + 1) & 1);
#pragma unroll
                for (int n = 0; n < 4; ++n) { o[0][4 * h + n] = mfma16(av[hs & 1][n], pb[0][ks], o[0][4 * h + n]); o[1][4 * h + n] = mfma16(av[hs & 1][n], pb[1][ks], o[1][4 * h + n]); }
                SCHED_BAR(); }
#undef ATTN_LDV
            PIN_ACC8(o[0]); PIN_ACC8(o[1]);
        }
        __syncthreads();
    }
#undef ATTN_FETCH
#undef ATTN_STORE
#pragma unroll
    for (int qg = 0; qg < 2; ++qg) { float lt = lrow[qg]; lt += shfl_xor_f(lt, 16); lt += shfl_xor_f(lt, 32); const float inv = frcp(lt); int lid = lane; LAUNDER_V(lid);
        const unsigned ooff = (unsigned)(32 * w + 16 * qg + (lid & 15)) * (unsigned)ldo + 4u * (lid >> 4);
#pragma unroll
        for (int nt = 0; nt < 8; ++nt) { u32x2 ov; ov.x = cvt_pk_bf16(o[qg][nt][0] * inv, o[qg][nt][1] * inv); ov.y = cvt_pk_bf16(o[qg][nt][2] * inv, o[qg][nt][3] * inv); *(u32x2*)(Op + (ooff + 16u * nt)) = ov; } }
}
constexpr int NQB = SEQ / 256, NQP = (NQB + 1) / 2;
DI void mla_attn_item(const Frame& F, int item) {
    const int pj = item % NQP, hh = (item / NQP) & 7, b = item / (NQP * 8);
    const bf16_t* QF = F.wp<bf16_t>(O_QF); const bf16_t* KVF = F.wp<bf16_t>(O_KVF); const bf16_t* KR = F.wp<bf16_t>(O_KR); bf16_t* Yc = F.wp<bf16_t>(O_Y) + (size_t)2 * NTOK * 1024;
    const size_t rb = (size_t)b * SEQ;
    for (int k = 0; k < 2; ++k) { const int qb = k ? (NQB - 1 - pj) : pj;
        if (k == 1 && qb == pj) break;
        attn_block<192, true>(F, QF + (rb + qb * 256) * 1536 + hh * 192, 1536, KVF + rb * 2048 + hh * 256, 2048, KR + rb * 64, KVF + rb * 2048 + hh * 256 + 128, 2048,
                              Yc + (rb + qb * 256) * 1024 + hh * 128, 1024, (qb + 1) * 4, qb * 256, 0.07216878364870322f * 1.4426950408889634f); }
}
DI void xattn_item(const Frame& F, int item) {
    const int qb = item % NQB, hh = (item / NQB) & 3, b = item / (NQB * 4);
    const bf16_t* XQ = F.wp<bf16_t>(O_XQ); const bf16_t* XKV = F.wp<bf16_t>(O_XKV); bf16_t* XO = F.wp<bf16_t>(O_XO);
    attn_block<128, false>(F, XQ + ((size_t)b * SEQ + qb * 256) * 512 + hh * 128, 512, XKV + (size_t)b * MEMLEN * 1024 + hh * 128, 1024, nullptr,
                           XKV + (size_t)b * MEMLEN * 1024 + 512 + hh * 128, 1024, XO + ((size_t)b * SEQ + qb * 256) * 512 + hh * 128, 512, MEMLEN / 64, 0, 0.08838834764831845f * 1.4426950408889634f);
}

DI void phase_fixup(const Frame& F, int l) {
    const int gw = F.bid * 8 + F.wave, NGW = F.G * 8, lane = F.lane;
    bf16_t* Ya = F.wp<bf16_t>(O_Y); bf16_t* Yb = Ya + (size_t)NTOK * 1024; const bf16_t* U = F.wp<bf16_t>(O_U);
    const float* mlnorm = F.inp(6) + l * 1024; const float* ssnorm = F.inp(12) + l * 1024;
    for (int r = gw; r < NTOK; r += NGW) {
        u32x4 hva[2], hvb[2], ovp[2];
        hva[0] = *(const u32x4*)(Ya + (size_t)r * 1024 + 16 * lane); hva[1] = *(const u32x4*)(Ya + (size_t)r * 1024 + 16 * lane + 8);
        hvb[0] = *(const u32x4*)(Yb + (size_t)r * 1024 + 16 * lane); hvb[1] = *(const u32x4*)(Yb + (size_t)r * 1024 + 16 * lane + 8);
        ovp[0] = *(const u32x4*)(U + (size_t)r * UWP + UC_MLO + 16 * lane); ovp[1] = *(const u32x4*)(U + (size_t)r * UWP + UC_MLO + 16 * lane + 8);
        {   u32x4 hv[2]; float x[16]; float s = 0.f;
            hv[0] = hva[0]; hv[1] = hva[1];
#pragma unroll
            for (int k = 0; k < 2; ++k) { x[8 * k + 0] = bflo(hv[k].x); x[8 * k + 1] = bfhi(hv[k].x); x[8 * k + 2] = bflo(hv[k].y); x[8 * k + 3] = bfhi(hv[k].y); x[8 * k + 4] = bflo(hv[k].z); x[8 * k + 5] = bfhi(hv[k].z); x[8 * k + 6] = bflo(hv[k].w); x[8 * k + 7] = bfhi(hv[k].w); }
#pragma unroll
            for (int i = 0; i < 16; ++i) s += x[i] * x[i];
            s = grp16_sum(s);
            const float rstd = 1.0f / sqrtf(s * (1.0f / 256) + RMS_EPS);
            u32x4 ov[2]; ov[0] = ovp[0]; ov[1] = ovp[1];
            float og[16];
#pragma unroll
            for (int k = 0; k < 2; ++k) { og[8 * k + 0] = bflo(ov[k].x); og[8 * k + 1] = bfhi(ov[k].x); og[8 * k + 2] = bflo(ov[k].y); og[8 * k + 3] = bfhi(ov[k].y); og[8 * k + 4] = bflo(ov[k].z); og[8 * k + 5] = bfhi(ov[k].z); og[8 * k + 6] = bflo(ov[k].w); og[8 * k + 7] = bfhi(ov[k].w); }
            float y[16];
#pragma unroll
            for (int i = 0; i < 16; ++i) y[i] = sigmoidf_(og[i]) * x[i] * rstd * mlnorm[16 * lane + i];
            u32x4 o0, o1; o0.x = cvt_pk_bf16(y[0], y[1]); o0.y = cvt_pk_bf16(y[2], y[3]); o0.z = cvt_pk_bf16(y[4], y[5]); o0.w = cvt_pk_bf16(y[6], y[7]);
            o1.x = cvt_pk_bf16(y[8], y[9]); o1.y = cvt_pk_bf16(y[10], y[11]); o1.z = cvt_pk_bf16(y[12], y[13]); o1.w = cvt_pk_bf16(y[14], y[15]);
            *(u32x4*)(Ya + (size_t)r * 1024 + 16 * lane) = o0; *(u32x4*)(Ya + (size_t)r * 1024 + 16 * lane + 8) = o1; }
        {   u32x4 hv[2]; float x[16]; float s = 0.f;
            hv[0] = hvb[0]; hv[1] = hvb[1];
#pragma unroll
            for (int k = 0; k < 2; ++k) { x[8 * k + 0] = bflo(hv[k].x); x[8 * k + 1] = bfhi(hv[k].x); x[8 * k + 2] = bflo(hv[k].y); x[8 * k + 3] = bfhi(hv[k].y); x[8 * k + 4] = bflo(hv[k].z); x[8 * k + 5] = bfhi(hv[k].z); x[8 * k + 6] = bflo(hv[k].w); x[8 * k + 7] = bfhi(hv[k].w); }
#pragma unroll
            for (int i = 0; i < 16; ++i) s += x[i] * x[i];
            s = grp16_sum(s); s += shfl_xor_f(s, 16);
            const float rstd = 1.0f / sqrtf(s * (1.0f / 512) + RMS_EPS);
            float y[16];
#pragma unroll
            for (int i = 0; i < 16; ++i) y[i] = x[i] * rstd * ssnorm[16 * lane + i];
            u32x4 o0, o1; o0.x = cvt_pk_bf16(y[0], y[1]); o0.y = cvt_pk_bf16(y[2], y[3]); o0.z = cvt_pk_bf16(y[4], y[5]); o0.w = cvt_pk_bf16(y[6], y[7]);
            o1.x = cvt_pk_bf16(y[8], y[9]); o1.y = cvt_pk_bf16(y[10], y[11]); o1.z = cvt_pk_bf16(y[12], y[13]); o1.w = cvt_pk_bf16(y[14], y[15]);
            *(u32x4*)(Yb + (size_t)r * 1024 + 16 * lane) = o0; *(u32x4*)(Yb + (size_t)r * 1024 + 16 * lane + 8) = o1; }
    }
}

#ifndef PHMASK
#define PHMASK 0xFFFFFFFFu
#endif
#define EN(b) (((PHMASK) >> (b)) & 1u)
#ifndef REPMASK
#define REPMASK 0u
#endif
#define RP(b) (((REPMASK) >> (b)) & 1u)
constexpr int PH_PER_LAYER = 16, PH_FINAL = 1 + DEPTH * PH_PER_LAYER, PH_COUNT = PH_FINAL + 1;
#ifndef HOST_EMU
#define GEMM_LDS ((LAS unsigned char*)lds)
__global__ void __launch_bounds__(NTHREADS, 2) mk_fwd(Params P) {
    extern __shared__ __attribute__((aligned(16))) unsigned char lds[];
#else
#define GEMM_LDS (lds)
static void mk_fwd(Params P) {
    unsigned char* lds = emu::B->lds;
#endif
    const int wave0 = rfl((int)threadIdx.x >> 6);
    Frame F; make_frame(F, P, lds, wave0);
    int* misc = (int*)(lds + LDS_MISC);
    if (F.tid < 256) misc[F.tid] = 0;
    __syncthreads();
#ifndef HOST_EMU
    XcdBarrier bar; bar.bar = (unsigned*)(P.ws + O_CTL) + 4096; bar.x = 0; bar.st = nullptr; bar.wave = wave0;
    if (MK_N_LAUNCHES == 1) bar = xcd_barrier_post((unsigned*)(P.ws + O_CTL) + 4096, (volatile LAS unsigned*)(lds + LDS_MISC), wave0);
#define GRID_BAR() xcd_barrier(bar)
#else
#define GRID_BAR() emu::grid_sync()
#endif
    int* tile_e = misc + 16; int* pstart = misc + 16 + 160; int* ntiles = misc + 16 + 160 + 8; int* myoff = misc + 16 + 160 + 16;
    const int lo = P.ph_lo, hi = P.ph_hi;
#define IN(k) (lo <= (k) && (k) < hi)
#define SEAM(k) do { if (IN(k) && IN((k) + 1)) GRID_BAR(); } while (0)
    const int c = F.bid, cr = F.G - 1 - F.bid;

    if (EN(0) && IN(0)) for (int rep_ = 0; rep_ <= (int)RP(0); ++rep_) { REFRAME(); phase_prologue(F); REFRAME(); phase_rmsnorm_x(F, F.inp(0), F.inp(2)); }
    SEAM(0);
    for (int l = 0; l < DEPTH; ++l) {
        const int pb = 1 + l * PH_PER_LAYER;
        const bool moe = (l & 1) != 0;
#define HIN() (F.wp<bf16_t>(O_H))
#define HBUF() (F.wp<bf16_t>(O_H))
        if (l > 0) { if (EN(1) && IN(pb + 0)) for (int rep_ = 0; rep_ <= (int)RP(1); ++rep_) { REFRAME(); phase_rmsnorm(F, HBUF(), F.inp(2) + l * D); }
        SEAM(pb + 0); }
        if (EN(2) && IN(pb + 1)) for (int rep_ = 0; rep_ <= (int)RP(2); ++rep_) { REFRAME();
            pg8::Gemm g{HBUF(), D, F.wp<bf16_t>(O_WIN) + (size_t)l * UW * D, D, D}; pg8::OrdStatic S{NTOK / 256, UC_GATE / 256, F.G, c};
            pg8::EpiU E{F.wp<bf16_t>(O_U), F.wp<float>(O_SM), F.wp<float>(O_RSTD), (LAS float*)(GEMM_LDS + pg8::RS_TAB)};
            pg8::gemm_phase(GEMM_LDS, g, S, E, F.wave);
            {
                REFRAME();
                pg8::Gemm g8{(const bf16_t*)F.wp<unsigned char>(O_XN8), D / 2, (const bf16_t*)(F.wp<unsigned char>(O_WG8) + (size_t)l * 8192 * D), D / 2, D / 2};
                pg8::OrdStatic S8{NTOK / 256, 8192 / (128 * F8_NBJ), F.G, c};
                pg8::EpiGate8 E8{F.wp<unsigned char>(O_G8), 1.0f / (F8_ASCALE * F8_WSCALE)};
                pg8::gemm_phase_f8<pg8::EpiGate8, pg8::OrdStatic, true>(GEMM_LDS, g8, S8, E8, F.wave); }
#ifdef PROBE_NULL_WIN
            { pg8::EpiNull E0{F.wp<float>(O_CTL) + 1024}; pg8::gemm_phase(GEMM_LDS, g, S, E0, F.wave); }
#endif
#ifdef PROBE_L2_WIN
            { pg8::EpiUL2 E0{F.wp<bf16_t>(O_MACC) + (size_t)F.bid * 256 * 256}; pg8::gemm_phase(GEMM_LDS, g, S, E0, F.wave); }
#endif
        }
        SEAM(pb + 1);
        if (EN(3) && IN(pb + 2)) for (int rep_ = 0; rep_ <= (int)RP(3); ++rep_) { REFRAME(); phase_prep(F, l); }
        SEAM(pb + 2);
        if (IN(pb + 3)) {
            if (EN(4)) for (int rep_ = 0; rep_ <= (int)RP(4); ++rep_) { REFRAME(); pg8::Gemm g{F.wp<bf16_t>(O_CQN), 512, F.wp<bf16_t>(O_WUQ) + (size_t)l * 1536 * 512, 512, 512}; pg8::OrdStatic S{NTOK / 256, 1536 / 256, F.G, c};
              pg8::EpiBf16 E{F.wp<bf16_t>(O_QF), 1536}; pg8::gemm_phase(GEMM_LDS, g, S, E, F.wave); }
            if (EN(4)) for (int rep_ = 0; rep_ <= (int)RP(4); ++rep_) { REFRAME(); pg8::Gemm g{F.wp<bf16_t>(O_CKVN), 256, F.wp<bf16_t>(O_WUKV) + (size_t)l * 2048 * 256, 256, 256}; pg8::OrdStatic S{NTOK / 256, 2048 / 256, F.G, cr};
              pg8::EpiBf16 E{F.wp<bf16_t>(O_KVF), 2048}; pg8::gemm_phase(GEMM_LDS, g, S, E, F.wave); }
            __syncthreads();
            REFRAME(); if (EN(5)) for (int rep_ = 0; rep_ <= (int)RP(5); ++rep_) for (int it = c; it < BATCH * 4 * 8; it += F.G) mlstm_item(F, it);
            REFRAME(); if (EN(6)) for (int rep_ = 0; rep_ <= (int)RP(6); ++rep_) for (int it = cr; it < BATCH * 16 * 2; it += F.G) ssd_item(F, it, l);
            REFRAME(); if (EN(7)) for (int rep_ = 0; rep_ <= (int)RP(7); ++rep_) for (int it = c; it < BATCH * 4 * SW_NB; it += F.G) swa_item(F, it, l);
        }
        SEAM(pb + 3);
        if (IN(pb + 4)) {
            if (EN(8)) for (int rep_ = 0; rep_ <= (int)RP(8); ++rep_) for (int it = c; it < BATCH * 8 * NQP; it += F.G) mla_attn_item(F, it);
            REFRAME(); if (EN(9)) phase_fixup(F, l);
        }
        SEAM(pb + 4);
        if (EN(10) && IN(pb + 5)) for (int rep_ = 0; rep_ <= (int)RP(10); ++rep_) { REFRAME();
            pg8::Gemm g{F.wp<bf16_t>(O_Y), 1024, F.wp<bf16_t>(O_WBR) + (size_t)l * 4 * 2048 * 1024, 1024, 1024}; pg8::OrdMerge S{NTOK / 256, D / 256, F.G, c};
            pg8::EpiMerge E{F.wp<unsigned char>(O_G8), F.wp<bf16_t>(O_MERGED)};
            pg8::gemm_phase(GEMM_LDS, g, S, E, F.wave);
        }
        SEAM(pb + 5);
        if (EN(11) && IN(pb + 6)) for (int rep_ = 0; rep_ <= (int)RP(11); ++rep_) { REFRAME();
            pg8::Gemm g{F.wp<bf16_t>(O_MERGED), D, F.wp<bf16_t>(O_WOUT) + (size_t)l * D * D, D, D}; pg8::OrdStatic S{NTOK / 256, D / 256, F.G, c};
            pg8::EpiResidT<true> E{HIN(), HBUF(), F.wp<float>(O_SSQ)};
            pg8::gemm_phase(GEMM_LDS, g, S, E, F.wave);
        }
        SEAM(pb + 6);
        if (EN(12) && IN(pb + 8)) for (int rep_ = 0; rep_ <= (int)RP(12); ++rep_) { REFRAME();
            { pg8::Gemm g{HBUF(), D, F.wp<bf16_t>(O_WXQ) + (size_t)l * 512 * D, D, D}; pg8::OrdStatic S{NTOK / 256, 512 / 256, F.G, c};
              pg8::EpiBf16R E{F.wp<bf16_t>(O_XQ), 512, F.wp<float>(O_SSQ), (LAS float*)(GEMM_LDS + pg8::RS_TAB)}; pg8::gemm_phase(GEMM_LDS, g, S, E, F.wave); }
            { REFRAME(); pg8::Gemm g{F.wp<bf16_t>(O_MEMN) + (size_t)l * NMEM * D, D, F.wp<bf16_t>(O_WXKV) + (size_t)l * 1024 * D, D, D}; pg8::OrdStatic S{NMEM / 256, 1024 / 256, F.G, cr};
              pg8::EpiBf16 E{F.wp<bf16_t>(O_XKV), 1024}; pg8::gemm_phase(GEMM_LDS, g, S, E, F.wave); }
        }
        SEAM(pb + 8);
        if (EN(13) && IN(pb + 9)) for (int rep_ = 0; rep_ <= (int)RP(13); ++rep_) { REFRAME(); for (int it = c; it < BATCH * 4 * NQB; it += F.G) xattn_item(F, it); }
        SEAM(pb + 9);
        if (EN(14) && IN(pb + 10)) for (int rep_ = 0; rep_ <= (int)RP(14); ++rep_) { REFRAME();
            pg8::Gemm g{F.wp<bf16_t>(O_XO), 512, F.wp<bf16_t>(O_WXO) + (size_t)l * D * 512, 512, 512}; pg8::OrdStatic S{NTOK / 256, D / 256, F.G, c};
            if (!moe) { pg8::EpiResidT<true> E{HBUF(), HBUF(), F.wp<float>(O_SSQ)}; pg8::gemm_phase(GEMM_LDS, g, S, E, F.wave); }
            else { pg8::EpiResid E{HBUF(), HBUF(), nullptr}; pg8::gemm_phase(GEMM_LDS, g, S, E, F.wave); }
        }
        SEAM(pb + 10);
        if (!moe) {
            if (EN(15) && IN(pb + 12)) for (int rep_ = 0; rep_ <= (int)RP(15); ++rep_) { REFRAME();
                pg8::Gemm g{HBUF(), D, F.wp<bf16_t>(O_W13), D, D}; pg8::OrdStatic S{NTOK / 256, 2 * FFN / 256, F.G, c};
                pg8::EpiSwiGLUR E{F.wp<bf16_t>(O_ACT), F.wp<float>(O_SSQ), (LAS float*)(GEMM_LDS + pg8::RS_TAB)};
                pg8::gemm_phase(GEMM_LDS, g, S, E, F.wave);
            }
            SEAM(pb + 12);
            if (EN(16) && IN(pb + 13)) for (int rep_ = 0; rep_ <= (int)RP(16); ++rep_) { REFRAME();
                pg8::Gemm g{F.wp<bf16_t>(O_ACT), FFN, F.wp<bf16_t>(O_W2), FFN, FFN}; pg8::OrdStatic S{NTOK / 256, D / 256, F.G, c};
                pg8::EpiResid E{HBUF(), HBUF(), nullptr};
                pg8::gemm_phase(GEMM_LDS, g, S, E, F.wave);
            }
            if (IN(pb + 13) && IN(pb + PH_PER_LAYER)) GRID_BAR();
        } else {
            if (EN(17) && IN(pb + 11)) for (int rep_ = 0; rep_ <= (int)RP(17); ++rep_) { REFRAME(); phase_rmsnorm_route(F, HBUF(), F.inp(25) + l * D, F.inp(28)); }
            SEAM(pb + 11);
            if (EN(18) && IN(pb + 12)) for (int rep_ = 0; rep_ <= (int)RP(18); ++rep_) { REFRAME(); phase_moe_scatter(F, tile_e, pstart, ntiles, myoff); }
            SEAM(pb + 12);
            if (EN(19) && IN(pb + 13)) for (int rep_ = 0; rep_ <= (int)RP(19); ++rep_) { REFRAME();
                if (!IN(pb + 12)) moe_tables(F, tile_e, pstart, ntiles);
                pg8::Gemm g{(const bf16_t*)F.wp<unsigned char>(O_XG), D / 2, (const bf16_t*)F.wp<unsigned char>(O_MW13), D / 2, D / 2}; pg8::OrdMoe S{*ntiles, 2 * FFN / (128 * F8_NBJ), F.G, c, tile_e, 1 << 30};
                pg8::EpiSwiGLU8<F8_NBJ> E{F.wp<unsigned char>(O_ACTM), 1.0f / (F8_ASCALE * F8_WSCALE)};
                pg8::gemm_phase_f8<pg8::EpiSwiGLU8<F8_NBJ>, pg8::OrdMoe, F8_FULL != 0>(GEMM_LDS, g, S, E, F.wave);
            }
            SEAM(pb + 13);
            if (EN(20) && IN(pb + 14)) for (int rep_ = 0; rep_ <= (int)RP(20); ++rep_) { REFRAME();
                if (!IN(pb + 13)) moe_tables(F, tile_e, pstart, ntiles);
                int full, R, sp; pg8::moe_tail_split(*ntiles, F.G, full, R, sp);
                { pg8::Gemm g{(const bf16_t*)F.wp<unsigned char>(O_ACTM), FFN / 2, (const bf16_t*)F.wp<unsigned char>(O_MW2), FFN / 2, FFN / 2}; pg8::OrdMoe S{*ntiles, D / 256, F.G, c, tile_e, full};
                  pg8::EpiBf16S<2> E{F.wp<bf16_t>(O_YG), D, 1.0f / (F8_ASCALE * F8_WSCALE)};
                  pg8::gemm_phase_f8<pg8::EpiBf16S<2>, pg8::OrdMoe, true>(GEMM_LDS, g, S, E, F.wave); }
                if (R > 0) {
                    REFRAME();
                    const int uix = c / sp, kp = c - uix * sp, Kp = FFN / sp;
                    pg8::OrdOne S1; S1.valid = (uix < R); S1.u.pm = 0; S1.u.pn = 0; S1.u.pa = 0; S1.u.pb = 0; S1.u.aux = 0; S1.u.ui = 0;
                    if (S1.valid) { pg8::static_map((long)full * F.G + uix, *ntiles, D / 256, S1.u.pm, S1.u.pn); S1.u.aux = tile_e[S1.u.pm]; S1.u.pa = S1.u.pm; S1.u.pb = S1.u.aux * (D / 256) + S1.u.pn; }
                    pg8::Gemm g1{(const bf16_t*)(F.wp<unsigned char>(O_ACTM) + (size_t)kp * Kp), FFN / 2, (const bf16_t*)(F.wp<unsigned char>(O_MW2) + (size_t)kp * Kp), FFN / 2, Kp / 2};
                    pg8::EpiPart E1{F.wp<float>(O_TAILACC) + (size_t)(S1.valid ? c : 0) * 65536, 1.0f / (F8_ASCALE * F8_WSCALE)};
                    pg8::gemm_phase_f8<pg8::EpiPart, pg8::OrdOne, true>(GEMM_LDS, g1, S1, E1, F.wave);
                }
            }
            if (IN(pb + 14) && IN(pb + PH_PER_LAYER)) GRID_BAR();
        }
    }
    if (EN(21) && IN(PH_FINAL)) for (int rep_ = 0; rep_ <= (int)RP(21); ++rep_) { REFRAME(); if (!IN(PH_FINAL - 2) && (((DEPTH - 1) & 1) != 0)) moe_tables(F, tile_e, pstart, ntiles); phase_final(F, ((DEPTH - 1) & 1) != 0, ntiles, (unsigned char*)(misc + 256)); }
#undef IN
#undef SEAM
}

#ifndef HOST_EMU
extern "C" void kernel_launch(void* const* d_in, const int* in_sizes, int n_in, void* d_out, int out_size, void* d_ws, size_t ws_size, hipStream_t stream) {
    static int grid = 0;
    if (grid == 0) {
        if (n_in != 32 || in_sizes[0] != NTOK * D || out_size != NTOK * D || ws_size < WS_END) {
            fprintf(stderr, "kernel_launch: shape/workspace mismatch: n_in %d in0 %d out %d ws %zu (need %zu)\n", n_in, n_in > 0 ? in_sizes[0] : -1, out_size, ws_size, (size_t)WS_END); grid = -1; return; }
        int dev = 0, cus = 0, per_cu = 0;
        if (hipGetDevice(&dev) != hipSuccess || hipDeviceGetAttribute(&cus, hipDeviceAttributeMultiprocessorCount, dev) != hipSuccess) { grid = -1; return; }
        if (hipFuncSetAttribute((const void*)mk_fwd, hipFuncAttributeMaxDynamicSharedMemorySize, LDS_BYTES) != hipSuccess) { fprintf(stderr, "kernel_launch: hipFuncSetAttribute failed\n"); grid = -1; return; }
        if (hipOccupancyMaxActiveBlocksPerMultiprocessor(&per_cu, (const void*)mk_fwd, NTHREADS, LDS_BYTES) != hipSuccess || per_cu < 1)
            fprintf(stderr, "kernel_launch: occupancy query reports %d workgroups per CU\n", per_cu);
        (void)hipGetLastError();
        grid = cus;
    }
    if (grid < 0) return;
    if (hipMemsetAsync((char*)d_ws + O_CTL, 0, SZ_CTL, stream) != hipSuccess) { fprintf(stderr, "kernel_launch: memset failed\n"); return; }
    Params p{};
    for (int i = 0; i < 32; ++i) p.in[i] = (const float*)d_in[i];
    p.out = (float*)d_out; p.ws = (unsigned char*)d_ws;
    if (MK_N_LAUNCHES == 1) {
        p.ph_lo = 0; p.ph_hi = PH_COUNT;
        hipLaunchKernelGGL(mk_fwd, dim3(grid), dim3(NTHREADS), LDS_BYTES, stream, p);
    } else {
        for (int ph = 0; ph < PH_COUNT; ++ph) {
            const int k = (ph - 1) % PH_PER_LAYER, l = (ph - 1) / PH_PER_LAYER;
            if (ph >= 1 && ph < PH_FINAL && (k == 15 || (k == 14 && (l & 1) == 0) || (k == 0 && l == 0))) continue;
            p.ph_lo = ph; p.ph_hi = ph + 1;
            hipLaunchKernelGGL(mk_fwd, dim3(grid), dim3(NTHREADS), LDS_BYTES, stream, p);
        }
    }
    const hipError_t le = hipPeekAtLastError();
    if (le != hipSuccess) fprintf(stderr, "kernel_launch: launch failed: %s\n", hipGetErrorName(le));
}
#endif
```

```cpp
#ifndef HOST_EMU
#include <hip/hip_runtime.h>
#endif
#include <cstdio>
#include <cstdint>
#include <cstddef>

#ifndef CFG_BATCH
#define CFG_BATCH 8
#endif
#ifndef CFG_SEQ
#define CFG_SEQ 2048
#endif
#ifndef MK_N_LAUNCHES
#define MK_N_LAUNCHES 1
#endif

typedef unsigned short bf16_t;
#ifndef HOST_EMU
#define DI __device__ __forceinline__
#define LAS __attribute__((address_space(3)))
#define GAS __attribute__((address_space(1)))
typedef short bf16x8 __attribute__((ext_vector_type(8)));
typedef short s16x4 __attribute__((ext_vector_type(4)));
typedef float f32x4 __attribute__((ext_vector_type(4)));
typedef float f32x2 __attribute__((ext_vector_type(2)));
typedef unsigned u32x4 __attribute__((ext_vector_type(4)));
typedef unsigned u32x2 __attribute__((ext_vector_type(2)));
DI f32x4 mfma16(bf16x8 a, bf16x8 b, f32x4 c) { return __builtin_amdgcn_mfma_f32_16x16x32_bf16(a, b, c, 0, 0, 0); }
DI s16x4 lds_tr4(const void* p) { return __builtin_amdgcn_ds_read_tr16_b64_v4i16((LAS s16x4*)(p)); }
DI float shfl_xor_f(float v, int m) { return __shfl_xor(v, m); }
DI float shfl_f(float v, int src) { return __shfl(v, src); }
DI int shfl_xor_i(int v, int m) { return __shfl_xor(v, m); }
DI int rfl(int v) { return __builtin_amdgcn_readfirstlane(v); }
DI int lane_id_hw() { return (int)__builtin_amdgcn_mbcnt_hi(~0u, __builtin_amdgcn_mbcnt_lo(~0u, 0u)); }
DI float fexp2(float x) { return __builtin_amdgcn_exp2f(x); }
DI float fexp(float x) { return __expf(x); }
DI float flog(float x) { return __logf(x); }
DI float frcp(float x) { return __builtin_amdgcn_rcpf(x); }
DI float frsqrt(float x) { return __builtin_amdgcn_rsqf(x); }
DI float fsin_rev(float rev) { return __builtin_amdgcn_sinf(rev); }
DI float fcos_rev(float rev) { return __builtin_amdgcn_cosf(rev); }
DI int atomic_add_i(int* p, int v) { return __hip_atomic_fetch_add(p, v, __ATOMIC_RELAXED, __HIP_MEMORY_SCOPE_AGENT); }
DI int lds_atomic_add_i(int* p, int v) { return __hip_atomic_fetch_add(p, v, __ATOMIC_RELAXED, __HIP_MEMORY_SCOPE_WORKGROUP); }
DI void atomic_add_f(float* p, float v) { (void)__hip_atomic_fetch_add(p, v, __ATOMIC_RELAXED, __HIP_MEMORY_SCOPE_AGENT); }
DI unsigned cvt_pk_bf16(float lo, float hi) { unsigned r; asm volatile("s_nop 0\n\tv_cvt_pk_bf16_f32 %0, %1, %2" : "=v"(r) : "v"(lo), "v"(hi)); return r; }
#define WAVE_FENCE() asm volatile("s_waitcnt lgkmcnt(0)" ::: "memory")
#define SCHED_BAR() __builtin_amdgcn_sched_barrier(0)
#define PIN_ACC8(a) asm volatile("" : "+v"((a)[0]), "+v"((a)[1]), "+v"((a)[2]), "+v"((a)[3]), "+v"((a)[4]), "+v"((a)[5]), "+v"((a)[6]), "+v"((a)[7]))
DI float u2f(unsigned u) { return __uint_as_float(u); }
DI unsigned f2u(float f) { return __float_as_uint(f); }
#else
#define DI inline __attribute__((always_inline))
#define WAVE_FENCE() emu::wave_sync()
#define SCHED_BAR()
#define PIN_ACC8(a)
DI float u2f(unsigned u) { float f; memcpy(&f, &u, 4); return f; }
DI unsigned f2u(float f) { unsigned u; memcpy(&u, &f, 4); return u; }
#endif

#ifndef HOST_EMU
#define LAUNDER_V(x) asm volatile("" : "+v"(x))
#define LAUNDER_S(x) asm volatile("" : "+s"(x))
#else
#define LAUNDER_V(x)
#define LAUNDER_S(x)
#endif
#ifndef HOST_EMU
typedef int i32x8 __attribute__((ext_vector_type(8)));
DI unsigned cvt_pk4_fp8(float a, float b, float c, float d) { int v = __builtin_amdgcn_cvt_pk_fp8_f32(a, b, 0, false); v = __builtin_amdgcn_cvt_pk_fp8_f32(c, d, v, true); return (unsigned)v; }
#else
DI unsigned f2fp8_host(float f) {
    unsigned s = f < 0.f ? 0x80u : 0u; float a = fabsf(f); if (!(a == a)) return s | 0x7f; if (a >= 448.f) return s | 0x7e;
    if (a < 0.0009765625f) return s;
    int e; float m = frexpf(a, &e); e -= 1; m *= 2.f;
    if (e < -6) { const float q = a * 512.f; int n = (int)lrintf(q); return s | (unsigned)n; }
    int n = (int)lrintf((m - 1.f) * 8.f); if (n == 8) { n = 0; e += 1; } if (e > 8 || (e == 8 && n > 6)) return s | 0x7e;
    return s | (unsigned)((e + 7) << 3) | (unsigned)n; }
DI unsigned cvt_pk4_fp8(float a, float b, float c, float d) { return f2fp8_host(a) | (f2fp8_host(b) << 8) | (f2fp8_host(c) << 16) | (f2fp8_host(d) << 24); }
DI float fp82f_host(unsigned v) { const unsigned s = v & 0x80u, e = (v >> 3) & 15u, m = v & 7u; float r = e == 0 ? (float)m * 0.001953125f : (1.f + (float)m * 0.125f) * exp2f((float)e - 7.f); return s ? -r : r; }
#endif
constexpr float F8_ASCALE = 16.0f, F8_WSCALE = 1024.0f;
#ifndef F8_FULL
#define F8_FULL 1
#endif
constexpr int F8_NBJ = F8_FULL ? 2 : 1;
DI float bf2f(bf16_t b) { return u2f(((unsigned)b) << 16); }
DI bf16_t f2bf(float f) { unsigned u = f2u(f); return (bf16_t)((u + 0x7fffu + ((u >> 16) & 1u)) >> 16); }
DI float bflo(unsigned w) { return u2f(w << 16); }
DI float bfhi(unsigned w) { return u2f(w & 0xffff0000u); }
DI float wave_sum(float v) {
#pragma unroll
    for (int o = 1; o < 64; o <<= 1) v += shfl_xor_f(v, o);
    return v;
}
#ifndef HOST_EMU
DI float xmax16(float v) { typedef unsigned u2_ __attribute__((ext_vector_type(2))); const unsigned u = f2u(v); const u2_ r = __builtin_amdgcn_permlane16_swap(u, u, false, false); return fmaxf(u2f(r.x), u2f(r.y)); }
DI float xmax32(float v) { typedef unsigned u2_ __attribute__((ext_vector_type(2))); const unsigned u = f2u(v); const u2_ r = __builtin_amdgcn_permlane32_swap(u, u, false, false); return fmaxf(u2f(r.x), u2f(r.y)); }
DI bool wave_any(bool p) { return __any(p ? 1 : 0) != 0; }
#else
DI float xmax16(float v) { return fmaxf(v, shfl_xor_f(v, 16)); }
DI float xmax32(float v) { return fmaxf(v, shfl_xor_f(v, 32)); }
DI bool wave_any(bool p) { int v = p ? 1 : 0;
    for (int o = 1; o < 64; o <<= 1) v |= shfl_xor_i(v, o);
    return v != 0; }
#endif
DI unsigned vzero() { unsigned z = 0u; LAUNDER_V(z); return z; }
DI float sigmoidf_(float x) { return frcp(1.0f + fexp(-x)); }
DI float siluf_(float x) { return x * frcp(1.0f + fexp(-x)); }

constexpr int BATCH = CFG_BATCH, SEQ = CFG_SEQ, NTOK = BATCH * SEQ, D = 2048, DEPTH = 2, MEMLEN = 256, NMEM = BATCH * MEMLEN;
constexpr int IN_TOTAL = 16216, UW = 16384, UWP = UW + 64;
constexpr float RMS_EPS = 1e-6f;
constexpr int FFN = 7168, NEXP = 8;
constexpr int UC_MLQ = 0, UC_MLK = 512, UC_MLV = 1024, UC_MLO = 2048, UC_SSZ = 3072, UC_XBC = 4096, UC_CQ = 5632, UC_CKV = 6144, UC_SM = 6400,
              UC_SWQ = 6656, UC_SWK = 7680, UC_SWV = 7936, UC_GATE = 8192;
constexpr int SM_TILE = UC_SM / 256;
constexpr int SO_MLI = 3072, SO_SSZ = 3080, SO_XBC = 4104, SO_DT = 5640, SO_CQ = 5656, SO_CKV = 6168, SO_KR = 6424, SO_SWQ = 6488, SO_SWK = 7512, SO_SWV = 7768, SO_GATE = 8024;
constexpr int SLOTS = 2 * NTOK + NEXP * 256;
constexpr int MAXTILES = SLOTS / 256;

constexpr size_t al256(size_t x) { return (x + 255) & ~(size_t)255; }
constexpr size_t O_CTL = 0, SZ_CTL = 1u << 20;
constexpr size_t O_WIN = O_CTL + SZ_CTL;
constexpr size_t O_WUQ = O_WIN + (size_t)DEPTH * UW * D * 2;
constexpr size_t O_WUKV = O_WUQ + (size_t)DEPTH * 1536 * 512 * 2;
constexpr size_t O_WBR = O_WUKV + (size_t)DEPTH * 2048 * 256 * 2;
constexpr size_t O_WOUT = O_WBR + (size_t)DEPTH * 4 * 2048 * 1024 * 2;
constexpr size_t O_WXQ = O_WOUT + (size_t)DEPTH * 2048 * 2048 * 2;
constexpr size_t O_WXKV = O_WXQ + (size_t)DEPTH * 512 * 2048 * 2;
constexpr size_t O_WXO = O_WXKV + (size_t)DEPTH * 1024 * 2048 * 2;
constexpr size_t O_W13 = O_WXO + (size_t)DEPTH * 2048 * 512 * 2;
constexpr size_t O_W2 = O_W13 + (size_t)2 * FFN * D * 2;
constexpr size_t O_MW13 = O_W2 + (size_t)D * FFN * 2;
constexpr size_t O_MW2 = O_MW13 + (size_t)NEXP * 2 * FFN * D * 2;
constexpr size_t O_ROPE = O_MW2 + (size_t)NEXP * D * FFN * 2;
constexpr size_t O_H = al256(O_ROPE + (size_t)SEQ * 64 * 4);
constexpr size_t O_G8 = O_H + (size_t)NTOK * D * 2;
constexpr size_t O_XN = O_H + (size_t)NTOK * D * 4;
constexpr size_t O_MEMN = O_XN + (size_t)NTOK * D * 2;
constexpr size_t O_U = O_MEMN + (size_t)DEPTH * NMEM * D * 2;
constexpr size_t O_SM = O_U + (size_t)NTOK * UWP * 2;
constexpr size_t O_CQN = O_SM + (size_t)NTOK * 256 * 4;
constexpr size_t O_CKVN = O_CQN + (size_t)NTOK * 512 * 2;
constexpr size_t O_KR = O_CKVN + (size_t)NTOK * 256 * 2;
constexpr size_t O_XBC = O_KR + (size_t)NTOK * 64 * 2;
constexpr size_t O_DT = O_XBC + (size_t)NTOK * 1536 * 2;
constexpr size_t O_DA = O_DT + (size_t)NTOK * 16 * 4;
constexpr size_t O_GI = O_DA + (size_t)NTOK * 16 * 4;
constexpr size_t O_LF = O_GI + (size_t)NTOK * 4 * 4;
constexpr size_t O_QF = O_LF + (size_t)NTOK * 4 * 4;
constexpr size_t O_KVF = O_QF + (size_t)NTOK * 1536 * 2;
constexpr size_t O_Y = O_KVF + (size_t)NTOK * 2048 * 2;
constexpr size_t O_MACC = O_Y + (size_t)4 * NTOK * 1024 * 2;
constexpr size_t O_SSQ = O_MACC;
constexpr size_t O_RSTD = O_SSQ + (size_t)NTOK * 32 * 4;
constexpr size_t O_MERGED = O_MACC + (size_t)NTOK * D * 4;
constexpr size_t O_XQ = O_MERGED + (size_t)NTOK * D * 2;
constexpr size_t O_XKV = O_XQ + (size_t)NTOK * 512 * 2;
constexpr size_t O_XO = O_XKV + (size_t)NMEM * 1024 * 2;
constexpr size_t O_ACT = O_XO + (size_t)NTOK * 512 * 2;
constexpr size_t O_XG = O_ACT + (size_t)NTOK * FFN * 2;
constexpr size_t O_YG = O_XG + (size_t)SLOTS * D * 2;
constexpr size_t O_ROUTE = O_YG + (size_t)SLOTS * D * 2;
constexpr size_t O_BLKCNT = O_ROUTE + (size_t)NTOK * 2 * 4 * 3;
constexpr size_t O_TAILACC = al256(O_BLKCNT + 1024 * 8 * 4);
constexpr size_t O_XN8 = al256(O_TAILACC + (size_t)256 * 65536 * 4);
constexpr size_t O_WG8 = O_XN8 + (size_t)NTOK * D;
constexpr size_t O_ACTM = al256(O_WG8 + (size_t)DEPTH * 8192 * D);
constexpr size_t WS_END = O_ACTM + (size_t)SLOTS * FFN * 2;

constexpr int LDS_BYTES = 147456;
constexpr int LDS_MISC = 143360;
constexpr int NTHREADS = 512;

struct Params { const float* in[32]; float* out; unsigned char* ws; int ph_lo, ph_hi, flags, pad; };

#ifndef HOST_EMU
#define XB_TMO      128
#define XB_XCNT(j)  (256  + 64 * (j))
#define XB_XSUB(j)  (1280 + 64 * (j))
#define XB_XGEN(j)  (2304 + 64 * (j))
#define XB_TOP      3328
#define XB_TOPGEN   3392
#define XCD_BAR_WORDS 3456
#define XB_SPIN_CAP (1u << 22)
__device__ __forceinline__ unsigned xb_ld(unsigned* p)              { return __hip_atomic_load(p, __ATOMIC_RELAXED, __HIP_MEMORY_SCOPE_AGENT); }
__device__ __forceinline__ unsigned xb_add(unsigned* p, unsigned v) { return __hip_atomic_fetch_add(p, v, __ATOMIC_RELAXED, __HIP_MEMORY_SCOPE_AGENT); }
__device__ __forceinline__ unsigned xb_xcc_id() { return (unsigned)__builtin_amdgcn_s_getreg((3 << 11) | 20) & 0xFu; }
#define XB_SPIN(cond, bar) do { unsigned _sp = 0; while (cond) { __builtin_amdgcn_s_sleep(1); \
    if ((++_sp & 255u) == 0u) { if (xb_ld(&(bar)[XB_TMO])) break; if (_sp > XB_SPIN_CAP) { atomicAdd(&(bar)[XB_TMO], 1u); break; } } } } while (0)
struct XcdBarrier { unsigned* bar; unsigned x; volatile LAS unsigned* st; int wave; };
__device__ __forceinline__ bool xb_thread0(int wave) { return wave == 0 && lane_id_hw() == 0; }
__device__ __forceinline__ XcdBarrier xcd_barrier_post(unsigned* bar, volatile LAS unsigned* st, int wave) {
    XcdBarrier b; b.bar = bar; b.x = xb_xcc_id(); b.st = st; b.wave = wave;
    if (xb_thread0(wave)) (void)xb_add(&bar[XB_XCNT(b.x)], 1u);
    return b;
}
__device__ __forceinline__ void xcd_barrier_complete(unsigned* bar, unsigned x, unsigned& nloc, unsigned& nx) {
    const unsigned G = gridDim.x * gridDim.y * gridDim.z;
    unsigned sum, cnt, mine, sp = 0u;
    for (;;) {
        sum = 0u; cnt = 0u; mine = 0u;
#pragma unroll
        for (unsigned j = 0; j < 16; ++j) { const unsigned c = xb_ld(&bar[XB_XCNT(j)]); sum += c; cnt += (c > 0u) ? 1u : 0u; mine = (j == x) ? c : mine; }
        if (sum == G) break;
        __builtin_amdgcn_s_sleep(1);
        if ((++sp & 255u) == 0u) { if (xb_ld(&bar[XB_TMO])) break; if (sp > XB_SPIN_CAP) { atomicAdd(&bar[XB_TMO], 1u); break; } }
    }
    nloc = mine > 0u ? mine : 1u; nx = cnt > 0u ? cnt : 1u;
}
__device__ __forceinline__ void xcd_barrier(const XcdBarrier& b) {
    asm volatile("s_waitcnt vmcnt(0)" ::: "memory");
    __syncthreads();
    if (xb_thread0(b.wave)) {
        unsigned* bar = b.bar;
        __builtin_amdgcn_s_waitcnt(0);
        unsigned nloc = b.st[0], nx = b.st[1];
        if (nloc == 0u) { xcd_barrier_complete(bar, b.x, nloc, nx); b.st[0] = nloc; b.st[1] = nx; }
        const unsigned old = xb_add(&bar[XB_XSUB(b.x)], 1u);
        const unsigned gen = old / nloc;
        if (old + 1u == (gen + 1u) * nloc) {
            __builtin_amdgcn_fence(__ATOMIC_RELEASE, "agent");
            asm volatile("s_waitcnt vmcnt(0)" ::: "memory");
            const unsigned og = xb_add(&bar[XB_TOP], 1u);
            const unsigned tg = og / nx;
            if (og + 1u == (tg + 1u) * nx) xb_add(&bar[XB_TOPGEN], 1u);
            else XB_SPIN(xb_ld(&bar[XB_TOPGEN]) == tg, bar);
            __builtin_amdgcn_fence(__ATOMIC_ACQUIRE, "agent");
            xb_add(&bar[XB_XGEN(b.x)], 1u);
            asm volatile("s_waitcnt vmcnt(0)" ::: "memory");
        } else {
            XB_SPIN(xb_ld(&bar[XB_XGEN(b.x)]) == gen, bar);
            __builtin_amdgcn_fence(__ATOMIC_ACQUIRE, "agent");
            asm volatile("s_waitcnt vmcnt(0)" ::: "memory");
        }
    }
    __syncthreads();
}
#endif

namespace pg8 {
constexpr int BM = 256, BK = 64, HALF = 128, HTB = HALF * BK * 2, STAGE_BYTES = 8 * HTB, NXCD = 8, WGM = 4;
DI int lds_byte(int r, int c) { const int st = (r >> 4) * 2 + (c >> 5), rr = r & 15, cc = c & 31, ob = rr * 64 + cc * 2; return st * 1024 + (ob ^ (((ob >> 9) & 1) << 5)); }
DI void stage_rc(int b, int& R, int& C) { const int st = b / 1024, sb = b % 1024, swz = sb ^ (((sb >> 9) & 1) << 5); R = (st >> 1) * 16 + swz / 64; C = (st & 1) * 32 + (swz % 64) / 2; }
DI int perm32(int rho) { const int n = rho >> 4, i = rho & 15; return 8 * (i >> 2) + 4 * n + (i & 3); }
struct Unit { int pa, pb, pm, pn, aux, ui; };
struct Gemm { const bf16_t* A; int lda; const bf16_t* Bt; int ldb; int K; };
DI bool static_map(long L, int nM, int nN, int& pm, int& pn) {
    const int nwg = nM * nN; if (L >= nwg) return false;
    int wgid = (int)L; { const int q = nwg / NXCD, r = nwg % NXCD, xcd = wgid % NXCD, off = wgid / NXCD; wgid = (xcd < r ? xcd * (q + 1) : r * (q + 1) + (xcd - r) * q) + off; }
    const int nig = WGM * nN, gid = wgid / nig, fm = gid * WGM, gsz = (nM - fm) < WGM ? (nM - fm) : WGM;
    pm = fm + ((wgid % nig) % gsz); pn = (wgid % nig) / gsz; return true;
}
struct OrdStatic { int nM, nN, G, c;
    DI bool next(int i, Unit& u) const { if (!static_map((long)i * G + c, nM, nN, u.pm, u.pn)) return false; u.pa = u.pm; u.pb = u.pn; u.aux = 0; u.ui = i; return true; } };
struct OrdMerge { int nM, nN, G, c;
    DI bool next(int i, Unit& u) const { if (!static_map((long)(i >> 2) * G + c, nM, nN, u.pm, u.pn)) return false; u.aux = i & 3; u.pa = u.aux * nM + u.pm; u.pb = u.aux * nN + u.pn; u.ui = i; return true; } };
struct OrdMoe { int nM, nN, G, c; const int* tile_e; int imax;
    DI bool next(int i, Unit& u) const { if (i >= imax || !static_map((long)i * G + c, nM, nN, u.pm, u.pn)) return false; u.aux = tile_e[u.pm]; u.pa = u.pm; u.pb = u.aux * nN + u.pn; u.ui = i; return true; } };
struct OrdOne { Unit u; bool valid;
    DI bool next(int i, Unit& o) const { if (i != 0 || !valid) return false; o = u; return true; } };
DI void moe_tail_split(int ntiles, int G, int& full, int& R, int& sp) {
    const int units = ntiles * 8; full = units / G; R = units - full * G; sp = 0;
    if (R > 0) { sp = 1; if (R * 2 <= G) sp = 2; if (R * 4 <= G) sp = 4; if (R * 7 <= G) sp = 7; }
}

#ifndef HOST_EMU
template <class Epi, class Sched>
__device__ __forceinline__ void gemm_phase(LAS unsigned char* lds, const Gemm g, const Sched& S, const Epi& E, int wave_id) {
    int lane_ = lane_id_hw(); asm volatile("" : "+v"(lane_)); int wid_ = wave_id; asm volatile("" : "+s"(wid_));
    const int tid = wid_ * 64 + lane_, wid = wid_, lane = tid & 63, wr = wid >> 2, wc = wid & 3, fr = lane & 15, fq = lane >> 4;
    const int K = g.K, nt = K / BK;
    unsigned voffA[2], voffB[2];
#pragma unroll
    for (int i = 0; i < 2; ++i) { int R, C; stage_rc(tid * 16 + i * 8192, R, C); const int Rb = Epi::PERM ? ((R & ~31) + perm32(R & 31)) : R;
        voffA[i] = (unsigned)(R * g.lda + C) * 2u; voffB[i] = (unsigned)(Rb * g.ldb + C) * 2u; }
    const size_t kstep = (size_t)(BK * 2);
    const size_t hstepA = (size_t)HALF * g.lda * 2, hstepB = (size_t)HALF * g.ldb * 2;
    const size_t tstepA = 2 * hstepA, tstepB = 2 * hstepB;
    const unsigned ldsw = (unsigned)wid * 1024u;
    const int aoff = lds_byte(wr * 64 + fr, fq * 8), boff = lds_byte(wc * 32 + fr, fq * 8);
#define PG8_SA(b, h) (((b) * 2 + (h)) * HTB)
#define PG8_SB(b, h) ((4 + (b) * 2 + (h)) * HTB)
#define PG8_STAGE(bufoff, gbase, voff) do { _Pragma("unroll") for (int _i = 0; _i < 2; ++_i) \
        __builtin_amdgcn_global_load_lds((const unsigned*)((const char*)(gbase) + (voff)[_i]), (LAS unsigned*)(lds + (bufoff) + ldsw + _i * 8192), 16, 0, 0); } while (0)
#define PG8_LDA(dst, b, h) do { _Pragma("unroll") for (int m = 0; m < 4; ++m) _Pragma("unroll") for (int k = 0; k < 2; ++k) dst[m][k] = *(const LAS bf16x8*)(lds + PG8_SA(b, h) + aoff + m * 2048 + k * 1024); } while (0)
#define PG8_LDB(dst, b, h) do { _Pragma("unroll") for (int n = 0; n < 2; ++n) _Pragma("unroll") for (int k = 0; k < 2; ++k) dst[n][k] = *(const LAS bf16x8*)(lds + PG8_SB(b, h) + boff + n * 2048 + k * 1024); } while (0)
#define PG8_MMA(ai, bj, At, Bt) do { __builtin_amdgcn_s_setprio(1); _Pragma("unroll") for (int m = 0; m < 4; ++m) _Pragma("unroll") for (int n = 0; n < 2; ++n) _Pragma("unroll") for (int k = 0; k < 2; ++k) \
        acc[ai][bj][m][n] = __builtin_amdgcn_mfma_f32_16x16x32_bf16(Bt[n][k], At[m][k], acc[ai][bj][m][n], 0, 0, 0); __builtin_amdgcn_s_setprio(0); } while (0)
#define PG8_WAIT_V(n) asm volatile("s_waitcnt vmcnt(" #n ")" ::: "memory")
#define PG8_WAIT_L(n) asm volatile("s_waitcnt lgkmcnt(" #n ")" ::: "memory")
#define PG8_BAR __builtin_amdgcn_s_barrier()
#define PG8_SCHED __builtin_amdgcn_sched_barrier(0)
    Unit cur, nxt; int ui = 0;
    if (!S.next(0, cur)) return;
    if constexpr (Epi::HAS_PREP) E.prep(cur, tid);
    f32x4 acc[2][2][4][2];
#pragma unroll
    for (int a = 0; a < 2; ++a)
#pragma unroll
        for (int b = 0; b < 2; ++b)
#pragma unroll
            for (int m = 0; m < 4; ++m)
#pragma unroll
                for (int n = 0; n < 2; ++n) acc[a][b][m][n] = (f32x4){0.f, 0.f, 0.f, 0.f};
    bf16x8 At[4][2], B0[2][2], B1[2][2];
    const char* cA = (const char*)g.A + (size_t)cur.pa * tstepA; const char* cB = (const char*)g.Bt + (size_t)cur.pb * tstepB;
    PG8_STAGE(PG8_SB(0, 0), cB, voffB); PG8_STAGE(PG8_SB(0, 1), cB + hstepB, voffB); PG8_STAGE(PG8_SA(0, 0), cA, voffA); PG8_STAGE(PG8_SA(0, 1), cA + hstepA, voffA);
    if (wr == 1) PG8_BAR;
    PG8_WAIT_V(2); PG8_BAR;
    PG8_STAGE(PG8_SB(1, 0), cB + kstep, voffB); PG8_STAGE(PG8_SA(1, 0), cA + kstep, voffA); PG8_STAGE(PG8_SB(1, 1), cB + hstepB + kstep, voffB);
    PG8_WAIT_V(6); PG8_BAR;
    for (;;) {
        const bool has_next = S.next(ui + 1, nxt);
        const char* nA = has_next ? (const char*)g.A + (size_t)nxt.pa * tstepA : cA; const char* nB = has_next ? (const char*)g.Bt + (size_t)nxt.pb * tstepB : cB;
        for (int t = 0; t < nt; t += 2) {
            const bool last = (t == nt - 2);
            const char* a1 = cA + (size_t)(t + 1) * kstep;
            const char* a2 = last ? nA : cA + (size_t)(t + 2) * kstep; const char* b2 = last ? nB : cB + (size_t)(t + 2) * kstep;
            const char* a3 = a2 + kstep; const char* b3 = b2 + kstep;
            PG8_LDB(B0, 0, 0); PG8_LDB(B1, 0, 1); PG8_SCHED; PG8_LDA(At, 0, 0); PG8_STAGE(PG8_SA(1, 1), a1 + hstepA, voffA);
            PG8_WAIT_V(8); PG8_WAIT_L(0); PG8_BAR; PG8_MMA(0, 0, At, B0); PG8_MMA(0, 1, At, B1); PG8_BAR; PG8_SCHED;
            PG8_LDA(At, 0, 1); PG8_STAGE(PG8_SB(0, 0), b2, voffB); PG8_STAGE(PG8_SB(0, 1), b2 + hstepB, voffB); PG8_STAGE(PG8_SA(0, 0), a2, voffA);
            PG8_WAIT_V(8); PG8_WAIT_L(0); PG8_BAR; PG8_MMA(1, 0, At, B0); PG8_MMA(1, 1, At, B1); PG8_BAR; PG8_SCHED;
            PG8_LDB(B0, 1, 0); PG8_LDB(B1, 1, 1); PG8_SCHED; PG8_LDA(At, 1, 0); PG8_STAGE(PG8_SA(0, 1), a2 + hstepA, voffA);
            PG8_WAIT_V(8); PG8_WAIT_L(0); PG8_BAR; PG8_MMA(0, 0, At, B0); PG8_MMA(0, 1, At, B1); PG8_BAR; PG8_SCHED;
            PG8_LDA(At, 1, 1); PG8_STAGE(PG8_SB(1, 0), b3, voffB); PG8_STAGE(PG8_SB(1, 1), b3 + hstepB, voffB); PG8_STAGE(PG8_SA(1, 0), a3, voffA);
            PG8_WAIT_V(8); PG8_WAIT_L(0); PG8_BAR; PG8_MMA(1, 0, At, B0); PG8_MMA(1, 1, At, B1); PG8_BAR; PG8_SCHED;
        }
        if (wr == 0) PG8_BAR;
        E(acc, cur, wr, wc, fr, fq);
        if (!has_next) break;
        if constexpr (Epi::HAS_PREP) E.prep(nxt, tid);
#pragma unroll
        for (int a = 0; a < 2; ++a)
#pragma unroll
            for (int b = 0; b < 2; ++b)
#pragma unroll
                for (int m = 0; m < 4; ++m)
#pragma unroll
                    for (int n = 0; n < 2; ++n) acc[a][b][m][n] = (f32x4){0.f, 0.f, 0.f, 0.f};
        cur = nxt; cA = nA; cB = nB; ++ui;
        if (wr == 1) PG8_BAR;
    }
    PG8_WAIT_V(0);
    PG8_BAR;
#undef PG8_SA
#undef PG8_SB
#undef PG8_STAGE
#undef PG8_LDA
#undef PG8_LDB
#undef PG8_MMA
#undef PG8_WAIT_V
#undef PG8_WAIT_L
#undef PG8_BAR
#undef PG8_SCHED
}
template <class Epi, class Sched, bool FULLN = false>
__device__ __forceinline__ void gemm_phase_f8(LAS unsigned char* lds, const Gemm g, const Sched& S, const Epi& E, int wave_id) {
    int lane_ = lane_id_hw(); asm volatile("" : "+v"(lane_)); int wid_ = wave_id; asm volatile("" : "+s"(wid_));
    const int tid = wid_ * 64 + lane_, wid = wid_, lane = tid & 63, wr = wid >> 2, wc = wid & 3, fr = lane & 15, fq = lane >> 4;
    const int K = g.K, nt = K / BK;
    unsigned voffA[2], voffB[2];
#pragma unroll
    for (int i = 0; i < 2; ++i) { int R, C; stage_rc(tid * 16 + i * 8192, R, C); const int Rb = Epi::PERM ? ((R & ~31) + perm32(R & 31)) : R;
        voffA[i] = (unsigned)(R * g.lda + C) * 2u; voffB[i] = (unsigned)(Rb * g.ldb + C) * 2u; }
    const size_t kstep = (size_t)(BK * 2);
    const size_t hstepA = (size_t)HALF * g.lda * 2, hstepB = (size_t)HALF * g.ldb * 2;
    const size_t tstepA = 2 * hstepA, tstepB = 2 * hstepB;
    const unsigned ldsw = (unsigned)wid * 1024u;
    const int aoff0 = lds_byte(wr * 64 + fr, ((2 * fq) & 3) * 8) + (fq >> 1) * 1024, aoff1 = lds_byte(wr * 64 + fr, ((2 * fq + 1) & 3) * 8) + (fq >> 1) * 1024;
    const int boff0 = lds_byte(wc * 32 + fr, ((2 * fq) & 3) * 8) + (fq >> 1) * 1024, boff1 = lds_byte(wc * 32 + fr, ((2 * fq + 1) & 3) * 8) + (fq >> 1) * 1024;
#define PG8_SA(b, h) (((b) * 2 + (h)) * HTB)
#define PG8_SB(b, h) ((4 + (b) * 2 + (h)) * HTB)
#define PG8_STAGE(bufoff, gbase, voff) do { _Pragma("unroll") for (int _i = 0; _i < 2; ++_i) \
        __builtin_amdgcn_global_load_lds((const unsigned*)((const char*)(gbase) + (voff)[_i]), (LAS unsigned*)(lds + (bufoff) + ldsw + _i * 8192), 16, 0, 0); } while (0)
#define PG8_LDA(dst, b, h) do { _Pragma("unroll") for (int m = 0; m < 4; ++m) { dst[m][0] = *(const LAS u32x4*)(lds + PG8_SA(b, h) + aoff0 + m * 2048); dst[m][1] = *(const LAS u32x4*)(lds + PG8_SA(b, h) + aoff1 + m * 2048); } } while (0)
#define PG8_LDB(dst, b, h) do { _Pragma("unroll") for (int n = 0; n < 2; ++n) { dst[n][0] = *(const LAS u32x4*)(lds + PG8_SB(b, h) + boff0 + n * 2048); dst[n][1] = *(const LAS u32x4*)(lds + PG8_SB(b, h) + boff1 + n * 2048); } } while (0)
#define PG8_F8OP(x) __builtin_shufflevector(__builtin_bit_cast(i32x4_, (x)[0]), __builtin_bit_cast(i32x4_, (x)[1]), 0, 1, 2, 3, 4, 5, 6, 7)
#define PG8_MMA(ai, bj, At, Bt) do { __builtin_amdgcn_s_setprio(1); _Pragma("unroll") for (int m = 0; m < 4; ++m) _Pragma("unroll") for (int n = 0; n < 2; ++n) { \
        const i32x8 a8_ = PG8_F8OP(Bt[n]), b8_ = PG8_F8OP(At[m]); \
        asm volatile("v_mfma_scale_f32_16x16x128_f8f6f4 %0, %1, %2, %0, %3, %3 op_sel_hi:[0,0,0]" : "+v"(acc[ai][bj][m][n]) : "v"(a8_), "v"(b8_), "v"(f8one)); } \
        __builtin_amdgcn_s_setprio(0); } while (0)
#define PG8_WAIT_V(n) asm volatile("s_waitcnt vmcnt(" #n ")" ::: "memory")
#define PG8_WAIT_L(n) asm volatile("s_waitcnt lgkmcnt(" #n ")" ::: "memory")
#define PG8_BAR __builtin_amdgcn_s_barrier()
#define PG8_SCHED __builtin_amdgcn_sched_barrier(0)
    Unit cur, nxt; int ui = 0;
    if (!S.next(0, cur)) return;
    f32x4 acc[2][2][4][2];
#pragma unroll
    for (int a = 0; a < 2; ++a)
#pragma unroll
        for (int b = 0; b < 2; ++b)
#pragma unroll
            for (int m = 0; m < 4; ++m)
#pragma unroll
                for (int n = 0; n < 2; ++n) acc[a][b][m][n] = (f32x4){0.f, 0.f, 0.f, 0.f};
    typedef int i32x4_ __attribute__((ext_vector_type(4)));
    int f8one = 0x7F7F7F7F; asm volatile("" : "+v"(f8one));
    u32x4 At[4][2], B0[2][2], B1[2][2];
    const char* cA = (const char*)g.A + (size_t)cur.pa * tstepA; const char* cB = (const char*)g.Bt + (size_t)cur.pb * (FULLN ? tstepB : hstepB);
    PG8_STAGE(PG8_SB(0, 0), cB, voffB); PG8_STAGE(PG8_SB(0, 1), cB + hstepB, voffB); PG8_STAGE(PG8_SA(0, 0), cA, voffA); PG8_STAGE(PG8_SA(0, 1), cA + hstepA, voffA);
    if (wr == 1) PG8_BAR;
    PG8_WAIT_V(2); PG8_BAR;
    PG8_STAGE(PG8_SB(1, 0), cB + kstep, voffB); PG8_STAGE(PG8_SA(1, 0), cA + kstep, voffA); PG8_STAGE(PG8_SB(1, 1), cB + hstepB + kstep, voffB);
    PG8_WAIT_V(6); PG8_BAR;
    for (;;) {
        const bool has_next = S.next(ui + 1, nxt);
        const char* nA = has_next ? (const char*)g.A + (size_t)nxt.pa * tstepA : cA; const char* nB = has_next ? (const char*)g.Bt + (size_t)nxt.pb * (FULLN ? tstepB : hstepB) : cB;
        for (int t = 0; t < nt; t += 2) {
            const bool last = (t == nt - 2);
            const char* a1 = cA + (size_t)(t + 1) * kstep;
            const char* a2 = last ? nA : cA + (size_t)(t + 2) * kstep; const char* b2 = last ? nB : cB + (size_t)(t + 2) * kstep;
            const char* a3 = a2 + kstep; const char* b3 = b2 + kstep;
            PG8_LDB(B0, 0, 0); if constexpr (FULLN) PG8_LDB(B1, 0, 1); PG8_SCHED; PG8_LDA(At, 0, 0); PG8_STAGE(PG8_SA(1, 1), a1 + hstepA, voffA);
            PG8_WAIT_V(8); PG8_WAIT_L(0); PG8_BAR; PG8_MMA(0, 0, At, B0); if constexpr (FULLN) PG8_MMA(0, 1, At, B1); PG8_BAR; PG8_SCHED;
            PG8_LDA(At, 0, 1); PG8_STAGE(PG8_SB(0, 0), b2, voffB); PG8_STAGE(PG8_SB(0, 1), b2 + hstepB, voffB); PG8_STAGE(PG8_SA(0, 0), a2, voffA);
            PG8_WAIT_V(8); PG8_WAIT_L(0); PG8_BAR; PG8_MMA(1, 0, At, B0); if constexpr (FULLN) PG8_MMA(1, 1, At, B1); PG8_BAR; PG8_SCHED;
            PG8_LDB(B0, 1, 0); if constexpr (FULLN) PG8_LDB(B1, 1, 1); PG8_SCHED; PG8_LDA(At, 1, 0); PG8_STAGE(PG8_SA(0, 1), a2 + hstepA, voffA);
            PG8_WAIT_V(8); PG8_WAIT_L(0); PG8_BAR; PG8_MMA(0, 0, At, B0); if constexpr (FULLN) PG8_MMA(0, 1, At, B1); PG8_BAR; PG8_SCHED;
            PG8_LDA(At, 1, 1); PG8_STAGE(PG8_SB(1, 0), b3, voffB); PG8_STAGE(PG8_SB(1, 1), b3 + hstepB, voffB); PG8_STAGE(PG8_SA(1, 0), a3, voffA);
            PG8_WAIT_V(8); PG8_WAIT_L(0); PG8_BAR; PG8_MMA(1, 0, At, B0); if constexpr (FULLN) PG8_MMA(1, 1, At, B1); PG8_BAR; PG8_SCHED;
        }
        if (wr == 0) PG8_BAR;
        asm volatile("s_nop 15\n\ts_nop 15" : "+v"(acc[0][0][0][0]), "+v"(acc[0][0][0][1]), "+v"(acc[0][0][1][0]), "+v"(acc[0][0][1][1]), "+v"(acc[0][0][2][0]), "+v"(acc[0][0][2][1]), "+v"(acc[0][0][3][0]), "+v"(acc[0][0][3][1]) :: "memory");
        PIN_ACC8(&acc[0][1][0][0]); PIN_ACC8(&acc[1][0][0][0]); PIN_ACC8(&acc[1][1][0][0]);
        E(acc, cur, wr, wc, fr, fq);
        if (!has_next) break;
#pragma unroll
        for (int a = 0; a < 2; ++a)
#pragma unroll
            for (int b = 0; b < 2; ++b)
#pragma unroll
                for (int m = 0; m < 4; ++m)
#pragma unroll
                    for (int n = 0; n < 2; ++n) acc[a][b][m][n] = (f32x4){0.f, 0.f, 0.f, 0.f};
        cur = nxt; cA = nA; cB = nB; ++ui;
        if (wr == 1) PG8_BAR;
    }
    PG8_WAIT_V(0);
    PG8_BAR;
#undef PG8_SA
#undef PG8_SB
#undef PG8_STAGE
#undef PG8_LDA
#undef PG8_LDB
#undef PG8_MMA
#undef PG8_F8OP
#undef PG8_WAIT_V
#undef PG8_WAIT_L
#undef PG8_BAR
#undef PG8_SCHED
}
#else
template <class Epi, class Sched>
static void gemm_phase(unsigned char* lds, const Gemm g, const Sched& S, const Epi& E, int wave_id) {
    const int tid = threadIdx.x, wid = tid >> 6, lane = tid & 63, wr = wid >> 2, wc = wid & 3, fr = lane & 15, fq = lane >> 4;
    static thread_local float* Cbuf = nullptr; static thread_local float* Af = nullptr; static thread_local float* Bf = nullptr;
    Unit u;
    for (int i = 0; S.next(i, u); ++i) {
        __syncthreads();
        if constexpr (Epi::HAS_PREP) E.prep(u, tid);
        if (tid == 0) {
            if (!Cbuf) { Cbuf = (float*)malloc(256 * 256 * 4); Af = (float*)malloc((size_t)256 * 8192 * 4); Bf = (float*)malloc((size_t)256 * 8192 * 4); }
            const int K = g.K;
            for (int r = 0; r < 256; ++r) for (int k = 0; k < K; ++k) { Af[(size_t)r * K + k] = bf2f(g.A[((size_t)u.pa * 256 + r) * g.lda + k]); Bf[(size_t)r * K + k] = bf2f(g.Bt[((size_t)u.pb * 256 + r) * g.ldb + k]); }
            for (int r = 0; r < 256; ++r) for (int c = 0; c < 256; ++c) { const float* a = Af + (size_t)r * K; const float* b = Bf + (size_t)c * K; float s = 0.f;
                for (int k = 0; k < K; ++k) s += a[k] * b[k]; Cbuf[r * 256 + c] = s; }
        }
        __syncthreads();
        f32x4 acc[2][2][4][2];
        for (int ai = 0; ai < 2; ++ai) for (int bj = 0; bj < 2; ++bj) for (int m = 0; m < 4; ++m) for (int n = 0; n < 2; ++n) for (int j = 0; j < 4; ++j) {
            const int r = 128 * ai + 64 * wr + 16 * m + fr;
            const int c = Epi::PERM ? (128 * bj + 32 * wc + 8 * fq + 4 * n + j) : (128 * bj + 32 * wc + 16 * n + 4 * fq + j);
            acc[ai][bj][m][n][j] = Cbuf[r * 256 + c]; }
        E(acc, u, wr, wc, fr, fq);
    }
    __syncthreads();
}
#endif

typedef const f32x4 (&AccRef)[2][2][4][2];
struct EpiBf16 {
    static constexpr bool PERM = true; static constexpr bool HAS_PREP = false;
    bf16_t* O; int ldc;
    DI void operator()(AccRef acc, const Unit& u, int wr, int wc, int fr, int fq) const {
        const int row0 = u.pm * BM + wr * 64 + fr, col0 = u.pn * BM + wc * 32 + 8 * fq;
        float one = 1.0f; LAUNDER_S(one);
#pragma unroll
        for (int ai = 0; ai < 2; ++ai)
#pragma unroll
            for (int m = 0; m < 4; ++m) { bf16_t* rowp = O + (size_t)(row0 + ai * HALF + m * 16) * ldc + col0;
#pragma unroll
                for (int bj = 0; bj < 2; ++bj) { const f32x4 v0 = acc[ai][bj][m][0] * one, v1 = acc[ai][bj][m][1] * one;
                    u32x4 w; w.x = cvt_pk_bf16(v0[0], v0[1]); w.y = cvt_pk_bf16(v0[2], v0[3]); w.z = cvt_pk_bf16(v1[0], v1[1]); w.w = cvt_pk_bf16(v1[2], v1[3]);
                    *(u32x4*)(rowp + bj * HALF) = w; } }
    }
};
template <int NBJ, bool SIGM = false> struct EpiBf16S {
    static constexpr bool PERM = true; static constexpr bool HAS_PREP = false;
    bf16_t* O; int ldc; float scale;
    DI void operator()(AccRef acc, const Unit& u, int wr, int wc, int fr, int fq) const {
        const int row0 = u.pm * BM + wr * 64 + fr, col0 = u.pn * (HALF * NBJ) + wc * 32 + 8 * fq;
#pragma unroll
        for (int ai = 0; ai < 2; ++ai)
#pragma unroll
            for (int m = 0; m < 4; ++m) { bf16_t* rowp = O + (size_t)(row0 + ai * HALF + m * 16) * ldc + col0;
#pragma unroll
                for (int bj = 0; bj < NBJ; ++bj) { f32x4 v0 = acc[ai][bj][m][0] * scale, v1 = acc[ai][bj][m][1] * scale;
                    if constexpr (SIGM) {
#pragma unroll
                        for (int q = 0; q < 4; ++q) { v0[q] = frcp(1.0f + fexp2(v0[q] * -1.4426950408889634f)); v1[q] = frcp(1.0f + fexp2(v1[q] * -1.4426950408889634f)); } }
                    u32x4 w; w.x = cvt_pk_bf16(v0[0], v0[1]); w.y = cvt_pk_bf16(v0[2], v0[3]); w.z = cvt_pk_bf16(v1[0], v1[1]); w.w = cvt_pk_bf16(v1[2], v1[3]);
                    *(u32x4*)(rowp + bj * HALF) = w; } }
    }
};
struct EpiGate8 {
    static constexpr bool PERM = true; static constexpr bool HAS_PREP = false;
    unsigned char* G; float scale;
    DI void operator()(AccRef acc, const Unit& u, int wr, int wc, int fr, int fq) const {
        const int row0 = u.pm * BM + wr * 64 + fr, col0 = u.pn * BM + wc * 32 + 8 * fq;
#pragma unroll
        for (int ai = 0; ai < 2; ++ai)
#pragma unroll
            for (int m = 0; m < 4; ++m) { unsigned char* rowp = G + (size_t)(row0 + ai * HALF + m * 16) * (4 * D) + col0;
#pragma unroll
                for (int bj = 0; bj < 2; ++bj) { const f32x4 v0 = acc[ai][bj][m][0] * scale, v1 = acc[ai][bj][m][1] * scale; unsigned b[8];
#pragma unroll
                    for (int q = 0; q < 4; ++q) { b[q] = (unsigned)(frcp(1.0f + fexp2(v0[q] * -1.4426950408889634f)) * 255.0f + 0.5f); b[4 + q] = (unsigned)(frcp(1.0f + fexp2(v1[q] * -1.4426950408889634f)) * 255.0f + 0.5f); }
                    u32x2 w; w.x = b[0] | (b[1] << 8) | (b[2] << 16) | (b[3] << 24); w.y = b[4] | (b[5] << 8) | (b[6] << 16) | (b[7] << 24);
                    *(u32x2*)(rowp + bj * HALF) = w; } }
    }
};
template <int NBJ> struct EpiSwiGLU8 {
    static constexpr bool PERM = true; static constexpr bool HAS_PREP = false;
    unsigned char* act8; float scale;
    DI void operator()(AccRef acc, const Unit& u, int wr, int wc, int fr, int fq) const {
        const int row0 = u.pm * BM + wr * 64 + fr;
#pragma unroll
        for (int ai = 0; ai < 2; ++ai)
#pragma unroll
            for (int m = 0; m < 4; ++m)
#pragma unroll
                for (int bj = 0; bj < NBJ; ++bj) { const int col0 = (u.pn * NBJ + bj) * 64 + 4 * (4 * wc + fq);
                    const f32x4 a = acc[ai][bj][m][0] * scale, b = acc[ai][bj][m][1] * scale; float o[4];
#pragma unroll
                    for (int j = 0; j < 4; ++j) o[j] = siluf_(a[j]) * b[j] * F8_ASCALE;
                    *(unsigned*)(act8 + (size_t)(row0 + ai * HALF + m * 16) * FFN + col0) = cvt_pk4_fp8(o[0], o[1], o[2], o[3]); }
    }
};
struct EpiU {
    static constexpr bool PERM = true; static constexpr bool HAS_PREP = true;
    bf16_t* U; float* SM; const float* rstd; LAS float* tab;
    DI void prep(const Unit& u, int tid) const { if (tid < 256) tab[(u.ui & 1) * 256 + tid] = rstd[u.pm * BM + tid]; }
    DI void operator()(AccRef acc, const Unit& u, int wr, int wc, int fr, int fq) const {
        const int row0 = u.pm * BM + wr * 64 + fr;
        const LAS float* tb = tab + (u.ui & 1) * 256 + wr * 64 + fr;
        if (u.pn == SM_TILE) {
#pragma unroll
            for (int ai = 0; ai < 2; ++ai)
#pragma unroll
                for (int m = 0; m < 4; ++m) { float* rowp = SM + (size_t)(row0 + ai * HALF + m * 16) * 256 + wc * 32 + 8 * fq; const float rs = tb[ai * HALF + m * 16];
#pragma unroll
                    for (int bj = 0; bj < 2; ++bj) { *(f32x4*)(rowp + bj * HALF) = acc[ai][bj][m][0] * rs; *(f32x4*)(rowp + bj * HALF + 4) = acc[ai][bj][m][1] * rs; } }
        } else {
            const int col0 = u.pn * BM + wc * 32 + 8 * fq;
#pragma unroll
            for (int ai = 0; ai < 2; ++ai)
#pragma unroll
                for (int m = 0; m < 4; ++m) { bf16_t* rowp = U + (size_t)(row0 + ai * HALF + m * 16) * UWP + col0; const float rs = tb[ai * HALF + m * 16];
#pragma unroll
                    for (int bj = 0; bj < 2; ++bj) { const f32x4 v0 = acc[ai][bj][m][0] * rs, v1 = acc[ai][bj][m][1] * rs;
                        u32x4 w; w.x = cvt_pk_bf16(v0[0], v0[1]); w.y = cvt_pk_bf16(v0[2], v0[3]); w.z = cvt_pk_bf16(v1[0], v1[1]); w.w = cvt_pk_bf16(v1[2], v1[3]);
                        *(u32x4*)(rowp + bj * HALF) = w; } }
        }
    }
};
struct EpiPart {
    static constexpr bool PERM = true; static constexpr bool HAS_PREP = false;
    float* dst; float scale;
    DI void operator()(AccRef a, const Unit& u, int wr, int wc, int fr, int fq) const {
        const int row0 = wr * 64 + fr, col0 = wc * 32 + 8 * fq;
#pragma unroll
        for (int ai = 0; ai < 2; ++ai)
#pragma unroll
            for (int m = 0; m < 4; ++m) { float* rowp = dst + (row0 + ai * HALF + m * 16) * 256 + col0;
#pragma unroll
                for (int bj = 0; bj < 2; ++bj) { *(f32x4*)(rowp + bj * HALF) = a[ai][bj][m][0] * scale; *(f32x4*)(rowp + bj * HALF + 4) = a[ai][bj][m][1] * scale; } }
    }
};
struct EpiNull {
    static constexpr bool PERM = true; static constexpr bool HAS_PREP = false;
    float* sink;
    DI void operator()(AccRef acc, const Unit& u, int wr, int wc, int fr, int fq) const {
        f32x4 s = {0.f, 0.f, 0.f, 0.f};
#pragma unroll
        for (int ai = 0; ai < 2; ++ai)
#pragma unroll
            for (int bj = 0; bj < 2; ++bj)
#pragma unroll
                for (int m = 0; m < 4; ++m)
#pragma unroll
                    for (int n = 0; n < 2; ++n) s += acc[ai][bj][m][n];
        if (s[0] + s[1] + s[2] + s[3] == 123456.789f) sink[0] = s[0];
    }
};
struct EpiUL2 {
    static constexpr bool PERM = true; static constexpr bool HAS_PREP = false;
    bf16_t* T;
    DI void operator()(AccRef acc, const Unit& u, int wr, int wc, int fr, int fq) const {
        const int row0 = wr * 64 + fr, col0 = wc * 32 + 8 * fq;
#pragma unroll
        for (int ai = 0; ai < 2; ++ai)
#pragma unroll
            for (int m = 0; m < 4; ++m) { bf16_t* rowp = T + (size_t)(row0 + ai * HALF + m * 16) * 256 + col0;
#pragma unroll
                for (int bj = 0; bj < 2; ++bj) { const f32x4 v0 = acc[ai][bj][m][0], v1 = acc[ai][bj][m][1];
                    u32x4 w; w.x = cvt_pk_bf16(v0[0], v0[1]); w.y = cvt_pk_bf16(v0[2], v0[3]); w.z = cvt_pk_bf16(v1[0], v1[1]); w.w = cvt_pk_bf16(v1[2], v1[3]);
                    *(u32x4*)(rowp + bj * HALF) = w; } }
    }
};
template <bool SSQ> struct EpiResidT {
    static constexpr bool PERM = true; static constexpr bool HAS_PREP = false;
    const bf16_t* base; bf16_t* out; float* ssq;
    DI void operator()(AccRef acc, const Unit& u, int wr, int wc, int fr, int fq) const {
        const int row0 = u.pm * BM + wr * 64 + fr, col0 = u.pn * BM + wc * 32 + 8 * fq;
        u32x4 bv[4][2];
#define ER_LOAD(slot, rg) do { const size_t off_ = (size_t)(row0 + ((rg) >> 2) * HALF + ((rg) & 3) * 16) * D + col0; \
        _Pragma("unroll") for (int bj_ = 0; bj_ < 2; ++bj_) bv[slot][bj_] = *(const u32x4*)(base + off_ + bj_ * HALF); } while (0)
        ER_LOAD(0, 0); ER_LOAD(1, 1); ER_LOAD(2, 2);
#pragma unroll
        for (int rg = 0; rg < 8; ++rg) { const int ai = rg >> 2, m = rg & 3; const size_t off = (size_t)(row0 + ai * HALF + m * 16) * D + col0;
            if (rg + 3 < 8) ER_LOAD((rg + 3) & 3, rg + 3);
            asm volatile("" ::: "memory");
            float sq = 0.f;
#pragma unroll
            for (int bj = 0; bj < 2; ++bj) { const u32x4 b = bv[rg & 3][bj];
                const f32x4 v0 = (f32x4){bflo(b.x), bfhi(b.x), bflo(b.y), bfhi(b.y)} + acc[ai][bj][m][0], v1 = (f32x4){bflo(b.z), bfhi(b.z), bflo(b.w), bfhi(b.w)} + acc[ai][bj][m][1];
                if constexpr (SSQ) sq += (v0[0] * v0[0] + v0[1] * v0[1]) + (v0[2] * v0[2] + v0[3] * v0[3]) + (v1[0] * v1[0] + v1[1] * v1[1]) + (v1[2] * v1[2] + v1[3] * v1[3]);
                u32x4 w; w.x = cvt_pk_bf16(v0[0], v0[1]); w.y = cvt_pk_bf16(v0[2], v0[3]); w.z = cvt_pk_bf16(v1[0], v1[1]); w.w = cvt_pk_bf16(v1[2], v1[3]);
                *(u32x4*)(out + off + bj * HALF) = w; }
            if constexpr (SSQ) { sq += shfl_xor_f(sq, 16); sq += shfl_xor_f(sq, 32);
                if (fq == 0) ssq[(size_t)(row0 + ai * HALF + m * 16) * 32 + u.pn * 4 + wc] = sq; } }
#undef ER_LOAD
    }
};
typedef EpiResidT<false> EpiResid;
constexpr int RS_TAB = STAGE_BYTES;
DI float row_rstd(const float* ssq, int row) { const f32x4* p = (const f32x4*)(ssq + (size_t)row * 32); f32x4 t = p[0];
#pragma unroll
    for (int j = 1; j < 8; ++j) t += p[j];
    return 1.0f / sqrtf(((t[0] + t[1]) + (t[2] + t[3])) * (1.0f / D) + RMS_EPS); }
struct EpiBf16R {
    static constexpr bool PERM = true; static constexpr bool HAS_PREP = true;
    bf16_t* O; int ldc; const float* ssq; LAS float* tab;
    DI void prep(const Unit& u, int tid) const { if (tid < 256) tab[(u.ui & 1) * 256 + tid] = row_rstd(ssq, u.pm * BM + tid); }
    DI void operator()(AccRef acc, const Unit& u, int wr, int wc, int fr, int fq) const {
        const int row0 = u.pm * BM + wr * 64 + fr, col0 = u.pn * BM + wc * 32 + 8 * fq;
        const LAS float* tb = tab + (u.ui & 1) * 256 + wr * 64 + fr;
#pragma unroll
        for (int ai = 0; ai < 2; ++ai)
#pragma unroll
            for (int m = 0; m < 4; ++m) { bf16_t* rowp = O + (size_t)(row0 + ai * HALF + m * 16) * ldc + col0; const float rs = tb[ai * HALF + m * 16];
#pragma unroll
                for (int bj = 0; bj < 2; ++bj) { const f32x4 v0 = acc[ai][bj][m][0] * rs, v1 = acc[ai][bj][m][1] * rs;
                    u32x4 w; w.x = cvt_pk_bf16(v0[0], v0[1]); w.y = cvt_pk_bf16(v0[2], v0[3]); w.z = cvt_pk_bf16(v1[0], v1[1]); w.w = cvt_pk_bf16(v1[2], v1[3]);
                    *(u32x4*)(rowp + bj * HALF) = w; } }
    }
};
struct EpiMerge {
    static constexpr bool PERM = true; static constexpr bool HAS_PREP = false;
    const unsigned char* G; bf16_t* merged;
    DI void operator()(AccRef acc, const Unit& u, int wr, int wc, int fr, int fq) const {
        const int row0 = u.pm * BM + wr * 64 + fr, col0 = u.pn * BM + wc * 32 + 8 * fq, n_br = u.aux;
        u32x2 gv[4][2]; u32x4 pv[4][2];
#define EM_LOAD(slot, rg) do { const size_t row_ = (size_t)(row0 + ((rg) >> 2) * HALF + ((rg) & 3) * 16); \
        _Pragma("unroll") for (int bj_ = 0; bj_ < 2; ++bj_) { gv[slot][bj_] = *(const u32x2*)(G + row_ * (4 * D) + n_br * D + col0 + bj_ * HALF); \
            if (n_br > 0) pv[slot][bj_] = *(const u32x4*)(merged + row_ * D + col0 + bj_ * HALF); } } while (0)
        EM_LOAD(0, 0); EM_LOAD(1, 1); EM_LOAD(2, 2);
#pragma unroll
        for (int rg = 0; rg < 8; ++rg) { const int ai = rg >> 2, m = rg & 3; const size_t row = (size_t)(row0 + ai * HALF + m * 16);
            if (rg + 3 < 8) EM_LOAD((rg + 3) & 3, rg + 3);
            asm volatile("" ::: "memory");
#pragma unroll
            for (int bj = 0; bj < 2; ++bj) { const int c = col0 + bj * HALF; const u32x2 gw = gv[rg & 3][bj];
                f32x4 v0 = acc[ai][bj][m][0], v1 = acc[ai][bj][m][1];
                {
                    const float k = 1.0f / 255.0f;
                    v0[0] *= (float)(gw.x & 255u) * k; v0[1] *= (float)((gw.x >> 8) & 255u) * k; v0[2] *= (float)((gw.x >> 16) & 255u) * k; v0[3] *= (float)(gw.x >> 24) * k;
                    v1[0] *= (float)(gw.y & 255u) * k; v1[1] *= (float)((gw.y >> 8) & 255u) * k; v1[2] *= (float)((gw.y >> 16) & 255u) * k; v1[3] *= (float)(gw.y >> 24) * k; }
                if (n_br > 0) { const u32x4 pw = pv[rg & 3][bj];
                    v0[0] += bflo(pw.x); v0[1] += bfhi(pw.x); v0[2] += bflo(pw.y); v0[3] += bfhi(pw.y); v1[0] += bflo(pw.z); v1[1] += bfhi(pw.z); v1[2] += bflo(pw.w); v1[3] += bfhi(pw.w); }
                u32x4 w; w.x = cvt_pk_bf16(v0[0], v0[1]); w.y = cvt_pk_bf16(v0[2], v0[3]); w.z = cvt_pk_bf16(v1[0], v1[1]); w.w = cvt_pk_bf16(v1[2], v1[3]);
                *(u32x4*)(merged + row * D + c) = w; } }
#undef EM_LOAD
    }
};
struct EpiSwiGLU {
    static constexpr bool PERM = true; static constexpr bool HAS_PREP = false;
    bf16_t* act;
    DI void operator()(AccRef acc, const Unit& u, int wr, int wc, int fr, int fq) const {
        const int row0 = u.pm * BM + wr * 64 + fr, col0 = u.pn * HALF + wc * 32 + 8 * fq;
#pragma unroll
        for (int ai = 0; ai < 2; ++ai)
#pragma unroll
            for (int m = 0; m < 4; ++m) { bf16_t* rowp = act + (size_t)(row0 + ai * HALF + m * 16) * FFN + col0;
                float o[8];
#pragma unroll
                for (int n = 0; n < 2; ++n)
#pragma unroll
                    for (int jp = 0; jp < 2; ++jp) {
                        const f32x2 a = {acc[ai][0][m][n][2 * jp], acc[ai][0][m][n][2 * jp + 1]}, b = {acc[ai][1][m][n][2 * jp], acc[ai][1][m][n][2 * jp + 1]};
                        const f32x2 t = a * (-1.4426950408889634f); f32x2 e; e.x = fexp2(t.x); e.y = fexp2(t.y);
                        const f32x2 d = e + 1.0f; f32x2 r; r.x = frcp(d.x); r.y = frcp(d.y);
                        const f32x2 y = (a * b) * r; o[4 * n + 2 * jp] = y.x; o[4 * n + 2 * jp + 1] = y.y; }
                u32x4 w; w.x = cvt_pk_bf16(o[0], o[1]); w.y = cvt_pk_bf16(o[2], o[3]); w.z = cvt_pk_bf16(o[4], o[5]); w.w = cvt_pk_bf16(o[6], o[7]);
                *(u32x4*)rowp = w; asm volatile("" ::: "memory"); }
    }
};
struct EpiSwiGLUR {
    static constexpr bool PERM = true; static constexpr bool HAS_PREP = true;
    bf16_t* act; const float* ssq; LAS float* tab;
    DI void prep(const Unit& u, int tid) const { if (tid < 256) tab[(u.ui & 1) * 256 + tid] = row_rstd(ssq, u.pm * BM + tid); }
    DI void operator()(AccRef acc, const Unit& u, int wr, int wc, int fr, int fq) const {
        const int row0 = u.pm * BM + wr * 64 + fr, col0 = u.pn * HALF + wc * 32 + 8 * fq;
        const LAS float* tb = tab + (u.ui & 1) * 256 + wr * 64 + fr;
#pragma unroll
        for (int ai = 0; ai < 2; ++ai)
#pragma unroll
            for (int m = 0; m < 4; ++m) { bf16_t* rowp = act + (size_t)(row0 + ai * HALF + m * 16) * FFN + col0; const float rs = tb[ai * HALF + m * 16];
                float o[8];
#pragma unroll
                for (int n = 0; n < 2; ++n)
#pragma unroll
                    for (int jp = 0; jp < 2; ++jp) {
                        const f32x2 a = (f32x2){acc[ai][0][m][n][2 * jp], acc[ai][0][m][n][2 * jp + 1]} * rs, b = (f32x2){acc[ai][1][m][n][2 * jp], acc[ai][1][m][n][2 * jp + 1]} * rs;
                        const f32x2 t = a * (-1.4426950408889634f); f32x2 e; e.x = fexp2(t.x); e.y = fexp2(t.y);
                        const f32x2 d = e + 1.0f; f32x2 r; r.x = frcp(d.x); r.y = frcp(d.y);
                        const f32x2 y = (a * b) * r; o[4 * n + 2 * jp] = y.x; o[4 * n + 2 * jp + 1] = y.y; }
                u32x4 w; w.x = cvt_pk_bf16(o[0], o[1]); w.y = cvt_pk_bf16(o[2], o[3]); w.z = cvt_pk_bf16(o[4], o[5]); w.w = cvt_pk_bf16(o[6], o[7]);
                *(u32x4*)rowp = w; asm volatile("" ::: "memory"); }
    }
};
#ifdef HOST_EMU
template <class Epi, class Sched, bool FULLN = false>
static void gemm_phase_f8(unsigned char* lds, const Gemm g, const Sched& S, const Epi& E, int wave_id) {
    const int tid = threadIdx.x, wid = tid >> 6, lane = tid & 63, wr = wid >> 2, wc = wid & 3, fr = lane & 15, fq = lane >> 4;
    static thread_local float* Cbuf = nullptr; static thread_local float* Af = nullptr; static thread_local float* Bf = nullptr;
    Unit u;
    for (int i = 0; S.next(i, u); ++i) {
        __syncthreads();
        if (tid == 0) {
            if (!Cbuf) { Cbuf = (float*)malloc(256 * 256 * 4); Af = (float*)malloc((size_t)256 * 8192 * 4); Bf = (float*)malloc((size_t)256 * 8192 * 4); }
            const int K = 2 * g.K; const unsigned char* A8 = (const unsigned char*)g.A; const unsigned char* B8 = (const unsigned char*)g.Bt;
            for (int r = 0; r < 256; ++r) for (int k = 0; k < K; ++k) { Af[(size_t)r * K + k] = fp82f_host(A8[((size_t)u.pa * 256 + r) * 2 * g.lda + k]); Bf[(size_t)r * K + k] = (FULLN || r < 128) ? fp82f_host(B8[((size_t)u.pb * (FULLN ? 256 : 128) + r) * 2 * g.ldb + k]) : 0.f; }
            for (int r = 0; r < 256; ++r) for (int c = 0; c < 256; ++c) { const float* a = Af + (size_t)r * K; const float* b = Bf + (size_t)c * K; float sum = 0.f;
                for (int k = 0; k < K; ++k) sum += a[k] * b[k]; Cbuf[r * 256 + c] = sum; }
        }
        __syncthreads();
        f32x4 acc[2][2][4][2];
        for (int ai = 0; ai < 2; ++ai) for (int bj = 0; bj < 2; ++bj) for (int m = 0; m < 4; ++m) for (int n = 0; n < 2; ++n) for (int j = 0; j < 4; ++j) {
            const int r = 128 * ai + 64 * wr + 16 * m + fr;
            const int c = 128 * bj + 32 * wc + 8 * fq + 4 * n + j;
            acc[ai][bj][m][n][j] = Cbuf[r * 256 + c]; }
        E(acc, u, wr, wc, fr, fq);
    }
    __syncthreads();
}
#endif
}

struct Frame {
    unsigned char* lds; int tid, lane, wave, G, bid, flags;
    const float* const* in; float* out; unsigned char* ws;
#ifndef HOST_EMU
    template <class T> DI T* wp(size_t off) const { return (T*)(GAS T*)(ws + off); }
    DI const float* inp(int i) const { return (const float*)(GAS const float*)in[i]; }
    DI float* outp() const { return (float*)(GAS float*)out; }
#else
    template <class T> DI T* wp(size_t off) const { return (T*)(ws + off); }
    DI const float* inp(int i) const { return in[i]; }
    DI float* outp() const { return out; }
#endif
};

DI void make_frame(Frame& F, const Params& P, unsigned char* lds, int wave0) {
#ifndef HOST_EMU
    int wv = wave0; LAUNDER_S(wv); int ln = lane_id_hw(); LAUNDER_V(ln); int tid = wv * 64 + ln;
#else
    int tid = threadIdx.x;
#endif
    size_t wz = 0; LAUNDER_S(wz); unsigned char* ws = P.ws + wz;
    F.lds = lds; F.tid = tid; F.lane = tid & 63; F.wave = tid >> 6;
#ifndef HOST_EMU
    F.wave = wv;
#endif
    F.G = gridDim.x; F.bid = blockIdx.x;
    F.in = P.in; F.out = P.out; F.ws = ws; F.flags = P.flags;
}
#define REFRAME() make_frame(F, P, lds, wave0)
DI bf16x8 frag_r(const bf16_t* T, int pitch, int r0, int k0, int lane) { return *(const bf16x8*)(T + (r0 + (lane & 15)) * pitch + k0 + 8 * (lane >> 4)); }
DI bf16x8 frag_k(const bf16_t* T, int pitch, int k0, int n0, int lane) {
    const int g = lane >> 4, q = (lane & 15) >> 2, p = lane & 3;
    const bf16_t* p0 = T + (k0 + 8 * g + q) * pitch + n0 + 4 * p;
    const s16x4 lo = lds_tr4(p0), hi = lds_tr4(p0 + 4 * pitch);
    return __builtin_shufflevector(lo, hi, 0, 1, 2, 3, 4, 5, 6, 7);
}
#ifndef HOST_EMU
template <int CTRL> DI float dppf(float v) { return __builtin_bit_cast(float, __builtin_amdgcn_update_dpp(0, __builtin_bit_cast(int, v), CTRL, 0xF, 0xF, true)); }
DI float grp16_max(float v) { v = fmaxf(v, dppf<0xB1>(v)); v = fmaxf(v, dppf<0x4E>(v)); v = fmaxf(v, dppf<0x141>(v)); v = fmaxf(v, dppf<0x140>(v)); return v; }
DI float grp16_sum(float v) { v += dppf<0xB1>(v); v += dppf<0x4E>(v); v += dppf<0x141>(v); v += dppf<0x140>(v); return v; }
#else
DI float grp16_max(float v) { v = fmaxf(v, shfl_xor_f(v, 1)); v = fmaxf(v, shfl_xor_f(v, 2)); v = fmaxf(v, shfl_xor_f(v, 4)); v = fmaxf(v, shfl_xor_f(v, 8)); return v; }
DI float grp16_sum(float v) { v += shfl_xor_f(v, 1); v += shfl_xor_f(v, 2); v += shfl_xor_f(v, 4); v += shfl_xor_f(v, 8); return v; }
#endif

template <class ColMap>
DI void tr_load(const float* W, int ldw, const ColMap& cm, int item, int nblk  , int lane, f32x4 (&v)[16]) {
    const int kb = item / nblk, nb = item - kb * nblk, k0 = 64 * kb, n0 = 64 * nb;
    const int col = cm(n0 + 4 * (lane & 15)), rq = lane >> 4;
#pragma unroll
    for (int i = 0; i < 16; ++i) v[i] = (f32x4){0.f, 0.f, 0.f, 0.f};
    if (col >= 0) {
        const float* src = W + (size_t)(k0 + rq) * ldw + col;
#pragma unroll
        for (int i = 0; i < 16; ++i) v[i] = *(const f32x4*)(src + (size_t)(4 * i) * ldw);
    }
}
DI void tr_store(int K, bf16_t* WT, bf16_t* scr  , int item, int nblk, int lane, const f32x4 (&v)[16], const float* ks  ) {
    const int kb = item / nblk, nb = item - kb * nblk, k0 = 64 * kb, n0 = 64 * nb, rq = lane >> 4;
#pragma unroll
    for (int i = 0; i < 16; ++i) { f32x4 x = v[i]; if (ks) x *= ks[k0 + rq + 4 * i];
        u32x2 o; o.x = cvt_pk_bf16(x[0], x[1]); o.y = cvt_pk_bf16(x[2], x[3]); *(u32x2*)(scr + (rq + 4 * i) * 72 + 4 * (lane & 15)) = o; }
    WAVE_FENCE();
#pragma unroll
    for (int kq = 0; kq < 2; ++kq)
#pragma unroll
        for (int nq = 0; nq < 4; ++nq) { const bf16x8 f = frag_k(scr, 72, 32 * kq, 16 * nq, lane);
            *(bf16x8*)(WT + (size_t)(n0 + 16 * nq + (lane & 15)) * K + k0 + 32 * kq + 8 * (lane >> 4)) = f; }
    WAVE_FENCE();
}
DI void tr_store_f8(int K, unsigned char* WT8, bf16_t* scr, int item, int nblk, int lane, const f32x4 (&v)[16], float wscale) {
    const int kb = item / nblk, nb = item - kb * nblk, k0 = 64 * kb, n0 = 64 * nb, rq = lane >> 4;
#pragma unroll
    for (int i = 0; i < 16; ++i) { u32x2 o; o.x = cvt_pk_bf16(v[i][0] * wscale, v[i][1] * wscale); o.y = cvt_pk_bf16(v[i][2] * wscale, v[i][3] * wscale); *(u32x2*)(scr + (rq + 4 * i) * 72 + 4 * (lane & 15)) = o; }
    WAVE_FENCE();
#pragma unroll
    for (int kq = 0; kq < 2; ++kq)
#pragma unroll
        for (int nq = 0; nq < 4; ++nq) { const bf16x8 f = frag_k(scr, 72, 32 * kq, 16 * nq, lane);
            u32x2 o; o.x = cvt_pk4_fp8(bf2f((bf16_t)f[0]), bf2f((bf16_t)f[1]), bf2f((bf16_t)f[2]), bf2f((bf16_t)f[3])); o.y = cvt_pk4_fp8(bf2f((bf16_t)f[4]), bf2f((bf16_t)f[5]), bf2f((bf16_t)f[6]), bf2f((bf16_t)f[7]));
            *(u32x2*)(WT8 + (size_t)(n0 + 16 * nq + (lane & 15)) * K + k0 + 32 * kq + 8 * (lane >> 4)) = o; }
    WAVE_FENCE();
}
struct CmGate { DI int operator()(int n) const { return SO_GATE + n; } };
struct CmW13F8 { DI int operator()(int r) const { const int pn = r >> 7, c = r & 127, q = c >> 3, n = (c >> 2) & 1, j = c & 3; return (n ? FFN : 0) + 64 * pn + 4 * q + j; } };
struct CmIdent { DI int operator()(int n) const { return n; } };
struct CmWin { DI int operator()(int r) const {
    if (r < 3072) return r;
    if (r < 4096) return SO_SSZ + (r - 3072);
    if (r < 5632) return SO_XBC + (r - 4096);
    if (r < 6144) return SO_CQ + (r - 5632);
    if (r < 6400) return SO_CKV + (r - 6144);
    if (r < 6656) { const int j = r - 6400; if (j < 64) return SO_KR + j; if (j < 72) return SO_MLI + (j - 64); if (j < 88) return SO_DT + (j - 72); return -1; }
    if (r < 7680) return SO_SWQ + (r - 6656);
    if (r < 7936) return SO_SWK + (r - 7680);
    if (r < 8192) return SO_SWV + (r - 7936);
    return SO_GATE + (r - 8192); } };
struct CmW13 { DI int operator()(int r) const { const int pn = r >> 8, rr = r & 255; return rr < 128 ? 128 * pn + rr : FFN + 128 * pn + (rr - 128); } };
template <class ColMap>
DI void convert_weight_f8(const Frame& F, const float* W, int ldw, int K, int N, unsigned char* WT8, const ColMap& cm, float wscale, int& rot) {
    bf16_t* scr = (bf16_t*)(F.lds + F.wave * 16384);
    const int NGW = F.G * 8, nblk = N / 64, items = (K / 64) * nblk;
    int gw = F.bid * 8 + F.wave - rot; if (gw < 0) gw += NGW;
    rot = (rot + items) % NGW;
    if (gw < items) {
        f32x4 v[16]; tr_load(W, ldw, cm, gw, nblk, F.lane, v);
        for (int it = gw;;) { const int nx = it + NGW; f32x4 vn[16];
            if (nx < items) tr_load(W, ldw, cm, nx, nblk, F.lane, vn);
            tr_store_f8(K, WT8, scr, it, nblk, F.lane, v, wscale);
            if (nx >= items) break;
#pragma unroll
            for (int i = 0; i < 16; ++i) v[i] = vn[i];
            it = nx; }
    }
}
template <class ColMap>
DI void convert_weight(const Frame& F, const float* W, int ldw, int K, int N, bf16_t* WT, const ColMap& cm, int& rot, const float* ks = nullptr) {
    bf16_t* scr = (bf16_t*)(F.lds + F.wave * 16384);
    const int NGW = F.G * 8, nblk = N / 64, items = (K / 64) * nblk;
    int gw = F.bid * 8 + F.wave - rot; if (gw < 0) gw += NGW;
    rot = (rot + items) % NGW;
    if (gw < items) {
        f32x4 v[16]; tr_load(W, ldw, cm, gw, nblk, F.lane, v);
        for (int it = gw;;) { const int nx = it + NGW; f32x4 vn[16];
            if (nx < items) tr_load(W, ldw, cm, nx, nblk, F.lane, vn);
            tr_store(K, WT, scr, it, nblk, F.lane, v, ks);
            if (nx >= items) break;
#pragma unroll
            for (int i = 0; i < 16; ++i) v[i] = vn[i];
            it = nx; }
    }
}
DI void rms_row_to_bf16(const float* xrow, const float* w, bf16_t* orow, int lane, unsigned char* o8 = nullptr, bf16_t* h16 = nullptr, float* rs_out = nullptr) {
    f32x4 v[8]; float s = 0.f;
#pragma unroll
    for (int j = 0; j < 8; ++j) { v[j] = *(const f32x4*)(xrow + 4 * (lane + 64 * j)); s += (v[j][0] * v[j][0] + v[j][1] * v[j][1]) + (v[j][2] * v[j][2] + v[j][3] * v[j][3]);
        if (h16) { u32x2 hc; hc.x = cvt_pk_bf16(v[j][0], v[j][1]); hc.y = cvt_pk_bf16(v[j][2], v[j][3]); *(u32x2*)(h16 + 4 * (lane + 64 * j)) = hc; } }
    const float rstd = 1.0f / sqrtf(wave_sum(s) * (1.0f / D) + RMS_EPS);
    if (rs_out && lane == 0) *rs_out = rstd;
#pragma unroll
    for (int j = 0; j < 8; ++j) { const f32x4 ww = *(const f32x4*)(w + 4 * (lane + 64 * j));
        const float y0 = v[j][0] * rstd * ww[0], y1 = v[j][1] * rstd * ww[1], y2 = v[j][2] * rstd * ww[2], y3 = v[j][3] * rstd * ww[3];
        u32x2 o; o.x = cvt_pk_bf16(y0, y1); o.y = cvt_pk_bf16(y2, y3);
        if (orow) *(u32x2*)(orow + 4 * (lane + 64 * j)) = o;
        if (o8) *(unsigned*)(o8 + 4 * (lane + 64 * j)) = cvt_pk4_fp8(y0 * F8_ASCALE, y1 * F8_ASCALE, y2 * F8_ASCALE, y3 * F8_ASCALE); }
}
DI void rms_row16_to_bf16(const bf16_t* xrow, const float* w, bf16_t* orow, int lane, unsigned char* o8 = nullptr, float* rs_out = nullptr) {
    f32x4 v[8]; float s = 0.f;
#pragma unroll
    for (int j = 0; j < 8; ++j) { const u32x2 a = *(const u32x2*)(xrow + 4 * (lane + 64 * j)); v[j] = (f32x4){bflo(a.x), bfhi(a.x), bflo(a.y), bfhi(a.y)};
        s += (v[j][0] * v[j][0] + v[j][1] * v[j][1]) + (v[j][2] * v[j][2] + v[j][3] * v[j][3]); }
    const float rstd = 1.0f / sqrtf(wave_sum(s) * (1.0f / D) + RMS_EPS);
    if (rs_out && lane == 0) *rs_out = rstd;
#pragma unroll
    for (int j = 0; j < 8; ++j) { const f32x4 ww = *(const f32x4*)(w + 4 * (lane + 64 * j));
        const float y0 = v[j][0] * rstd * ww[0], y1 = v[j][1] * rstd * ww[1], y2 = v[j][2] * rstd * ww[2], y3 = v[j][3] * rstd * ww[3];
        u32x2 o; o.x = cvt_pk_bf16(y0, y1); o.y = cvt_pk_bf16(y2, y3);
        if (orow) *(u32x2*)(orow + 4 * (lane + 64 * j)) = o;
        if (o8) *(unsigned*)(o8 + 4 * (lane + 64 * j)) = cvt_pk4_fp8(y0 * F8_ASCALE, y1 * F8_ASCALE, y2 * F8_ASCALE, y3 * F8_ASCALE); }
}
DI void phase_prologue(const Frame& F) {
    CmIdent id; int rot = 0;
    for (int l = 0; l < DEPTH; ++l) {
        if (!(F.flags & 4)) { convert_weight(F, F.inp(3) + (size_t)l * D * IN_TOTAL, IN_TOTAL, D, UC_GATE, F.wp<bf16_t>(O_WIN) + (size_t)l * UW * D, CmWin(), rot, F.inp(2) + (size_t)l * D);
            convert_weight_f8(F, F.inp(3) + (size_t)l * D * IN_TOTAL, IN_TOTAL, D, 8192, F.wp<unsigned char>(O_WG8) + (size_t)l * 8192 * D, CmGate(), F8_WSCALE, rot); }
        convert_weight(F, F.inp(14) + (size_t)l * 512 * 1536, 1536, 512, 1536, F.wp<bf16_t>(O_WUQ) + (size_t)l * 1536 * 512, id, rot);
        convert_weight(F, F.inp(16) + (size_t)l * 256 * 2048, 2048, 256, 2048, F.wp<bf16_t>(O_WUKV) + (size_t)l * 2048 * 256, id, rot);
        for (int n = 0; n < 4; ++n)
            convert_weight(F, F.inp(18) + ((size_t)l * 4 + n) * 1024 * 2048, 2048, 1024, 2048, F.wp<bf16_t>(O_WBR) + ((size_t)l * 4 + n) * 2048 * 1024, id, rot);
        convert_weight(F, F.inp(19) + (size_t)l * D * D, D, D, D, F.wp<bf16_t>(O_WOUT) + (size_t)l * D * D, id, rot);
        convert_weight(F, F.inp(22) + (size_t)l * D * 512, 512, D, 512, F.wp<bf16_t>(O_WXQ) + (size_t)l * 512 * D, id, rot, F.inp(20) + (size_t)l * D);
        convert_weight(F, F.inp(23) + (size_t)l * D * 1024, 1024, D, 1024, F.wp<bf16_t>(O_WXKV) + (size_t)l * 1024 * D, id, rot);
        convert_weight(F, F.inp(24) + (size_t)l * 512 * D, D, 512, D, F.wp<bf16_t>(O_WXO) + (size_t)l * D * 512, id, rot);
    }
    if (!(F.flags & 2)) { convert_weight(F, F.inp(26), 2 * FFN, D, 2 * FFN, F.wp<bf16_t>(O_W13), CmW13(), rot, F.inp(25));
    convert_weight(F, F.inp(27), D, FFN, D, F.wp<bf16_t>(O_W2), id, rot); }
    if (!(F.flags & 1)) for (int e = 0; e < NEXP; ++e) {
        convert_weight_f8(F, F.inp(29) + (size_t)e * D * 2 * FFN, 2 * FFN, D, 2 * FFN, F.wp<unsigned char>(O_MW13) + (size_t)e * 2 * FFN * D, CmW13F8(), F8_WSCALE, rot);
        convert_weight_f8(F, F.inp(30) + (size_t)e * FFN * D, D, FFN, D, F.wp<unsigned char>(O_MW2) + (size_t)e * D * FFN, id, F8_WSCALE, rot);
    }
    float* rope = F.wp<float>(O_ROPE);
    for (int idx = F.bid * NTHREADS + F.tid; idx < SEQ * 32; idx += F.G * NTHREADS) {
        const int t = idx >> 5, i = idx & 31;
        const float inv_freq = fexp2(-(float)i * (13.287712379549449f / 32.0f));
        const float ang = (float)t * inv_freq;
        const double rev = (double)ang * 0.15915494309189535; const float fr = (float)(rev - (double)(long long)rev);
        rope[2 * idx] = fcos_rev(fr); rope[2 * idx + 1] = fsin_rev(fr);
    }
    const int gw = F.bid * 8 + F.wave, NGW = F.G * 8;
    for (int r = gw; r < DEPTH * NMEM; r += NGW) { const int l = r / NMEM, m = r % NMEM;
        rms_row_to_bf16(F.inp(1) + (size_t)m * D, F.inp(21) + (size_t)l * D, F.wp<bf16_t>(O_MEMN) + (size_t)r * D, F.lane); }
}

DI void phase_rmsnorm_x(const Frame& F, const float* src, const float* w) {
    const int gw = F.bid * 8 + F.wave, NGW = F.G * 8;
    unsigned char* x8 = F.wp<unsigned char>(O_XN8);
    for (int r = gw; r < NTOK; r += NGW) rms_row_to_bf16(src + (size_t)r * D, w, nullptr, F.lane, x8 + (size_t)r * D, F.wp<bf16_t>(O_H) + (size_t)r * D, F.wp<float>(O_RSTD) + r);
}
DI void phase_rmsnorm(const Frame& F, const bf16_t* src, const float* w) {
    const int gw = F.bid * 8 + F.wave, NGW = F.G * 8;
    unsigned char* x8 = F.wp<unsigned char>(O_XN8);
    const int lane = F.lane; float* rsd = F.wp<float>(O_RSTD);
    for (int r = gw; r < NTOK; r += 2 * NGW) { const int r2 = r + NGW;
        if (r2 >= NTOK) { rms_row16_to_bf16(src + (size_t)r * D, w, nullptr, lane, x8 + (size_t)r * D, rsd + r); break; }
        u32x2 a[8], b[8];
#pragma unroll
        for (int j = 0; j < 8; ++j) { a[j] = *(const u32x2*)(src + (size_t)r * D + 4 * (lane + 64 * j)); b[j] = *(const u32x2*)(src + (size_t)r2 * D + 4 * (lane + 64 * j)); }
        float sa = 0.f, sb = 0.f;
#pragma unroll
        for (int j = 0; j < 8; ++j) { sa += (bflo(a[j].x) * bflo(a[j].x) + bfhi(a[j].x) * bfhi(a[j].x)) + (bflo(a[j].y) * bflo(a[j].y) + bfhi(a[j].y) * bfhi(a[j].y));
            sb += (bflo(b[j].x) * bflo(b[j].x) + bfhi(b[j].x) * bfhi(b[j].x)) + (bflo(b[j].y) * bflo(b[j].y) + bfhi(b[j].y) * bfhi(b[j].y)); }
        const float ra = 1.0f / sqrtf(wave_sum(sa) * (1.0f / D) + RMS_EPS), rb = 1.0f / sqrtf(wave_sum(sb) * (1.0f / D) + RMS_EPS);
        if (lane == 0) { rsd[r] = ra; rsd[r2] = rb; }
#pragma unroll
        for (int j = 0; j < 8; ++j) { const int c0 = 4 * (lane + 64 * j); const f32x4 ww = *(const f32x4*)(w + c0);
            *(unsigned*)(x8 + (size_t)r * D + c0) = cvt_pk4_fp8(bflo(a[j].x) * ra * ww[0] * F8_ASCALE, bfhi(a[j].x) * ra * ww[1] * F8_ASCALE, bflo(a[j].y) * ra * ww[2] * F8_ASCALE, bfhi(a[j].y) * ra * ww[3] * F8_ASCALE);
            *(unsigned*)(x8 + (size_t)r2 * D + c0) = cvt_pk4_fp8(bflo(b[j].x) * rb * ww[0] * F8_ASCALE, bfhi(b[j].x) * rb * ww[1] * F8_ASCALE, bflo(b[j].y) * rb * ww[2] * F8_ASCALE, bfhi(b[j].y) * rb * ww[3] * F8_ASCALE); }
    }
}
DI void block_rows(const Frame& F, int& r0, int& r1) { r0 = (int)(((long)NTOK * F.bid) / F.G); r1 = (int)(((long)NTOK * (F.bid + 1)) / F.G); }
DI void phase_rmsnorm_route(const Frame& F, const bf16_t* src, const float* w, const float* router) {
    int* cnt = (int*)(F.lds);
    float* RT = (float*)(F.lds + 1024);
    if (F.tid < 8) cnt[F.tid] = 0;
    for (int c = F.tid; c < D; c += NTHREADS) { const f32x4 ra = *(const f32x4*)(router + (size_t)c * 8), rb = *(const f32x4*)(router + (size_t)c * 8 + 4);
        RT[c] = ra[0]; RT[D + c] = ra[1]; RT[2 * D + c] = ra[2]; RT[3 * D + c] = ra[3]; RT[4 * D + c] = rb[0]; RT[5 * D + c] = rb[1]; RT[6 * D + c] = rb[2]; RT[7 * D + c] = rb[3]; }
    __syncthreads();
    int r0, r1; block_rows(F, r0, r1);
    int* r_e = F.wp<int>(O_ROUTE); float* r_g = (float*)(r_e + 2 * NTOK);
    u32x2 nx[8];
    if (r0 + F.wave < r1) {
#pragma unroll
        for (int j = 0; j < 8; ++j) nx[j] = *(const u32x2*)(src + (size_t)(r0 + F.wave) * D + 4 * (F.lane + 64 * j)); }
    for (int r = r0 + F.wave; r < r1; r += 8) {
        const int lane = F.lane;
        u32x2 cur[8];
#pragma unroll
        for (int j = 0; j < 8; ++j) cur[j] = nx[j];
        if (r + 8 < r1) {
#pragma unroll
            for (int j = 0; j < 8; ++j) nx[j] = *(const u32x2*)(src + (size_t)(r + 8) * D + 4 * (lane + 64 * j)); }
        f32x4 v[8]; float s = 0.f;
#pragma unroll
        for (int j = 0; j < 8; ++j) { const u32x2 a_ = cur[j]; v[j] = (f32x4){bflo(a_.x), bfhi(a_.x), bflo(a_.y), bfhi(a_.y)}; s += (v[j][0] * v[j][0] + v[j][1] * v[j][1]) + (v[j][2] * v[j][2] + v[j][3] * v[j][3]); }
        const float rstd = 1.0f / sqrtf(wave_sum(s) * (1.0f / D) + RMS_EPS);
        float lg[8];
#pragma unroll
        for (int e = 0; e < 8; ++e) lg[e] = 0.f;
        unsigned char* orow = F.wp<unsigned char>(O_XN8) + (size_t)r * D;
#pragma unroll
        for (int j = 0; j < 8; ++j) { const int c0 = 4 * (lane + 64 * j); const f32x4 ww = *(const f32x4*)(w + c0);
            const f32x4 y = {v[j][0] * rstd * ww[0], v[j][1] * rstd * ww[1], v[j][2] * rstd * ww[2], v[j][3] * rstd * ww[3]};
            *(unsigned*)(orow + c0) = cvt_pk4_fp8(y[0] * F8_ASCALE, y[1] * F8_ASCALE, y[2] * F8_ASCALE, y[3] * F8_ASCALE);
#pragma unroll
            for (int e = 0; e < 8; ++e) { const f32x4 rw = *(const f32x4*)(RT + e * D + c0); lg[e] += (y[0] * rw[0] + y[1] * rw[1]) + (y[2] * rw[2] + y[3] * rw[3]); }
            SCHED_BAR(); }
#pragma unroll
        for (int e = 0; e < 8; ++e) lg[e] = wave_sum(lg[e]);
        int i0 = 0; float v0 = lg[0];
#pragma unroll
        for (int e = 1; e < 8; ++e) if (lg[e] > v0) { v0 = lg[e]; i0 = e; }
        int i1 = -1; float v1 = -3.0e38f;
#pragma unroll
        for (int e = 0; e < 8; ++e) if (e != i0 && lg[e] > v1) { v1 = lg[e]; i1 = e; }
        const float e1 = fexp(v1 - v0), g0 = 1.0f / (1.0f + e1), g1 = e1 * g0;
        if (lane == 0) { r_e[2 * r] = i0; r_e[2 * r + 1] = i1; r_g[2 * r] = g0; r_g[2 * r + 1] = g1; lds_atomic_add_i(&cnt[i0], 1); lds_atomic_add_i(&cnt[i1], 1); }
    }
    __syncthreads();
    if (F.tid < 8) F.wp<int>(O_BLKCNT)[F.bid * 8 + F.tid] = cnt[F.tid];
}
DI void moe_tables(const Frame& F, int* tile_e, int* pstart, int* ntiles_out) {
    const int* bc = F.wp<int>(O_BLKCNT);
    if (F.tid == 0) {
        int tot[8];
        for (int e = 0; e < 8; ++e) tot[e] = 0;
        for (int b = 0; b < F.G; ++b) for (int e = 0; e < 8; ++e) tot[e] += bc[b * 8 + e];
        int ps = 0, nt = 0;
        for (int e = 0; e < 8; ++e) { pstart[e] = ps; const int t = (tot[e] + 255) >> 8;
_Pragma("clang loop vectorize(disable) unroll(disable)")
            for (int j = 0; j < t; ++j) tile_e[nt + j] = e;
            nt += t; ps += t * 256; }
        *ntiles_out = nt;
    }
    __syncthreads();
}
DI void phase_moe_scatter(const Frame& F, int* tile_e, int* pstart, int* ntiles, int* myoff  ) {
    moe_tables(F, tile_e, pstart, ntiles);
    const int* bc = F.wp<int>(O_BLKCNT);
    int r0, r1; block_rows(F, r0, r1);
    int* r_e = F.wp<int>(O_ROUTE); int* r_s = r_e + 4 * NTOK;
    if (F.tid < 8) { int s = 0; for (int b = 0; b < F.bid; ++b) s += bc[b * 8 + F.tid]; myoff[F.tid] = pstart[F.tid] + s; }
    __syncthreads();
    {
        int* es = (int*)F.lds; const int np = 2 * (r1 - r0);
        for (int p = F.tid; p < np; p += NTHREADS) es[p] = r_e[2 * r0 + p];
        __syncthreads();
        for (int p = F.tid; p < np; p += NTHREADS) { const int e = es[p]; int before = 0;
            for (int q = 0; q < p; ++q) before += (es[q] == e) ? 1 : 0;
            r_s[2 * r0 + p] = myoff[e] + before; }
    }
    __syncthreads();
    asm volatile("" ::: "memory");
    const unsigned char* xn8 = F.wp<unsigned char>(O_XN8); unsigned char* xg8 = F.wp<unsigned char>(O_XG);
    for (int i = 2 * r0 + F.wave; i < 2 * r1; i += 32) {
        u32x4 v[4][2]; int slot[4];
#pragma unroll
        for (int q = 0; q < 4; ++q) { const int ii = i + 8 * q; const bool ok = ii < 2 * r1; const int ic = ok ? ii : i; slot[q] = ok ? r_s[ic] : -1;
            const u32x4* sp_ = (const u32x4*)(xn8 + (size_t)(ic >> 1) * D); v[q][0] = sp_[F.lane]; v[q][1] = sp_[F.lane + 64]; }
#pragma unroll
        for (int q = 0; q < 4; ++q) if (slot[q] >= 0) { u32x4* dp_ = (u32x4*)(xg8 + (size_t)slot[q] * D); dp_[F.lane] = v[q][0]; dp_[F.lane + 64] = v[q][1]; } }
}
DI void phase_final(const Frame& F, bool moe_last, const int* ntiles_p, unsigned char* tail_of  ) {
    const int gw = F.bid * 8 + F.wave, NGW = F.G * 8, lane = F.lane;
    const bf16_t* H = F.wp<bf16_t>(O_H); const bf16_t* yg = F.wp<bf16_t>(O_YG); const float* w = F.inp(31); const float* tacc = F.wp<float>(O_TAILACC);
    const int* r_e = F.wp<int>(O_ROUTE); const float* r_g = (const float*)(r_e + 2 * NTOK); const int* r_s = r_e + 4 * NTOK;
    int full = 0, R = 0, sp = 0;
    if (moe_last) {
        pg8::moe_tail_split(*ntiles_p, F.G, full, R, sp);
_Pragma("clang loop vectorize(disable) unroll(disable)")
        for (int i = F.tid; i < MAXTILES * 8; i += NTHREADS) tail_of[i] = 0;
        __syncthreads();
        for (int u = F.tid; u < R; u += NTHREADS) { int pm, pn; pg8::static_map((long)full * F.G + u, *ntiles_p, D / 256, pm, pn); tail_of[pm * 8 + pn] = (unsigned char)(u + 1); }
        __syncthreads();
    }
    for (int r = gw; r < NTOK; r += NGW) {
        f32x4 v[8]; float s = 0.f;
        float g0 = 0.f, g1 = 0.f; int s0 = 0, s1 = 0;
        if (moe_last) { g0 = r_g[2 * r]; g1 = r_g[2 * r + 1]; s0 = r_s[2 * r]; s1 = r_s[2 * r + 1]; }
#pragma unroll
        for (int j = 0; j < 8; ++j) { const int c0 = 4 * (lane + 64 * j); { const u32x2 a_ = *(const u32x2*)(H + (size_t)r * D + c0); v[j] = (f32x4){bflo(a_.x), bfhi(a_.x), bflo(a_.y), bfhi(a_.y)}; }
            if (moe_last) {
                f32x4 ya, yb;
                const int t0 = tail_of[(s0 >> 8) * 8 + j], t1 = tail_of[(s1 >> 8) * 8 + j];
                if (t0) { ya = (f32x4){0.f, 0.f, 0.f, 0.f}; for (int p = 0; p < sp; ++p) ya += *(const f32x4*)(tacc + (size_t)((t0 - 1) * sp + p) * 65536 + (s0 & 255) * 256 + 4 * lane); }
                else { const u32x2 a = *(const u32x2*)(yg + (size_t)s0 * D + c0); ya = (f32x4){bflo(a.x), bfhi(a.x), bflo(a.y), bfhi(a.y)}; }
                if (t1) { yb = (f32x4){0.f, 0.f, 0.f, 0.f}; for (int p = 0; p < sp; ++p) yb += *(const f32x4*)(tacc + (size_t)((t1 - 1) * sp + p) * 65536 + (s1 & 255) * 256 + 4 * lane); }
                else { const u32x2 bb = *(const u32x2*)(yg + (size_t)s1 * D + c0); yb = (f32x4){bflo(bb.x), bfhi(bb.x), bflo(bb.y), bfhi(bb.y)}; }
                v[j] += g0 * ya + g1 * yb; }
            s += (v[j][0] * v[j][0] + v[j][1] * v[j][1]) + (v[j][2] * v[j][2] + v[j][3] * v[j][3]); }
        const float rstd = 1.0f / sqrtf(wave_sum(s) * (1.0f / D) + RMS_EPS);
#pragma unroll
        for (int j = 0; j < 8; ++j) { const int c0 = 4 * (lane + 64 * j); const f32x4 ww = *(const f32x4*)(w + c0);
            *(f32x4*)(F.outp() + (size_t)r * D + c0) = (f32x4){v[j][0] * rstd * ww[0], v[j][1] * rstd * ww[1], v[j][2] * rstd * ww[2], v[j][3] * rstd * ww[3]}; }
    }
}

DI float log_sigmoid_(float x) { return fminf(x, 0.f) - log1pf(expf(-fabsf(x))); }
DI float softplus_(float x) { return fmaxf(x, 0.f) + log1pf(expf(-fabsf(x))); }
DI void phase_prep(const Frame& F, int l) {
    const int gw = F.bid * 8 + F.wave, NGW = F.G * 8, lane = F.lane;
    const bf16_t* U = F.wp<bf16_t>(O_U); const float* SM = F.wp<float>(O_SM); const float* rope = F.wp<float>(O_ROPE);
    const float* qnorm = F.inp(13) + l * 512; const float* kvnorm = F.inp(15) + l * 256;
    const float* convw = F.inp(7) + (size_t)l * 4 * 1536; const float* convb = F.inp(8) + l * 1536;
    for (int r = gw; r < NTOK; r += NGW) {
        const int t = r % SEQ; const bf16_t* urow = U + (size_t)r * UWP; const float* smrow = SM + (size_t)r * 256;
        const int ckc = 8 * (lane & 31);
        const u32x4 wq = *(const u32x4*)(urow + UC_CQ + 8 * lane), wkv = *(const u32x4*)(urow + UC_CKV + ckc);
        const float sm_x1 = smrow[lane & 31], sm_x2 = smrow[32 + (lane & 31)], sm_gi = smrow[64 + (lane & 3)], sm_gf = smrow[68 + (lane & 3)], sm_dt = smrow[72 + (lane & 15)];
        const float rp_c = rope[2 * (t * 32 + (lane & 31))], rp_s = rope[2 * (t * 32 + (lane & 31)) + 1];
        u32x4 xw[3][4];
#pragma unroll
        for (int j = 0; j < 3; ++j)
#pragma unroll
            for (int tap = 0; tap < 4; ++tap) { const bool ok = (t - 3 + tap) >= 0;
                const u32x4 w = *(const u32x4*)(urow + (ok ? (long)(tap - 3) * UWP : 0l) + UC_XBC + 8 * lane + 512 * j);
                xw[j][tap].x = ok ? w.x : 0u; xw[j][tap].y = ok ? w.y : 0u; xw[j][tap].z = ok ? w.z : 0u; xw[j][tap].w = ok ? w.w : 0u; }
        {
            const u32x4 w = wq;
            float x[8] = {bflo(w.x), bfhi(w.x), bflo(w.y), bfhi(w.y), bflo(w.z), bfhi(w.z), bflo(w.w), bfhi(w.w)}; float s = 0.f;
#pragma unroll
            for (int i = 0; i < 8; ++i) s += x[i] * x[i];
            const float rstd = 1.0f / sqrtf(wave_sum(s) * (1.0f / 512) + RMS_EPS);
            const f32x4 n0 = *(const f32x4*)(qnorm + 8 * lane), n1 = *(const f32x4*)(qnorm + 8 * lane + 4);
            u32x4 o; o.x = cvt_pk_bf16(x[0] * rstd * n0[0], x[1] * rstd * n0[1]); o.y = cvt_pk_bf16(x[2] * rstd * n0[2], x[3] * rstd * n0[3]);
            o.z = cvt_pk_bf16(x[4] * rstd * n1[0], x[5] * rstd * n1[1]); o.w = cvt_pk_bf16(x[6] * rstd * n1[2], x[7] * rstd * n1[3]);
            *(u32x4*)(F.wp<bf16_t>(O_CQN) + (size_t)r * 512 + 8 * lane) = o;
        }
        {
            const int c = ckc;
            const u32x4 w = wkv;
            float x[8] = {bflo(w.x), bfhi(w.x), bflo(w.y), bfhi(w.y), bflo(w.z), bfhi(w.z), bflo(w.w), bfhi(w.w)}; float s = 0.f;
#pragma unroll
            for (int i = 0; i < 8; ++i) s += x[i] * x[i];
            if (lane >= 32) s = 0.f;
            const float rstd = 1.0f / sqrtf(wave_sum(s) * (1.0f / 256) + RMS_EPS);
            const f32x4 n0 = *(const f32x4*)(kvnorm + c), n1 = *(const f32x4*)(kvnorm + c + 4);
            u32x4 o; o.x = cvt_pk_bf16(x[0] * rstd * n0[0], x[1] * rstd * n0[1]); o.y = cvt_pk_bf16(x[2] * rstd * n0[2], x[3] * rstd * n0[3]);
            o.z = cvt_pk_bf16(x[4] * rstd * n1[0], x[5] * rstd * n1[1]); o.w = cvt_pk_bf16(x[6] * rstd * n1[2], x[7] * rstd * n1[3]);
            if (lane < 32) *(u32x4*)(F.wp<bf16_t>(O_CKVN) + (size_t)r * 256 + c) = o;
        }
        if (lane < 32) {
            const float x1 = sm_x1, x2 = sm_x2, cs = rp_c, sn = rp_s;
            bf16_t* kr = F.wp<bf16_t>(O_KR) + (size_t)r * 64;
            kr[lane] = f2bf(x1 * cs - x2 * sn); kr[32 + lane] = f2bf(x2 * cs + x1 * sn);
        }
        if (lane < 4) {
            F.wp<float>(O_GI)[(size_t)r * 4 + lane] = sm_gi + F.inp(4)[l * 4 + lane];
            F.wp<float>(O_LF)[(size_t)r * 4 + lane] = log_sigmoid_(sm_gf + F.inp(5)[l * 4 + lane]);
        }
        if (lane < 16) {
            const float dtv = softplus_(sm_dt + F.inp(9)[l * 16 + lane]);
            F.wp<float>(O_DT)[(size_t)r * 16 + lane] = dtv;
            F.wp<float>(O_DA)[(size_t)r * 16 + lane] = -dtv * expf(F.inp(10)[l * 16 + lane]);
        }
#pragma unroll
        for (int j = 0; j < 3; ++j) { const int c0 = 8 * lane + 512 * j;
            float y[8];
            { const f32x4 b0 = *(const f32x4*)(convb + c0), b1 = *(const f32x4*)(convb + c0 + 4); y[0] = b0[0]; y[1] = b0[1]; y[2] = b0[2]; y[3] = b0[3]; y[4] = b1[0]; y[5] = b1[1]; y[6] = b1[2]; y[7] = b1[3]; }
#pragma unroll
            for (int tap = 0; tap < 4; ++tap) { const u32x4 w = xw[j][tap];
                const f32x4 w0 = *(const f32x4*)(convw + tap * 1536 + c0), w1 = *(const f32x4*)(convw + tap * 1536 + c0 + 4);
                y[0] += bflo(w.x) * w0[0]; y[1] += bfhi(w.x) * w0[1]; y[2] += bflo(w.y) * w0[2]; y[3] += bfhi(w.y) * w0[3];
                y[4] += bflo(w.z) * w1[0]; y[5] += bfhi(w.z) * w1[1]; y[6] += bflo(w.w) * w1[2]; y[7] += bfhi(w.w) * w1[3]; }
            u32x4 o; o.x = cvt_pk_bf16(siluf_(y[0]), siluf_(y[1])); o.y = cvt_pk_bf16(siluf_(y[2]), siluf_(y[3])); o.z = cvt_pk_bf16(siluf_(y[4]), siluf_(y[5])); o.w = cvt_pk_bf16(siluf_(y[6]), siluf_(y[7]));
            *(u32x4*)(F.wp<bf16_t>(O_XBC) + (size_t)r * 1536 + c0) = o; }
    }
}

constexpr int ML_NC = SEQ / 64;
DI void mlstm_item(const Frame& F, int item) {
    const int vs = item & 7, hh = (item >> 3) & 3, b = item >> 5;
    int tid_ = F.tid; LAUNDER_V(tid_);
    const int tid = tid_, lane = tid & 63, w = F.wave, g = lane >> 4, lc = lane & 15;
    float* s_bb = (float*)F.lds; float* s_dd = s_bb + SEQ; float* s_cm = s_dd + SEQ; float* s_ch = s_cm + SEQ;
    bf16_t* sQ = (bf16_t*)(s_ch + 4 * ML_NC);
    bf16_t* sK = sQ + 64 * 136;
    bf16_t* sV = sK + 64 * 136;
    bf16_t* sVw = sV + 64 * 56;
    bf16_t* sCb = sVw + 64 * 56;
    const bf16_t* U = F.wp<bf16_t>(O_U); const float* GI = F.wp<float>(O_GI); const float* LF = F.wp<float>(O_LF);
    bf16_t* Ya = F.wp<bf16_t>(O_Y);
    const float scale = 0.08838834764831845f;
    const unsigned z0 = vzero();
    for (int i = tid; i < SEQ; i += NTHREADS) { const size_t row = (size_t)b * SEQ + i; s_dd[i] = GI[row * 4 + hh]; s_bb[i] = LF[row * 4 + hh]; }
    for (int i = tid; i < 48 * 136 / 2; i += NTHREADS) ((unsigned*)sCb)[i] = z0;
    __syncthreads();
    if (tid < ML_NC) { float acc = 0.f, cm = -3.0e38f;
        for (int t = 0; t < 64; ++t) { const int i = tid * 64 + t; acc += s_bb[i]; s_bb[i] = acc; const float d = s_dd[i] - acc; s_dd[i] = d; cm = fmaxf(cm, d); s_cm[i] = cm; } }
    __syncthreads();
    if (tid == 0) { float m = 0.f;
        for (int c = 0; c < ML_NC; ++c) { const float btot = s_bb[c * 64 + 63], cmL = s_cm[c * 64 + 63], mloc = btot + cmL, mnew = fmaxf(btot + m, mloc);
            s_ch[c] = m; s_ch[ML_NC + c] = fexp(btot + m - mnew); s_ch[2 * ML_NC + c] = fexp(mloc - mnew); s_ch[3 * ML_NC + c] = cmL; m = mnew; } }
    __syncthreads();
    f32x4 Cst[3][2];
#pragma unroll
    for (int a = 0; a < 3; ++a)
#pragma unroll
        for (int c = 0; c < 2; ++c) Cst[a][c] = (f32x4){0.f, 0.f, 0.f, 0.f};
    const bf16_t* Ub = U + (size_t)b * SEQ * UWP;
    u32x4 qr[2], kr[2], vr = {z0, z0, z0, z0};
#define ML_FETCH(c_) do { const bf16_t* ub_ = Ub + (size_t)(c_) * 64 * UWP; \
        _Pragma("unroll") for (int i_ = 0; i_ < 2; ++i_) { const unsigned ch_ = tid + i_ * NTHREADS, r_ = ch_ >> 4, cc_ = (ch_ & 15) * 8; \
            qr[i_] = *(const u32x4*)(ub_ + (r_ * (unsigned)UWP + UC_MLQ + hh * 128u + cc_)); kr[i_] = *(const u32x4*)(ub_ + (r_ * (unsigned)UWP + UC_MLK + hh * 128u + cc_)); } \
        if (tid < 256) { const unsigned r_ = tid >> 2, cc_ = (tid & 3) * 8; vr = *(const u32x4*)(ub_ + (r_ * (unsigned)UWP + UC_MLV + hh * 256u + vs * 32u + cc_)); } } while (0)
    ML_FETCH(0);
    for (int c = 0; c < ML_NC; ++c) {
        const float m_prev = s_ch[c], da = s_ch[ML_NC + c], db = s_ch[2 * ML_NC + c], cmL = s_ch[3 * ML_NC + c];
        const size_t row0 = (size_t)b * SEQ + c * 64;
#pragma unroll
        for (int i = 0; i < 2; ++i) { const int ch = tid + i * NTHREADS, r = ch >> 4, cc = (ch & 15) * 8;
            *(u32x4*)(sQ + r * 136 + cc) = qr[i]; *(u32x4*)(sK + r * 136 + cc) = kr[i]; }
        if (tid < 256) { const int r = tid >> 2, cc = (tid & 3) * 8;
            const u32x4 v = vr;
            *(u32x4*)(sV + r * 56 + cc) = v;
            const float wt = db * fexp(s_dd[c * 64 + r] - cmL) * scale;
            u32x4 o; o.x = cvt_pk_bf16(bflo(v.x) * wt, bfhi(v.x) * wt); o.y = cvt_pk_bf16(bflo(v.y) * wt, bfhi(v.y) * wt); o.z = cvt_pk_bf16(bflo(v.z) * wt, bfhi(v.z) * wt); o.w = cvt_pk_bf16(bflo(v.w) * wt, bfhi(v.w) * wt);
            *(u32x4*)(sVw + r * 56 + cc) = o;
        } else if (tid < 320) { const int r = tid - 256;
            const float wt = db * fexp(s_dd[c * 64 + r] - cmL) * scale;
            *(u32x4*)(sV + r * 56 + 32) = (u32x4){0x3F80u | z0, z0, z0, z0}; *(u32x4*)(sV + r * 56 + 40) = (u32x4){z0, z0, z0, z0};
            *(u32x4*)(sVw + r * 56 + 32) = (u32x4){(unsigned)f2bf(wt), z0, z0, z0}; *(u32x4*)(sVw + r * 56 + 40) = (u32x4){z0, z0, z0, z0};
        }
        __syncthreads();
        if (c + 1 < ML_NC) ML_FETCH(c + 1);
        if (w < 4) {
            const int sl = 16 * w + lc; const float mx = fmaxf(m_prev, s_cm[c * 64 + sl]), inter = fexp(m_prev - mx);
            bf16x8 bq[4];
#pragma unroll
            for (int kt = 0; kt < 4; ++kt) bq[kt] = frag_r(sQ, 136, 16 * w, 32 * kt, lane);
            f32x4 st[4];
#pragma unroll
            for (int j = 0; j < 4; ++j) st[j] = (f32x4){0.f, 0.f, 0.f, 0.f};
#pragma unroll
            for (int j = 0; j < 4; ++j) if (j <= w) {
#pragma unroll
                for (int kt = 0; kt < 4; ++kt) st[j] = mfma16(frag_r(sK, 136, 16 * j, 32 * kt, lane), bq[kt], st[j]);
                const f32x4 d4 = *(const f32x4*)(s_dd + c * 64 + 16 * j + 4 * g);
#pragma unroll
                for (int i = 0; i < 4; ++i) { const int t = 16 * j + 4 * g + i; st[j][i] = (t <= sl) ? fexp(d4[i] - mx) * st[j][i] * scale : 0.f; } }
            f32x4 n1[3], n2[3];
#pragma unroll
            for (int vt = 0; vt < 3; ++vt) { n1[vt] = (f32x4){0.f, 0.f, 0.f, 0.f}; n2[vt] = (f32x4){0.f, 0.f, 0.f, 0.f}; }
            const bf16_t* vb = sV + (4 * g + ((lane & 15) >> 2)) * 56 + 4 * (lane & 3);
#pragma unroll
            for (int ks = 0; ks < 2; ++ks) if (2 * ks <= w) {
                u32x4 pw; pw.x = cvt_pk_bf16(st[2 * ks][0], st[2 * ks][1]); pw.y = cvt_pk_bf16(st[2 * ks][2], st[2 * ks][3]); pw.z = cvt_pk_bf16(st[2 * ks + 1][0], st[2 * ks + 1][1]); pw.w = cvt_pk_bf16(st[2 * ks + 1][2], st[2 * ks + 1][3]);
                const bf16x8 pb = __builtin_bit_cast(bf16x8, pw);
#pragma unroll
                for (int vt = 0; vt < 3; ++vt) { const s16x4 lo = lds_tr4(vb + (32 * ks) * 56 + 16 * vt), hi = lds_tr4(vb + (32 * ks + 16) * 56 + 16 * vt);
                    n1[vt] = mfma16(__builtin_shufflevector(lo, hi, 0, 1, 2, 3, 4, 5, 6, 7), pb, n1[vt]); } }
#pragma unroll
            for (int kt = 0; kt < 4; ++kt)
#pragma unroll
                for (int vt = 0; vt < 3; ++vt) n2[vt] = mfma16(frag_r(sCb, 136, 16 * vt, 32 * kt, lane), bq[kt], n2[vt]);
            const float den = shfl_f(n1[2][0] + inter * n2[2][0], lc);
            const float inv = frcp(fmaxf(fabsf(den), fexp(-(s_bb[c * 64 + sl] + mx))));
#pragma unroll
            for (int vt = 0; vt < 2; ++vt) { u32x2 ov; ov.x = cvt_pk_bf16((n1[vt][0] + inter * n2[vt][0]) * inv, (n1[vt][1] + inter * n2[vt][1]) * inv);
                ov.y = cvt_pk_bf16((n1[vt][2] + inter * n2[vt][2]) * inv, (n1[vt][3] + inter * n2[vt][3]) * inv);
                *(u32x2*)(Ya + ((row0 + sl) * 1024 + hh * 256 + vs * 32 + 16 * vt + 4 * g)) = ov; }
        } else {
            const int j = w - 4;
#pragma unroll
            for (int mt = 0; mt < 3; ++mt)
#pragma unroll
                for (int nl = 0; nl < 2; ++nl) Cst[mt][nl] *= da;
#pragma unroll
            for (int kt = 0; kt < 2; ++kt) {
                bf16x8 bk[2];
#pragma unroll
                for (int nl = 0; nl < 2; ++nl) bk[nl] = frag_k(sK, 136, 32 * kt, 16 * (2 * j + nl), lane);
#pragma unroll
                for (int mt = 0; mt < 3; ++mt) { const bf16x8 a = frag_k(sVw, 56, 32 * kt, 16 * mt, lane);
#pragma unroll
                    for (int nl = 0; nl < 2; ++nl) Cst[mt][nl] = mfma16(a, bk[nl], Cst[mt][nl]); } }
        }
        __syncthreads();
        if (w >= 4) { const int j = w - 4;
#pragma unroll
            for (int mt = 0; mt < 3; ++mt)
#pragma unroll
                for (int nl = 0; nl < 2; ++nl)
#pragma unroll
                    for (int i = 0; i < 4; ++i) sCb[(16 * mt + 4 * g + i) * 136 + 16 * (2 * j + nl) + lc] = f2bf(Cst[mt][nl][i]); }
    }
#undef ML_FETCH
    __syncthreads();
}

constexpr int SS_NC = SEQ / 128;
DI void ssd_item(const Frame& F, int item, int l) {
    const int ps = item & 1, hd = (item >> 1) & 15, b = item >> 5, grp = hd >> 3;
    int tid_ = F.tid; LAUNDER_V(tid_);
    const int tid = tid_, lane = tid & 63, w = F.wave, g = lane >> 4, lc = lane & 15;
    float* s_acs = (float*)F.lds; float* s_dt = s_acs + 256;
    bf16_t* sC = (bf16_t*)(s_dt + 256);
    bf16_t* sB = sC + 128 * 136;
    bf16_t* sX = sB + 128 * 136;
    bf16_t* sXw = sX + 128 * 40;
    bf16_t* sHb = sXw + 128 * 40;
    const bf16_t* XBC = F.wp<bf16_t>(O_XBC) + (size_t)b * SEQ * 1536; const bf16_t* Uz = F.wp<bf16_t>(O_U) + (size_t)b * SEQ * UWP + UC_SSZ + hd * 64 + ps * 32;
    const float* DT = F.wp<float>(O_DT) + (size_t)b * SEQ * 16 + hd; const float* DA = F.wp<float>(O_DA) + (size_t)b * SEQ * 16 + hd;
    bf16_t* Yb = F.wp<bf16_t>(O_Y) + (size_t)NTOK * 1024 + (size_t)b * SEQ * 1024 + hd * 64 + ps * 32;
    const float Dh = F.inp(11)[l * 16 + hd];
    const unsigned z0 = vzero();
    for (int i = tid; i < 32 * 136 / 2; i += NTHREADS) ((unsigned*)sHb)[i] = z0;
    f32x4 Hst[2];
    Hst[0] = (f32x4){0.f, 0.f, 0.f, 0.f}; Hst[1] = (f32x4){0.f, 0.f, 0.f, 0.f};
    u32x4 cr[4], br[4], xr; float da0 = 0.f, da1 = 0.f, dtv = 0.f;
#define SSD_FETCH(c_) do { const bf16_t* xb_ = XBC + (size_t)(c_) * 128 * 1536; \
        _Pragma("unroll") for (int i_ = 0; i_ < 4; ++i_) { const unsigned ch_ = tid + i_ * NTHREADS, r_ = ch_ >> 4, cc_ = (ch_ & 15) * 8; \
            cr[i_] = *(const u32x4*)(xb_ + (r_ * 1536u + 1280u + grp * 128u + cc_)); br[i_] = *(const u32x4*)(xb_ + (r_ * 1536u + 1024u + grp * 128u + cc_)); } \
        { const unsigned r_ = tid >> 2, cc_ = (tid & 3) * 8; xr = *(const u32x4*)(xb_ + (r_ * 1536u + hd * 64u + ps * 32u + cc_)); } \
        if (w == 0) { da0 = DA[((c_) * 128 + 2 * lane) * 16]; da1 = DA[((c_) * 128 + 2 * lane + 1) * 16]; } else if (w < 3) dtv = DT[((c_) * 128 + tid - 64) * 16]; } while (0)
#define SSD_SCAN(nb_) do { if (w == 0) { float p_ = da0 + da1; \
            _Pragma("unroll") for (int off_ = 1; off_ < 64; off_ <<= 1) { const float t_ = shfl_f(p_, (lane - off_) & 63); if (lane >= off_) p_ += t_; } \
            s_acs[(nb_) * 128 + 2 * lane + 1] = p_; s_acs[(nb_) * 128 + 2 * lane] = p_ - da1; } \
        else if (w < 3) s_dt[(nb_) * 128 + tid - 64] = dtv; } while (0)
    SSD_FETCH(0);
    SSD_SCAN(0);
    __syncthreads();
    for (int c = 0; c < SS_NC; ++c) {
        const int row0 = c * 128; const float* acs = s_acs + (c & 1) * 128; const float* dtc = s_dt + (c & 1) * 128;
        const float acsL = acs[127];
#pragma unroll
        for (int i = 0; i < 4; ++i) { const int ch = tid + i * NTHREADS, r = ch >> 4, cc = (ch & 15) * 8; *(u32x4*)(sC + r * 136 + cc) = cr[i]; *(u32x4*)(sB + r * 136 + cc) = br[i]; }
        { const int r = tid >> 2, cc = (tid & 3) * 8; const u32x4 v = xr;
            *(u32x4*)(sX + r * 40 + cc) = v;
            const float wt = dtc[r] * fexp(acsL - acs[r]);
            u32x4 o; o.x = cvt_pk_bf16(bflo(v.x) * wt, bfhi(v.x) * wt); o.y = cvt_pk_bf16(bflo(v.y) * wt, bfhi(v.y) * wt); o.z = cvt_pk_bf16(bflo(v.z) * wt, bfhi(v.z) * wt); o.w = cvt_pk_bf16(bflo(v.w) * wt, bfhi(v.w) * wt);
            *(u32x4*)(sXw + r * 40 + cc) = o; }
        __syncthreads();
        u32x2 zr[2];
#pragma unroll
        for (int pt = 0; pt < 2; ++pt) zr[pt] = *(const u32x2*)(Uz + ((unsigned)(row0 + 16 * w + lc) * (unsigned)UWP + 16u * pt + 4u * g));
        if (c + 1 < SS_NC) SSD_FETCH(c + 1);
        {
            const int sl = 16 * w + lc; const float as = acs[sl];
            bf16x8 bq[4];
#pragma unroll
            for (int kt = 0; kt < 4; ++kt) bq[kt] = frag_r(sC, 136, 16 * w, 32 * kt, lane);
            f32x4 ct[8];
#pragma unroll
            for (int j = 0; j < 8; ++j) ct[j] = (f32x4){0.f, 0.f, 0.f, 0.f};
#pragma unroll
            for (int j = 0; j < 8; ++j) if (j <= w) {
#pragma unroll
                for (int kt = 0; kt < 4; ++kt) ct[j] = mfma16(frag_r(sB, 136, 16 * j, 32 * kt, lane), bq[kt], ct[j]);
                const f32x4 a4 = *(const f32x4*)(acs + 16 * j + 4 * g), d4 = *(const f32x4*)(dtc + 16 * j + 4 * g);
#pragma unroll
                for (int i = 0; i < 4; ++i) { const int t = 16 * j + 4 * g + i; ct[j][i] = (t <= sl) ? ct[j][i] * fexp(as - a4[i]) * d4[i] : 0.f; } }
            f32x4 y1[2], y2[2];
#pragma unroll
            for (int pt = 0; pt < 2; ++pt) { y1[pt] = (f32x4){0.f, 0.f, 0.f, 0.f}; y2[pt] = (f32x4){0.f, 0.f, 0.f, 0.f}; }
            const bf16_t* xb = sX + (4 * g + ((lane & 15) >> 2)) * 40 + 4 * (lane & 3);
#pragma unroll
            for (int ks = 0; ks < 4; ++ks) if (2 * ks <= w) {
                u32x4 pw; pw.x = cvt_pk_bf16(ct[2 * ks][0], ct[2 * ks][1]); pw.y = cvt_pk_bf16(ct[2 * ks][2], ct[2 * ks][3]); pw.z = cvt_pk_bf16(ct[2 * ks + 1][0], ct[2 * ks + 1][1]); pw.w = cvt_pk_bf16(ct[2 * ks + 1][2], ct[2 * ks + 1][3]);
                const bf16x8 pb = __builtin_bit_cast(bf16x8, pw);
#pragma unroll
                for (int pt = 0; pt < 2; ++pt) { const s16x4 lo = lds_tr4(xb + (32 * ks) * 40 + 16 * pt), hi = lds_tr4(xb + (32 * ks + 16) * 40 + 16 * pt);
                    y1[pt] = mfma16(__builtin_shufflevector(lo, hi, 0, 1, 2, 3, 4, 5, 6, 7), pb, y1[pt]); } }
#pragma unroll
            for (int kt = 0; kt < 4; ++kt)
#pragma unroll
                for (int pt = 0; pt < 2; ++pt) y2[pt] = mfma16(frag_r(sHb, 136, 16 * pt, 32 * kt, lane), bq[kt], y2[pt]);
            const float ea = fexp(as);
#pragma unroll
            for (int pt = 0; pt < 2; ++pt) { const u32x2 xw = *(const u32x2*)(sX + sl * 40 + 16 * pt + 4 * g);
                const float x0 = bflo(xw.x), x1 = bfhi(xw.x), x2 = bflo(xw.y), x3 = bfhi(xw.y), z0f = bflo(zr[pt].x), z1f = bfhi(zr[pt].x), z2f = bflo(zr[pt].y), z3f = bfhi(zr[pt].y);
                u32x2 ov; ov.x = cvt_pk_bf16((y1[pt][0] + ea * y2[pt][0] + x0 * Dh) * siluf_(z0f), (y1[pt][1] + ea * y2[pt][1] + x1 * Dh) * siluf_(z1f));
                ov.y = cvt_pk_bf16((y1[pt][2] + ea * y2[pt][2] + x2 * Dh) * siluf_(z2f), (y1[pt][3] + ea * y2[pt][3] + x3 * Dh) * siluf_(z3f));
                *(u32x2*)(Yb + ((unsigned)(row0 + sl) * 1024u + 16u * pt + 4u * g)) = ov; }
            const float cd = fexp(acsL);
            Hst[0] *= cd; Hst[1] *= cd;
#pragma unroll
            for (int kt = 0; kt < 4; ++kt) { const bf16x8 bb = frag_k(sB, 136, 32 * kt, 16 * w, lane);
#pragma unroll
                for (int mt2 = 0; mt2 < 2; ++mt2) Hst[mt2] = mfma16(frag_k(sXw, 40, 32 * kt, 16 * mt2, lane), bb, Hst[mt2]); }
        }
        if (c + 1 < SS_NC) SSD_SCAN((c + 1) & 1);
        __syncthreads();
#pragma unroll
        for (int mt2 = 0; mt2 < 2; ++mt2)
#pragma unroll
            for (int i = 0; i < 4; ++i) sHb[(16 * mt2 + 4 * g + i) * 136 + 16 * w + lc] = f2bf(Hst[mt2][i]);
    }
#undef SSD_FETCH
#undef SSD_SCAN
    __syncthreads();
}

constexpr int SW_NB = SEQ / 128;
DI void swa_item(const Frame& F, int item, int l) {
    const int nb = item % SW_NB, kvh = (item / SW_NB) & 3, b = item / (SW_NB * 4);
    int tid_ = F.tid; LAUNDER_V(tid_);
    const int tid = tid_, lane = tid & 63, w = F.wave, g = lane >> 4, lc = lane & 15;
    bf16_t* sK = (bf16_t*)F.lds;
    bf16_t* sV = sK + 256 * 72;
    const long rowb = (long)b * SEQ + (long)nb * 128 - 128;
    const bf16_t* Ub = F.wp<bf16_t>(O_U) + rowb * UWP; bf16_t* Yd = F.wp<bf16_t>(O_Y) + (size_t)3 * NTOK * 1024 + (rowb + 128) * 1024;
    const unsigned z0 = vzero();
#pragma unroll
    for (int i = 0; i < 4; ++i) { const unsigned ch = tid + i * NTHREADS, r = ch >> 3, cc = (ch & 7) * 8;
        u32x4 kv = {z0, z0, z0, z0}, vv = {z0, z0, z0, z0};
        if (nb > 0 || r >= 128) { kv = *(const u32x4*)(Ub + (r * (unsigned)UWP + UC_SWK + kvh * 64u + cc)); vv = *(const u32x4*)(Ub + (r * (unsigned)UWP + UC_SWV + kvh * 64u + cc)); }
        *(u32x4*)(sK + r * 72 + cc) = kv; *(u32x4*)(sV + r * 72 + cc) = vv; }
    if (tid < 128) { const int r = 256 + (tid >> 3), cc = (tid & 7) * 8; *(u32x4*)(sV + r * 72 + cc) = (u32x4){z0, z0, z0, z0}; }
    __syncthreads();
    const int hq = kvh * 4 + (w >> 1);
    const float sink2 = F.inp(17)[l * 16 + hq] * 1.4426950408889634f;
    for (int gi = 0; gi < 4; ++gi) {
        const int r0 = 64 * (w & 1) + 16 * gi;
        const unsigned qoff = (unsigned)(128 + r0 + lc) * (unsigned)UWP + UC_SWQ + hq * 64u + 8u * g;
        const bf16x8 bq0 = *(const bf16x8*)(Ub + qoff), bq1 = *(const bf16x8*)(Ub + (qoff + 32u));
        f32x4 st[10];
#pragma unroll
        for (int j = 0; j < 10; ++j) st[j] = (f32x4){0.f, 0.f, 0.f, 0.f};
#pragma unroll
        for (int j = 0; j < 9; ++j) { st[j] = mfma16(frag_r(sK, 72, r0 + 16 * j, 0, lane), bq0, st[j]); st[j] = mfma16(frag_r(sK, 72, r0 + 16 * j, 32, lane), bq1, st[j]); }
        const int qpos = 128 + r0 + lc;
        float mx = -3.0e38f;
#pragma unroll
        for (int j = 0; j < 9; ++j)
#pragma unroll
            for (int i = 0; i < 4; ++i) { const int tp = r0 + 16 * j + 4 * g + i; const bool ok = (tp <= qpos) && (qpos - tp < 128) && (nb > 0 || tp >= 128);
                const float v = ok ? st[j][i] * (0.125f * 1.4426950408889634f) : -3.0e38f; st[j][i] = v; mx = fmaxf(mx, v); }
        mx = fmaxf(mx, shfl_xor_f(mx, 16)); mx = fmaxf(mx, shfl_xor_f(mx, 32));
        mx = fmaxf(mx, sink2);
        float sum = 0.f;
#pragma unroll
        for (int j = 0; j < 9; ++j)
#pragma unroll
            for (int i = 0; i < 4; ++i) { const float e = fexp2(st[j][i] - mx); st[j][i] = e; sum += e; }
        sum += shfl_xor_f(sum, 16); sum += shfl_xor_f(sum, 32);
        sum += fexp2(sink2 - mx);
        const float inv = frcp(sum);
        f32x4 o[4];
#pragma unroll
        for (int nt = 0; nt < 4; ++nt) o[nt] = (f32x4){0.f, 0.f, 0.f, 0.f};
        const bf16_t* vb = sV + (r0 + 4 * g + ((lane & 15) >> 2)) * 72 + 4 * (lane & 3);
#pragma unroll
        for (int ks = 0; ks < 5; ++ks) {
            u32x4 pw; pw.x = cvt_pk_bf16(st[2 * ks][0], st[2 * ks][1]); pw.y = cvt_pk_bf16(st[2 * ks][2], st[2 * ks][3]); pw.z = cvt_pk_bf16(st[2 * ks + 1][0], st[2 * ks + 1][1]); pw.w = cvt_pk_bf16(st[2 * ks + 1][2], st[2 * ks + 1][3]);
            const bf16x8 pb = __builtin_bit_cast(bf16x8, pw);
#pragma unroll
            for (int nt = 0; nt < 4; ++nt) { const s16x4 lo = lds_tr4(vb + (32 * ks) * 72 + 16 * nt), hi = lds_tr4(vb + (32 * ks + 16) * 72 + 16 * nt);
                o[nt] = mfma16(__builtin_shufflevector(lo, hi, 0, 1, 2, 3, 4, 5, 6, 7), pb, o[nt]); } }
        const unsigned ooff = (unsigned)(r0 + lc) * 1024u + hq * 64u + 4u * g;
#pragma unroll
        for (int nt = 0; nt < 4; ++nt) { u32x2 ov; ov.x = cvt_pk_bf16(o[nt][0] * inv, o[nt][1] * inv); ov.y = cvt_pk_bf16(o[nt][2] * inv, o[nt][3] * inv); *(u32x2*)(Yd + (ooff + 16u * nt)) = ov; }
    }
    __syncthreads();
}

template <int DQK, bool MLA>
DI void attn_block(const Frame& F, const bf16_t* Qp, int ldq, const bf16_t* Kp, int ldk, const bf16_t* K2p  , const bf16_t* Vp, int ldv, bf16_t* Op, int ldo,
                   int nkt  , int qpos0  , float scale_log2e) {
    constexpr int PQ = DQK + 8, NKR = MLA ? 1 : 0, NKT = DQK / 32;
    int tid_ = F.tid; LAUNDER_V(tid_);
    const int tid = tid_, lane = tid & 63, w = F.wave, g = lane >> 4, lc = lane & 15;
    bf16_t* sK = (bf16_t*)F.lds;
    bf16_t* sV = sK + 2 * 64 * PQ;
    u32x4 kreg[2], rreg[1], vreg[2];
    unsigned koffb[2], voffb[2];
#pragma unroll
    for (int i_ = 0; i_ < 2; ++i_) { const unsigned c_ = tid + i_ * NTHREADS, r_ = c_ >> 4, ch_ = c_ & 15; koffb[i_] = (r_ * (unsigned)ldk + ch_ * 8u) * 2u; voffb[i_] = (r_ * (unsigned)ldv + ch_ * 8u) * 2u; }
    const unsigned roffb = ((tid >> 3) * 64u + (tid & 7) * 8u) * 2u;
#define ATTN_FETCH(t) do { int t_ = (t); LAUNDER_S(t_);     \
        const char* kb_ = (const char*)(Kp + (size_t)t_ * 64 * ldk); const char* vb_ = (const char*)(Vp + (size_t)t_ * 64 * ldv); const char* rb_ = (const char*)(K2p + (size_t)t_ * 64 * 64); \
        _Pragma("unroll") for (int i_ = 0; i_ < 2; ++i_) { kreg[i_] = *(const u32x4*)(kb_ + koffb[i_]); vreg[i_] = *(const u32x4*)(vb_ + voffb[i_]); } \
        _Pragma("unroll") for (int i_ = 0; i_ < NKR; ++i_) { rreg[i_] = *(const u32x4*)(rb_ + roffb); } } while (0)
#define ATTN_STORE(bf) do { bf16_t* k_ = sK + (bf) * 64 * PQ; bf16_t* v_ = sV + (bf) * 64 * 136; \
        _Pragma("unroll") for (int i_ = 0; i_ < 2; ++i_) { const int c_ = tid + i_ * NTHREADS, r_ = c_ >> 4, ch_ = c_ & 15; *(u32x4*)(k_ + r_ * PQ + ch_ * 8) = kreg[i_]; *(u32x4*)(v_ + r_ * 136 + ch_ * 8) = vreg[i_]; } \
        _Pragma("unroll") for (int i_ = 0; i_ < NKR; ++i_) { const int r_ = tid >> 3, ch_ = tid & 7; *(u32x4*)(k_ + r_ * PQ + 128 + ch_ * 8) = rreg[i_]; } } while (0)
    ATTN_FETCH(0);
    bf16x8 bq[2][NKT];
#pragma unroll
    for (int qg = 0; qg < 2; ++qg) { const unsigned qoff = (unsigned)(32 * w + 16 * qg + lc) * (unsigned)ldq + 8u * g;
#pragma unroll
        for (int kt = 0; kt < NKT; ++kt) bq[qg][kt] = *(const bf16x8*)(Qp + (qoff + 32u * kt));
        if constexpr (MLA) {
            const char* rpb = (const char*)F.wp<float>(O_ROPE); const unsigned rpo = 8u * ((unsigned)(qpos0 + 32 * w + 16 * qg + lc) * 32u + 8u * g);
            bf16x8 x1 = bq[qg][4], x2 = bq[qg][5];
#pragma unroll
            for (int j = 0; j < 4; ++j) { const f32x4 cs4 = *(const f32x4*)(rpb + (rpo + 16u * j));
#pragma unroll
              for (int h = 0; h < 2; ++h) { const int jj = 2 * j + h; const float a = bf2f((bf16_t)x1[jj]), c2 = bf2f((bf16_t)x2[jj]), cs = cs4[2 * h], sn = cs4[2 * h + 1];
                x1[jj] = (short)f2bf(a * cs - c2 * sn); x2[jj] = (short)f2bf(c2 * cs + a * sn); } }
#if 0
            for (int j = 0; j < 8; ++j) { const float a = 0, c2 = 0, cs = 0, sn = 0;
                x1[j] = (short)f2bf(a * cs - c2 * sn); x2[j] = (short)f2bf(c2 * cs + a * sn); }
#endif
            bq[qg][4] = x1; bq[qg][5] = x2; } }
    __syncthreads();
    ATTN_STORE(0);
    __syncthreads();
    f32x4 o[2][8]; float mrow[2] = {-3.0e38f, -3.0e38f}, lrow[2] = {0.f, 0.f};
#pragma unroll
    for (int qg = 0; qg < 2; ++qg)
#pragma unroll
        for (int nt = 0; nt < 8; ++nt) o[qg][nt] = (f32x4){0.f, 0.f, 0.f, 0.f};
    if (nkt > 1) ATTN_FETCH(1);
    for (int kt0 = 0; kt0 < nkt; ++kt0) {
        const bf16_t* cK = sK + (kt0 & 1) * 64 * PQ; const bf16_t* cV = sV + (kt0 & 1) * 64 * 136;
        if (kt0 + 1 < nkt) ATTN_STORE((kt0 + 1) & 1);
        if (kt0 + 2 < nkt) ATTN_FETCH(kt0 + 2);
        f32x4 st[2][4];
#pragma unroll
        for (int qg = 0; qg < 2; ++qg)
#pragma unroll
            for (int j = 0; j < 4; ++j) st[qg][j] = (f32x4){0.f, 0.f, 0.f, 0.f};
        {
            bf16x8 ak[2][4];
#pragma unroll
            for (int j = 0; j < 4; ++j) ak[0][j] = frag_r(cK, PQ, 16 * j, 0, lane);
#pragma unroll
            for (int kt = 0; kt < NKT; ++kt) {
                if (kt + 1 < NKT) {
#pragma unroll
                    for (int j = 0; j < 4; ++j) ak[(kt + 1) & 1][j] = frag_r(cK, PQ, 16 * j, 32 * (kt + 1), lane); }
#pragma unroll
                for (int j = 0; j < 4; ++j) { st[0][j] = mfma16(ak[kt & 1][j], bq[0][kt], st[0][j]); st[1][j] = mfma16(ak[kt & 1][j], bq[1][kt], st[1][j]); }
                SCHED_BAR(); } }
        const bool need_mask = MLA && (kt0 * 64 + 63 > qpos0 + 32 * w);
        bf16x8 pb[2][2];
        float mxq[2];
#pragma unroll
        for (int qg = 0; qg < 2; ++qg) {
            const int qp = qpos0 + 32 * w + 16 * qg + lc;
            float mx = -3.0e38f;
#pragma unroll
            for (int j = 0; j < 4; ++j)
#pragma unroll
                for (int i = 0; i < 4; ++i) { float v = st[qg][j][i] * scale_log2e;
                    if (need_mask) { const int kp = kt0 * 64 + 16 * j + 4 * g + i; v = (kp <= qp) ? v : -3.0e38f; }
                    st[qg][j][i] = v; mx = fmaxf(mx, v); }
            mx = xmax16(mx); mx = xmax32(mx);
            mxq[qg] = mx; }
        if (wave_any((mxq[0] - mrow[0] > 8.0f) || (mxq[1] - mrow[1] > 8.0f))) {
#pragma unroll
            for (int qg = 0; qg < 2; ++qg) { const float mnew = fmaxf(mrow[qg], mxq[qg]), alpha = fexp2(mrow[qg] - mnew);
                lrow[qg] *= alpha; mrow[qg] = mnew;
#pragma unroll
                for (int nt = 0; nt < 8; ++nt) o[qg][nt] *= alpha; } }
#pragma unroll
        for (int qg = 0; qg < 2; ++qg) {
            const float mcur = mrow[qg];
            float sum = 0.f;
#pragma unroll
            for (int j = 0; j < 4; ++j)
#pragma unroll
                for (int i = 0; i < 4; ++i) { const float e = fexp2(st[qg][j][i] - mcur); st[qg][j][i] = e; sum += e; }
            lrow[qg] += sum;
#pragma unroll
            for (int ks = 0; ks < 2; ++ks) { u32x4 pw; pw.x = cvt_pk_bf16(st[qg][2 * ks][0], st[qg][2 * ks][1]); pw.y = cvt_pk_bf16(st[qg][2 * ks][2], st[qg][2 * ks][3]);
                pw.z = cvt_pk_bf16(st[qg][2 * ks + 1][0], st[qg][2 * ks + 1][1]); pw.w = cvt_pk_bf16(st[qg][2 * ks + 1][2], st[qg][2 * ks + 1][3]); pb[qg][ks] = __builtin_bit_cast(bf16x8, pw); }
        }
        {
            const bf16_t* vb = cV + (4 * g + ((lane & 15) >> 2)) * 136 + 4 * (lane & 3);
            bf16x8 av[2][4];
#define ATTN_LDV(dst, ks_, h_) do { _Pragma("unroll") for (int n_ = 0; n_ < 4; ++n_) { const s16x4 lo_ = lds_tr4(vb + (32 * (ks_)) * 136 + 16 * (4 * (h_) + n_)), hi_ = lds_tr4(vb + (32 * (ks_) + 16) * 136 + 16 * (4 * (h_) + n_)); \
                dst[n_] = __builtin_shufflevector(lo_, hi_, 0, 1, 2, 3, 4, 5, 6, 7); } } while (0)
            ATTN_LDV(av[0], 0, 0);
#pragma unroll
            for (int hs = 0; hs < 4; ++hs) { const int ks = hs >> 1, h = hs & 1;
                if (hs + 1 < 4) ATTN_LDV(av[(hs + 1) & 1], (hs + 1) >> 1, (hs + 1) & 1);
#pragma unroll
                for (int n = 0; n < 4; ++n) { o[0][4 * h + n] = mfma16(av[hs & 1][n], pb[0][ks], o[0][4 * h + n]); o[1][4 * h + n] = mfma16(av[hs & 1][n], pb[1][ks], o[1][4 * h + n]); }
                SCHED_BAR(); }
#undef ATTN_LDV
            PIN_ACC8(o[0]); PIN_ACC8(o[1]);
        }
        __syncthreads();
    }
#undef ATTN_FETCH
#undef ATTN_STORE
#pragma unroll
    for (int qg = 0; qg < 2; ++qg) { float lt = lrow[qg]; lt += shfl_xor_f(lt, 16); lt += shfl_xor_f(lt, 32); const float inv = frcp(lt); int lid = lane; LAUNDER_V(lid);
        const unsigned ooff = (unsigned)(32 * w + 16 * qg + (lid & 15)) * (unsigned)ldo + 4u * (lid >> 4);
#pragma unroll
        for (int nt = 0; nt < 8; ++nt) { u32x2 ov; ov.x = cvt_pk_bf16(o[qg][nt][0] * inv, o[qg][nt][1] * inv); ov.y = cvt_pk_bf16(o[qg][nt][2] * inv, o[qg][nt][3] * inv); *(u32x2*)(Op + (ooff + 16u * nt)) = ov; } }
}
constexpr int NQB = SEQ / 256, NQP = (NQB + 1) / 2;
DI void mla_attn_item(const Frame& F, int item) {
    const int pj = item % NQP, hh = (item / NQP) & 7, b = item / (NQP * 8);
    const bf16_t* QF = F.wp<bf16_t>(O_QF); const bf16_t* KVF = F.wp<bf16_t>(O_KVF); const bf16_t* KR = F.wp<bf16_t>(O_KR); bf16_t* Yc = F.wp<bf16_t>(O_Y) + (size_t)2 * NTOK * 1024;
    const size_t rb = (size_t)b * SEQ;
    for (int k = 0; k < 2; ++k) { const int qb = k ? (NQB - 1 - pj) : pj;
        if (k == 1 && qb == pj) break;
        attn_block<192, true>(F, QF + (rb + qb * 256) * 1536 + hh * 192, 1536, KVF + rb * 2048 + hh * 256, 2048, KR + rb * 64, KVF + rb * 2048 + hh * 256 + 128, 2048,
                              Yc + (rb + qb * 256) * 1024 + hh * 128, 1024, (qb + 1) * 4, qb * 256, 0.07216878364870322f * 1.4426950408889634f); }
}
DI void xattn_item(const Frame& F, int item) {
    const int qb = item % NQB, hh = (item / NQB) & 3, b = item / (NQB * 4);
    const bf16_t* XQ = F.wp<bf16_t>(O_XQ); const bf16_t* XKV = F.wp<bf16_t>(O_XKV); bf16_t* XO = F.wp<bf16_t>(O_XO);
    attn_block<128, false>(F, XQ + ((size_t)b * SEQ + qb * 256) * 512 + hh * 128, 512, XKV + (size_t)b * MEMLEN * 1024 + hh * 128, 1024, nullptr,
                           XKV + (size_t)b * MEMLEN * 1024 + 512 + hh * 128, 1024, XO + ((size_t)b * SEQ + qb * 256) * 512 + hh * 128, 512, MEMLEN / 64, 0, 0.08838834764831845f * 1.4426950408889634f);
}

DI void phase_fixup(const Frame& F, int l) {
    const int gw = F.bid * 8 + F.wave, NGW = F.G * 8, lane = F.lane;
    bf16_t* Ya = F.wp<bf16_t>(O_Y); bf16_t* Yb = Ya + (size_t)NTOK * 1024; const bf16_t* U = F.wp<bf16_t>(O_U);
    const float* mlnorm = F.inp(6) + l * 1024; const float* ssnorm = F.inp(12) + l * 1024;
    for (int r = gw; r < NTOK; r += NGW) {
        u32x4 hva[2], hvb[2], ovp[2];
        hva[0] = *(const u32x4*)(Ya + (size_t)r * 1024 + 16 * lane); hva[1] = *(const u32x4*)(Ya + (size_t)r * 1024 + 16 * lane + 8);
        hvb[0] = *(const u32x4*)(Yb + (size_t)r * 1024 + 16 * lane); hvb[1] = *(const u32x4*)(Yb + (size_t)r * 1024 + 16 * lane + 8);
        ovp[0] = *(const u32x4*)(U + (size_t)r * UWP + UC_MLO + 16 * lane); ovp[1] = *(const u32x4*)(U + (size_t)r * UWP + UC_MLO + 16 * lane + 8);
        {   u32x4 hv[2]; float x[16]; float s = 0.f;
            hv[0] = hva[0]; hv[1] = hva[1];
#pragma unroll
            for (int k = 0; k < 2; ++k) { x[8 * k + 0] = bflo(hv[k].x); x[8 * k + 1] = bfhi(hv[k].x); x[8 * k + 2] = bflo(hv[k].y); x[8 * k + 3] = bfhi(hv[k].y); x[8 * k + 4] = bflo(hv[k].z); x[8 * k + 5] = bfhi(hv[k].z); x[8 * k + 6] = bflo(hv[k].w); x[8 * k + 7] = bfhi(hv[k].w); }
#pragma unroll
            for (int i = 0; i < 16; ++i) s += x[i] * x[i];
            s = grp16_sum(s);
            const float rstd = 1.0f / sqrtf(s * (1.0f / 256) + RMS_EPS);
            u32x4 ov[2]; ov[0] = ovp[0]; ov[1] = ovp[1];
            float og[16];
#pragma unroll
            for (int k = 0; k < 2; ++k) { og[8 * k + 0] = bflo(ov[k].x); og[8 * k + 1] = bfhi(ov[k].x); og[8 * k + 2] = bflo(ov[k].y); og[8 * k + 3] = bfhi(ov[k].y); og[8 * k + 4] = bflo(ov[k].z); og[8 * k + 5] = bfhi(ov[k].z); og[8 * k + 6] = bflo(ov[k].w); og[8 * k + 7] = bfhi(ov[k].w); }
            float y[16];
#pragma unroll
            for (int i = 0; i < 16; ++i) y[i] = sigmoidf_(og[i]) * x[i] * rstd * mlnorm[16 * lane + i];
            u32x4 o0, o1; o0.x = cvt_pk_bf16(y[0], y[1]); o0.y = cvt_pk_bf16(y[2], y[3]); o0.z = cvt_pk_bf16(y[4], y[5]); o0.w = cvt_pk_bf16(y[6], y[7]);
            o1.x = cvt_pk_bf16(y[8], y[9]); o1.y = cvt_pk_bf16(y[10], y[11]); o1.z = cvt_pk_bf16(y[12], y[13]); o1.w = cvt_pk_bf16(y[14], y[15]);
            *(u32x4*)(Ya + (size_t)r * 1024 + 16 * lane) = o0; *(u32x4*)(Ya + (size_t)r * 1024 + 16 * lane + 8) = o1; }
        {   u32x4 hv[2]; float x[16]; float s = 0.f;
            hv[0] = hvb[0]; hv[1] = hvb[1];
#pragma unroll
            for (int k = 0; k < 2; ++k) { x[8 * k + 0] = bflo(hv[k].x); x[8 * k + 1] = bfhi(hv[k].x); x[8 * k + 2] = bflo(hv[k].y); x[8 * k + 3] = bfhi(hv[k].y); x[8 * k + 4] = bflo(hv[k].z); x[8 * k + 5] = bfhi(hv[k].z); x[8 * k + 6] = bflo(hv[k].w); x[8 * k + 7] = bfhi(hv[k].w); }
#pragma unroll
            for (int i = 0; i < 16; ++i) s += x[i] * x[i];
            s = grp16_sum(s); s += shfl_xor_f(s, 16);
            const float rstd = 1.0f / sqrtf(s * (1.0f / 512) + RMS_EPS);
            float y[16];
#pragma unroll
            for (int i = 0; i < 16; ++i) y[i] = x[i] * rstd * ssnorm[16 * lane + i];
            u32x4 o0, o1; o0.x = cvt_pk_bf16(y[0], y[1]); o0.y = cvt_pk_bf16(y[2], y[3]); o0.z = cvt_pk_bf16(y[4], y[5]); o0.w = cvt_pk_bf16(y[6], y[7]);
            o1.x = cvt_pk_bf16(y[8], y[9]); o1.y = cvt_pk_bf16(y[10], y[11]); o1.z = cvt_pk_bf16(y[12], y[13]); o1.w = cvt_pk_bf16(y[14], y[15]);
            *(u32x4*)(Yb + (size_t)r * 1024 + 16 * lane) = o0; *(u32x4*)(Yb + (size_t)r * 1024 + 16 * lane + 8) = o1; }
    }
}

#ifndef PHMASK
#define PHMASK 0xFFFFFFFFu
#endif
#define EN(b) (((PHMASK) >> (b)) & 1u)
#ifndef REPMASK
#define REPMASK 0u
#endif
#define RP(b) (((REPMASK) >> (b)) & 1u)
constexpr int PH_PER_LAYER = 16, PH_FINAL = 1 + DEPTH * PH_PER_LAYER, PH_COUNT = PH_FINAL + 1;
#ifndef HOST_EMU
#define GEMM_LDS ((LAS unsigned char*)lds)
__global__ void __launch_bounds__(NTHREADS, 2) mk_fwd(Params P) {
    extern __shared__ __attribute__((aligned(16))) unsigned char lds[];
#else
#define GEMM_LDS (lds)
static void mk_fwd(Params P) {
    unsigned char* lds = emu::B->lds;
#endif
    const int wave0 = rfl((int)threadIdx.x >> 6);
    Frame F; make_frame(F, P, lds, wave0);
    int* misc = (int*)(lds + LDS_MISC);
    if (F.tid < 256) misc[F.tid] = 0;
    __syncthreads();
#ifndef HOST_EMU
    XcdBarrier bar; bar.bar = (unsigned*)(P.ws + O_CTL) + 4096; bar.x = 0; bar.st = nullptr; bar.wave = wave0;
    if (MK_N_LAUNCHES == 1) bar = xcd_barrier_post((unsigned*)(P.ws + O_CTL) + 4096, (volatile LAS unsigned*)(lds + LDS_MISC), wave0);
#define GRID_BAR() xcd_barrier(bar)
#else
#define GRID_BAR() emu::grid_sync()
#endif
    int* tile_e = misc + 16; int* pstart = misc + 16 + 160; int* ntiles = misc + 16 + 160 + 8; int* myoff = misc + 16 + 160 + 16;
    const int lo = P.ph_lo, hi = P.ph_hi;
#define IN(k) (lo <= (k) && (k) < hi)
#define SEAM(k) do { if (IN(k) && IN((k) + 1)) GRID_BAR(); } while (0)
    const int c = F.bid, cr = F.G - 1 - F.bid;

    if (EN(0) && IN(0)) for (int rep_ = 0; rep_ <= (int)RP(0); ++rep_) { REFRAME(); phase_prologue(F); REFRAME(); phase_rmsnorm_x(F, F.inp(0), F.inp(2)); }
    SEAM(0);
    for (int l = 0; l < DEPTH; ++l) {
        const int pb = 1 + l * PH_PER_LAYER;
        const bool moe = (l & 1) != 0;
#define HIN() (F.wp<bf16_t>(O_H))
#define HBUF() (F.wp<bf16_t>(O_H))
        if (l > 0) { if (EN(1) && IN(pb + 0)) for (int rep_ = 0; rep_ <= (int)RP(1); ++rep_) { REFRAME(); phase_rmsnorm(F, HBUF(), F.inp(2) + l * D); }
        SEAM(pb + 0); }
        if (EN(2) && IN(pb + 1)) for (int rep_ = 0; rep_ <= (int)RP(2); ++rep_) { REFRAME();
            pg8::Gemm g{HBUF(), D, F.wp<bf16_t>(O_WIN) + (size_t)l * UW * D, D, D}; pg8::OrdStatic S{NTOK / 256, UC_GATE / 256, F.G, c};
            pg8::EpiU E{F.wp<bf16_t>(O_U), F.wp<float>(O_SM), F.wp<float>(O_RSTD), (LAS float*)(GEMM_LDS + pg8::RS_TAB)};
            pg8::gemm_phase(GEMM_LDS, g, S, E, F.wave);
            {
                REFRAME();
                pg8::Gemm g8{(const bf16_t*)F.wp<unsigned char>(O_XN8), D / 2, (const bf16_t*)(F.wp<unsigned char>(O_WG8) + (size_t)l * 8192 * D), D / 2, D / 2};
                pg8::OrdStatic S8{NTOK / 256, 8192 / (128 * F8_NBJ), F.G, c};
                pg8::EpiGate8 E8{F.wp<unsigned char>(O_G8), 1.0f / (F8_ASCALE * F8_WSCALE)};
                pg8::gemm_phase_f8<pg8::EpiGate8, pg8::OrdStatic, true>(GEMM_LDS, g8, S8, E8, F.wave); }
#ifdef PROBE_NULL_WIN
            { pg8::EpiNull E0{F.wp<float>(O_CTL) + 1024}; pg8::gemm_phase(GEMM_LDS, g, S, E0, F.wave); }
#endif
#ifdef PROBE_L2_WIN
            { pg8::EpiUL2 E0{F.wp<bf16_t>(O_MACC) + (size_t)F.bid * 256 * 256}; pg8::gemm_phase(GEMM_LDS, g, S, E0, F.wave); }
#endif
        }
        SEAM(pb + 1);
        if (EN(3) && IN(pb + 2)) for (int rep_ = 0; rep_ <= (int)RP(3); ++rep_) { REFRAME(); phase_prep(F, l); }
        SEAM(pb + 2);
        if (IN(pb + 3)) {
            if (EN(4)) for (int rep_ = 0; rep_ <= (int)RP(4); ++rep_) { REFRAME(); pg8::Gemm g{F.wp<bf16_t>(O_CQN), 512, F.wp<bf16_t>(O_WUQ) + (size_t)l * 1536 * 512, 512, 512}; pg8::OrdStatic S{NTOK / 256, 1536 / 256, F.G, c};
              pg8::EpiBf16 E{F.wp<bf16_t>(O_QF), 1536}; pg8::gemm_phase(GEMM_LDS, g, S, E, F.wave); }
            if (EN(4)) for (int rep_ = 0; rep_ <= (int)RP(4); ++rep_) { REFRAME(); pg8::Gemm g{F.wp<bf16_t>(O_CKVN), 256, F.wp<bf16_t>(O_WUKV) + (size_t)l * 2048 * 256, 256, 256}; pg8::OrdStatic S{NTOK / 256, 2048 / 256, F.G, cr};
              pg8::EpiBf16 E{F.wp<bf16_t>(O_KVF), 2048}; pg8::gemm_phase(GEMM_LDS, g, S, E, F.wave); }
            __syncthreads();
            REFRAME(); if (EN(5)) for (int rep_ = 0; rep_ <= (int)RP(5); ++rep_) for (int it = c; it < BATCH * 4 * 8; it += F.G) mlstm_item(F, it);
            REFRAME(); if (EN(6)) for (int rep_ = 0; rep_ <= (int)RP(6); ++rep_) for (int it = cr; it < BATCH * 16 * 2; it += F.G) ssd_item(F, it, l);
            REFRAME(); if (EN(7)) for (int rep_ = 0; rep_ <= (int)RP(7); ++rep_) for (int it = c; it < BATCH * 4 * SW_NB; it += F.G) swa_item(F, it, l);
        }
        SEAM(pb + 3);
        if (IN(pb + 4)) {
            if (EN(8)) for (int rep_ = 0; rep_ <= (int)RP(8); ++rep_) for (int it = c; it < BATCH * 8 * NQP; it += F.G) mla_attn_item(F, it);
            REFRAME(); if (EN(9)) phase_fixup(F, l);
        }
        SEAM(pb + 4);
        if (EN(10) && IN(pb + 5)) for (int rep_ = 0; rep_ <= (int)RP(10); ++rep_) { REFRAME();
            pg8::Gemm g{F.wp<bf16_t>(O_Y), 1024, F.wp<bf16_t>(O_WBR) + (size_t)l * 4 * 2048 * 1024, 1024, 1024}; pg8::OrdMerge S{NTOK / 256, D / 256, F.G, c};
            pg8::EpiMerge E{F.wp<unsigned char>(O_G8), F.wp<bf16_t>(O_MERGED)};
            pg8::gemm_phase(GEMM_LDS, g, S, E, F.wave);
        }
        SEAM(pb + 5);
        if (EN(11) && IN(pb + 6)) for (int rep_ = 0; rep_ <= (int)RP(11); ++rep_) { REFRAME();
            pg8::Gemm g{F.wp<bf16_t>(O_MERGED), D, F.wp<bf16_t>(O_WOUT) + (size_t)l * D * D, D, D}; pg8::OrdStatic S{NTOK / 256, D / 256, F.G, c};
            pg8::EpiResidT<true> E{HIN(), HBUF(), F.wp<float>(O_SSQ)};
            pg8::gemm_phase(GEMM_LDS, g, S, E, F.wave);
        }
        SEAM(pb + 6);
        if (EN(12) && IN(pb + 8)) for (int rep_ = 0; rep_ <= (int)RP(12); ++rep_) { REFRAME();
            { pg8::Gemm g{HBUF(), D, F.wp<bf16_t>(O_WXQ) + (size_t)l * 512 * D, D, D}; pg8::OrdStatic S{NTOK / 256, 512 / 256, F.G, c};
              pg8::EpiBf16R E{F.wp<bf16_t>(O_XQ), 512, F.wp<float>(O_SSQ), (LAS float*)(GEMM_LDS + pg8::RS_TAB)}; pg8::gemm_phase(GEMM_LDS, g, S, E, F.wave); }
            { REFRAME(); pg8::Gemm g{F.wp<bf16_t>(O_MEMN) + (size_t)l * NMEM * D, D, F.wp<bf16_t>(O_WXKV) + (size_t)l * 1024 * D, D, D}; pg8::OrdStatic S{NMEM / 256, 1024 / 256, F.G, cr};
              pg8::EpiBf16 E{F.wp<bf16_t>(O_XKV), 1024}; pg8::gemm_phase(GEMM_LDS, g, S, E, F.wave); }
        }
        SEAM(pb + 8);
        if (EN(13) && IN(pb + 9)) for (int rep_ = 0; rep_ <= (int)RP(13); ++rep_) { REFRAME(); for (int it = c; it < BATCH * 4 * NQB; it += F.G) xattn_item(F, it); }
        SEAM(pb + 9);
        if (EN(14) && IN(pb + 10)) for (int rep_ = 0; rep_ <= (int)RP(14); ++rep_) { REFRAME();
            pg8::Gemm g{F.wp<bf16_t>(O_XO), 512, F.wp<bf16_t>(O_WXO) + (size_t)l * D * 512, 512, 512}; pg8::OrdStatic S{NTOK / 256, D / 256, F.G, c};
            if (!moe) { pg8::EpiResidT<true> E{HBUF(), HBUF(), F.wp<float>(O_SSQ)}; pg8::gemm_phase(GEMM_LDS, g, S, E, F.wave); }
            else { pg8::EpiResid E{HBUF(), HBUF(), nullptr}; pg8::gemm_phase(GEMM_LDS, g, S, E, F.wave); }
        }
        SEAM(pb + 10);
        if (!moe) {
            if (EN(15) && IN(pb + 12)) for (int rep_ = 0; rep_ <= (int)RP(15); ++rep_) { REFRAME();
                pg8::Gemm g{HBUF(), D, F.wp<bf16_t>(O_W13), D, D}; pg8::OrdStatic S{NTOK / 256, 2 * FFN / 256, F.G, c};
                pg8::EpiSwiGLUR E{F.wp<bf16_t>(O_ACT), F.wp<float>(O_SSQ), (LAS float*)(GEMM_LDS + pg8::RS_TAB)};
                pg8::gemm_phase(GEMM_LDS, g, S, E, F.wave);
            }
            SEAM(pb + 12);
            if (EN(16) && IN(pb + 13)) for (int rep_ = 0; rep_ <= (int)RP(16); ++rep_) { REFRAME();
                pg8::Gemm g{F.wp<bf16_t>(O_ACT), FFN, F.wp<bf16_t>(O_W2), FFN, FFN}; pg8::OrdStatic S{NTOK / 256, D / 256, F.G, c};
                pg8::EpiResid E{HBUF(), HBUF(), nullptr};
                pg8::gemm_phase(GEMM_LDS, g, S, E, F.wave);
            }
            if (IN(pb + 13) && IN(pb + PH_PER_LAYER)) GRID_BAR();
        } else {
            if (EN(17) && IN(pb + 11)) for (int rep_ = 0; rep_ <= (int)RP(17); ++rep_) { REFRAME(); phase_rmsnorm_route(F, HBUF(), F.inp(25) + l * D, F.inp(28)); }
            SEAM(pb + 11);
            if (EN(18) && IN(pb + 12)) for (int rep_ = 0; rep_ <= (int)RP(18); ++rep_) { REFRAME(); phase_moe_scatter(F, tile_e, pstart, ntiles, myoff); }
            SEAM(pb + 12);
            if (EN(19) && IN(pb + 13)) for (int rep_ = 0; rep_ <= (int)RP(19); ++rep_) { REFRAME();
                if (!IN(pb + 12)) moe_tables(F, tile_e, pstart, ntiles);
                pg8::Gemm g{(const bf16_t*)F.wp<unsigned char>(O_XG), D / 2, (const bf16_t*)F.wp<unsigned char>(O_MW13), D / 2, D / 2}; pg8::OrdMoe S{*ntiles, 2 * FFN / (128 * F8_NBJ), F.G, c, tile_e, 1 << 30};
                pg8::EpiSwiGLU8<F8_NBJ> E{F.wp<unsigned char>(O_ACTM), 1.0f / (F8_ASCALE * F8_WSCALE)};
                pg8::gemm_phase_f8<pg8::EpiSwiGLU8<F8_NBJ>, pg8::OrdMoe, F8_FULL != 0>(GEMM_LDS, g, S, E, F.wave);
            }
            SEAM(pb + 13);
            if (EN(20) && IN(pb + 14)) for (int rep_ = 0; rep_ <= (int)RP(20); ++rep_) { REFRAME();
                if (!IN(pb + 13)) moe_tables(F, tile_e, pstart, ntiles);
                int full, R, sp; pg8::moe_tail_split(*ntiles, F.G, full, R, sp);
                { pg8::Gemm g{(const bf16_t*)F.wp<unsigned char>(O_ACTM), FFN / 2, (const bf16_t*)F.wp<unsigned char>(O_MW2), FFN / 2, FFN / 2}; pg8::OrdMoe S{*ntiles, D / 256, F.G, c, tile_e, full};
                  pg8::EpiBf16S<2> E{F.wp<bf16_t>(O_YG), D, 1.0f / (F8_ASCALE * F8_WSCALE)};
                  pg8::gemm_phase_f8<pg8::EpiBf16S<2>, pg8::OrdMoe, true>(GEMM_LDS, g, S, E, F.wave); }
                if (R > 0) {
                    REFRAME();
                    const int uix = c / sp, kp = c - uix * sp, Kp = FFN / sp;
                    pg8::OrdOne S1; S1.valid = (uix < R); S1.u.pm = 0; S1.u.pn = 0; S1.u.pa = 0; S1.u.pb = 0; S1.u.aux = 0; S1.u.ui = 0;
                    if (S1.valid) { pg8::static_map((long)full * F.G + uix, *ntiles, D / 256, S1.u.pm, S1.u.pn); S1.u.aux = tile_e[S1.u.pm]; S1.u.pa = S1.u.pm; S1.u.pb = S1.u.aux * (D / 256) + S1.u.pn; }
                    pg8::Gemm g1{(const bf16_t*)(F.wp<unsigned char>(O_ACTM) + (size_t)kp * Kp), FFN / 2, (const bf16_t*)(F.wp<unsigned char>(O_MW2) + (size_t)kp * Kp), FFN / 2, Kp / 2};
                    pg8::EpiPart E1{F.wp<float>(O_TAILACC) + (size_t)(S1.valid ? c : 0) * 65536, 1.0f / (F8_ASCALE * F8_WSCALE)};
                    pg8::gemm_phase_f8<pg8::EpiPart, pg8::OrdOne, true>(GEMM_LDS, g1, S1, E1, F.wave);
                }
            }
            if (IN(pb + 14) && IN(pb + PH_PER_LAYER)) GRID_BAR();
        }
    }
    if (EN(21) && IN(PH_FINAL)) for (int rep_ = 0; rep_ <= (int)RP(21); ++rep_) { REFRAME(); if (!IN(PH_FINAL - 2) && (((DEPTH - 1) & 1) != 0)) moe_tables(F, tile_e, pstart, ntiles); phase_final(F, ((DEPTH - 1) & 1) != 0, ntiles, (unsigned char*)(misc + 256)); }
#undef IN
#undef SEAM
}

#ifndef HOST_EMU
extern "C" void kernel_launch(void* const* d_in, const int* in_sizes, int n_in, void* d_out, int out_size, void* d_ws, size_t ws_size, hipStream_t stream) {
    static int grid = 0;
    if (grid == 0) {
        if (n_in != 32 || in_sizes[0] != NTOK * D || out_size != NTOK * D || ws_size < WS_END) {
            fprintf(stderr, "kernel_launch: shape/workspace mismatch: n_in %d in0 %d out %d ws %zu (need %zu)\n", n_in, n_in > 0 ? in_sizes[0] : -1, out_size, ws_size, (size_t)WS_END); grid = -1; return; }
        int dev = 0, cus = 0, per_cu = 0;
        if (hipGetDevice(&dev) != hipSuccess || hipDeviceGetAttribute(&cus, hipDeviceAttributeMultiprocessorCount, dev) != hipSuccess) { grid = -1; return; }
        if (hipFuncSetAttribute((const void*)mk_fwd, hipFuncAttributeMaxDynamicSharedMemorySize, LDS_BYTES) != hipSuccess) { fprintf(stderr, "kernel_launch: hipFuncSetAttribute failed\n"); grid = -1; return; }
        if (hipOccupancyMaxActiveBlocksPerMultiprocessor(&per_cu, (const void*)mk_fwd, NTHREADS, LDS_BYTES) != hipSuccess || per_cu < 1)
            fprintf(stderr, "kernel_launch: occupancy query reports %d workgroups per CU\n", per_cu);
        (void)hipGetLastError();
        grid = cus;
    }
    if (grid < 0) return;
    if (hipMemsetAsync((char*)d_ws + O_CTL, 0, SZ_CTL, stream) != hipSuccess) { fprintf(stderr, "kernel_launch: memset failed\n"); return; }
    Params p{};
    for (int i = 0; i < 32; ++i) p.in[i] = (const float*)d_in[i];
    p.out = (float*)d_out; p.ws = (unsigned char*)d_ws;
    if (MK_N_LAUNCHES == 1) {
        p.ph_lo = 0; p.ph_hi = PH_COUNT;
        hipLaunchKernelGGL(mk_fwd, dim3(grid), dim3(NTHREADS), LDS_BYTES, stream, p);
    } else {
        for (int ph = 0; ph < PH_COUNT; ++ph) {
            const int k = (ph - 1) % PH_PER_LAYER, l = (ph - 1) / PH_PER_LAYER;
            if (ph >= 1 && ph < PH_FINAL && (k == 15 || (k == 14 && (l & 1) == 0) || (k == 0 && l == 0))) continue;
            p.ph_lo = ph; p.ph_hi = ph + 1;
            hipLaunchKernelGGL(mk_fwd, dim3(grid), dim3(NTHREADS), LDS_BYTES, stream, p);
        }
    }
    const hipError_t le = hipPeekAtLastError();
    if (le != hipSuccess) fprintf(stderr, "kernel_launch: launch failed: %s\n", hipGetErrorName(le));
}
#endif
```
